# Optimizing an MI355X kernel written in HIP

```python
import jax, jax.numpy as jnp
from jax import lax
import numpy as np

D_MODEL = 2048
BATCH = 1
SEQ = 16384
DEPTH = 1

HEAD_DIM = 128
N_MLSTM_HEADS = D_MODEL // 2 // HEAD_DIM
N_RET_HEADS = D_MODEL // 2 // HEAD_DIM
D_MLSTM = N_MLSTM_HEADS * HEAD_DIM
D_RET = N_RET_HEADS * HEAD_DIM
D_MIX = D_MLSTM + D_RET
D_PROJ = 4 * D_MLSTM + 2 * N_MLSTM_HEADS + 4 * D_RET
CHUNK = 128
CONV_WIDTH = 4
ROPE_BASE = 10000.0
D_FF = -(-(8 * D_MODEL) // (3 * 256)) * 256
NORM_EPS = 1e-6

kernel_name = "hybrid_mlstm_retention_sandwich_block"

SPLITS = list(np.cumsum([D_MLSTM, D_MLSTM, D_MLSTM, D_MLSTM, N_MLSTM_HEADS, N_MLSTM_HEADS, D_RET, D_RET, D_RET]))


def rmsnorm(x, g):
    xf = x.astype(jnp.float32)
    y = xf * lax.rsqrt(jnp.mean(xf * xf, axis=-1, keepdims=True) + NORM_EPS)
    return (y * g.astype(jnp.float32)).astype(x.dtype)


def head_rmsnorm(h, g):
    B, S, H, D = h.shape
    y = h * lax.rsqrt(jnp.mean(h * h, axis=-1, keepdims=True) + NORM_EPS)
    return y.reshape(B, S, H * D) * g.astype(jnp.float32)


def causal_dwconv(u, w, b):
    C = u.shape[-1]
    out = lax.conv_general_dilated(u, w.astype(u.dtype)[:, None, :], window_strides=(1,),
                                   padding=[(CONV_WIDTH - 1, 0)],
                                   dimension_numbers=("NWC", "WIO", "NWC"),
                                   feature_group_count=C)
    return out + b.astype(u.dtype)


def split_heads(t, H):
    B, S, _ = t.shape
    return t.reshape(B, S, H, HEAD_DIM)


def rotary(t, positions):
    D = t.shape[-1]
    inv_freq = ROPE_BASE ** (-jnp.arange(0, D, 2, dtype=jnp.float32) / D)
    ang = positions.astype(jnp.float32)[..., None] * inv_freq
    cos, sin = jnp.cos(ang)[:, :, None, :], jnp.sin(ang)[:, :, None, :]
    t1, t2 = t[..., : D // 2], t[..., D // 2:]
    return jnp.concatenate([t1 * cos - t2 * sin, t2 * cos + t1 * sin], axis=-1)


def to_chunks(t):
    B, S, H, D = t.shape
    return t.reshape(B, S // CHUNK, CHUNK, H, D).transpose(0, 3, 1, 2, 4)


def gate_chunks(t):
    B, S, H = t.shape
    return t.reshape(B, S // CHUNK, CHUNK, H).transpose(0, 3, 1, 2)


def from_chunks(t):
    B, H, NC, L, D = t.shape
    return t.transpose(0, 2, 3, 1, 4).reshape(B, NC * L, H, D)


def mlstm_chunkwise(q, k, v, i_pre, f_pre):
    B, S, H, D = q.shape
    q, k, v = to_chunks(q), to_chunks(k) * (D ** -0.5), to_chunks(v)
    ig = gate_chunks(i_pre)
    b = jnp.cumsum(gate_chunks(jax.nn.log_sigmoid(f_pre)), axis=-1)
    b_last = b[..., -1]
    w_end = b_last[..., None] - b + ig

    def step(carry, inp):
        C, n, m = carry
        kc, vc, wc, bl = inp
        m_new = jnp.maximum(bl + m, wc.max(-1))
        decay = jnp.exp(bl + m - m_new)
        a = jnp.exp(wc - m_new[..., None])[..., None] * kc
        C_new = decay[..., None, None] * C + jnp.einsum("bhld,bhle->bhde", a, vc)
        n_new = decay[..., None] * n + a.sum(axis=2)
        return (C_new, n_new, m_new), (C, n, m)

    init = (jnp.zeros((B, H, D, D), jnp.float32), jnp.zeros((B, H, D), jnp.float32),
            jnp.zeros((B, H), jnp.float32))
    xs = (jnp.moveaxis(k, 2, 0), jnp.moveaxis(v, 2, 0), jnp.moveaxis(w_end, 2, 0), jnp.moveaxis(b_last, 2, 0))
    _, (C0, n0, m0) = lax.scan(step, init, xs)
    C0 = jnp.moveaxis(C0, 0, 2)
    n0 = jnp.moveaxis(n0, 0, 2)
    m0 = jnp.moveaxis(m0, 0, 2)

    causal = jnp.tril(jnp.ones((CHUNK, CHUNK), dtype=bool))
    log_d = jnp.where(causal, b[..., :, None] - b[..., None, :] + ig[..., None, :], -jnp.inf)
    log_inter = b + m0[..., None]
    m_row = jnp.maximum(log_inter, log_d.max(-1))
    dmat = jnp.exp(log_d - m_row[..., None])
    inter_scale = jnp.exp(log_inter - m_row)
    s = jnp.einsum("bhcld,bhcsd->bhcls", q, k) * dmat
    num = inter_scale[..., None] * jnp.einsum("bhcld,bhcde->bhcle", q, C0) + jnp.einsum("bhcls,bhcse->bhcle", s, v)
    den = inter_scale * jnp.einsum("bhcld,bhcd->bhcl", q, n0) + s.sum(-1)
    h = num / jnp.maximum(jnp.abs(den), jnp.exp(-m_row))[..., None]
    return from_chunks(h)


def retention_chunkwise(q, k, v):
    B, S, H, D = q.shape
    log_gamma = jnp.log(1.0 - jnp.exp2(-5.0 - jnp.arange(H, dtype=jnp.float32)))
    q, k, v = to_chunks(q), to_chunks(k) * (D ** -0.5), to_chunks(v)
    idx = jnp.arange(CHUNK, dtype=jnp.float32)
    rel = idx[:, None] - idx[None, :]
    decay_mask = jnp.where(rel >= 0, jnp.exp(log_gamma[:, None, None] * jnp.maximum(rel, 0.0)), 0.0)
    scores = jnp.einsum("bhcld,bhcsd->bhcls", q, k) * decay_mask[None, :, None]
    o_intra = jnp.einsum("bhcls,bhcse->bhcle", scores, v)

    key_decay = jnp.exp(log_gamma[:, None] * (CHUNK - 1 - idx))
    U = jnp.einsum("bhcld,bhcle->bhcde", k * key_decay[None, :, None, :, None], v)
    chunk_decay = jnp.exp(log_gamma * CHUNK)[None, :, None, None]

    def step(R, u):
        return chunk_decay * R + u, R

    _, R0 = lax.scan(step, jnp.zeros((B, H, D, D), jnp.float32), jnp.moveaxis(U, 2, 0))
    R0 = jnp.moveaxis(R0, 0, 2)
    query_decay = jnp.exp(log_gamma[:, None] * (idx + 1.0))
    o_inter = jnp.einsum("bhcld,bhcde->bhcle", q * query_decay[None, :, None, :, None], R0)
    return from_chunks(o_intra + o_inter)


def setup_inputs(seed: int = 0) -> dict:
    key = jax.random.key(seed)
    ks = jax.random.split(key, 20)
    f32 = jnp.float32

    def nrm(k, shape, scale):
        return jax.random.normal(k, shape, f32) * scale

    def gain(k, shape):
        return 1.0 + 0.02 * jax.random.normal(k, shape, f32)

    x = jax.random.normal(ks[0], (BATCH, SEQ, D_MODEL), f32)
    start = jax.random.randint(ks[1], (BATCH, 1), 0, 1024, dtype=jnp.int32)
    positions = (start + jnp.arange(SEQ, dtype=jnp.int32)[None, :]).astype(jnp.int32)
    b_fgate = jnp.linspace(3.0, 6.0, N_MLSTM_HEADS, dtype=f32)[None, :] + nrm(ks[7], (DEPTH, N_MLSTM_HEADS), 0.01)
    return {
        "x": x,
        "positions": positions,
        "g_mix_pre": gain(ks[2], (DEPTH, D_MODEL)),
        "w_in": nrm(ks[3], (DEPTH, D_MODEL, D_PROJ), D_MODEL ** -0.5),
        "conv_w": nrm(ks[4], (DEPTH, CONV_WIDTH, 2 * D_MLSTM), CONV_WIDTH ** -0.5),
        "conv_b": nrm(ks[5], (DEPTH, 2 * D_MLSTM), 0.02),
        "b_igate": nrm(ks[6], (DEPTH, N_MLSTM_HEADS), 0.1),
        "b_fgate": b_fgate,
        "g_mlstm_head": gain(ks[8], (DEPTH, D_MLSTM)),
        "g_ret_head": gain(ks[9], (DEPTH, D_RET)),
        "w_out": nrm(ks[10], (DEPTH, D_MIX, D_MODEL), D_MIX ** -0.5),
        "g_mix_post": gain(ks[11], (DEPTH, D_MODEL)),
        "g_ffn_pre": gain(ks[12], (DEPTH, D_MODEL)),
        "w_gate": nrm(ks[13], (DEPTH, D_MODEL, D_FF), D_MODEL ** -0.5),
        "w_up": nrm(ks[14], (DEPTH, D_MODEL, D_FF), D_MODEL ** -0.5),
        "w_down": nrm(ks[15], (DEPTH, D_FF, D_MODEL), D_FF ** -0.5),
        "g_ffn_post": gain(ks[16], (DEPTH, D_MODEL)),
    }


def reference(x, positions, g_mix_pre, w_in, conv_w, conv_b, b_igate, b_fgate, g_mlstm_head, g_ret_head,
              w_out, g_mix_post, g_ffn_pre, w_gate, w_up, w_down, g_ffn_post):
    f32 = jnp.float32
    for l in range(DEPTH):
        h = rmsnorm(x, g_mix_pre[l])
        proj = h @ w_in[l]
        mq, mk, mv, mo, mi, mf, rq, rk, rv, rg = jnp.split(proj, SPLITS, axis=-1)

        qk = jax.nn.silu(causal_dwconv(jnp.concatenate([mq, mk], axis=-1), conv_w[l], conv_b[l]))
        mq, mk = qk[..., :D_MLSTM], qk[..., D_MLSTM:]
        hm = mlstm_chunkwise(split_heads(mq, N_MLSTM_HEADS).astype(f32),
                             split_heads(mk, N_MLSTM_HEADS).astype(f32),
                             split_heads(mv, N_MLSTM_HEADS).astype(f32),
                             (mi + b_igate[l]).astype(f32), (mf + b_fgate[l]).astype(f32))
        hm = head_rmsnorm(hm, g_mlstm_head[l]) * jax.nn.sigmoid(mo.astype(f32))

        rq_h = rotary(split_heads(rq, N_RET_HEADS).astype(f32), positions)
        rk_h = rotary(split_heads(rk, N_RET_HEADS).astype(f32), positions)
        hr = retention_chunkwise(rq_h, rk_h, split_heads(rv, N_RET_HEADS).astype(f32))
        hr = head_rmsnorm(hr, g_ret_head[l]) * jax.nn.silu(rg.astype(f32))

        mix = jnp.concatenate([hm, hr], axis=-1).astype(x.dtype) @ w_out[l]
        x = x + rmsnorm(mix, g_mix_post[l])

        h = rmsnorm(x, g_ffn_pre[l])
        ff = (jax.nn.silu(h @ w_gate[l]) * (h @ w_up[l])) @ w_down[l]
        x = x + rmsnorm(ff, g_ffn_post[l])
    return x
```

```cpp
#include <hip/hip_runtime.h>
#include <cstdio>
#include <cstdint>

#ifndef MK_N_LAUNCHES
#define MK_N_LAUNCHES 1
#endif

namespace pg8 {
#define PG8_LAS __attribute__((address_space(3)))
typedef unsigned short bf16_t;
typedef short bf16x8 __attribute__((ext_vector_type(8)));
typedef float f32x4 __attribute__((ext_vector_type(4)));
typedef unsigned u32x4 __attribute__((ext_vector_type(4)));
constexpr int BM = 256, BK = 64, HALF = 128, HTB = HALF * BK * 2  , STAGE_BYTES = 8 * HTB, NXCD = 8, WGM = 8;

__host__ __device__ __forceinline__ int lds_byte(int r, int c) { const int st = (r >> 4) * 2 + (c >> 5), rr = r & 15, cc = c & 31, ob = rr * 64 + cc * 2; return st * 1024 + (ob ^ (((ob >> 9) & 1) << 5)); }
__host__ __device__ __forceinline__ void stage_rc(int b, int& R, int& C) { const int st = b / 1024, sb = b % 1024, swz = sb ^ (((sb >> 9) & 1) << 5); R = (st >> 1) * 16 + swz / 64; C = (st & 1) * 32 + (swz % 64) / 2; }
__host__ __device__ __forceinline__ int perm32(int rho) { const int n = rho >> 4, i = rho & 15; return 8 * (i >> 2) + 4 * n + (i & 3); }

struct Unit { int pm, pn; };
struct Gemm { const bf16_t* A; const bf16_t* Bt; int M, N, K; };

struct StaticOrder {
    int nM, nN, nwg, G, c;
    __host__ __device__ void init(int M, int N, int G_, int c_) { nM = M / BM; nN = N / BM; nwg = nM * nN; G = G_; c = c_; }
    __host__ __device__ bool next(int i, Unit& u) const {
        const long L = (long)i * G + c; if (L >= nwg) return false;
        int wgid = (int)L; { const int q = nwg / NXCD, r = nwg % NXCD, xcd = wgid % NXCD, off = wgid / NXCD; wgid = (xcd < r ? xcd * (q + 1) : r * (q + 1) + (xcd - r) * q) + off; }
        const int nig = WGM * nN, gid = wgid / nig, fm = gid * WGM, gsz = (nM - fm) < WGM ? (nM - fm) : WGM;
        u.pm = fm + ((wgid % nig) % gsz); u.pn = (wgid % nig) / gsz; return true;
    }
    __device__ __forceinline__ void a_ready(const Unit&) const {}
    __device__ __forceinline__ void done(const Unit&) const {}
};

__device__ __forceinline__ unsigned cvt_pk_bf16(float lo, float hi) { unsigned r; asm volatile("v_cvt_pk_bf16_f32 %0, %1, %2" : "=v"(r) : "v"(lo), "v"(hi)); return r; }

struct EpiF32 {
    static constexpr bool PERM = false, AFTER_DRAIN = false;
    float* C; int ldc;
    __device__ __forceinline__ void operator()(const f32x4 (&acc)[2][2][4][2], const Unit& u, int wr, int wc, int fr, int fq) const {
        const int row0 = u.pm * BM + wr * 64 + fr, col0 = u.pn * BM + wc * 32 + 4 * fq;
#pragma unroll
        for (int ai = 0; ai < 2; ++ai)
#pragma unroll
            for (int m = 0; m < 4; ++m) { float* rowp = C + (size_t)(row0 + ai * HALF + m * 16) * ldc + col0;
#pragma unroll
                for (int bj = 0; bj < 2; ++bj)
#pragma unroll
                    for (int n = 0; n < 2; ++n) *(f32x4*)(rowp + bj * HALF + n * 16) = acc[ai][bj][m][n]; }
    }
};
struct EpiBf16 {
    static constexpr bool PERM = true, AFTER_DRAIN = false;
    bf16_t* O; int ldc;
    __device__ __forceinline__ void operator()(const f32x4 (&acc)[2][2][4][2], const Unit& u, int wr, int wc, int fr, int fq) const {
        const int row0 = u.pm * BM + wr * 64 + fr, col0 = u.pn * BM + wc * 32 + 8 * fq;
#pragma unroll
        for (int ai = 0; ai < 2; ++ai)
#pragma unroll
            for (int m = 0; m < 4; ++m) { bf16_t* rowp = O + (size_t)(row0 + ai * HALF + m * 16) * ldc + col0;
#pragma unroll
                for (int bj = 0; bj < 2; ++bj) { const f32x4 v0 = acc[ai][bj][m][0], v1 = acc[ai][bj][m][1];
                    u32x4 w; w.x = cvt_pk_bf16(v0[0], v0[1]); w.y = cvt_pk_bf16(v0[2], v0[3]); w.z = cvt_pk_bf16(v1[0], v1[1]); w.w = cvt_pk_bf16(v1[2], v1[3]);
                    *(u32x4*)(rowp + bj * HALF) = w; } }
    }
};
__device__ __forceinline__ float silu_f(float x) { return x / (1.0f + __expf(-x)); }
struct EpiSwiGLU {
    static constexpr bool PERM = true, AFTER_DRAIN = false;
    bf16_t* O; int ldc;
    __device__ __forceinline__ void operator()(const f32x4 (&acc)[2][2][4][2], const Unit& u, int wr, int wc, int fr, int fq) const {
        const int row0 = u.pm * BM + wr * 64 + fr, col0 = u.pn * HALF + wc * 32 + 8 * fq;
#pragma unroll
        for (int ai = 0; ai < 2; ++ai)
#pragma unroll
            for (int m = 0; m < 4; ++m) { bf16_t* rowp = O + (size_t)(row0 + ai * HALF + m * 16) * ldc + col0;
                const f32x4 g0 = acc[ai][0][m][0], g1 = acc[ai][0][m][1], u0 = acc[ai][1][m][0], u1 = acc[ai][1][m][1];
                u32x4 w; w.x = cvt_pk_bf16(silu_f(g0[0]) * u0[0], silu_f(g0[1]) * u0[1]); w.y = cvt_pk_bf16(silu_f(g0[2]) * u0[2], silu_f(g0[3]) * u0[3]);
                w.z = cvt_pk_bf16(silu_f(g1[0]) * u1[0], silu_f(g1[1]) * u1[1]); w.w = cvt_pk_bf16(silu_f(g1[2]) * u1[2], silu_f(g1[3]) * u1[3]);
                *(u32x4*)rowp = w; }
    }
};

template <class Epi, class Sched, bool ALIGN_EPI = false, bool SP2 = false>
__device__ __forceinline__ void gemm_phase(PG8_LAS unsigned char* lds, const Gemm g, const Sched& S, const Epi& E) {
    const int tid = threadIdx.x, wid = __builtin_amdgcn_readfirstlane(tid >> 6), lane = tid & 63, wr = wid >> 2, wc = wid & 3, fr = lane & 15, fq = lane >> 4;
    const int K = g.K, nt = K / BK;
    unsigned voffA[2], voffB[2];
#pragma unroll
    for (int i = 0; i < 2; ++i) { int R, C; stage_rc(tid * 16 + i * 8192, R, C); const int Rb = Epi::PERM ? ((R & ~31) + perm32(R & 31)) : R;
        voffA[i] = (unsigned)(R * K + C) * 2u; voffB[i] = (unsigned)(Rb * K + C) * 2u; }
    const size_t kstep = (size_t)(BK * 2);
    const size_t hstep = (size_t)HALF * K * 2;
    const size_t tstep = 2 * hstep;
    const unsigned ldsw = (unsigned)wid * 1024u;
    const int aoff = lds_byte(wr * 64 + fr, fq * 8), boff = lds_byte(wc * 32 + fr, fq * 8);
#define PG8_SA(b, h) (((b) * 2 + (h)) * HTB)
#define PG8_SB(b, h) ((4 + (b) * 2 + (h)) * HTB)
#define PG8_STAGE(bufoff, gbase, voff) do { _Pragma("unroll") for (int _i = 0; _i < 2; ++_i) \
        __builtin_amdgcn_global_load_lds((const unsigned*)((const char*)(gbase) + (voff)[_i]), (PG8_LAS unsigned*)(lds + (bufoff) + ldsw + _i * 8192), 16, 0, 0); } while (0)
#define PG8_LDA(dst, b, h) do { _Pragma("unroll") for (int m = 0; m < 4; ++m) _Pragma("unroll") for (int k = 0; k < 2; ++k) dst[m][k] = *(const PG8_LAS bf16x8*)(lds + PG8_SA(b, h) + aoff + m * 2048 + k * 1024); } while (0)
#define PG8_LDB(dst, b, h) do { _Pragma("unroll") for (int n = 0; n < 2; ++n) _Pragma("unroll") for (int k = 0; k < 2; ++k) dst[n][k] = *(const PG8_LAS bf16x8*)(lds + PG8_SB(b, h) + boff + n * 2048 + k * 1024); } while (0)
#define PG8_MMA(ai, bj, At, Bt) do { __builtin_amdgcn_s_setprio(1); _Pragma("unroll") for (int m = 0; m < 4; ++m) _Pragma("unroll") for (int n = 0; n < 2; ++n) _Pragma("unroll") for (int k = 0; k < 2; ++k) \
        acc[ai][bj][m][n] = __builtin_amdgcn_mfma_f32_16x16x32_bf16(Bt[n][k], At[m][k], acc[ai][bj][m][n], 0, 0, 0); __builtin_amdgcn_s_setprio(0); } while (0)
#define PG8_WAIT_V(n) asm volatile("s_waitcnt vmcnt(" #n ")" ::: "memory")
#define PG8_WAIT_L(n) asm volatile("s_waitcnt lgkmcnt(" #n ")" ::: "memory")
#define PG8_BAR __builtin_amdgcn_s_barrier()
#define PG8_SCHED __builtin_amdgcn_sched_barrier(0)
    Unit cur, nxt; int ui = 0;
    if (!S.next(0, cur)) return;
    f32x4 acc[2][2][4][2];
#pragma unroll
    for (int a = 0; a < 2; ++a)
#pragma unroll
        for (int b = 0; b < 2; ++b)
#pragma unroll
            for (int m = 0; m < 4; ++m)
#pragma unroll
                for (int n = 0; n < 2; ++n) acc[a][b][m][n] = (f32x4){0.f, 0.f, 0.f, 0.f};
    bf16x8 At[4][2], B0[2][2], B1[2][2];
    const char* cA = (const char*)g.A + (size_t)cur.pm * tstep; const char* cB = (const char*)g.Bt + (size_t)cur.pn * tstep;
    S.a_ready(cur);
    if constexpr (SP2) {
        PG8_STAGE(PG8_SB(0, 0), cB, voffB); PG8_STAGE(PG8_SB(0, 1), cB + hstep, voffB); PG8_STAGE(PG8_SA(0, 0), cA, voffA); PG8_STAGE(PG8_SA(0, 1), cA + hstep, voffA);
        if (wr == 1) PG8_BAR;
        PG8_WAIT_V(2); PG8_BAR;
        PG8_STAGE(PG8_SB(1, 0), cB + kstep, voffB); PG8_STAGE(PG8_SA(1, 0), cA + kstep, voffA); PG8_STAGE(PG8_SB(1, 1), cB + hstep + kstep, voffB);
        PG8_WAIT_V(6); PG8_BAR;
    } else {
        PG8_STAGE(PG8_SB(0, 0), cB, voffB); PG8_STAGE(PG8_SA(0, 0), cA, voffA); PG8_STAGE(PG8_SB(0, 1), cB + hstep, voffB); PG8_STAGE(PG8_SA(0, 1), cA + hstep, voffA);
        if (wr == 1) PG8_BAR;
        PG8_WAIT_V(4); PG8_BAR;
        PG8_STAGE(PG8_SB(1, 0), cB + kstep, voffB); PG8_STAGE(PG8_SA(1, 0), cA + kstep, voffA); PG8_STAGE(PG8_SB(1, 1), cB + hstep + kstep, voffB);
        PG8_WAIT_V(6); PG8_BAR;
    }
    for (;;) {
        const bool has_next = S.next(ui + 1, nxt);
        const char* nA = has_next ? (const char*)g.A + (size_t)nxt.pm * tstep : cA; const char* nB = has_next ? (const char*)g.Bt + (size_t)nxt.pn * tstep : cB;
        for (int t = 0; t < nt; t += 2) {
            const bool last = (t == nt - 2);
            const char* a1 = cA + (size_t)(t + 1) * kstep;
            const char* a2 = last ? nA : cA + (size_t)(t + 2) * kstep; const char* b2 = last ? nB : cB + (size_t)(t + 2) * kstep;
            const char* a3 = a2 + kstep; const char* b3 = b2 + kstep;
            if (last && has_next) S.a_ready(nxt);
            if constexpr (SP2) {
            PG8_LDB(B0, 0, 0); PG8_LDB(B1, 0, 1); PG8_SCHED; PG8_LDA(At, 0, 0); PG8_STAGE(PG8_SA(1, 1), a1 + hstep, voffA);
            PG8_WAIT_V(8); PG8_WAIT_L(0); PG8_BAR; PG8_MMA(0, 0, At, B0); PG8_MMA(0, 1, At, B1); PG8_BAR; PG8_SCHED;
            PG8_LDA(At, 0, 1); PG8_STAGE(PG8_SB(0, 0), b2, voffB); PG8_STAGE(PG8_SB(0, 1), b2 + hstep, voffB); PG8_STAGE(PG8_SA(0, 0), a2, voffA);
            PG8_WAIT_V(8); PG8_WAIT_L(0); PG8_BAR; PG8_MMA(1, 0, At, B0); PG8_MMA(1, 1, At, B1); PG8_BAR; PG8_SCHED;
            PG8_LDB(B0, 1, 0); PG8_LDB(B1, 1, 1); PG8_SCHED; PG8_LDA(At, 1, 0); PG8_STAGE(PG8_SA(0, 1), a2 + hstep, voffA);
            PG8_WAIT_V(8); PG8_WAIT_L(0); PG8_BAR; PG8_MMA(0, 0, At, B0); PG8_MMA(0, 1, At, B1); PG8_BAR; PG8_SCHED;
            PG8_LDA(At, 1, 1); PG8_STAGE(PG8_SB(1, 0), b3, voffB); PG8_STAGE(PG8_SB(1, 1), b3 + hstep, voffB); PG8_STAGE(PG8_SA(1, 0), a3, voffA);
            PG8_WAIT_V(8); PG8_WAIT_L(0); PG8_BAR; PG8_MMA(1, 0, At, B0); PG8_MMA(1, 1, At, B1); PG8_BAR; PG8_SCHED;
            } else {
            PG8_LDB(B0, 0, 0); PG8_SCHED; PG8_LDA(At, 0, 0); PG8_STAGE(PG8_SA(1, 1), a1 + hstep, voffA);
            PG8_WAIT_L(8); PG8_BAR; PG8_WAIT_L(0); PG8_MMA(0, 0, At, B0); PG8_BAR; PG8_SCHED;
            PG8_LDB(B1, 0, 1); PG8_STAGE(PG8_SB(0, 0), b2, voffB);
            PG8_BAR; PG8_WAIT_L(0); PG8_MMA(0, 1, At, B1); PG8_BAR;
            PG8_LDA(At, 0, 1); PG8_STAGE(PG8_SA(0, 0), a2, voffA);
            PG8_BAR; PG8_WAIT_L(0); PG8_MMA(1, 0, At, B0); PG8_BAR; PG8_SCHED;
            PG8_STAGE(PG8_SB(0, 1), b2 + hstep, voffB);
            PG8_WAIT_V(6); PG8_BAR; PG8_MMA(1, 1, At, B1); PG8_BAR;
            PG8_LDB(B0, 1, 0); PG8_SCHED; PG8_LDA(At, 1, 0); PG8_STAGE(PG8_SA(0, 1), a2 + hstep, voffA);
            PG8_WAIT_L(8); PG8_BAR; PG8_WAIT_L(0); PG8_MMA(0, 0, At, B0); PG8_BAR; PG8_SCHED;
            PG8_LDB(B1, 1, 1); PG8_STAGE(PG8_SB(1, 0), b3, voffB);
            PG8_BAR; PG8_WAIT_L(0); PG8_MMA(0, 1, At, B1); PG8_BAR;
            PG8_LDA(At, 1, 1); PG8_STAGE(PG8_SA(1, 0), a3, voffA);
            PG8_BAR; PG8_WAIT_L(0); PG8_MMA(1, 0, At, B0); PG8_BAR; PG8_SCHED;
            PG8_STAGE(PG8_SB(1, 1), b3 + hstep, voffB);
            PG8_WAIT_V(6); PG8_BAR; PG8_MMA(1, 1, At, B1); PG8_BAR;
            }
        }
        if constexpr (ALIGN_EPI) { if (wr == 0) PG8_BAR; }
        if constexpr (!Epi::AFTER_DRAIN) { E(acc, cur, wr, wc, fr, fq); S.done(cur); }
        if (!has_next) break;
#pragma unroll
        for (int a = 0; a < 2; ++a)
#pragma unroll
            for (int b = 0; b < 2; ++b)
#pragma unroll
                for (int m = 0; m < 4; ++m)
#pragma unroll
                    for (int n = 0; n < 2; ++n) acc[a][b][m][n] = (f32x4){0.f, 0.f, 0.f, 0.f};
        cur = nxt; cA = nA; cB = nB; ++ui;
        if constexpr (ALIGN_EPI) { if (wr == 1) PG8_BAR; }
    }
    PG8_WAIT_V(0);
    if constexpr (!ALIGN_EPI) { if (wr == 0) PG8_BAR; }
    PG8_BAR;
#undef PG8_SA
#undef PG8_SB
#undef PG8_STAGE
#undef PG8_LDA
#undef PG8_LDB
#undef PG8_MMA
#undef PG8_WAIT_V
#undef PG8_WAIT_L
#undef PG8_BAR
#undef PG8_SCHED
}
}

constexpr int NWAVES = 8, NTHR = 512;
constexpr int SEQ = 16384, DM = 2048, HD = 128, NHG = 8, DPROJ = 8208, NPJ = 8192, DFF = 5632, CH = 128, NCH = SEQ / CH, NHEADS = 16;
constexpr float NORM_EPS = 1e-6f;
constexpr int N_LAUNCHES = MK_N_LAUNCHES, NPHASES = 10;
constexpr int PC_MQ = 0, PC_MK = 1024, PC_MV = 2048, PC_MO = 3072, PC_RQ = 4096, PC_RK = 5120, PC_RV = 6144, PC_RG = 7168;

constexpr size_t MiB = 1u << 20;
constexpr size_t WS_CTL = 0, CTL_ZERO_BYTES = 64 * 1024;
constexpr size_t WS_WIN = 2 * MiB, WS_WO = 34 * MiB, WS_WGU = 42 * MiB, WS_WD = 86 * MiB;
constexpr size_t WS_PRE = 108 * MiB;
constexpr size_t WS_RS = 109 * MiB;
constexpr size_t WS_NLOC = 110 * MiB;
constexpr size_t WS_N0 = 110 * MiB + 512 * 1024;
constexpr size_t WS_DEC = 111 * MiB;
constexpr size_t WS_COS = 112 * MiB, WS_SIN = 116 * MiB;
constexpr size_t WS_B = 128 * MiB;
constexpr size_t WS_A = 384 * MiB;
constexpr size_t WS_FF = WS_B + 176 * MiB;
constexpr size_t WS_END = 448 * MiB;
constexpr int CW_BAR = 1024;

constexpr int RING_BYTES = 131072;
constexpr int GATE_OFF = RING_BYTES;
constexpr int MISC_OFF = RING_BYTES + 2048;
constexpr int LDS_BYTES = 147456;

#define GAS __attribute__((address_space(1)))
#define LAS __attribute__((address_space(3)))
#define DI __device__ __forceinline__
typedef unsigned short bf16;
typedef unsigned u32x4 __attribute__((ext_vector_type(4)));
typedef unsigned u32x2 __attribute__((ext_vector_type(2)));
typedef float f32x4 __attribute__((ext_vector_type(4)));
typedef float f32x2 __attribute__((ext_vector_type(2)));
typedef LAS unsigned char* ldsp;
#define LDS_WAIT() asm volatile("s_waitcnt lgkmcnt(0)" ::: "memory")

DI unsigned f2bf(float f) { unsigned u = __builtin_bit_cast(unsigned, f); return (u + 0x7fffu + ((u >> 16) & 1u)) >> 16; }
DI unsigned pk2(float lo, float hi) { return f2bf(lo) | (f2bf(hi) << 16); }
DI float bflo(unsigned w) { return __builtin_bit_cast(float, w << 16); }
DI float bfhi(unsigned w) { return __builtin_bit_cast(float, w & 0xffff0000u); }
DI void unpack8(const u32x4 w, float (&f)[8]) { f[0] = bflo(w.x); f[1] = bfhi(w.x); f[2] = bflo(w.y); f[3] = bfhi(w.y); f[4] = bflo(w.z); f[5] = bfhi(w.z); f[6] = bflo(w.w); f[7] = bfhi(w.w); }
DI u32x4 pack8(const float (&f)[8]) { u32x4 w; w.x = pk2(f[0], f[1]); w.y = pk2(f[2], f[3]); w.z = pk2(f[4], f[5]); w.w = pk2(f[6], f[7]); return w; }
DI float sigmoid_f(float x) { return 1.0f / (1.0f + __expf(-x)); }
DI float silu_f(float x) { return x / (1.0f + __expf(-x)); }
DI float wave_sum(float v) {
#pragma unroll
    for (int o = 1; o < 64; o <<= 1) v += __shfl_xor(v, o);
    return v;
}

#define XB_TMO      128
#define XB_XCNT(j)  (256  + 64 * (j))
#define XB_XSUB(j)  (1280 + 64 * (j))
#define XB_XGEN(j)  (2304 + 64 * (j))
#define XB_TOP      3328
#define XB_TOPGEN   3392
#define XCD_BAR_WORDS 3456
#define XB_SPIN_CAP (1u << 18)
__device__ __forceinline__ unsigned xb_ld(unsigned* p)              { return __hip_atomic_load(p, __ATOMIC_RELAXED, __HIP_MEMORY_SCOPE_AGENT); }
__device__ __forceinline__ unsigned xb_add(unsigned* p, unsigned v) { return __hip_atomic_fetch_add(p, v, __ATOMIC_RELAXED, __HIP_MEMORY_SCOPE_AGENT); }
__device__ __forceinline__ unsigned xb_xcc_id() { return (unsigned)__builtin_amdgcn_s_getreg((3 << 11) | 20) & 0xFu; }
#define XB_SPIN(cond, bar) do { unsigned _sp = 0; while (cond) { __builtin_amdgcn_s_sleep(1); \
    if ((++_sp & 255u) == 0u) { if (xb_ld(&(bar)[XB_TMO])) break; if (_sp > XB_SPIN_CAP) { atomicAdd(&(bar)[XB_TMO], 1u); break; } } } } while (0)
struct XcdBarrier { unsigned* bar; unsigned x; volatile LAS unsigned* st; };
__device__ __forceinline__ XcdBarrier xcd_barrier_post(unsigned* bar, volatile LAS unsigned* st) {
    XcdBarrier b; b.bar = bar; b.x = xb_xcc_id(); b.st = st;
    if (threadIdx.x == 0) (void)xb_add(&bar[XB_XCNT(b.x)], 1u);
    return b;
}
__device__ __forceinline__ void xcd_barrier_complete(unsigned* bar, unsigned x, unsigned& nloc, unsigned& nx) {
    const unsigned G = gridDim.x * gridDim.y * gridDim.z;
    unsigned sum, cnt, mine, sp = 0u;
    for (;;) {
        sum = 0u; cnt = 0u; mine = 0u;
#pragma unroll
        for (unsigned j = 0; j < 16; ++j) { const unsigned c = xb_ld(&bar[XB_XCNT(j)]); sum += c; cnt += (c > 0u) ? 1u : 0u; mine = (j == x) ? c : mine; }
        if (sum == G) break;
        __builtin_amdgcn_s_sleep(1);
        if ((++sp & 255u) == 0u) { if (xb_ld(&bar[XB_TMO])) break; if (sp > XB_SPIN_CAP) { atomicAdd(&bar[XB_TMO], 1u); break; } }
    }
    nloc = mine > 0u ? mine : 1u; nx = cnt > 0u ? cnt : 1u;
}
__device__ __forceinline__ void xcd_barrier(const XcdBarrier& b) {
    asm volatile("s_waitcnt vmcnt(0)" ::: "memory");
    __syncthreads();
    if (threadIdx.x == 0) {
        unsigned* bar = b.bar;
        __builtin_amdgcn_s_waitcnt(0);
        unsigned nloc = b.st[0], nx = b.st[1];
        if (nloc == 0u) { xcd_barrier_complete(bar, b.x, nloc, nx); b.st[0] = nloc; b.st[1] = nx; }
        const unsigned old = xb_add(&bar[XB_XSUB(b.x)], 1u);
        const unsigned gen = old / nloc;
        if (old + 1u == (gen + 1u) * nloc) {
            __builtin_amdgcn_fence(__ATOMIC_RELEASE, "agent");
            asm volatile("s_waitcnt vmcnt(0)" ::: "memory");
            const unsigned og = xb_add(&bar[XB_TOP], 1u);
            const unsigned tg = og / nx;
            if (og + 1u == (tg + 1u) * nx) xb_add(&bar[XB_TOPGEN], 1u);
            else XB_SPIN(xb_ld(&bar[XB_TOPGEN]) == tg, bar);
            __builtin_amdgcn_fence(__ATOMIC_ACQUIRE, "agent");
            xb_add(&bar[XB_XGEN(b.x)], 1u);
            asm volatile("s_waitcnt vmcnt(0)" ::: "memory");
        } else {
            XB_SPIN(xb_ld(&bar[XB_XGEN(b.x)]) == gen, bar);
            __builtin_amdgcn_fence(__ATOMIC_ACQUIRE, "agent");
            asm volatile("s_waitcnt vmcnt(0)" ::: "memory");
        }
    }
    __syncthreads();
}

struct Args { const void* in[17]; float* out; unsigned char* ws; int ph_lo, ph_hi, li, pad; };
enum { IN_X = 0, IN_POS, IN_GPRE, IN_WIN, IN_CW, IN_CB, IN_BI, IN_BF, IN_GMH, IN_GRH, IN_WOUT, IN_GPOST, IN_GFPRE, IN_WG, IN_WU, IN_WDN, IN_GFPOST };

DI void p0_transpose_item(const float* W, int K, int ldw, int src_col, bf16* WT, int dst_row, LAS float* scr, int kb, int lane) {
    const int k0 = 64 * kb;
#pragma unroll 8
    for (int i = 0; i < 32; ++i) { const int kk = 2 * i + (lane >> 5); scr[kk * 33 + (lane & 31)] = W[(size_t)(k0 + kk) * ldw + src_col + (lane & 31)]; }
    LDS_WAIT(); asm volatile("" ::: "memory");
    const int c = lane & 7;
#pragma unroll
    for (int j = 0; j < 4; ++j) { const int n = (lane >> 3) + 8 * j; const LAS float* s = scr + (8 * c) * 33 + n;
        u32x4 o; o.x = pk2(s[0 * 33], s[1 * 33]); o.y = pk2(s[2 * 33], s[3 * 33]); o.z = pk2(s[4 * 33], s[5 * 33]); o.w = pk2(s[6 * 33], s[7 * 33]);
        *(GAS u32x4*)(WT + (size_t)(dst_row + n) * K + k0 + 8 * c) = o; }
    LDS_WAIT(); asm volatile("" ::: "memory");
}
DI void phase_p0(const Args& a, ldsp lds, int tid, int lane, int wave, int vcu, int G) {
    const int gw = vcu * NWAVES + wave, NGW = G * NWAVES;
    LAS float* scr = (LAS float*)(lds + wave * 16384);
    const float* w_in = (const float*)a.in[IN_WIN]; const float* w_out = (const float*)a.in[IN_WOUT];
    const float* w_g = (const float*)a.in[IN_WG]; const float* w_u = (const float*)a.in[IN_WU]; const float* w_d = (const float*)a.in[IN_WDN];
    bf16* WinT = (bf16*)(a.ws + WS_WIN); bf16* WoT = (bf16*)(a.ws + WS_WO); bf16* WguT = (bf16*)(a.ws + WS_WGU); bf16* WdT = (bf16*)(a.ws + WS_WD);
    constexpr int I_IN = 32 * 256, I_O = 32 * 64, I_G = 32 * 176, I_D = 88 * 64, NITEMS = I_IN + I_O + 2 * I_G + I_D;
    for (int it = gw; it < NITEMS; it += NGW) {
        int r = it;
        if (r < I_IN) { const int kb = r / 256, nb = r % 256; const int sc = nb < 128 ? 32 * nb : 4112 + 32 * (nb - 128);
            p0_transpose_item(w_in, DM, DPROJ, sc, WinT, 32 * nb, scr, kb, lane); continue; } r -= I_IN;
        if (r < I_O) { const int kb = r / 64, nb = r % 64; p0_transpose_item(w_out, DM, DM, 32 * nb, WoT, 32 * nb, scr, kb, lane); continue; } r -= I_O;
        if (r < I_G) { const int kb = r / 176, nb = r % 176; p0_transpose_item(w_g, DM, DFF, 32 * nb, WguT, 256 * (nb >> 2) + 32 * (nb & 3), scr, kb, lane); continue; } r -= I_G;
        if (r < I_G) { const int kb = r / 176, nb = r % 176; p0_transpose_item(w_u, DM, DFF, 32 * nb, WguT, 256 * (nb >> 2) + 128 + 32 * (nb & 3), scr, kb, lane); continue; } r -= I_G;
        { const int kb = r / 64, nb = r % 64; p0_transpose_item(w_d, DFF, DM, 32 * nb, WdT, 32 * nb, scr, kb, lane); }
    }
    const float* x = (const float*)a.in[IN_X]; const float* gpre = (const float*)a.in[IN_GPRE];
    bf16* hb = (bf16*)(a.ws + WS_A); float* rs = (float*)(a.ws + WS_RS);
    for (int m = gw; m < SEQ; m += NGW) {
        const GAS f32x4* xr = (const GAS f32x4*)(x + (size_t)m * DM) + lane; const GAS f32x4* gr = (const GAS f32x4*)gpre + lane;
        f32x4 v[8]; float s = 0.f;
#pragma unroll
        for (int j = 0; j < 8; ++j) { v[j] = xr[64 * j]; s += (v[j].x * v[j].x + v[j].y * v[j].y) + (v[j].z * v[j].z + v[j].w * v[j].w); }
        const float r = 1.0f / sqrtf(wave_sum(s) * (1.0f / DM) + NORM_EPS);
        if (lane == 0) rs[m] = r;
        GAS u32x2* o = (GAS u32x2*)(hb + (size_t)m * DM) + lane;
#pragma unroll
        for (int j = 0; j < 8; ++j) { const f32x4 gg = gr[64 * j]; u32x2 w; w.x = pk2(v[j].x * r * gg.x, v[j].y * r * gg.y); w.y = pk2(v[j].z * r * gg.z, v[j].w * r * gg.w); o[64 * j] = w; }
    }
    const int* pos = (const int*)a.in[IN_POS]; float* COS = (float*)(a.ws + WS_COS); float* SIN = (float*)(a.ws + WS_SIN);
    for (int i = vcu * NTHR + tid; i < SEQ * 64; i += G * NTHR) { const int t = i >> 6, j = i & 63;
        const float inv = (float)pow(10000.0, -(double)(2 * j) / 128.0); const float ang = (float)pos[t] * inv; float sn, cs; sincosf(ang, &sn, &cs); COS[i] = cs; SIN[i] = sn; }
}

DI void phase_gates(const Args& a, int tid, int vcu, int G) {
    const float* x = (const float*)a.in[IN_X]; const float* gpre = (const float*)a.in[IN_GPRE]; const float* w_in = (const float*)a.in[IN_WIN];
    const float* rs = (const float*)(a.ws + WS_RS); float* PRE = (float*)(a.ws + WS_PRE);
    for (int i = vcu * NTHR + tid; i < SEQ * 16; i += G * NTHR) { const int t = i >> 4, cc = i & 15;
        const float* xr = x + (size_t)t * DM; const float* wc = w_in + 4096 + cc; float acc = 0.f;
#pragma unroll 8
        for (int k = 0; k < DM; ++k) acc += xr[k] * gpre[k] * wc[(size_t)k * DPROJ];
        PRE[i] = acc * rs[t]; }
}

DI int tile_off(int row, int col) { return row * 256 + ((((col >> 3) ^ row) & 15) << 4) + ((col & 7) << 1); }
DI void store_row8(ldsp tile, int row, int col0, const float (&f)[8]) { *(LAS u32x4*)(tile + tile_off(row, col0)) = pack8(f); }
DI void store_T8(ldsp tile, int s, int d0, const float (&f)[8]) {
#pragma unroll
    for (int i = 0; i < 8; ++i) *(LAS unsigned short*)(tile + tile_off(d0 + i, s)) = (unsigned short)f2bf(f[i]);
}
DI void store_T8_bits(ldsp tile, int s, int d0, const u32x4 w) {
    const unsigned ww[4] = {w.x, w.y, w.z, w.w};
#pragma unroll
    for (int i = 0; i < 4; ++i) { *(LAS unsigned short*)(tile + tile_off(d0 + 2 * i, s)) = (unsigned short)(ww[i] & 0xffffu); *(LAS unsigned short*)(tile + tile_off(d0 + 2 * i + 1, s)) = (unsigned short)(ww[i] >> 16); }
}
DI void load_tile8(ldsp tile, int row, int col0, float (&f)[8]) { unpack8(*(const LAS u32x4*)(tile + tile_off(row, col0)), f); }
DI void gload8(const bf16* p, float (&f)[8]) { unpack8(*(const GAS u32x4*)p, f); }

DI void mixer_gates(const Args& a, ldsp lds, int g, int c, int tid, int lane, int wave) {
    LAS float* rowv = (LAS float*)(lds + GATE_OFF); LAS float* colv = rowv + 128; LAS float* alog = rowv + 256;
    if (g < NHG) {
        if (wave == 0) {
            const float* PRE = (const float*)(a.ws + WS_PRE); const float bi = ((const float*)a.in[IN_BI])[g], bfg = ((const float*)a.in[IN_BF])[g];
            const int t0 = c * CH + 2 * lane;
            const float i0 = PRE[(size_t)t0 * 16 + g] + bi, i1 = PRE[(size_t)(t0 + 1) * 16 + g] + bi;
            const float f0 = PRE[(size_t)t0 * 16 + 8 + g] + bfg, f1 = PRE[(size_t)(t0 + 1) * 16 + 8 + g] + bfg;
            const float l0 = fminf(f0, 0.f) - log1pf(__expf(-fabsf(f0))), l1 = fminf(f1, 0.f) - log1pf(__expf(-fabsf(f1)));
            float p = l0 + l1;
#pragma unroll
            for (int o = 1; o < 64; o <<= 1) { const float y = __shfl_up(p, o); if (lane >= o) p += y; }
            const float b1 = p, b0 = p - l1;
            rowv[2 * lane] = b0; rowv[2 * lane + 1] = b1; alog[2 * lane] = b0; alog[2 * lane + 1] = b1; colv[2 * lane] = i0 - b0; colv[2 * lane + 1] = i1 - b1;
        }
    } else if (tid < 128) {
        const float lg = log1pf(-exp2f(-5.0f - (float)(g - NHG)));
        rowv[tid] = (float)tid * lg; colv[tid] = -(float)tid * lg; alog[tid] = (float)(tid + 1) * lg;
    }
    LDS_WAIT(); __syncthreads();
}
DI void conv8(const bf16* proj, const float* cw, const float* cb, int t, int col, float (&o)[8]) {
    float acc[8];
    { const f32x4 b0 = *(const GAS f32x4*)(cb + col), b1 = *(const GAS f32x4*)(cb + col + 4); acc[0] = b0.x; acc[1] = b0.y; acc[2] = b0.z; acc[3] = b0.w; acc[4] = b1.x; acc[5] = b1.y; acc[6] = b1.z; acc[7] = b1.w; }
#pragma unroll
    for (int j = 0; j < 4; ++j) { const int tt = t - 3 + j;
        if (tt >= 0) { float u[8]; gload8(proj + (size_t)tt * NPJ + col, u);
            const f32x4 w0 = *(const GAS f32x4*)(cw + j * 2048 + col), w1 = *(const GAS f32x4*)(cw + j * 2048 + col + 4);
            acc[0] += w0.x * u[0]; acc[1] += w0.y * u[1]; acc[2] += w0.z * u[2]; acc[3] += w0.w * u[3]; acc[4] += w1.x * u[4]; acc[5] += w1.y * u[5]; acc[6] += w1.z * u[6]; acc[7] += w1.w * u[7]; } }
#pragma unroll
    for (int i = 0; i < 8; ++i) o[i] = silu_f(acc[i]);
}
template <int MODE> DI void mixer_tiles(const Args& a, ldsp lds, int g, int c, int tid) {
    const bf16* proj = (const bf16*)(a.ws + WS_B);
    const LAS float* rowv = (const LAS float*)(lds + GATE_OFF); const LAS float* colv = rowv + 128;
    ldsp T0 = lds, T1 = lds + 32768, T2 = lds + 65536; ldsp TV = MODE == 1 ? T1 : T2;
    const float kscale = 0.08838834764831845f;
    if (g < NHG) {
        const float* cw = (const float*)a.in[IN_CW]; const float* cb = (const float*)a.in[IN_CB];
        for (int i = 0; i < 4; ++i) { const int item = tid + NTHR * i, s = item >> 4, dg = item & 15, t = c * CH + s;
            float kv[8]; conv8(proj, cw, cb, t, PC_MK + g * HD + 8 * dg, kv);
            const float sc = MODE == 1 ? kscale * __expf(rowv[127] + colv[s]) : kscale;
#pragma unroll
            for (int j = 0; j < 8; ++j) kv[j] *= sc;
            if (MODE == 1) store_T8(T0, s, 8 * dg, kv); else store_row8(T1, s, 8 * dg, kv);
            store_T8_bits(TV, s, 8 * dg, *(const GAS u32x4*)(proj + (size_t)t * NPJ + PC_MV + g * HD + 8 * dg));
            if (MODE == 3) { float qv[8]; conv8(proj, cw, cb, t, PC_MQ + g * HD + 8 * dg, qv); store_row8(T0, s, 8 * dg, qv); }
        }
    } else {
        const int gr = g - NHG; const float* COS = (const float*)(a.ws + WS_COS); const float* SIN = (const float*)(a.ws + WS_SIN);
        for (int i = 0; i < 2; ++i) { const int item = tid + NTHR * i, s = item >> 3, dg = item & 7, t = c * CH + s;
            float cs[8], sn[8];
            { const f32x4 c0 = *(const GAS f32x4*)(COS + (size_t)t * 64 + 8 * dg), c1 = *(const GAS f32x4*)(COS + (size_t)t * 64 + 8 * dg + 4), s0 = *(const GAS f32x4*)(SIN + (size_t)t * 64 + 8 * dg), s1 = *(const GAS f32x4*)(SIN + (size_t)t * 64 + 8 * dg + 4);
              cs[0] = c0.x; cs[1] = c0.y; cs[2] = c0.z; cs[3] = c0.w; cs[4] = c1.x; cs[5] = c1.y; cs[6] = c1.z; cs[7] = c1.w; sn[0] = s0.x; sn[1] = s0.y; sn[2] = s0.z; sn[3] = s0.w; sn[4] = s1.x; sn[5] = s1.y; sn[6] = s1.z; sn[7] = s1.w; }
            float lo[8], hi[8], olo[8], ohi[8];
            gload8(proj + (size_t)t * NPJ + PC_RK + gr * HD + 8 * dg, lo); gload8(proj + (size_t)t * NPJ + PC_RK + gr * HD + 64 + 8 * dg, hi);
            const float sc = MODE == 1 ? kscale * __expf(rowv[127] + colv[s]) : kscale;
#pragma unroll
            for (int j = 0; j < 8; ++j) { olo[j] = (lo[j] * cs[j] - hi[j] * sn[j]) * sc; ohi[j] = (hi[j] * cs[j] + lo[j] * sn[j]) * sc; }
            if (MODE == 1) { store_T8(T0, s, 8 * dg, olo); store_T8(T0, s, 64 + 8 * dg, ohi); } else { store_row8(T1, s, 8 * dg, olo); store_row8(T1, s, 64 + 8 * dg, ohi); }
            if (MODE == 3) {
                gload8(proj + (size_t)t * NPJ + PC_RQ + gr * HD + 8 * dg, lo); gload8(proj + (size_t)t * NPJ + PC_RQ + gr * HD + 64 + 8 * dg, hi);
#pragma unroll
                for (int j = 0; j < 8; ++j) { olo[j] = lo[j] * cs[j] - hi[j] * sn[j]; ohi[j] = hi[j] * cs[j] + lo[j] * sn[j]; }
                store_row8(T0, s, 8 * dg, olo); store_row8(T0, s, 64 + 8 * dg, ohi);
            }
        }
        for (int i = 0; i < 4; ++i) { const int item = tid + NTHR * i, s = item >> 4, dg = item & 15, t = c * CH + s;
            store_T8_bits(TV, s, 8 * dg, *(const GAS u32x4*)(proj + (size_t)t * NPJ + PC_RV + gr * HD + 8 * dg)); }
    }
    LDS_WAIT(); __syncthreads();
}

DI void phase_m1(const Args& a, ldsp lds, int tid, int lane, int wave, int vcu, int G) {
    float* UT = a.out; float* NLOC = (float*)(a.ws + WS_NLOC); float* DEC = (float*)(a.ws + WS_DEC);
    const LAS float* alog = (const LAS float*)(lds + GATE_OFF) + 256;
    for (int u = vcu; u < NHEADS * NCH; u += G) { const int g = u / NCH, c = u % NCH;
        mixer_gates(a, lds, g, c, tid, lane, wave);
        mixer_tiles<1>(a, lds, g, c, tid);
        ldsp KT = lds, VT = lds + 32768;
        if (tid == 0) DEC[g * NCH + c] = __expf(alog[127]);
        if (g < NHG && tid < 128) { float s = 0.f;
            for (int sc = 0; sc < 16; ++sc) { float k8[8]; load_tile8(KT, tid, 8 * sc, k8); s += ((k8[0] + k8[1]) + (k8[2] + k8[3])) + ((k8[4] + k8[5]) + (k8[6] + k8[7])); }
            NLOC[((size_t)g * NCH + c) * HD + tid] = s; }
        const int e = tid >> 2, dq = tid & 3;
        float acc[32];
#pragma unroll
        for (int i = 0; i < 32; ++i) acc[i] = 0.f;
        for (int sc = 0; sc < 16; ++sc) { float v8[8]; load_tile8(VT, e, 8 * sc, v8);
#pragma unroll
            for (int i = 0; i < 32; ++i) { float k8[8]; load_tile8(KT, 32 * dq + i, 8 * sc, k8);
#pragma unroll
                for (int j = 0; j < 8; ++j) acc[i] += v8[j] * k8[j]; } }
        float* o = UT + ((size_t)(g * NCH + c) << 14) + e * HD + 32 * dq;
#pragma unroll
        for (int i = 0; i < 8; ++i) *(GAS f32x4*)(o + 4 * i) = (f32x4){acc[4 * i], acc[4 * i + 1], acc[4 * i + 2], acc[4 * i + 3]};
        __syncthreads();
    }
}
DI void phase_m2(const Args& a, int tid, int vcu, int G) {
    const float* UT = a.out; bf16* C0T = (bf16*)(a.ws + WS_A); const float* DEC = (const float*)(a.ws + WS_DEC);
    const float* NLOC = (const float*)(a.ws + WS_NLOC); float* N0 = (float*)(a.ws + WS_N0);
    const int gt = vcu * NTHR + tid, NT = G * NTHR;
    for (int p = gt; p < NHEADS * 8192; p += NT) { const int e0 = p * 2, g = e0 >> 14, r = e0 & 16383;
        const float* dec = DEC + g * NCH; float c0 = 0.f, c1 = 0.f;
        for (int c = 0; c < NCH; c += 8) { f32x2 uu[8];
#pragma unroll
            for (int j = 0; j < 8; ++j) uu[j] = *(const GAS f32x2*)(UT + ((size_t)(g * NCH + c + j) << 14) + r);
#pragma unroll
            for (int j = 0; j < 8; ++j) { *(GAS unsigned*)(C0T + ((size_t)(g * NCH + c + j) << 14) + r) = pk2(c0, c1); const float d = dec[c + j]; c0 = d * c0 + uu[j].x; c1 = d * c1 + uu[j].y; } }
    }
    for (int p = gt; p < NHG * HD; p += NT) { const int g = p >> 7, d = p & 127; float n = 0.f;
        for (int c = 0; c < NCH; ++c) { N0[((size_t)g * NCH + c) * HD + d] = n; n = DEC[g * NCH + c] * n + NLOC[((size_t)g * NCH + c) * HD + d]; } }
}
DI void phase_m3(const Args& a, ldsp lds, int tid, int lane, int wave, int vcu, int G) {
    const bf16* proj = (const bf16*)(a.ws + WS_B); const bf16* C0T = (const bf16*)(a.ws + WS_A); const float* N0 = (const float*)(a.ws + WS_N0);
    bf16* mixb = (bf16*)a.out;
    const LAS float* rowv = (const LAS float*)(lds + GATE_OFF); const LAS float* colv = rowv + 128; const LAS float* alog = rowv + 256;
    ldsp Q = lds, K = lds + 32768, VT = lds + 65536; LAS float* S = (LAS float*)(lds + 98304);
    for (int u = vcu; u < NHEADS * NCH; u += G) { const int g = u / NCH, c = u % NCH; const bool ml = g < NHG;
        mixer_gates(a, lds, g, c, tid, lane, wave);
        mixer_tiles<3>(a, lds, g, c, tid);
        const bf16* c0t = C0T + ((size_t)(g * NCH + c) << 14);
        for (int hh = 0; hh < 2; ++hh) {
            const int tl = tid >> 3, sg = tid & 7, t = 64 * hh + tl;
            { float acc[16];
#pragma unroll
              for (int i = 0; i < 16; ++i) acc[i] = 0.f;
              for (int dc = 0; dc < 16; ++dc) { float q8[8]; load_tile8(Q, t, 8 * dc, q8);
#pragma unroll
                  for (int i = 0; i < 16; ++i) { float k8[8]; load_tile8(K, 16 * sg + i, 8 * dc, k8);
#pragma unroll
                      for (int j = 0; j < 8; ++j) acc[i] += q8[j] * k8[j]; } }
              const float rv = rowv[t];
#pragma unroll
              for (int i = 0; i < 16; ++i) { const int s = 16 * sg + i; S[tl * 128 + s] = (s <= t) ? acc[i] * __expf(rv + colv[s]) : 0.f; }
            }
            LDS_WAIT(); __syncthreads();
            { const int eg = sg; float acc[16], acc2[16]; float den = 0.f, den2 = 0.f;
#pragma unroll
              for (int i = 0; i < 16; ++i) { acc[i] = 0.f; acc2[i] = 0.f; }
              for (int sc = 0; sc < 16; ++sc) { float s8[8];
                  { const f32x4 s0 = *(const LAS f32x4*)(S + tl * 128 + 8 * sc), s1 = *(const LAS f32x4*)(S + tl * 128 + 8 * sc + 4); s8[0] = s0.x; s8[1] = s0.y; s8[2] = s0.z; s8[3] = s0.w; s8[4] = s1.x; s8[5] = s1.y; s8[6] = s1.z; s8[7] = s1.w; }
#pragma unroll
                  for (int j = 0; j < 8; ++j) den += s8[j];
#pragma unroll
                  for (int i = 0; i < 16; ++i) { float v8[8]; load_tile8(VT, 16 * eg + i, 8 * sc, v8);
#pragma unroll
                      for (int j = 0; j < 8; ++j) acc[i] += s8[j] * v8[j]; } }
              for (int dc = 0; dc < 16; ++dc) { float q8[8]; load_tile8(Q, t, 8 * dc, q8);
                  if (ml) { const f32x4 n0 = *(const GAS f32x4*)(N0 + ((size_t)g * NCH + c) * HD + 8 * dc), n1 = *(const GAS f32x4*)(N0 + ((size_t)g * NCH + c) * HD + 8 * dc + 4);
                      den2 += q8[0] * n0.x + q8[1] * n0.y + q8[2] * n0.z + q8[3] * n0.w + q8[4] * n1.x + q8[5] * n1.y + q8[6] * n1.z + q8[7] * n1.w; }
#pragma unroll
                  for (int i = 0; i < 16; ++i) { float c8[8]; gload8(c0t + (16 * eg + i) * HD + 8 * dc, c8);
#pragma unroll
                      for (int j = 0; j < 8; ++j) acc2[i] += q8[j] * c8[j]; } }
              const float al = __expf(alog[t]); float h[16]; float ss = 0.f;
              const float dn = den + al * den2; const float rden = ml ? 1.0f / fmaxf(fabsf(dn), 1.0f) : 1.0f;
#pragma unroll
              for (int i = 0; i < 16; ++i) { h[i] = (acc[i] + al * acc2[i]) * rden; ss += h[i] * h[i]; }
              ss += __shfl_xor(ss, 1); ss += __shfl_xor(ss, 2); ss += __shfl_xor(ss, 4);
              const float rn = 1.0f / sqrtf(ss * (1.0f / HD) + NORM_EPS);
              const int tg = c * CH + t; const int hc = ml ? g * HD + 16 * eg : (g - NHG) * HD + 16 * eg;
              const float* gh = (ml ? (const float*)a.in[IN_GMH] : (const float*)a.in[IN_GRH]) + hc;
              const bf16* gp = proj + (size_t)tg * NPJ + (ml ? PC_MO : PC_RG) + hc;
              float ga[16]; { float t8[8]; gload8(gp, t8);
#pragma unroll
                  for (int j = 0; j < 8; ++j) ga[j] = t8[j]; gload8(gp + 8, t8);
#pragma unroll
                  for (int j = 0; j < 8; ++j) ga[8 + j] = t8[j]; }
              float o[16];
#pragma unroll
              for (int i = 0; i < 16; ++i) o[i] = h[i] * rn * gh[i] * (ml ? sigmoid_f(ga[i]) : silu_f(ga[i]));
              bf16* op = mixb + (size_t)tg * DM + (ml ? 0 : 1024) + hc;
              u32x4 w0, w1; w0.x = pk2(o[0], o[1]); w0.y = pk2(o[2], o[3]); w0.z = pk2(o[4], o[5]); w0.w = pk2(o[6], o[7]); w1.x = pk2(o[8], o[9]); w1.y = pk2(o[10], o[11]); w1.z = pk2(o[12], o[13]); w1.w = pk2(o[14], o[15]);
              *(GAS u32x4*)op = w0; *(GAS u32x4*)(op + 8) = w1;
            }
            __syncthreads();
        }
    }
}
DI void phase_r1(const Args& a, int lane, int wave, int vcu, int G) {
    const int gw = vcu * NWAVES + wave, NGW = G * NWAVES;
    const float* x = (const float*)a.in[IN_X]; const float* mix = (const float*)(a.ws + WS_B); float* x1 = a.out; bf16* h2 = (bf16*)(a.ws + WS_A);
    const GAS f32x4* gp = (const GAS f32x4*)a.in[IN_GPOST] + lane; const GAS f32x4* gf = (const GAS f32x4*)a.in[IN_GFPRE] + lane;
    for (int m = gw; m < SEQ; m += NGW) {
        const GAS f32x4* mr = (const GAS f32x4*)(mix + (size_t)m * DM) + lane; const GAS f32x4* xr = (const GAS f32x4*)(x + (size_t)m * DM) + lane;
        f32x4 v[8]; float s = 0.f;
#pragma unroll
        for (int j = 0; j < 8; ++j) { v[j] = mr[64 * j]; s += (v[j].x * v[j].x + v[j].y * v[j].y) + (v[j].z * v[j].z + v[j].w * v[j].w); }
        const float r = 1.0f / sqrtf(wave_sum(s) * (1.0f / DM) + NORM_EPS); float s2 = 0.f;
        GAS f32x4* xo = (GAS f32x4*)(x1 + (size_t)m * DM) + lane;
#pragma unroll
        for (int j = 0; j < 8; ++j) { const f32x4 xx = xr[64 * j], gg = gp[64 * j]; v[j] = xx + v[j] * r * gg; xo[64 * j] = v[j]; s2 += (v[j].x * v[j].x + v[j].y * v[j].y) + (v[j].z * v[j].z + v[j].w * v[j].w); }
        const float r2 = 1.0f / sqrtf(wave_sum(s2) * (1.0f / DM) + NORM_EPS);
        GAS u32x2* o = (GAS u32x2*)(h2 + (size_t)m * DM) + lane;
#pragma unroll
        for (int j = 0; j < 8; ++j) { const f32x4 gg = gf[64 * j]; u32x2 w; w.x = pk2(v[j].x * r2 * gg.x, v[j].y * r2 * gg.y); w.y = pk2(v[j].z * r2 * gg.z, v[j].w * r2 * gg.w); o[64 * j] = w; }
    }
}
DI void phase_r2(const Args& a, int lane, int wave, int vcu, int G, bool poison) {
    const int gw = vcu * NWAVES + wave, NGW = G * NWAVES;
    const float* ff = (const float*)(a.ws + WS_FF); float* out = a.out; const GAS f32x4* gp = (const GAS f32x4*)a.in[IN_GFPOST] + lane;
    const float qn = __builtin_nanf("");
    for (int m = gw; m < SEQ; m += NGW) {
        const GAS f32x4* fr = (const GAS f32x4*)(ff + (size_t)m * DM) + lane; GAS f32x4* xo = (GAS f32x4*)(out + (size_t)m * DM) + lane;
        f32x4 v[8]; float s = 0.f;
#pragma unroll
        for (int j = 0; j < 8; ++j) { v[j] = fr[64 * j]; s += (v[j].x * v[j].x + v[j].y * v[j].y) + (v[j].z * v[j].z + v[j].w * v[j].w); }
        const float r = 1.0f / sqrtf(wave_sum(s) * (1.0f / DM) + NORM_EPS);
#pragma unroll
        for (int j = 0; j < 8; ++j) { const f32x4 gg = gp[64 * j]; f32x4 o = xo[64 * j] + v[j] * r * gg; if (poison) o = (f32x4){qn, qn, qn, qn}; xo[64 * j] = o; }
    }
}

__global__ void __launch_bounds__(NTHR, 2) fwd(Args a) {
    extern __shared__ __attribute__((aligned(16))) unsigned char lds_raw[];
    ldsp lds = (ldsp)lds_raw;
    const int tid = threadIdx.x, lane = tid & 63, wave = __builtin_amdgcn_readfirstlane(tid >> 6);
    const int G = gridDim.x; const int bx = blockIdx.x; const int vcu = (G % 8 == 0) ? (bx % 8) * (G / 8) + bx / 8 : bx;
    volatile LAS unsigned* MISC = (volatile LAS unsigned*)(lds + MISC_OFF);
    if (tid < 32) MISC[tid] = 0u;
    __syncthreads();
    unsigned* ctl = (unsigned*)(a.ws + WS_CTL);
    XcdBarrier bar; bar.bar = ctl + CW_BAR; bar.x = 0; bar.st = nullptr;
    if (N_LAUNCHES == 1) bar = xcd_barrier_post(ctl + CW_BAR, MISC + 8);
    const int lo = a.ph_lo, hi = a.ph_hi;
#define IN(k) (lo <= (k) && (k) < hi)
#define SEAM(k) do { if (IN(k) && IN((k) + 1)) xcd_barrier(bar); } while (0)

    if (IN(0)) { phase_p0(a, lds, tid, lane, wave, vcu, G); SEAM(0); }
    if (IN(1)) {
        phase_gates(a, tid, vcu, G);
        __syncthreads();
        pg8::Gemm g{(const bf16*)(a.ws + WS_A), (const bf16*)(a.ws + WS_WIN), SEQ, NPJ, DM}; pg8::StaticOrder S; S.init(SEQ, NPJ, G, bx);
        pg8::EpiBf16 E{(bf16*)(a.ws + WS_B), NPJ};
        pg8::gemm_phase<pg8::EpiBf16, pg8::StaticOrder, true, true>(lds, g, S, E);
        SEAM(1);
    }
    if (IN(2)) { phase_m1(a, lds, tid, lane, wave, vcu, G); SEAM(2); }
    if (IN(3)) { phase_m2(a, tid, vcu, G); SEAM(3); }
    if (IN(4)) { phase_m3(a, lds, tid, lane, wave, vcu, G); SEAM(4); }
    if (IN(5)) {
        pg8::Gemm g{(const bf16*)a.out, (const bf16*)(a.ws + WS_WO), SEQ, DM, DM}; pg8::StaticOrder S; S.init(SEQ, DM, G, bx);
        pg8::EpiF32 E{(float*)(a.ws + WS_B), DM};
        pg8::gemm_phase<pg8::EpiF32, pg8::StaticOrder, true, true>(lds, g, S, E);
        SEAM(5);
    }
    if (IN(6)) { phase_r1(a, lane, wave, vcu, G); SEAM(6); }
    if (IN(7)) {
        pg8::Gemm g{(const bf16*)(a.ws + WS_A), (const bf16*)(a.ws + WS_WGU), SEQ, 2 * DFF, DM}; pg8::StaticOrder S; S.init(SEQ, 2 * DFF, G, bx);
        pg8::EpiSwiGLU E{(bf16*)(a.ws + WS_B), DFF};
        pg8::gemm_phase<pg8::EpiSwiGLU, pg8::StaticOrder, true, true>(lds, g, S, E);
        SEAM(7);
    }
    if (IN(8)) {
        pg8::Gemm g{(const bf16*)(a.ws + WS_B), (const bf16*)(a.ws + WS_WD), SEQ, DM, DFF}; pg8::StaticOrder S; S.init(SEQ, DM, G, bx);
        pg8::EpiF32 E{(float*)(a.ws + WS_FF), DM};
        pg8::gemm_phase<pg8::EpiF32, pg8::StaticOrder, true, true>(lds, g, S, E);
        SEAM(8);
    }
    if (IN(9)) {
        bool poison = false;
        if (N_LAUNCHES == 1) poison = __hip_atomic_load(ctl + CW_BAR + XB_TMO, __ATOMIC_RELAXED, __HIP_MEMORY_SCOPE_AGENT) != 0u;
        phase_r2(a, lane, wave, vcu, G, poison);
    }
#undef IN
#undef SEAM
}

extern "C" void kernel_launch(void* const* d_in, const int* in_sizes, int n_in, void* d_out, int out_size, void* d_ws, size_t ws_size, hipStream_t stream) {
    static int grid = 0;
    if (grid == 0) {
        if (n_in != 17 || in_sizes[0] != SEQ * DM || out_size != SEQ * DM || ws_size < WS_END) {
            fprintf(stderr, "kernel_launch: unexpected shapes (n_in %d, in0 %d, out %d, ws %zu); nothing launched\n", n_in, n_in > 0 ? in_sizes[0] : -1, out_size, ws_size); grid = -1; return; }
        int dev = 0, cus = 0, per_cu = 0;
        if (hipGetDevice(&dev) != hipSuccess || hipDeviceGetAttribute(&cus, hipDeviceAttributeMultiprocessorCount, dev) != hipSuccess) { grid = -1; return; }
        if (hipFuncSetAttribute((const void*)fwd, hipFuncAttributeMaxDynamicSharedMemorySize, LDS_BYTES) != hipSuccess) { fprintf(stderr, "kernel_launch: hipFuncSetAttribute failed\n"); grid = -1; return; }
        if (hipOccupancyMaxActiveBlocksPerMultiprocessor(&per_cu, (const void*)fwd, NTHR, LDS_BYTES) != hipSuccess || per_cu < 1)
            fprintf(stderr, "kernel_launch: note: occupancy query reports %d workgroups per CU\n", per_cu);
        (void)hipGetLastError();
        grid = cus;
    }
    if (grid < 0) return;
    if (hipMemsetAsync((char*)d_ws + WS_CTL, 0, CTL_ZERO_BYTES, stream) != hipSuccess) return;
    Args a{};
    for (int i = 0; i < 17; ++i) a.in[i] = d_in[i];
    a.out = (float*)d_out; a.ws = (unsigned char*)d_ws;
    if (N_LAUNCHES == 1) { a.ph_lo = 0; a.ph_hi = NPHASES; a.li = 0; hipLaunchKernelGGL(fwd, dim3(grid), dim3(NTHR), LDS_BYTES, stream, a); }
    else for (int li = 0; li < NPHASES; ++li) { a.ph_lo = li; a.ph_hi = li + 1; a.li = li; hipLaunchKernelGGL(fwd, dim3(grid), dim3(NTHR), LDS_BYTES, stream, a); }
}
```

```cpp
#include <hip/hip_runtime.h>
#include <cstdio>
#include <cstdint>

#ifndef MK_N_LAUNCHES
#define MK_N_LAUNCHES 1
#endif

namespace pg8 {
#define PG8_LAS __attribute__((address_space(3)))
typedef unsigned short bf16_t;
typedef short bf16x8 __attribute__((ext_vector_type(8)));
typedef float f32x4 __attribute__((ext_vector_type(4)));
typedef unsigned u32x4 __attribute__((ext_vector_type(4)));
constexpr int BM = 256, BK = 64, HALF = 128, HTB = HALF * BK * 2  , STAGE_BYTES = 8 * HTB, NXCD = 8, WGM = 8;

__host__ __device__ __forceinline__ int lds_byte(int r, int c) { const int st = (r >> 4) * 2 + (c >> 5), rr = r & 15, cc = c & 31, ob = rr * 64 + cc * 2; return st * 1024 + (ob ^ (((ob >> 9) & 1) << 5)); }
__host__ __device__ __forceinline__ void stage_rc(int b, int& R, int& C) { const int st = b / 1024, sb = b % 1024, swz = sb ^ (((sb >> 9) & 1) << 5); R = (st >> 1) * 16 + swz / 64; C = (st & 1) * 32 + (swz % 64) / 2; }
__host__ __device__ __forceinline__ int perm32(int rho) { const int n = rho >> 4, i = rho & 15; return 8 * (i >> 2) + 4 * n + (i & 3); }

struct Unit { int pm, pn; };
struct Gemm { const bf16_t* A; const bf16_t* Bt; int M, N, K; };

struct StaticOrder {
    int nM, nN, nwg, G, c;
    __host__ __device__ void init(int M, int N, int G_, int c_) { nM = M / BM; nN = N / BM; nwg = nM * nN; G = G_; c = c_; }
    __host__ __device__ bool next(int i, Unit& u) const {
        const long L = (long)i * G + c; if (L >= nwg) return false;
        int wgid = (int)L; { const int q = nwg / NXCD, r = nwg % NXCD, xcd = wgid % NXCD, off = wgid / NXCD; wgid = (xcd < r ? xcd * (q + 1) : r * (q + 1) + (xcd - r) * q) + off; }
        const int nig = WGM * nN, gid = wgid / nig, fm = gid * WGM, gsz = (nM - fm) < WGM ? (nM - fm) : WGM;
        u.pm = fm + ((wgid % nig) % gsz); u.pn = (wgid % nig) / gsz; return true;
    }
    __device__ __forceinline__ void a_ready(const Unit&) const {}
    __device__ __forceinline__ void done(const Unit&) const {}
};

__device__ __forceinline__ unsigned cvt_pk_bf16(float lo, float hi) { unsigned r; asm volatile("v_cvt_pk_bf16_f32 %0, %1, %2" : "=v"(r) : "v"(lo), "v"(hi)); return r; }

struct EpiF32 {
    static constexpr bool PERM = false, AFTER_DRAIN = false;
    float* C; int ldc;
    __device__ __forceinline__ void operator()(const f32x4 (&acc)[2][2][4][2], const Unit& u, int wr, int wc, int fr, int fq) const {
        const int row0 = u.pm * BM + wr * 64 + fr, col0 = u.pn * BM + wc * 32 + 4 * fq;
#pragma unroll
        for (int ai = 0; ai < 2; ++ai)
#pragma unroll
            for (int m = 0; m < 4; ++m) { float* rowp = C + (size_t)(row0 + ai * HALF + m * 16) * ldc + col0;
#pragma unroll
                for (int bj = 0; bj < 2; ++bj)
#pragma unroll
                    for (int n = 0; n < 2; ++n) *(f32x4*)(rowp + bj * HALF + n * 16) = acc[ai][bj][m][n]; }
    }
};
struct EpiBf16 {
    static constexpr bool PERM = true, AFTER_DRAIN = false;
    bf16_t* O; int ldc;
    __device__ __forceinline__ void operator()(const f32x4 (&acc)[2][2][4][2], const Unit& u, int wr, int wc, int fr, int fq) const {
        const int row0 = u.pm * BM + wr * 64 + fr, col0 = u.pn * BM + wc * 32 + 8 * fq;
#pragma unroll
        for (int ai = 0; ai < 2; ++ai)
#pragma unroll
            for (int m = 0; m < 4; ++m) { bf16_t* rowp = O + (size_t)(row0 + ai * HALF + m * 16) * ldc + col0;
#pragma unroll
                for (int bj = 0; bj < 2; ++bj) { const f32x4 v0 = acc[ai][bj][m][0], v1 = acc[ai][bj][m][1];
                    u32x4 w; w.x = cvt_pk_bf16(v0[0], v0[1]); w.y = cvt_pk_bf16(v0[2], v0[3]); w.z = cvt_pk_bf16(v1[0], v1[1]); w.w = cvt_pk_bf16(v1[2], v1[3]);
                    *(u32x4*)(rowp + bj * HALF) = w; } }
    }
};
__device__ __forceinline__ float silu_f(float x) { return x / (1.0f + __expf(-x)); }
struct EpiSwiGLU {
    static constexpr bool PERM = true, AFTER_DRAIN = false;
    bf16_t* O; int ldc;
    __device__ __forceinline__ void operator()(const f32x4 (&acc)[2][2][4][2], const Unit& u, int wr, int wc, int fr, int fq) const {
        const int row0 = u.pm * BM + wr * 64 + fr, col0 = u.pn * HALF + wc * 32 + 8 * fq;
#pragma unroll
        for (int ai = 0; ai < 2; ++ai)
#pragma unroll
            for (int m = 0; m < 4; ++m) { bf16_t* rowp = O + (size_t)(row0 + ai * HALF + m * 16) * ldc + col0;
                const f32x4 g0 = acc[ai][0][m][0], g1 = acc[ai][0][m][1], u0 = acc[ai][1][m][0], u1 = acc[ai][1][m][1];
                u32x4 w; w.x = cvt_pk_bf16(silu_f(g0[0]) * u0[0], silu_f(g0[1]) * u0[1]); w.y = cvt_pk_bf16(silu_f(g0[2]) * u0[2], silu_f(g0[3]) * u0[3]);
                w.z = cvt_pk_bf16(silu_f(g1[0]) * u1[0], silu_f(g1[1]) * u1[1]); w.w = cvt_pk_bf16(silu_f(g1[2]) * u1[2], silu_f(g1[3]) * u1[3]);
                *(u32x4*)rowp = w; }
    }
};

template <class Epi, class Sched, bool ALIGN_EPI = false, bool SP2 = false>
__device__ __forceinline__ void gemm_phase(PG8_LAS unsigned char* lds, const Gemm g, const Sched& S, const Epi& E) {
    const int tid = threadIdx.x, wid = __builtin_amdgcn_readfirstlane(tid >> 6), lane = tid & 63, wr = wid >> 2, wc = wid & 3, fr = lane & 15, fq = lane >> 4;
    const int K = g.K, nt = K / BK;
    unsigned voffA[2], voffB[2];
#pragma unroll
    for (int i = 0; i < 2; ++i) { int R, C; stage_rc(tid * 16 + i * 8192, R, C); const int Rb = Epi::PERM ? ((R & ~31) + perm32(R & 31)) : R;
        voffA[i] = (unsigned)(R * K + C) * 2u; voffB[i] = (unsigned)(Rb * K + C) * 2u; }
    const size_t kstep = (size_t)(BK * 2);
    const size_t hstep = (size_t)HALF * K * 2;
    const size_t tstep = 2 * hstep;
    const unsigned ldsw = (unsigned)wid * 1024u;
    const int aoff = lds_byte(wr * 64 + fr, fq * 8), boff = lds_byte(wc * 32 + fr, fq * 8);
#define PG8_SA(b, h) (((b) * 2 + (h)) * HTB)
#define PG8_SB(b, h) ((4 + (b) * 2 + (h)) * HTB)
#define PG8_STAGE(bufoff, gbase, voff) do { _Pragma("unroll") for (int _i = 0; _i < 2; ++_i) \
        __builtin_amdgcn_global_load_lds((const unsigned*)((const char*)(gbase) + (voff)[_i]), (PG8_LAS unsigned*)(lds + (bufoff) + ldsw + _i * 8192), 16, 0, 0); } while (0)
#define PG8_LDA(dst, b, h) do { _Pragma("unroll") for (int m = 0; m < 4; ++m) _Pragma("unroll") for (int k = 0; k < 2; ++k) dst[m][k] = *(const PG8_LAS bf16x8*)(lds + PG8_SA(b, h) + aoff + m * 2048 + k * 1024); } while (0)
#define PG8_LDB(dst, b, h) do { _Pragma("unroll") for (int n = 0; n < 2; ++n) _Pragma("unroll") for (int k = 0; k < 2; ++k) dst[n][k] = *(const PG8_LAS bf16x8*)(lds + PG8_SB(b, h) + boff + n * 2048 + k * 1024); } while (0)
#define PG8_MMA(ai, bj, At, Bt) do { __builtin_amdgcn_s_setprio(1); _Pragma("unroll") for (int m = 0; m < 4; ++m) _Pragma("unroll") for (int n = 0; n < 2; ++n) _Pragma("unroll") for (int k = 0; k < 2; ++k) \
        acc[ai][bj][m][n] = __builtin_amdgcn_mfma_f32_16x16x32_bf16(Bt[n][k], At[m][k], acc[ai][bj][m][n], 0, 0, 0); __builtin_amdgcn_s_setprio(0); } while (0)
#define PG8_WAIT_V(n) asm volatile("s_waitcnt vmcnt(" #n ")" ::: "memory")
#define PG8_WAIT_L(n) asm volatile("s_waitcnt lgkmcnt(" #n ")" ::: "memory")
#define PG8_BAR __builtin_amdgcn_s_barrier()
#define PG8_SCHED __builtin_amdgcn_sched_barrier(0)
    Unit cur, nxt; int ui = 0;
    if (!S.next(0, cur)) return;
    f32x4 acc[2][2][4][2];
#pragma unroll
    for (int a = 0; a < 2; ++a)
#pragma unroll
        for (int b = 0; b < 2; ++b)
#pragma unroll
            for (int m = 0; m < 4; ++m)
#pragma unroll
                for (int n = 0; n < 2; ++n) acc[a][b][m][n] = (f32x4){0.f, 0.f, 0.f, 0.f};
    bf16x8 At[4][2], B0[2][2], B1[2][2];
    const char* cA = (const char*)g.A + (size_t)cur.pm * tstep; const char* cB = (const char*)g.Bt + (size_t)cur.pn * tstep;
    S.a_ready(cur);
    if constexpr (SP2) {
        PG8_STAGE(PG8_SB(0, 0), cB, voffB); PG8_STAGE(PG8_SB(0, 1), cB + hstep, voffB); PG8_STAGE(PG8_SA(0, 0), cA, voffA); PG8_STAGE(PG8_SA(0, 1), cA + hstep, voffA);
        if (wr == 1) PG8_BAR;
        PG8_WAIT_V(2); PG8_BAR;
        PG8_STAGE(PG8_SB(1, 0), cB + kstep, voffB); PG8_STAGE(PG8_SA(1, 0), cA + kstep, voffA); PG8_STAGE(PG8_SB(1, 1), cB + hstep + kstep, voffB);
        PG8_WAIT_V(6); PG8_BAR;
    } else {
        PG8_STAGE(PG8_SB(0, 0), cB, voffB); PG8_STAGE(PG8_SA(0, 0), cA, voffA); PG8_STAGE(PG8_SB(0, 1), cB + hstep, voffB); PG8_STAGE(PG8_SA(0, 1), cA + hstep, voffA);
        if (wr == 1) PG8_BAR;
        PG8_WAIT_V(4); PG8_BAR;
        PG8_STAGE(PG8_SB(1, 0), cB + kstep, voffB); PG8_STAGE(PG8_SA(1, 0), cA + kstep, voffA); PG8_STAGE(PG8_SB(1, 1), cB + hstep + kstep, voffB);
        PG8_WAIT_V(6); PG8_BAR;
    }
    for (;;) {
        const bool has_next = S.next(ui + 1, nxt);
        const char* nA = has_next ? (const char*)g.A + (size_t)nxt.pm * tstep : cA; const char* nB = has_next ? (const char*)g.Bt + (size_t)nxt.pn * tstep : cB;
        for (int t = 0; t < nt; t += 2) {
            const bool last = (t == nt - 2);
            const char* a1 = cA + (size_t)(t + 1) * kstep;
            const char* a2 = last ? nA : cA + (size_t)(t + 2) * kstep; const char* b2 = last ? nB : cB + (size_t)(t + 2) * kstep;
            const char* a3 = a2 + kstep; const char* b3 = b2 + kstep;
            if (last && has_next) S.a_ready(nxt);
            if constexpr (SP2) {
            PG8_LDB(B0, 0, 0); PG8_LDB(B1, 0, 1); PG8_SCHED; PG8_LDA(At, 0, 0); PG8_STAGE(PG8_SA(1, 1), a1 + hstep, voffA);
            PG8_WAIT_V(8); PG8_WAIT_L(0); PG8_BAR; PG8_MMA(0, 0, At, B0); PG8_MMA(0, 1, At, B1); PG8_BAR; PG8_SCHED;
            PG8_LDA(At, 0, 1); PG8_STAGE(PG8_SB(0, 0), b2, voffB); PG8_STAGE(PG8_SB(0, 1), b2 + hstep, voffB); PG8_STAGE(PG8_SA(0, 0), a2, voffA);
            PG8_WAIT_V(8); PG8_WAIT_L(0); PG8_BAR; PG8_MMA(1, 0, At, B0); PG8_MMA(1, 1, At, B1); PG8_BAR; PG8_SCHED;
            PG8_LDB(B0, 1, 0); PG8_LDB(B1, 1, 1); PG8_SCHED; PG8_LDA(At, 1, 0); PG8_STAGE(PG8_SA(0, 1), a2 + hstep, voffA);
            PG8_WAIT_V(8); PG8_WAIT_L(0); PG8_BAR; PG8_MMA(0, 0, At, B0); PG8_MMA(0, 1, At, B1); PG8_BAR; PG8_SCHED;
            PG8_LDA(At, 1, 1); PG8_STAGE(PG8_SB(1, 0), b3, voffB); PG8_STAGE(PG8_SB(1, 1), b3 + hstep, voffB); PG8_STAGE(PG8_SA(1, 0), a3, voffA);
            PG8_WAIT_V(8); PG8_WAIT_L(0); PG8_BAR; PG8_MMA(1, 0, At, B0); PG8_MMA(1, 1, At, B1); PG8_BAR; PG8_SCHED;
            } else {
            PG8_LDB(B0, 0, 0); PG8_SCHED; PG8_LDA(At, 0, 0); PG8_STAGE(PG8_SA(1, 1), a1 + hstep, voffA);
            PG8_WAIT_L(8); PG8_BAR; PG8_WAIT_L(0); PG8_MMA(0, 0, At, B0); PG8_BAR; PG8_SCHED;
            PG8_LDB(B1, 0, 1); PG8_STAGE(PG8_SB(0, 0), b2, voffB);
            PG8_BAR; PG8_WAIT_L(0); PG8_MMA(0, 1, At, B1); PG8_BAR;
            PG8_LDA(At, 0, 1); PG8_STAGE(PG8_SA(0, 0), a2, voffA);
            PG8_BAR; PG8_WAIT_L(0); PG8_MMA(1, 0, At, B0); PG8_BAR; PG8_SCHED;
            PG8_STAGE(PG8_SB(0, 1), b2 + hstep, voffB);
            PG8_WAIT_V(6); PG8_BAR; PG8_MMA(1, 1, At, B1); PG8_BAR;
            PG8_LDB(B0, 1, 0); PG8_SCHED; PG8_LDA(At, 1, 0); PG8_STAGE(PG8_SA(0, 1), a2 + hstep, voffA);
            PG8_WAIT_L(8); PG8_BAR; PG8_WAIT_L(0); PG8_MMA(0, 0, At, B0); PG8_BAR; PG8_SCHED;
            PG8_LDB(B1, 1, 1); PG8_STAGE(PG8_SB(1, 0), b3, voffB);
            PG8_BAR; PG8_WAIT_L(0); PG8_MMA(0, 1, At, B1); PG8_BAR;
            PG8_LDA(At, 1, 1); PG8_STAGE(PG8_SA(1, 0), a3, voffA);
            PG8_BAR; PG8_WAIT_L(0); PG8_MMA(1, 0, At, B0); PG8_BAR; PG8_SCHED;
            PG8_STAGE(PG8_SB(1, 1), b3 + hstep, voffB);
            PG8_WAIT_V(6); PG8_BAR; PG8_MMA(1, 1, At, B1); PG8_BAR;
            }
        }
        if constexpr (ALIGN_EPI) { if (wr == 0) PG8_BAR; }
        if constexpr (!Epi::AFTER_DRAIN) { E(acc, cur, wr, wc, fr, fq); S.done(cur); }
        if (!has_next) break;
#pragma unroll
        for (int a = 0; a < 2; ++a)
#pragma unroll
            for (int b = 0; b < 2; ++b)
#pragma unroll
                for (int m = 0; m < 4; ++m)
#pragma unroll
                    for (int n = 0; n < 2; ++n) acc[a][b][m][n] = (f32x4){0.f, 0.f, 0.f, 0.f};
        cur = nxt; cA = nA; cB = nB; ++ui;
        if constexpr (ALIGN_EPI) { if (wr == 1) PG8_BAR; }
    }
    PG8_WAIT_V(0);
    if constexpr (!ALIGN_EPI) { if (wr == 0) PG8_BAR; }
    PG8_BAR;
#undef PG8_SA
#undef PG8_SB
#undef PG8_STAGE
#undef PG8_LDA
#undef PG8_LDB
#undef PG8_MMA
#undef PG8_WAIT_V
#undef PG8_WAIT_L
#undef PG8_BAR
#undef PG8_SCHED
}
}

constexpr int NWAVES = 8, NTHR = 512;
constexpr int SEQ = 16384, DM = 2048, HD = 128, NHG = 8, DPROJ = 8208, NPJ = 8192, DFF = 5632, CH = 128, NCH = SEQ / CH, NHEADS = 16;
constexpr float NORM_EPS = 1e-6f;
constexpr int N_LAUNCHES = MK_N_LAUNCHES, NPHASES = 10;
constexpr int PC_MQ = 0, PC_MK = 1024, PC_MV = 2048, PC_MO = 3072, PC_RQ = 4096, PC_RK = 5120, PC_RV = 6144, PC_RG = 7168;

constexpr size_t MiB = 1u << 20;
constexpr size_t WS_CTL = 0, CTL_ZERO_BYTES = 64 * 1024;
constexpr size_t WS_WIN = 2 * MiB, WS_WO = 34 * MiB, WS_WGU = 42 * MiB, WS_WD = 86 * MiB;
constexpr size_t WS_PRE = 108 * MiB;
constexpr size_t WS_RS = 109 * MiB;
constexpr size_t WS_NLOC = 110 * MiB;
constexpr size_t WS_N0 = 110 * MiB + 512 * 1024;
constexpr size_t WS_DEC = 111 * MiB;
constexpr size_t WS_GHEAD = 111 * MiB + 65536;
constexpr size_t WS_COS = 112 * MiB, WS_SIN = 116 * MiB;
constexpr size_t WS_B = 128 * MiB;
constexpr size_t WS_A = 384 * MiB;
constexpr size_t WS_FF = WS_B + 176 * MiB;
constexpr size_t WS_END = 448 * MiB;
constexpr int CW_BAR = 1024;

constexpr int RING_BYTES = 131072;
constexpr int GATE_OFF = RING_BYTES;
constexpr int MISC_OFF = RING_BYTES + 2048;
constexpr int LDS_BYTES = 147456;

#define GAS __attribute__((address_space(1)))
#define LAS __attribute__((address_space(3)))
#define DI __device__ __forceinline__
typedef unsigned short bf16;
typedef unsigned u32x4 __attribute__((ext_vector_type(4)));
typedef unsigned u32x2 __attribute__((ext_vector_type(2)));
typedef float f32x4 __attribute__((ext_vector_type(4)));
typedef float f32x2 __attribute__((ext_vector_type(2)));
typedef LAS unsigned char* ldsp;
#define LDS_WAIT() asm volatile("s_waitcnt lgkmcnt(0)" ::: "memory")

DI unsigned f2bf(float f) { unsigned u = __builtin_bit_cast(unsigned, f); return (u + 0x7fffu + ((u >> 16) & 1u)) >> 16; }
DI unsigned pk2(float lo, float hi) { return f2bf(lo) | (f2bf(hi) << 16); }
DI float bflo(unsigned w) { return __builtin_bit_cast(float, w << 16); }
DI float bfhi(unsigned w) { return __builtin_bit_cast(float, w & 0xffff0000u); }
DI void unpack8(const u32x4 w, float (&f)[8]) { f[0] = bflo(w.x); f[1] = bfhi(w.x); f[2] = bflo(w.y); f[3] = bfhi(w.y); f[4] = bflo(w.z); f[5] = bfhi(w.z); f[6] = bflo(w.w); f[7] = bfhi(w.w); }
DI u32x4 pack8(const float (&f)[8]) { u32x4 w; w.x = pk2(f[0], f[1]); w.y = pk2(f[2], f[3]); w.z = pk2(f[4], f[5]); w.w = pk2(f[6], f[7]); return w; }
DI float sigmoid_f(float x) { return 1.0f / (1.0f + __expf(-x)); }
DI float silu_f(float x) { return x / (1.0f + __expf(-x)); }
DI float wave_sum(float v) {
#pragma unroll
    for (int o = 1; o < 64; o <<= 1) v += __shfl_xor(v, o);
    return v;
}

#define XB_TMO      128
#define XB_XCNT(j)  (256  + 64 * (j))
#define XB_XSUB(j)  (1280 + 64 * (j))
#define XB_XGEN(j)  (2304 + 64 * (j))
#define XB_TOP      3328
#define XB_TOPGEN   3392
#define XCD_BAR_WORDS 3456
#define XB_SPIN_CAP (1u << 18)
__device__ __forceinline__ unsigned xb_ld(unsigned* p)              { return __hip_atomic_load(p, __ATOMIC_RELAXED, __HIP_MEMORY_SCOPE_AGENT); }
__device__ __forceinline__ unsigned xb_add(unsigned* p, unsigned v) { return __hip_atomic_fetch_add(p, v, __ATOMIC_RELAXED, __HIP_MEMORY_SCOPE_AGENT); }
__device__ __forceinline__ unsigned xb_xcc_id() { return (unsigned)__builtin_amdgcn_s_getreg((3 << 11) | 20) & 0xFu; }
#define XB_SPIN(cond, bar) do { unsigned _sp = 0; while (cond) { __builtin_amdgcn_s_sleep(1); \
    if ((++_sp & 255u) == 0u) { if (xb_ld(&(bar)[XB_TMO])) break; if (_sp > XB_SPIN_CAP) { atomicAdd(&(bar)[XB_TMO], 1u); break; } } } } while (0)
struct XcdBarrier { unsigned* bar; unsigned x; volatile LAS unsigned* st; };
__device__ __forceinline__ XcdBarrier xcd_barrier_post(unsigned* bar, volatile LAS unsigned* st) {
    XcdBarrier b; b.bar = bar; b.x = xb_xcc_id(); b.st = st;
    if (threadIdx.x == 0) (void)xb_add(&bar[XB_XCNT(b.x)], 1u);
    return b;
}
__device__ __forceinline__ void xcd_barrier_complete(unsigned* bar, unsigned x, unsigned& nloc, unsigned& nx) {
    const unsigned G = gridDim.x * gridDim.y * gridDim.z;
    unsigned sum, cnt, mine, sp = 0u;
    for (;;) {
        sum = 0u; cnt = 0u; mine = 0u;
#pragma unroll
        for (unsigned j = 0; j < 16; ++j) { const unsigned c = xb_ld(&bar[XB_XCNT(j)]); sum += c; cnt += (c > 0u) ? 1u : 0u; mine = (j == x) ? c : mine; }
        if (sum == G) break;
        __builtin_amdgcn_s_sleep(1);
        if ((++sp & 255u) == 0u) { if (xb_ld(&bar[XB_TMO])) break; if (sp > XB_SPIN_CAP) { atomicAdd(&bar[XB_TMO], 1u); break; } }
    }
    nloc = mine > 0u ? mine : 1u; nx = cnt > 0u ? cnt : 1u;
}
__device__ __forceinline__ void xcd_barrier(const XcdBarrier& b) {
    asm volatile("s_waitcnt vmcnt(0)" ::: "memory");
    __syncthreads();
    if (threadIdx.x == 0) {
        unsigned* bar = b.bar;
        __builtin_amdgcn_s_waitcnt(0);
        unsigned nloc = b.st[0], nx = b.st[1];
        if (nloc == 0u) { xcd_barrier_complete(bar, b.x, nloc, nx); b.st[0] = nloc; b.st[1] = nx; }
        const unsigned old = xb_add(&bar[XB_XSUB(b.x)], 1u);
        const unsigned gen = old / nloc;
        if (old + 1u == (gen + 1u) * nloc) {
            __builtin_amdgcn_fence(__ATOMIC_RELEASE, "agent");
            asm volatile("s_waitcnt vmcnt(0)" ::: "memory");
            const unsigned og = xb_add(&bar[XB_TOP], 1u);
            const unsigned tg = og / nx;
            if (og + 1u == (tg + 1u) * nx) xb_add(&bar[XB_TOPGEN], 1u);
            else XB_SPIN(xb_ld(&bar[XB_TOPGEN]) == tg, bar);
            __builtin_amdgcn_fence(__ATOMIC_ACQUIRE, "agent");
            xb_add(&bar[XB_XGEN(b.x)], 1u);
            asm volatile("s_waitcnt vmcnt(0)" ::: "memory");
        } else {
            XB_SPIN(xb_ld(&bar[XB_XGEN(b.x)]) == gen, bar);
            __builtin_amdgcn_fence(__ATOMIC_ACQUIRE, "agent");
            asm volatile("s_waitcnt vmcnt(0)" ::: "memory");
        }
    }
    __syncthreads();
}

struct Args { const void* in[17]; float* out; unsigned char* ws; int ph_lo, ph_hi, li, pad; };
enum { IN_X = 0, IN_POS, IN_GPRE, IN_WIN, IN_CW, IN_CB, IN_BI, IN_BF, IN_GMH, IN_GRH, IN_WOUT, IN_GPOST, IN_GFPRE, IN_WG, IN_WU, IN_WDN, IN_GFPOST };

DI void p0_transpose_item(const float* W, int K, int ldw, int src_col, bf16* WT, int dst_row, LAS float* scr, int kb, int lane) {
    const int k0 = 64 * kb;
#pragma unroll 8
    for (int i = 0; i < 32; ++i) { const int kk = 2 * i + (lane >> 5); scr[kk * 33 + (lane & 31)] = W[(size_t)(k0 + kk) * ldw + src_col + (lane & 31)]; }
    LDS_WAIT(); asm volatile("" ::: "memory");
    const int c = lane & 7;
#pragma unroll
    for (int j = 0; j < 4; ++j) { const int n = (lane >> 3) + 8 * j; const LAS float* s = scr + (8 * c) * 33 + n;
        u32x4 o; o.x = pk2(s[0 * 33], s[1 * 33]); o.y = pk2(s[2 * 33], s[3 * 33]); o.z = pk2(s[4 * 33], s[5 * 33]); o.w = pk2(s[6 * 33], s[7 * 33]);
        *(GAS u32x4*)(WT + (size_t)(dst_row + n) * K + k0 + 8 * c) = o; }
    LDS_WAIT(); asm volatile("" ::: "memory");
}
DI void phase_p0(const Args& a, ldsp lds, int tid, int lane, int wave, int vcu, int G) {
    const int gw = vcu * NWAVES + wave, NGW = G * NWAVES;
    LAS float* scr = (LAS float*)(lds + wave * 16384);
    const float* w_in = (const float*)a.in[IN_WIN]; const float* w_out = (const float*)a.in[IN_WOUT];
    const float* w_g = (const float*)a.in[IN_WG]; const float* w_u = (const float*)a.in[IN_WU]; const float* w_d = (const float*)a.in[IN_WDN];
    bf16* WinT = (bf16*)(a.ws + WS_WIN); bf16* WoT = (bf16*)(a.ws + WS_WO); bf16* WguT = (bf16*)(a.ws + WS_WGU); bf16* WdT = (bf16*)(a.ws + WS_WD);
    constexpr int I_IN = 32 * 256, I_O = 32 * 64, I_G = 32 * 176, I_D = 88 * 64, NITEMS = I_IN + I_O + 2 * I_G + I_D;
    for (int it = gw; it < NITEMS; it += NGW) {
        int r = it;
        if (r < I_IN) { const int kb = r / 256, nb = r % 256; const int sc = nb < 128 ? 32 * nb : 4112 + 32 * (nb - 128);
            p0_transpose_item(w_in, DM, DPROJ, sc, WinT, 32 * nb, scr, kb, lane); continue; } r -= I_IN;
        if (r < I_O) { const int kb = r / 64, nb = r % 64; p0_transpose_item(w_out, DM, DM, 32 * nb, WoT, 32 * nb, scr, kb, lane); continue; } r -= I_O;
        if (r < I_G) { const int kb = r / 176, nb = r % 176; p0_transpose_item(w_g, DM, DFF, 32 * nb, WguT, 256 * (nb >> 2) + 32 * (nb & 3), scr, kb, lane); continue; } r -= I_G;
        if (r < I_G) { const int kb = r / 176, nb = r % 176; p0_transpose_item(w_u, DM, DFF, 32 * nb, WguT, 256 * (nb >> 2) + 128 + 32 * (nb & 3), scr, kb, lane); continue; } r -= I_G;
        { const int kb = r / 64, nb = r % 64; p0_transpose_item(w_d, DFF, DM, 32 * nb, WdT, 32 * nb, scr, kb, lane); }
    }
    const float* x = (const float*)a.in[IN_X]; const float* gpre = (const float*)a.in[IN_GPRE];
    bf16* hb = (bf16*)(a.ws + WS_A); float* rs = (float*)(a.ws + WS_RS);
    for (int m = gw; m < SEQ; m += NGW) {
        const GAS f32x4* xr = (const GAS f32x4*)(x + (size_t)m * DM) + lane; const GAS f32x4* gr = (const GAS f32x4*)gpre + lane;
        f32x4 v[8]; float s = 0.f;
#pragma unroll
        for (int j = 0; j < 8; ++j) { v[j] = xr[64 * j]; s += (v[j].x * v[j].x + v[j].y * v[j].y) + (v[j].z * v[j].z + v[j].w * v[j].w); }
        const float r = 1.0f / sqrtf(wave_sum(s) * (1.0f / DM) + NORM_EPS);
        if (lane == 0) rs[m] = r;
        GAS u32x2* o = (GAS u32x2*)(hb + (size_t)m * DM) + lane;
#pragma unroll
        for (int j = 0; j < 8; ++j) { const f32x4 gg = gr[64 * j]; u32x2 w; w.x = pk2(v[j].x * r * gg.x, v[j].y * r * gg.y); w.y = pk2(v[j].z * r * gg.z, v[j].w * r * gg.w); o[64 * j] = w; }
    }
    { float* GH = (float*)(a.ws + WS_GHEAD); const float* gmh = (const float*)a.in[IN_GMH]; const float* grh = (const float*)a.in[IN_GRH];
      for (int i = vcu * NTHR + tid; i < 1024; i += G * NTHR) GH[i] = gmh[i];
      for (int i = vcu * NTHR + tid; i < 1024; i += G * NTHR) GH[1024 + i] = grh[i]; }
    const int* pos = (const int*)a.in[IN_POS]; float* COS = (float*)(a.ws + WS_COS); float* SIN = (float*)(a.ws + WS_SIN);
    for (int i = vcu * NTHR + tid; i < SEQ * 64; i += G * NTHR) { const int t = i >> 6, j = i & 63;
        const float inv = (float)pow(10000.0, -(double)(2 * j) / 128.0); const float ang = (float)pos[t] * inv; float sn, cs; sincosf(ang, &sn, &cs); COS[i] = cs; SIN[i] = sn; }
}

DI void phase_gates(const Args& a, int tid, int vcu, int G) {
    const float* x = (const float*)a.in[IN_X]; const float* gpre = (const float*)a.in[IN_GPRE]; const float* w_in = (const float*)a.in[IN_WIN];
    const float* rs = (const float*)(a.ws + WS_RS); float* PRE = (float*)(a.ws + WS_PRE);
    for (int i = vcu * NTHR + tid; i < SEQ * 16; i += G * NTHR) { const int t = i >> 4, cc = i & 15;
        const float* xr = x + (size_t)t * DM; const float* wc = w_in + 4096 + cc; float acc = 0.f;
#pragma unroll 8
        for (int k = 0; k < DM; ++k) acc += xr[k] * gpre[k] * wc[(size_t)k * DPROJ];
        PRE[i] = acc * rs[t]; }
}

typedef short bf16x8 __attribute__((ext_vector_type(8)));
typedef float f32x16 __attribute__((ext_vector_type(16)));
#define MFMA32(a, b, c) __builtin_amdgcn_mfma_f32_32x32x16_bf16((a), (b), (c), 0, 0, 0)
DI int crow(int reg, int h) { return (reg & 3) + 8 * (reg >> 2) + 4 * h; }
DI bf16x8 bf_ones() { return (bf16x8){16256, 16256, 16256, 16256, 16256, 16256, 16256, 16256}; }
DI int tile_off(int row, int col) { return row * 256 + ((((col >> 3) ^ row) & 15) << 4) + ((col & 7) << 1); }
DI void store_row8(ldsp tile, int row, int col0, const float (&f)[8]) { *(LAS u32x4*)(tile + tile_off(row, col0)) = pack8(f); }
DI void store_T8(ldsp tile, int s, int d0, const float (&f)[8]) {
#pragma unroll
    for (int i = 0; i < 8; ++i) *(LAS unsigned short*)(tile + tile_off(d0 + i, s)) = (unsigned short)f2bf(f[i]);
}
DI void store_T8_bits(ldsp tile, int s, int d0, const u32x4 w) {
    const unsigned ww[4] = {w.x, w.y, w.z, w.w};
#pragma unroll
    for (int i = 0; i < 4; ++i) { *(LAS unsigned short*)(tile + tile_off(d0 + 2 * i, s)) = (unsigned short)(ww[i] & 0xffffu); *(LAS unsigned short*)(tile + tile_off(d0 + 2 * i + 1, s)) = (unsigned short)(ww[i] >> 16); }
}
DI void load_tile8(ldsp tile, int row, int col0, float (&f)[8]) { unpack8(*(const LAS u32x4*)(tile + tile_off(row, col0)), f); }
DI void gload8(const bf16* p, float (&f)[8]) { unpack8(*(const GAS u32x4*)p, f); }
DI bf16x8 ldfrag(ldsp tile, int row, int col0) { return *(const LAS bf16x8*)(tile + tile_off(row, col0)); }

DI void mixer_gates(const Args& a, ldsp lds, int g, int c, int tid, int lane, int wave) {
    LAS float* rowv = (LAS float*)(lds + GATE_OFF); LAS float* colv = rowv + 128; LAS float* alog = rowv + 256;
    if (g < NHG) {
        if (wave == 0) {
            const float* PRE = (const float*)(a.ws + WS_PRE); const float bi = ((const float*)a.in[IN_BI])[g], bfg = ((const float*)a.in[IN_BF])[g];
            const int t0 = c * CH + 2 * lane;
            const float i0 = PRE[(size_t)t0 * 16 + g] + bi, i1 = PRE[(size_t)(t0 + 1) * 16 + g] + bi;
            const float f0 = PRE[(size_t)t0 * 16 + 8 + g] + bfg, f1 = PRE[(size_t)(t0 + 1) * 16 + 8 + g] + bfg;
            const float l0 = fminf(f0, 0.f) - log1pf(__expf(-fabsf(f0))), l1 = fminf(f1, 0.f) - log1pf(__expf(-fabsf(f1)));
            float p = l0 + l1;
#pragma unroll
            for (int o = 1; o < 64; o <<= 1) { const float y = __shfl_up(p, o); if (lane >= o) p += y; }
            const float b1 = p, b0 = p - l1;
            rowv[2 * lane] = b0; rowv[2 * lane + 1] = b1; alog[2 * lane] = b0; alog[2 * lane + 1] = b1; colv[2 * lane] = i0 - b0; colv[2 * lane + 1] = i1 - b1;
        }
    } else if (tid < 128) {
        const float lg = log1pf(-exp2f(-5.0f - (float)(g - NHG)));
        rowv[tid] = (float)tid * lg; colv[tid] = -(float)tid * lg; alog[tid] = (float)(tid + 1) * lg;
    }
    LDS_WAIT(); __syncthreads();
}
DI void conv8(const bf16* proj, const float* cw, const float* cb, int t, int col, float (&o)[8]) {
    float acc[8];
    { const f32x4 b0 = *(const GAS f32x4*)(cb + col), b1 = *(const GAS f32x4*)(cb + col + 4); acc[0] = b0.x; acc[1] = b0.y; acc[2] = b0.z; acc[3] = b0.w; acc[4] = b1.x; acc[5] = b1.y; acc[6] = b1.z; acc[7] = b1.w; }
#pragma unroll
    for (int j = 0; j < 4; ++j) { const int tt = t - 3 + j;
        if (tt >= 0) { float u[8]; gload8(proj + (size_t)tt * NPJ + col, u);
            const f32x4 w0 = *(const GAS f32x4*)(cw + j * 2048 + col), w1 = *(const GAS f32x4*)(cw + j * 2048 + col + 4);
            acc[0] += w0.x * u[0]; acc[1] += w0.y * u[1]; acc[2] += w0.z * u[2]; acc[3] += w0.w * u[3]; acc[4] += w1.x * u[4]; acc[5] += w1.y * u[5]; acc[6] += w1.z * u[6]; acc[7] += w1.w * u[7]; } }
#pragma unroll
    for (int i = 0; i < 8; ++i) o[i] = silu_f(acc[i]);
}
template <int MODE> DI void mixer_tiles(const Args& a, ldsp lds, int g, int c, int tid) {
    const bf16* proj = (const bf16*)(a.ws + WS_B);
    const LAS float* rowv = (const LAS float*)(lds + GATE_OFF); const LAS float* colv = rowv + 128;
    ldsp T0 = lds, T1 = lds + 32768, T2 = lds + 65536; ldsp TV = MODE == 1 ? T1 : T2;
    const float kscale = 0.08838834764831845f;
    if (g < NHG) {
        const float* cw = (const float*)a.in[IN_CW]; const float* cb = (const float*)a.in[IN_CB];
        for (int i = 0; i < 4; ++i) { const int item = tid + NTHR * i, s = item >> 4, dg = item & 15, t = c * CH + s;
            float kv[8]; conv8(proj, cw, cb, t, PC_MK + g * HD + 8 * dg, kv);
            const float sc = MODE == 1 ? kscale * __expf(rowv[127] + colv[s]) : kscale;
#pragma unroll
            for (int j = 0; j < 8; ++j) kv[j] *= sc;
            if (MODE == 1) store_T8(T0, s, 8 * dg, kv); else store_row8(T1, s, 8 * dg, kv);
            store_T8_bits(TV, s, 8 * dg, *(const GAS u32x4*)(proj + (size_t)t * NPJ + PC_MV + g * HD + 8 * dg));
            if (MODE == 3) { float qv[8]; conv8(proj, cw, cb, t, PC_MQ + g * HD + 8 * dg, qv); store_row8(T0, s, 8 * dg, qv); }
        }
    } else {
        const int gr = g - NHG; const float* COS = (const float*)(a.ws + WS_COS); const float* SIN = (const float*)(a.ws + WS_SIN);
        for (int i = 0; i < 2; ++i) { const int item = tid + NTHR * i, s = item >> 3, dg = item & 7, t = c * CH + s;
            float cs[8], sn[8];
            { const f32x4 c0 = *(const GAS f32x4*)(COS + (size_t)t * 64 + 8 * dg), c1 = *(const GAS f32x4*)(COS + (size_t)t * 64 + 8 * dg + 4), s0 = *(const GAS f32x4*)(SIN + (size_t)t * 64 + 8 * dg), s1 = *(const GAS f32x4*)(SIN + (size_t)t * 64 + 8 * dg + 4);
              cs[0] = c0.x; cs[1] = c0.y; cs[2] = c0.z; cs[3] = c0.w; cs[4] = c1.x; cs[5] = c1.y; cs[6] = c1.z; cs[7] = c1.w; sn[0] = s0.x; sn[1] = s0.y; sn[2] = s0.z; sn[3] = s0.w; sn[4] = s1.x; sn[5] = s1.y; sn[6] = s1.z; sn[7] = s1.w; }
            float lo[8], hi[8], olo[8], ohi[8];
            gload8(proj + (size_t)t * NPJ + PC_RK + gr * HD + 8 * dg, lo); gload8(proj + (size_t)t * NPJ + PC_RK + gr * HD + 64 + 8 * dg, hi);
            const float sc = MODE == 1 ? kscale * __expf(rowv[127] + colv[s]) : kscale;
#pragma unroll
            for (int j = 0; j < 8; ++j) { olo[j] = (lo[j] * cs[j] - hi[j] * sn[j]) * sc; ohi[j] = (hi[j] * cs[j] + lo[j] * sn[j]) * sc; }
            if (MODE == 1) { store_T8(T0, s, 8 * dg, olo); store_T8(T0, s, 64 + 8 * dg, ohi); } else { store_row8(T1, s, 8 * dg, olo); store_row8(T1, s, 64 + 8 * dg, ohi); }
            if (MODE == 3) {
                gload8(proj + (size_t)t * NPJ + PC_RQ + gr * HD + 8 * dg, lo); gload8(proj + (size_t)t * NPJ + PC_RQ + gr * HD + 64 + 8 * dg, hi);
#pragma unroll
                for (int j = 0; j < 8; ++j) { olo[j] = lo[j] * cs[j] - hi[j] * sn[j]; ohi[j] = hi[j] * cs[j] + lo[j] * sn[j]; }
                store_row8(T0, s, 8 * dg, olo); store_row8(T0, s, 64 + 8 * dg, ohi);
            }
        }
        for (int i = 0; i < 4; ++i) { const int item = tid + NTHR * i, s = item >> 4, dg = item & 15, t = c * CH + s;
            store_T8_bits(TV, s, 8 * dg, *(const GAS u32x4*)(proj + (size_t)t * NPJ + PC_RV + gr * HD + 8 * dg)); }
    }
    LDS_WAIT(); __syncthreads();
}

DI void phase_m1(const Args& a, ldsp lds, int tid_in, int wave, int vcu, int G) {
    float* UT = a.out; float* NLOC = (float*)(a.ws + WS_NLOC); float* DEC = (float*)(a.ws + WS_DEC);
    const LAS float* alog = (const LAS float*)(lds + GATE_OFF) + 256;
    for (int u = vcu; u < NHEADS * NCH; u += G) { const int g = u / NCH, c = u % NCH;
        int tid_o = tid_in; asm volatile("" : "+v"(tid_o));
        const int tid = tid_o, lane = tid & 63;
        mixer_gates(a, lds, g, c, tid, lane, wave);
        mixer_tiles<1>(a, lds, g, c, tid);
        ldsp KT = lds, VT = lds + 32768;
        if (tid == 0) DEC[g * NCH + c] = __expf(alog[127]);
        { const int r = lane & 31, h = lane >> 5, wi = wave >> 1, wj = wave & 1; const bool ml = g < NHG;
          f32x16 accU[2], accN[2];
#pragma unroll
          for (int i = 0; i < 16; ++i) { accU[0][i] = 0.f; accU[1][i] = 0.f; accN[0][i] = 0.f; accN[1][i] = 0.f; }
#pragma unroll
          for (int ks = 0; ks < 8; ++ks) {
              const bf16x8 af = ldfrag(VT, 32 * wi + r, 16 * ks + 8 * h), b0 = ldfrag(KT, 64 * wj + r, 16 * ks + 8 * h), b1 = ldfrag(KT, 64 * wj + 32 + r, 16 * ks + 8 * h);
              accU[0] = MFMA32(af, b0, accU[0]); accU[1] = MFMA32(af, b1, accU[1]);
              if (ml && wi == 0) { accN[0] = MFMA32(bf_ones(), b0, accN[0]); accN[1] = MFMA32(bf_ones(), b1, accN[1]); }
          }
          float* o = UT + ((size_t)(g * NCH + c) << 14);
#pragma unroll
          for (int n = 0; n < 2; ++n)
#pragma unroll
              for (int i = 0; i < 16; ++i) o[(32 * wi + crow(i, h)) * HD + 64 * wj + 32 * n + r] = accU[n][i];
          if (ml && wi == 0 && h == 0) { NLOC[((size_t)g * NCH + c) * HD + 64 * wj + r] = accN[0][0]; NLOC[((size_t)g * NCH + c) * HD + 64 * wj + 32 + r] = accN[1][0]; }
        }
        __syncthreads();
    }
}
DI void phase_m2(const Args& a, int tid, int vcu, int G) {
    const float* UT = a.out; bf16* C0T = (bf16*)(a.ws + WS_A); const float* DEC = (const float*)(a.ws + WS_DEC);
    const float* NLOC = (const float*)(a.ws + WS_NLOC); float* N0 = (float*)(a.ws + WS_N0);
    const int gt = vcu * NTHR + tid, NT = G * NTHR;
    for (int p = gt; p < NHEADS * 8192; p += NT) { const int e0 = p * 2, g = e0 >> 14, r = e0 & 16383;
        const float* dec = DEC + g * NCH; float c0 = 0.f, c1 = 0.f;
        for (int c = 0; c < NCH; c += 8) { f32x2 uu[8];
#pragma unroll
            for (int j = 0; j < 8; ++j) uu[j] = *(const GAS f32x2*)(UT + ((size_t)(g * NCH + c + j) << 14) + r);
#pragma unroll
            for (int j = 0; j < 8; ++j) { *(GAS unsigned*)(C0T + ((size_t)(g * NCH + c + j) << 14) + r) = pk2(c0, c1); const float d = dec[c + j]; c0 = d * c0 + uu[j].x; c1 = d * c1 + uu[j].y; } }
    }
    for (int p = gt; p < NHG * HD; p += NT) { const int g = p >> 7, d = p & 127; float n = 0.f;
        for (int c = 0; c < NCH; ++c) { N0[((size_t)g * NCH + c) * HD + d] = n; n = DEC[g * NCH + c] * n + NLOC[((size_t)g * NCH + c) * HD + d]; } }
}
DI void phase_m3(const Args& a, ldsp lds, int tid_in, int wave, int vcu, int G) {
    const bf16* proj = (const bf16*)(a.ws + WS_B); const bf16* C0T = (const bf16*)(a.ws + WS_A); const float* N0 = (const float*)(a.ws + WS_N0);
    bf16* mixb = (bf16*)a.out;
    const LAS float* rowv = (const LAS float*)(lds + GATE_OFF); const LAS float* colv = rowv + 128; const LAS float* alog = rowv + 256;
    LAS unsigned short* n0b = (LAS unsigned short*)(lds + GATE_OFF + 1536);
    ldsp Q = lds, K = lds + 32768, VT = lds + 65536, C0 = lds + 98304, P = lds + 98304; LAS float* H = (LAS float*)lds;
    const int wi = wave >> 1, wj = wave & 1;
    for (int u = vcu; u < NHEADS * NCH; u += G) { const int g = u / NCH, c = u % NCH; const bool ml = g < NHG;
        int tid_o = tid_in; asm volatile("" : "+v"(tid_o));
        const int tid = tid_o, lane = tid & 63, r = lane & 31, h = lane >> 5;
        mixer_gates(a, lds, g, c, tid, lane, wave);
        { const bf16* c0t = C0T + ((size_t)(g * NCH + c) << 14);
#pragma unroll
          for (int i = 0; i < 4; ++i) { const int item = tid + NTHR * i, e = item >> 4, ch = item & 15; *(LAS u32x4*)(C0 + tile_off(e, 8 * ch)) = *(const GAS u32x4*)(c0t + e * HD + 8 * ch); }
          if (tid < 128) n0b[tid] = ml ? (unsigned short)f2bf(N0[((size_t)g * NCH + c) * HD + tid]) : (unsigned short)0; }
        mixer_tiles<3>(a, lds, g, c, tid);
        f32x16 accO[2], accS[2], accD;
#pragma unroll
        for (int i = 0; i < 16; ++i) { accO[0][i] = 0.f; accO[1][i] = 0.f; accS[0][i] = 0.f; accS[1][i] = 0.f; accD[i] = 0.f; }
#pragma unroll
        for (int ks = 0; ks < 8; ++ks) {
            const bf16x8 af = ldfrag(Q, 32 * wi + r, 16 * ks + 8 * h), b0 = ldfrag(C0, 64 * wj + r, 16 * ks + 8 * h), b1 = ldfrag(C0, 64 * wj + 32 + r, 16 * ks + 8 * h);
            accO[0] = MFMA32(af, b0, accO[0]); accO[1] = MFMA32(af, b1, accO[1]);
            if (ml) { const bf16x8 bn = *(const LAS bf16x8*)(n0b + 16 * ks + 8 * h); accD = MFMA32(af, bn, accD); }
        }
        float rv[16];
#pragma unroll
        for (int i = 0; i < 16; ++i) { const int t = 32 * wi + crow(i, h); const float al = __expf(alog[t]); rv[i] = rowv[t]; accO[0][i] *= al; accO[1][i] *= al; accD[i] *= al; }
#pragma unroll
        for (int ks = 0; ks < 8; ++ks) {
            const bf16x8 af = ldfrag(Q, 32 * wi + r, 16 * ks + 8 * h), b0 = ldfrag(K, 64 * wj + r, 16 * ks + 8 * h), b1 = ldfrag(K, 64 * wj + 32 + r, 16 * ks + 8 * h);
            accS[0] = MFMA32(af, b0, accS[0]); accS[1] = MFMA32(af, b1, accS[1]);
        }
        __syncthreads();
#pragma unroll
        for (int n = 0; n < 2; ++n) { const int sidx = 64 * wj + 32 * n + r; const float cv = colv[sidx];
#pragma unroll
            for (int i = 0; i < 16; ++i) { const int t = 32 * wi + crow(i, h); const float val = (sidx <= t) ? accS[n][i] * __expf(rv[i] + cv) : 0.f;
                *(LAS unsigned short*)(P + tile_off(t, sidx)) = (unsigned short)f2bf(val); } }
        LDS_WAIT(); __syncthreads();
#pragma unroll
        for (int ks = 0; ks < 8; ++ks) {
            const bf16x8 af = ldfrag(P, 32 * wi + r, 16 * ks + 8 * h), b0 = ldfrag(VT, 64 * wj + r, 16 * ks + 8 * h), b1 = ldfrag(VT, 64 * wj + 32 + r, 16 * ks + 8 * h);
            accO[0] = MFMA32(af, b0, accO[0]); accO[1] = MFMA32(af, b1, accO[1]);
            if (ml) accD = MFMA32(af, bf_ones(), accD);
        }
#pragma unroll
        for (int i = 0; i < 16; ++i) { const int t = 32 * wi + crow(i, h); const float rden = ml ? 1.0f / fmaxf(fabsf(accD[i]), 1.0f) : 1.0f;
            H[t * HD + 64 * wj + r] = accO[0][i] * rden; H[t * HD + 64 * wj + 32 + r] = accO[1][i] * rden; }
        LDS_WAIT(); __syncthreads();
        for (int hh = 0; hh < 2; ++hh) {
            const int tl = tid >> 3, eg = tid & 7, t = 64 * hh + tl;
            float hv[16]; float ss = 0.f;
#pragma unroll
            for (int q = 0; q < 4; ++q) { const f32x4 x4 = *(const LAS f32x4*)(H + t * HD + 16 * eg + 4 * q); hv[4 * q] = x4.x; hv[4 * q + 1] = x4.y; hv[4 * q + 2] = x4.z; hv[4 * q + 3] = x4.w; }
#pragma unroll
            for (int i = 0; i < 16; ++i) ss += hv[i] * hv[i];
            ss += __shfl_xor(ss, 1); ss += __shfl_xor(ss, 2); ss += __shfl_xor(ss, 4);
            const float rn = 1.0f / sqrtf(ss * (1.0f / HD) + NORM_EPS);
            const int tg = c * CH + t; const int hc = ml ? g * HD + 16 * eg : (g - NHG) * HD + 16 * eg;
            const float* gh = (const float*)(a.ws + WS_GHEAD) + (ml ? 0 : 1024) + hc;
            const bf16* gp = proj + (size_t)tg * NPJ + (ml ? PC_MO : PC_RG) + hc;
            float ga[16]; { float t8[8]; gload8(gp, t8);
#pragma unroll
                for (int j = 0; j < 8; ++j) ga[j] = t8[j]; gload8(gp + 8, t8);
#pragma unroll
                for (int j = 0; j < 8; ++j) ga[8 + j] = t8[j]; }
            float o[16];
#pragma unroll
            for (int i = 0; i < 16; ++i) o[i] = hv[i] * rn * gh[i] * (ml ? sigmoid_f(ga[i]) : silu_f(ga[i]));
            bf16* op = mixb + (size_t)tg * DM + (ml ? 0 : 1024) + hc;
            u32x4 w0, w1; w0.x = pk2(o[0], o[1]); w0.y = pk2(o[2], o[3]); w0.z = pk2(o[4], o[5]); w0.w = pk2(o[6], o[7]); w1.x = pk2(o[8], o[9]); w1.y = pk2(o[10], o[11]); w1.z = pk2(o[12], o[13]); w1.w = pk2(o[14], o[15]);
            *(GAS u32x4*)op = w0; *(GAS u32x4*)(op + 8) = w1;
        }
        __syncthreads();
    }
}
DI void phase_r1(const Args& a, int lane, int wave, int vcu, int G) {
    const int gw = vcu * NWAVES + wave, NGW = G * NWAVES;
    const float* x = (const float*)a.in[IN_X]; const float* mix = (const float*)(a.ws + WS_B); float* x1 = a.out; bf16* h2 = (bf16*)(a.ws + WS_A);
    const GAS f32x4* gp = (const GAS f32x4*)a.in[IN_GPOST] + lane; const GAS f32x4* gf = (const GAS f32x4*)a.in[IN_GFPRE] + lane;
    for (int m = gw; m < SEQ; m += NGW) {
        const GAS f32x4* mr = (const GAS f32x4*)(mix + (size_t)m * DM) + lane; const GAS f32x4* xr = (const GAS f32x4*)(x + (size_t)m * DM) + lane;
        f32x4 v[8]; float s = 0.f;
#pragma unroll
        for (int j = 0; j < 8; ++j) { v[j] = mr[64 * j]; s += (v[j].x * v[j].x + v[j].y * v[j].y) + (v[j].z * v[j].z + v[j].w * v[j].w); }
        const float r = 1.0f / sqrtf(wave_sum(s) * (1.0f / DM) + NORM_EPS); float s2 = 0.f;
        GAS f32x4* xo = (GAS f32x4*)(x1 + (size_t)m * DM) + lane;
#pragma unroll
        for (int j = 0; j < 8; ++j) { const f32x4 xx = xr[64 * j], gg = gp[64 * j]; v[j] = xx + v[j] * r * gg; xo[64 * j] = v[j]; s2 += (v[j].x * v[j].x + v[j].y * v[j].y) + (v[j].z * v[j].z + v[j].w * v[j].w); }
        const float r2 = 1.0f / sqrtf(wave_sum(s2) * (1.0f / DM) + NORM_EPS);
        GAS u32x2* o = (GAS u32x2*)(h2 + (size_t)m * DM) + lane;
#pragma unroll
        for (int j = 0; j < 8; ++j) { const f32x4 gg = gf[64 * j]; u32x2 w; w.x = pk2(v[j].x * r2 * gg.x, v[j].y * r2 * gg.y); w.y = pk2(v[j].z * r2 * gg.z, v[j].w * r2 * gg.w); o[64 * j] = w; }
    }
}
DI void phase_r2(const Args& a, int lane, int wave, int vcu, int G, bool poison) {
    const int gw = vcu * NWAVES + wave, NGW = G * NWAVES;
    const float* ff = (const float*)(a.ws + WS_FF); float* out = a.out; const GAS f32x4* gp = (const GAS f32x4*)a.in[IN_GFPOST] + lane;
    const float qn = __builtin_nanf("");
    for (int m = gw; m < SEQ; m += NGW) {
        const GAS f32x4* fr = (const GAS f32x4*)(ff + (size_t)m * DM) + lane; GAS f32x4* xo = (GAS f32x4*)(out + (size_t)m * DM) + lane;
        f32x4 v[8]; float s = 0.f;
#pragma unroll
        for (int j = 0; j < 8; ++j) { v[j] = fr[64 * j]; s += (v[j].x * v[j].x + v[j].y * v[j].y) + (v[j].z * v[j].z + v[j].w * v[j].w); }
        const float r = 1.0f / sqrtf(wave_sum(s) * (1.0f / DM) + NORM_EPS);
#pragma unroll
        for (int j = 0; j < 8; ++j) { const f32x4 gg = gp[64 * j]; f32x4 o = xo[64 * j] + v[j] * r * gg; if (poison) o = (f32x4){qn, qn, qn, qn}; xo[64 * j] = o; }
    }
}

__global__ void __launch_bounds__(NTHR, 2) fwd(Args a) {
    extern __shared__ __attribute__((aligned(16))) unsigned char lds_raw[];
    ldsp lds = (ldsp)lds_raw;
    const int tid = threadIdx.x, lane = tid & 63, wave = __builtin_amdgcn_readfirstlane(tid >> 6);
    const int G = gridDim.x; const int bx = blockIdx.x; const int vcu = (G % 8 == 0) ? (bx % 8) * (G / 8) + bx / 8 : bx;
    volatile LAS unsigned* MISC = (volatile LAS unsigned*)(lds + MISC_OFF);
    if (tid < 32) MISC[tid] = 0u;
    __syncthreads();
    unsigned* ctl = (unsigned*)(a.ws + WS_CTL);
    XcdBarrier bar; bar.bar = ctl + CW_BAR; bar.x = 0; bar.st = nullptr;
    if (N_LAUNCHES == 1) bar = xcd_barrier_post(ctl + CW_BAR, MISC + 8);
    const int lo = a.ph_lo, hi = a.ph_hi;
#define IN(k) (lo <= (k) && (k) < hi)
#define SEAM(k) do { if (IN(k) && IN((k) + 1)) xcd_barrier(bar); } while (0)

    if (IN(0)) { phase_p0(a, lds, tid, lane, wave, vcu, G); SEAM(0); }
    if (IN(1)) {
        phase_gates(a, tid, vcu, G);
        __syncthreads();
        pg8::Gemm g{(const bf16*)(a.ws + WS_A), (const bf16*)(a.ws + WS_WIN), SEQ, NPJ, DM}; pg8::StaticOrder S; S.init(SEQ, NPJ, G, bx);
        pg8::EpiBf16 E{(bf16*)(a.ws + WS_B), NPJ};
        pg8::gemm_phase<pg8::EpiBf16, pg8::StaticOrder, true, true>(lds, g, S, E);
        SEAM(1);
    }
    if (IN(2)) { phase_m1(a, lds, tid, wave, vcu, G); SEAM(2); }
    if (IN(3)) { phase_m2(a, tid, vcu, G); SEAM(3); }
    if (IN(4)) { phase_m3(a, lds, tid, wave, vcu, G); SEAM(4); }
    if (IN(5)) {
        pg8::Gemm g{(const bf16*)a.out, (const bf16*)(a.ws + WS_WO), SEQ, DM, DM}; pg8::StaticOrder S; S.init(SEQ, DM, G, bx);
        pg8::EpiF32 E{(float*)(a.ws + WS_B), DM};
        pg8::gemm_phase<pg8::EpiF32, pg8::StaticOrder, true, true>(lds, g, S, E);
        SEAM(5);
    }
    if (IN(6)) { phase_r1(a, lane, wave, vcu, G); SEAM(6); }
    if (IN(7)) {
        pg8::Gemm g{(const bf16*)(a.ws + WS_A), (const bf16*)(a.ws + WS_WGU), SEQ, 2 * DFF, DM}; pg8::StaticOrder S; S.init(SEQ, 2 * DFF, G, bx);
        pg8::EpiSwiGLU E{(bf16*)(a.ws + WS_B), DFF};
        pg8::gemm_phase<pg8::EpiSwiGLU, pg8::StaticOrder, true, true>(lds, g, S, E);
        SEAM(7);
    }
    if (IN(8)) {
        pg8::Gemm g{(const bf16*)(a.ws + WS_B), (const bf16*)(a.ws + WS_WD), SEQ, DM, DFF}; pg8::StaticOrder S; S.init(SEQ, DM, G, bx);
        pg8::EpiF32 E{(float*)(a.ws + WS_FF), DM};
        pg8::gemm_phase<pg8::EpiF32, pg8::StaticOrder, true, true>(lds, g, S, E);
        SEAM(8);
    }
    if (IN(9)) {
        bool poison = false;
        if (N_LAUNCHES == 1) poison = __hip_atomic_load(ctl + CW_BAR + XB_TMO, __ATOMIC_RELAXED, __HIP_MEMORY_SCOPE_AGENT) != 0u;
        phase_r2(a, lane, wave, vcu, G, poison);
    }
#undef IN
#undef SEAM
}

extern "C" void kernel_launch(void* const* d_in, const int* in_sizes, int n_in, void* d_out, int out_size, void* d_ws, size_t ws_size, hipStream_t stream) {
    static int grid = 0;
    if (grid == 0) {
        if (n_in != 17 || in_sizes[0] != SEQ * DM || out_size != SEQ * DM || ws_size < WS_END) {
            fprintf(stderr, "kernel_launch: unexpected shapes (n_in %d, in0 %d, out %d, ws %zu); nothing launched\n", n_in, n_in > 0 ? in_sizes[0] : -1, out_size, ws_size); grid = -1; return; }
        int dev = 0, cus = 0, per_cu = 0;
        if (hipGetDevice(&dev) != hipSuccess || hipDeviceGetAttribute(&cus, hipDeviceAttributeMultiprocessorCount, dev) != hipSuccess) { grid = -1; return; }
        if (hipFuncSetAttribute((const void*)fwd, hipFuncAttributeMaxDynamicSharedMemorySize, LDS_BYTES) != hipSuccess) { fprintf(stderr, "kernel_launch: hipFuncSetAttribute failed\n"); grid = -1; return; }
        if (hipOccupancyMaxActiveBlocksPerMultiprocessor(&per_cu, (const void*)fwd, NTHR, LDS_BYTES) != hipSuccess || per_cu < 1)
            fprintf(stderr, "kernel_launch: note: occupancy query reports %d workgroups per CU\n", per_cu);
        (void)hipGetLastError();
        grid = cus;
    }
    if (grid < 0) return;
    if (hipMemsetAsync((char*)d_ws + WS_CTL, 0, CTL_ZERO_BYTES, stream) != hipSuccess) return;
    Args a{};
    for (int i = 0; i < 17; ++i) a.in[i] = d_in[i];
    a.out = (float*)d_out; a.ws = (unsigned char*)d_ws;
    if (N_LAUNCHES == 1) { a.ph_lo = 0; a.ph_hi = NPHASES; a.li = 0; hipLaunchKernelGGL(fwd, dim3(grid), dim3(NTHR), LDS_BYTES, stream, a); }
    else for (int li = 0; li < NPHASES; ++li) { a.ph_lo = li; a.ph_hi = li + 1; a.li = li; hipLaunchKernelGGL(fwd, dim3(grid), dim3(NTHR), LDS_BYTES, stream, a); }
}
```

```cpp
#include <hip/hip_runtime.h>
#include <cstdio>
#include <cstdint>

#ifndef MK_N_LAUNCHES
#define MK_N_LAUNCHES 1
#endif

namespace pg8 {
#define PG8_LAS __attribute__((address_space(3)))
typedef unsigned short bf16_t;
typedef short bf16x8 __attribute__((ext_vector_type(8)));
typedef float f32x4 __attribute__((ext_vector_type(4)));
typedef unsigned u32x4 __attribute__((ext_vector_type(4)));
constexpr int BM = 256, BK = 64, HALF = 128, HTB = HALF * BK * 2  , STAGE_BYTES = 8 * HTB, NXCD = 8, WGM = 8;

__host__ __device__ __forceinline__ int lds_byte(int r, int c) { const int st = (r >> 4) * 2 + (c >> 5), rr = r & 15, cc = c & 31, ob = rr * 64 + cc * 2; return st * 1024 + (ob ^ (((ob >> 9) & 1) << 5)); }
__host__ __device__ __forceinline__ void stage_rc(int b, int& R, int& C) { const int st = b / 1024, sb = b % 1024, swz = sb ^ (((sb >> 9) & 1) << 5); R = (st >> 1) * 16 + swz / 64; C = (st & 1) * 32 + (swz % 64) / 2; }
__host__ __device__ __forceinline__ int perm32(int rho) { const int n = rho >> 4, i = rho & 15; return 8 * (i >> 2) + 4 * n + (i & 3); }

struct Unit { int pm, pn; };
struct Gemm { const bf16_t* A; const bf16_t* Bt; int M, N, K; };

struct StaticOrder {
    int nM, nN, nwg, G, c;
    __host__ __device__ void init(int M, int N, int G_, int c_) { nM = M / BM; nN = N / BM; nwg = nM * nN; G = G_; c = c_; }
    __host__ __device__ bool next(int i, Unit& u) const {
        const long L = (long)i * G + c; if (L >= nwg) return false;
        int wgid = (int)L; { const int q = nwg / NXCD, r = nwg % NXCD, xcd = wgid % NXCD, off = wgid / NXCD; wgid = (xcd < r ? xcd * (q + 1) : r * (q + 1) + (xcd - r) * q) + off; }
        const int nig = WGM * nN, gid = wgid / nig, fm = gid * WGM, gsz = (nM - fm) < WGM ? (nM - fm) : WGM;
        u.pm = fm + ((wgid % nig) % gsz); u.pn = (wgid % nig) / gsz; return true;
    }
    __device__ __forceinline__ void a_ready(const Unit&) const {}
    __device__ __forceinline__ void done(const Unit&) const {}
};

__device__ __forceinline__ unsigned cvt_pk_bf16(float lo, float hi) { unsigned r; asm volatile("v_cvt_pk_bf16_f32 %0, %1, %2" : "=v"(r) : "v"(lo), "v"(hi)); return r; }

struct EpiF32 {
    static constexpr bool PERM = false, AFTER_DRAIN = false;
    float* C; int ldc;
    __device__ __forceinline__ void operator()(const f32x4 (&acc)[2][2][4][2], const Unit& u, int wr, int wc, int fr, int fq) const {
        const int row0 = u.pm * BM + wr * 64 + fr, col0 = u.pn * BM + wc * 32 + 4 * fq;
#pragma unroll
        for (int ai = 0; ai < 2; ++ai)
#pragma unroll
            for (int m = 0; m < 4; ++m) { float* rowp = C + (size_t)(row0 + ai * HALF + m * 16) * ldc + col0;
#pragma unroll
                for (int bj = 0; bj < 2; ++bj)
#pragma unroll
                    for (int n = 0; n < 2; ++n) *(f32x4*)(rowp + bj * HALF + n * 16) = acc[ai][bj][m][n]; }
    }
};
struct EpiBf16 {
    static constexpr bool PERM = true, AFTER_DRAIN = false;
    bf16_t* O; int ldc;
    __device__ __forceinline__ void operator()(const f32x4 (&acc)[2][2][4][2], const Unit& u, int wr, int wc, int fr, int fq) const {
        const int row0 = u.pm * BM + wr * 64 + fr, col0 = u.pn * BM + wc * 32 + 8 * fq;
#pragma unroll
        for (int ai = 0; ai < 2; ++ai)
#pragma unroll
            for (int m = 0; m < 4; ++m) { bf16_t* rowp = O + (size_t)(row0 + ai * HALF + m * 16) * ldc + col0;
#pragma unroll
                for (int bj = 0; bj < 2; ++bj) { const f32x4 v0 = acc[ai][bj][m][0], v1 = acc[ai][bj][m][1];
                    u32x4 w; w.x = cvt_pk_bf16(v0[0], v0[1]); w.y = cvt_pk_bf16(v0[2], v0[3]); w.z = cvt_pk_bf16(v1[0], v1[1]); w.w = cvt_pk_bf16(v1[2], v1[3]);
                    *(u32x4*)(rowp + bj * HALF) = w; } }
    }
};
__device__ __forceinline__ float silu_f(float x) { return x / (1.0f + __expf(-x)); }
struct EpiSwiGLU {
    static constexpr bool PERM = true, AFTER_DRAIN = false;
    bf16_t* O; int ldc;
    __device__ __forceinline__ void operator()(const f32x4 (&acc)[2][2][4][2], const Unit& u, int wr, int wc, int fr, int fq) const {
        const int row0 = u.pm * BM + wr * 64 + fr, col0 = u.pn * HALF + wc * 32 + 8 * fq;
#pragma unroll
        for (int ai = 0; ai < 2; ++ai)
#pragma unroll
            for (int m = 0; m < 4; ++m) { bf16_t* rowp = O + (size_t)(row0 + ai * HALF + m * 16) * ldc + col0;
                const f32x4 g0 = acc[ai][0][m][0], g1 = acc[ai][0][m][1], u0 = acc[ai][1][m][0], u1 = acc[ai][1][m][1];
                u32x4 w; w.x = cvt_pk_bf16(silu_f(g0[0]) * u0[0], silu_f(g0[1]) * u0[1]); w.y = cvt_pk_bf16(silu_f(g0[2]) * u0[2], silu_f(g0[3]) * u0[3]);
                w.z = cvt_pk_bf16(silu_f(g1[0]) * u1[0], silu_f(g1[1]) * u1[1]); w.w = cvt_pk_bf16(silu_f(g1[2]) * u1[2], silu_f(g1[3]) * u1[3]);
                *(u32x4*)rowp = w; }
    }
};

template <class Epi, class Sched, bool ALIGN_EPI = false, bool SP2 = false>
__device__ __forceinline__ void gemm_phase(PG8_LAS unsigned char* lds, const Gemm g, const Sched& S, const Epi& E) {
    const int tid = threadIdx.x, wid = __builtin_amdgcn_readfirstlane(tid >> 6), lane = tid & 63, wr = wid >> 2, wc = wid & 3, fr = lane & 15, fq = lane >> 4;
    const int K = g.K, nt = K / BK;
    unsigned voffA[2], voffB[2];
#pragma unroll
    for (int i = 0; i < 2; ++i) { int R, C; stage_rc(tid * 16 + i * 8192, R, C); const int Rb = Epi::PERM ? ((R & ~31) + perm32(R & 31)) : R;
        voffA[i] = (unsigned)(R * K + C) * 2u; voffB[i] = (unsigned)(Rb * K + C) * 2u; }
    const size_t kstep = (size_t)(BK * 2);
    const size_t hstep = (size_t)HALF * K * 2;
    const size_t tstep = 2 * hstep;
    const unsigned ldsw = (unsigned)wid * 1024u;
    const int aoff = lds_byte(wr * 64 + fr, fq * 8), boff = lds_byte(wc * 32 + fr, fq * 8);
#define PG8_SA(b, h) (((b) * 2 + (h)) * HTB)
#define PG8_SB(b, h) ((4 + (b) * 2 + (h)) * HTB)
#define PG8_STAGE(bufoff, gbase, voff) do { _Pragma("unroll") for (int _i = 0; _i < 2; ++_i) \
        __builtin_amdgcn_global_load_lds((const unsigned*)((const char*)(gbase) + (voff)[_i]), (PG8_LAS unsigned*)(lds + (bufoff) + ldsw + _i * 8192), 16, 0, 0); } while (0)
#define PG8_LDA(dst, b, h) do { _Pragma("unroll") for (int m = 0; m < 4; ++m) _Pragma("unroll") for (int k = 0; k < 2; ++k) dst[m][k] = *(const PG8_LAS bf16x8*)(lds + PG8_SA(b, h) + aoff + m * 2048 + k * 1024); } while (0)
#define PG8_LDB(dst, b, h) do { _Pragma("unroll") for (int n = 0; n < 2; ++n) _Pragma("unroll") for (int k = 0; k < 2; ++k) dst[n][k] = *(const PG8_LAS bf16x8*)(lds + PG8_SB(b, h) + boff + n * 2048 + k * 1024); } while (0)
#define PG8_MMA(ai, bj, At, Bt) do { __builtin_amdgcn_s_setprio(1); _Pragma("unroll") for (int m = 0; m < 4; ++m) _Pragma("unroll") for (int n = 0; n < 2; ++n) _Pragma("unroll") for (int k = 0; k < 2; ++k) \
        acc[ai][bj][m][n] = __builtin_amdgcn_mfma_f32_16x16x32_bf16(Bt[n][k], At[m][k], acc[ai][bj][m][n], 0, 0, 0); __builtin_amdgcn_s_setprio(0); } while (0)
#define PG8_WAIT_V(n) asm volatile("s_waitcnt vmcnt(" #n ")" ::: "memory")
#define PG8_WAIT_L(n) asm volatile("s_waitcnt lgkmcnt(" #n ")" ::: "memory")
#define PG8_BAR __builtin_amdgcn_s_barrier()
#define PG8_SCHED __builtin_amdgcn_sched_barrier(0)
    Unit cur, nxt; int ui = 0;
    if (!S.next(0, cur)) return;
    f32x4 acc[2][2][4][2];
#pragma unroll
    for (int a = 0; a < 2; ++a)
#pragma unroll
        for (int b = 0; b < 2; ++b)
#pragma unroll
            for (int m = 0; m < 4; ++m)
#pragma unroll
                for (int n = 0; n < 2; ++n) acc[a][b][m][n] = (f32x4){0.f, 0.f, 0.f, 0.f};
    bf16x8 At[4][2], B0[2][2], B1[2][2];
    const char* cA = (const char*)g.A + (size_t)cur.pm * tstep; const char* cB = (const char*)g.Bt + (size_t)cur.pn * tstep;
    S.a_ready(cur);
    if constexpr (SP2) {
        PG8_STAGE(PG8_SB(0, 0), cB, voffB); PG8_STAGE(PG8_SB(0, 1), cB + hstep, voffB); PG8_STAGE(PG8_SA(0, 0), cA, voffA); PG8_STAGE(PG8_SA(0, 1), cA + hstep, voffA);
        if (wr == 1) PG8_BAR;
        PG8_WAIT_V(2); PG8_BAR;
        PG8_STAGE(PG8_SB(1, 0), cB + kstep, voffB); PG8_STAGE(PG8_SA(1, 0), cA + kstep, voffA); PG8_STAGE(PG8_SB(1, 1), cB + hstep + kstep, voffB);
        PG8_WAIT_V(6); PG8_BAR;
    } else {
        PG8_STAGE(PG8_SB(0, 0), cB, voffB); PG8_STAGE(PG8_SA(0, 0), cA, voffA); PG8_STAGE(PG8_SB(0, 1), cB + hstep, voffB); PG8_STAGE(PG8_SA(0, 1), cA + hstep, voffA);
        if (wr == 1) PG8_BAR;
        PG8_WAIT_V(4); PG8_BAR;
        PG8_STAGE(PG8_SB(1, 0), cB + kstep, voffB); PG8_STAGE(PG8_SA(1, 0), cA + kstep, voffA); PG8_STAGE(PG8_SB(1, 1), cB + hstep + kstep, voffB);
        PG8_WAIT_V(6); PG8_BAR;
    }
    for (;;) {
        const bool has_next = S.next(ui + 1, nxt);
        const char* nA = has_next ? (const char*)g.A + (size_t)nxt.pm * tstep : cA; const char* nB = has_next ? (const char*)g.Bt + (size_t)nxt.pn * tstep : cB;
        for (int t = 0; t < nt; t += 2) {
            const bool last = (t == nt - 2);
            const char* a1 = cA + (size_t)(t + 1) * kstep;
            const char* a2 = last ? nA : cA + (size_t)(t + 2) * kstep; const char* b2 = last ? nB : cB + (size_t)(t + 2) * kstep;
            const char* a3 = a2 + kstep; const char* b3 = b2 + kstep;
            if (last && has_next) S.a_ready(nxt);
            if constexpr (SP2) {
            PG8_LDB(B0, 0, 0); PG8_LDB(B1, 0, 1); PG8_SCHED; PG8_LDA(At, 0, 0); PG8_STAGE(PG8_SA(1, 1), a1 + hstep, voffA);
            PG8_WAIT_V(8); PG8_WAIT_L(0); PG8_BAR; PG8_MMA(0, 0, At, B0); PG8_MMA(0, 1, At, B1); PG8_BAR; PG8_SCHED;
            PG8_LDA(At, 0, 1); PG8_STAGE(PG8_SB(0, 0), b2, voffB); PG8_STAGE(PG8_SB(0, 1), b2 + hstep, voffB); PG8_STAGE(PG8_SA(0, 0), a2, voffA);
            PG8_WAIT_V(8); PG8_WAIT_L(0); PG8_BAR; PG8_MMA(1, 0, At, B0); PG8_MMA(1, 1, At, B1); PG8_BAR; PG8_SCHED;
            PG8_LDB(B0, 1, 0); PG8_LDB(B1, 1, 1); PG8_SCHED; PG8_LDA(At, 1, 0); PG8_STAGE(PG8_SA(0, 1), a2 + hstep, voffA);
            PG8_WAIT_V(8); PG8_WAIT_L(0); PG8_BAR; PG8_MMA(0, 0, At, B0); PG8_MMA(0, 1, At, B1); PG8_BAR; PG8_SCHED;
            PG8_LDA(At, 1, 1); PG8_STAGE(PG8_SB(1, 0), b3, voffB); PG8_STAGE(PG8_SB(1, 1), b3 + hstep, voffB); PG8_STAGE(PG8_SA(1, 0), a3, voffA);
            PG8_WAIT_V(8); PG8_WAIT_L(0); PG8_BAR; PG8_MMA(1, 0, At, B0); PG8_MMA(1, 1, At, B1); PG8_BAR; PG8_SCHED;
            } else {
            PG8_LDB(B0, 0, 0); PG8_SCHED; PG8_LDA(At, 0, 0); PG8_STAGE(PG8_SA(1, 1), a1 + hstep, voffA);
            PG8_WAIT_L(8); PG8_BAR; PG8_WAIT_L(0); PG8_MMA(0, 0, At, B0); PG8_BAR; PG8_SCHED;
            PG8_LDB(B1, 0, 1); PG8_STAGE(PG8_SB(0, 0), b2, voffB);
            PG8_BAR; PG8_WAIT_L(0); PG8_MMA(0, 1, At, B1); PG8_BAR;
            PG8_LDA(At, 0, 1); PG8_STAGE(PG8_SA(0, 0), a2, voffA);
            PG8_BAR; PG8_WAIT_L(0); PG8_MMA(1, 0, At, B0); PG8_BAR; PG8_SCHED;
            PG8_STAGE(PG8_SB(0, 1), b2 + hstep, voffB);
            PG8_WAIT_V(6); PG8_BAR; PG8_MMA(1, 1, At, B1); PG8_BAR;
            PG8_LDB(B0, 1, 0); PG8_SCHED; PG8_LDA(At, 1, 0); PG8_STAGE(PG8_SA(0, 1), a2 + hstep, voffA);
            PG8_WAIT_L(8); PG8_BAR; PG8_WAIT_L(0); PG8_MMA(0, 0, At, B0); PG8_BAR; PG8_SCHED;
            PG8_LDB(B1, 1, 1); PG8_STAGE(PG8_SB(1, 0), b3, voffB);
            PG8_BAR; PG8_WAIT_L(0); PG8_MMA(0, 1, At, B1); PG8_BAR;
            PG8_LDA(At, 1, 1); PG8_STAGE(PG8_SA(1, 0), a3, voffA);
            PG8_BAR; PG8_WAIT_L(0); PG8_MMA(1, 0, At, B0); PG8_BAR; PG8_SCHED;
            PG8_STAGE(PG8_SB(1, 1), b3 + hstep, voffB);
            PG8_WAIT_V(6); PG8_BAR; PG8_MMA(1, 1, At, B1); PG8_BAR;
            }
        }
        if constexpr (ALIGN_EPI) { if (wr == 0) PG8_BAR; }
        if constexpr (!Epi::AFTER_DRAIN) { E(acc, cur, wr, wc, fr, fq); S.done(cur); }
        if (!has_next) break;
#pragma unroll
        for (int a = 0; a < 2; ++a)
#pragma unroll
            for (int b = 0; b < 2; ++b)
#pragma unroll
                for (int m = 0; m < 4; ++m)
#pragma unroll
                    for (int n = 0; n < 2; ++n) acc[a][b][m][n] = (f32x4){0.f, 0.f, 0.f, 0.f};
        cur = nxt; cA = nA; cB = nB; ++ui;
        if constexpr (ALIGN_EPI) { if (wr == 1) PG8_BAR; }
    }
    PG8_WAIT_V(0);
    if constexpr (!ALIGN_EPI) { if (wr == 0) PG8_BAR; }
    PG8_BAR;
#undef PG8_SA
#undef PG8_SB
#undef PG8_STAGE
#undef PG8_LDA
#undef PG8_LDB
#undef PG8_MMA
#undef PG8_WAIT_V
#undef PG8_WAIT_L
#undef PG8_BAR
#undef PG8_SCHED
}
}

constexpr int NWAVES = 8, NTHR = 512;
constexpr int SEQ = 16384, DM = 2048, HD = 128, NHG = 8, DPROJ = 8208, NPJ = 8192, DFF = 5632, CH = 128, NCH = SEQ / CH, NHEADS = 16;
constexpr float NORM_EPS = 1e-6f;
constexpr int N_LAUNCHES = MK_N_LAUNCHES, NPHASES = 10;
constexpr int PC_MQ = 0, PC_MK = 1024, PC_MV = 2048, PC_MO = 3072, PC_RQ = 4096, PC_RK = 5120, PC_RV = 6144, PC_RG = 7168;

constexpr size_t MiB = 1u << 20;
constexpr size_t WS_CTL = 0, CTL_ZERO_BYTES = 64 * 1024;
constexpr size_t WS_WIN = 2 * MiB, WS_WO = 34 * MiB, WS_WGU = 42 * MiB, WS_WD = 86 * MiB;
constexpr size_t WS_PRE = 108 * MiB;
constexpr size_t WS_RS = 109 * MiB;
constexpr size_t WS_NLOC = 110 * MiB;
constexpr size_t WS_N0 = 110 * MiB + 512 * 1024;
constexpr size_t WS_DEC = 111 * MiB;
constexpr size_t WS_GHEAD = 111 * MiB + 65536;
constexpr size_t WS_COS = 112 * MiB, WS_SIN = 116 * MiB;
constexpr size_t WS_B = 128 * MiB;
constexpr size_t WS_A = 384 * MiB;
constexpr size_t WS_FF = WS_B + 176 * MiB;
constexpr size_t WS_END = 448 * MiB;
constexpr int CW_BAR = 1024;

constexpr int RING_BYTES = 131072;
constexpr int GATE_OFF = RING_BYTES;
constexpr int MISC_OFF = RING_BYTES + 2048;
constexpr int LDS_BYTES = 147456;

#define GAS __attribute__((address_space(1)))
#define LAS __attribute__((address_space(3)))
#define DI __device__ __forceinline__
typedef unsigned short bf16;
typedef unsigned u32x4 __attribute__((ext_vector_type(4)));
typedef unsigned u32x2 __attribute__((ext_vector_type(2)));
typedef float f32x4 __attribute__((ext_vector_type(4)));
typedef float f32x2 __attribute__((ext_vector_type(2)));
typedef LAS unsigned char* ldsp;
#define LDS_WAIT() asm volatile("s_waitcnt lgkmcnt(0)" ::: "memory")

DI unsigned f2bf(float f) { unsigned u = __builtin_bit_cast(unsigned, f); return (u + 0x7fffu + ((u >> 16) & 1u)) >> 16; }
DI unsigned pk2(float lo, float hi) { return f2bf(lo) | (f2bf(hi) << 16); }
DI float bflo(unsigned w) { return __builtin_bit_cast(float, w << 16); }
DI float bfhi(unsigned w) { return __builtin_bit_cast(float, w & 0xffff0000u); }
DI void unpack8(const u32x4 w, float (&f)[8]) { f[0] = bflo(w.x); f[1] = bfhi(w.x); f[2] = bflo(w.y); f[3] = bfhi(w.y); f[4] = bflo(w.z); f[5] = bfhi(w.z); f[6] = bflo(w.w); f[7] = bfhi(w.w); }
DI u32x4 pack8(const float (&f)[8]) { u32x4 w; w.x = pk2(f[0], f[1]); w.y = pk2(f[2], f[3]); w.z = pk2(f[4], f[5]); w.w = pk2(f[6], f[7]); return w; }
DI float sigmoid_f(float x) { return 1.0f / (1.0f + __expf(-x)); }
DI float silu_f(float x) { return x / (1.0f + __expf(-x)); }
DI float wave_sum(float v) {
#pragma unroll
    for (int o = 1; o < 64; o <<= 1) v += __shfl_xor(v, o);
    return v;
}

#define XB_TMO      128
#define XB_XCNT(j)  (256  + 64 * (j))
#define XB_XSUB(j)  (1280 + 64 * (j))
#define XB_XGEN(j)  (2304 + 64 * (j))
#define XB_TOP      3328
#define XB_TOPGEN   3392
#define XCD_BAR_WORDS 3456
#define XB_SPIN_CAP (1u << 18)
__device__ __forceinline__ unsigned xb_ld(unsigned* p)              { return __hip_atomic_load(p, __ATOMIC_RELAXED, __HIP_MEMORY_SCOPE_AGENT); }
__device__ __forceinline__ unsigned xb_add(unsigned* p, unsigned v) { return __hip_atomic_fetch_add(p, v, __ATOMIC_RELAXED, __HIP_MEMORY_SCOPE_AGENT); }
__device__ __forceinline__ unsigned xb_xcc_id() { return (unsigned)__builtin_amdgcn_s_getreg((3 << 11) | 20) & 0xFu; }
#define XB_SPIN(cond, bar) do { unsigned _sp = 0; while (cond) { __builtin_amdgcn_s_sleep(1); \
    if ((++_sp & 255u) == 0u) { if (xb_ld(&(bar)[XB_TMO])) break; if (_sp > XB_SPIN_CAP) { atomicAdd(&(bar)[XB_TMO], 1u); break; } } } } while (0)
struct XcdBarrier { unsigned* bar; unsigned x; volatile LAS unsigned* st; };
__device__ __forceinline__ XcdBarrier xcd_barrier_post(unsigned* bar, volatile LAS unsigned* st) {
    XcdBarrier b; b.bar = bar; b.x = xb_xcc_id(); b.st = st;
    if (threadIdx.x == 0) (void)xb_add(&bar[XB_XCNT(b.x)], 1u);
    return b;
}
__device__ __forceinline__ void xcd_barrier_complete(unsigned* bar, unsigned x, unsigned& nloc, unsigned& nx) {
    const unsigned G = gridDim.x * gridDim.y * gridDim.z;
    unsigned sum, cnt, mine, sp = 0u;
    for (;;) {
        sum = 0u; cnt = 0u; mine = 0u;
#pragma unroll
        for (unsigned j = 0; j < 16; ++j) { const unsigned c = xb_ld(&bar[XB_XCNT(j)]); sum += c; cnt += (c > 0u) ? 1u : 0u; mine = (j == x) ? c : mine; }
        if (sum == G) break;
        __builtin_amdgcn_s_sleep(1);
        if ((++sp & 255u) == 0u) { if (xb_ld(&bar[XB_TMO])) break; if (sp > XB_SPIN_CAP) { atomicAdd(&bar[XB_TMO], 1u); break; } }
    }
    nloc = mine > 0u ? mine : 1u; nx = cnt > 0u ? cnt : 1u;
}
__device__ __forceinline__ void xcd_barrier(const XcdBarrier& b) {
    asm volatile("s_waitcnt vmcnt(0)" ::: "memory");
    __syncthreads();
    if (threadIdx.x == 0) {
        unsigned* bar = b.bar;
        __builtin_amdgcn_s_waitcnt(0);
        unsigned nloc = b.st[0], nx = b.st[1];
        if (nloc == 0u) { xcd_barrier_complete(bar, b.x, nloc, nx); b.st[0] = nloc; b.st[1] = nx; }
        const unsigned old = xb_add(&bar[XB_XSUB(b.x)], 1u);
        const unsigned gen = old / nloc;
        if (old + 1u == (gen + 1u) * nloc) {
            __builtin_amdgcn_fence(__ATOMIC_RELEASE, "agent");
            asm volatile("s_waitcnt vmcnt(0)" ::: "memory");
            const unsigned og = xb_add(&bar[XB_TOP], 1u);
            const unsigned tg = og / nx;
            if (og + 1u == (tg + 1u) * nx) xb_add(&bar[XB_TOPGEN], 1u);
            else XB_SPIN(xb_ld(&bar[XB_TOPGEN]) == tg, bar);
            __builtin_amdgcn_fence(__ATOMIC_ACQUIRE, "agent");
            xb_add(&bar[XB_XGEN(b.x)], 1u);
            asm volatile("s_waitcnt vmcnt(0)" ::: "memory");
        } else {
            XB_SPIN(xb_ld(&bar[XB_XGEN(b.x)]) == gen, bar);
            __builtin_amdgcn_fence(__ATOMIC_ACQUIRE, "agent");
            asm volatile("s_waitcnt vmcnt(0)" ::: "memory");
        }
    }
    __syncthreads();
}

struct Args { const void* in[17]; float* out; unsigned char* ws; int ph_lo, ph_hi, li, pad; };
enum { IN_X = 0, IN_POS, IN_GPRE, IN_WIN, IN_CW, IN_CB, IN_BI, IN_BF, IN_GMH, IN_GRH, IN_WOUT, IN_GPOST, IN_GFPRE, IN_WG, IN_WU, IN_WDN, IN_GFPOST };

DI void p0_transpose_item(const float* W, int K, int ldw, int src_col, bf16* WT, int dst_row, LAS float* scr, int kb, int lane) {
    const int k0 = 64 * kb;
#pragma unroll 8
    for (int i = 0; i < 32; ++i) { const int kk = 2 * i + (lane >> 5); scr[kk * 33 + (lane & 31)] = W[(size_t)(k0 + kk) * ldw + src_col + (lane & 31)]; }
    LDS_WAIT(); asm volatile("" ::: "memory");
    const int c = lane & 7;
#pragma unroll
    for (int j = 0; j < 4; ++j) { const int n = (lane >> 3) + 8 * j; const LAS float* s = scr + (8 * c) * 33 + n;
        u32x4 o; o.x = pk2(s[0 * 33], s[1 * 33]); o.y = pk2(s[2 * 33], s[3 * 33]); o.z = pk2(s[4 * 33], s[5 * 33]); o.w = pk2(s[6 * 33], s[7 * 33]);
        *(GAS u32x4*)(WT + (size_t)(dst_row + n) * K + k0 + 8 * c) = o; }
    LDS_WAIT(); asm volatile("" ::: "memory");
}
typedef float f32x4g __attribute__((ext_vector_type(4)));
DI void p0_gates(const Args& a, ldsp lds, int tid, int lane, int wave, int vcu, int G) {
    const float* x = (const float*)a.in[IN_X]; const float* gpre = (const float*)a.in[IN_GPRE]; const float* w_in = (const float*)a.in[IN_WIN]; float* PRE = (float*)(a.ws + WS_PRE);
    LAS float* Wl = (LAS float*)lds;
    LAS float* part = (LAS float*)(lds + MISC_OFF + 1024);
#pragma unroll 4
    for (int i = 0; i < 16; ++i) { const int idx = tid + NTHR * i, k = idx >> 2, c4 = idx & 3;
        f32x4 w = *(const GAS f32x4*)(w_in + (size_t)k * DPROJ + 4096 + 4 * c4); w = w * gpre[k];
        const int row = (k & ~15) + 4 * (k & 3) + ((k >> 2) & 3);
        *(LAS f32x4*)(Wl + row * 16 + 4 * c4) = w; }
    LDS_WAIT(); __syncthreads();
    for (int rb = vcu; rb < SEQ / 64; rb += G) {
        const int tile = wave & 3, kh = wave >> 2, row = lane & 15, q = lane >> 4, t0 = rb * 64 + tile * 16;
        const GAS f32x4* xr = (const GAS f32x4*)(x + (size_t)(t0 + row) * DM + kh * 1024 + 4 * q);
        const LAS float* wl = Wl + (kh * 1024 + q) * 16 + row;
        f32x4g acc = {0.f, 0.f, 0.f, 0.f}; float ss = 0.f;
        for (int sp = 0; sp < 64; sp += 4) { f32x4 xv[4];
#pragma unroll
            for (int j = 0; j < 4; ++j) xv[j] = xr[4 * (sp + j)];
#pragma unroll
            for (int j = 0; j < 4; ++j) { ss += (xv[j].x * xv[j].x + xv[j].y * xv[j].y) + (xv[j].z * xv[j].z + xv[j].w * xv[j].w);
                const LAS float* wp = wl + (sp + j) * 256;
                acc = __builtin_amdgcn_mfma_f32_16x16x4f32(xv[j].x, wp[0], acc, 0, 0, 0); acc = __builtin_amdgcn_mfma_f32_16x16x4f32(xv[j].y, wp[64], acc, 0, 0, 0);
                acc = __builtin_amdgcn_mfma_f32_16x16x4f32(xv[j].z, wp[128], acc, 0, 0, 0); acc = __builtin_amdgcn_mfma_f32_16x16x4f32(xv[j].w, wp[192], acc, 0, 0, 0); } }
        if (kh == 1) {
#pragma unroll
            for (int j = 0; j < 4; ++j) part[(tile * 4 + j) * 64 + lane] = acc[j];
            part[1024 + tile * 64 + lane] = ss; }
        LDS_WAIT(); __syncthreads();
        if (kh == 0) {
#pragma unroll
            for (int j = 0; j < 4; ++j) acc[j] += part[(tile * 4 + j) * 64 + lane];
            ss += part[1024 + tile * 64 + lane];
            ss += __shfl_xor(ss, 16); ss += __shfl_xor(ss, 32);
            const float rs = 1.0f / sqrtf(ss * (1.0f / DM) + NORM_EPS);
#pragma unroll
            for (int j = 0; j < 4; ++j) { const int ri = 4 * q + j; const float rsi = __shfl(rs, ri); PRE[(size_t)(t0 + ri) * 16 + row] = acc[j] * rsi; } }
        __syncthreads();
    }
}
DI void phase_p0(const Args& a, ldsp lds, int tid, int lane, int wave, int vcu, int G) {
    p0_gates(a, lds, tid, lane, wave, vcu, G);
    const int gw = vcu * NWAVES + wave, NGW = G * NWAVES;
    LAS float* scr = (LAS float*)(lds + wave * 16384);
    const float* w_in = (const float*)a.in[IN_WIN]; const float* w_out = (const float*)a.in[IN_WOUT];
    const float* w_g = (const float*)a.in[IN_WG]; const float* w_u = (const float*)a.in[IN_WU]; const float* w_d = (const float*)a.in[IN_WDN];
    bf16* WinT = (bf16*)(a.ws + WS_WIN); bf16* WoT = (bf16*)(a.ws + WS_WO); bf16* WguT = (bf16*)(a.ws + WS_WGU); bf16* WdT = (bf16*)(a.ws + WS_WD);
    constexpr int I_IN = 32 * 256, I_O = 32 * 64, I_G = 32 * 176, I_D = 88 * 64, NITEMS = I_IN + I_O + 2 * I_G + I_D;
    for (int it = gw; it < NITEMS; it += NGW) {
        int r = it;
        if (r < I_IN) { const int kb = r / 256, nb = r % 256; const int sc = nb < 128 ? 32 * nb : 4112 + 32 * (nb - 128);
            p0_transpose_item(w_in, DM, DPROJ, sc, WinT, 32 * nb, scr, kb, lane); continue; } r -= I_IN;
        if (r < I_O) { const int kb = r / 64, nb = r % 64; p0_transpose_item(w_out, DM, DM, 32 * nb, WoT, 32 * nb, scr, kb, lane); continue; } r -= I_O;
        if (r < I_G) { const int kb = r / 176, nb = r % 176; p0_transpose_item(w_g, DM, DFF, 32 * nb, WguT, 256 * (nb >> 2) + 32 * (nb & 3), scr, kb, lane); continue; } r -= I_G;
        if (r < I_G) { const int kb = r / 176, nb = r % 176; p0_transpose_item(w_u, DM, DFF, 32 * nb, WguT, 256 * (nb >> 2) + 128 + 32 * (nb & 3), scr, kb, lane); continue; } r -= I_G;
        { const int kb = r / 64, nb = r % 64; p0_transpose_item(w_d, DFF, DM, 32 * nb, WdT, 32 * nb, scr, kb, lane); }
    }
    const float* x = (const float*)a.in[IN_X]; const float* gpre = (const float*)a.in[IN_GPRE];
    bf16* hb = (bf16*)(a.ws + WS_A);
    for (int m = gw; m < SEQ; m += NGW) {
        const GAS f32x4* xr = (const GAS f32x4*)(x + (size_t)m * DM) + lane; const GAS f32x4* gr = (const GAS f32x4*)gpre + lane;
        f32x4 v[8]; float s = 0.f;
#pragma unroll
        for (int j = 0; j < 8; ++j) { v[j] = xr[64 * j]; s += (v[j].x * v[j].x + v[j].y * v[j].y) + (v[j].z * v[j].z + v[j].w * v[j].w); }
        const float r = 1.0f / sqrtf(wave_sum(s) * (1.0f / DM) + NORM_EPS);
        GAS u32x2* o = (GAS u32x2*)(hb + (size_t)m * DM) + lane;
#pragma unroll
        for (int j = 0; j < 8; ++j) { const f32x4 gg = gr[64 * j]; u32x2 w; w.x = pk2(v[j].x * r * gg.x, v[j].y * r * gg.y); w.y = pk2(v[j].z * r * gg.z, v[j].w * r * gg.w); o[64 * j] = w; }
    }
    { float* GH = (float*)(a.ws + WS_GHEAD); const float* gmh = (const float*)a.in[IN_GMH]; const float* grh = (const float*)a.in[IN_GRH];
      for (int i = vcu * NTHR + tid; i < 1024; i += G * NTHR) GH[i] = gmh[i];
      for (int i = vcu * NTHR + tid; i < 1024; i += G * NTHR) GH[1024 + i] = grh[i]; }
    const int* pos = (const int*)a.in[IN_POS]; float* COS = (float*)(a.ws + WS_COS); float* SIN = (float*)(a.ws + WS_SIN);
    for (int i = vcu * NTHR + tid; i < SEQ * 64; i += G * NTHR) { const int t = i >> 6, j = i & 63;
        const float inv = (float)pow(10000.0, -(double)(2 * j) / 128.0); const float ang = (float)pos[t] * inv; float sn, cs; sincosf(ang, &sn, &cs); COS[i] = cs; SIN[i] = sn; }
}

typedef short bf16x8 __attribute__((ext_vector_type(8)));
typedef float f32x16 __attribute__((ext_vector_type(16)));
#define MFMA32(a, b, c) __builtin_amdgcn_mfma_f32_32x32x16_bf16((a), (b), (c), 0, 0, 0)
DI int crow(int reg, int h) { return (reg & 3) + 8 * (reg >> 2) + 4 * h; }
DI bf16x8 bf_ones() { return (bf16x8){16256, 16256, 16256, 16256, 16256, 16256, 16256, 16256}; }
DI int tile_off(int row, int col) { return row * 256 + ((((col >> 3) ^ row) & 15) << 4) + ((col & 7) << 1); }
DI void store_row8(ldsp tile, int row, int col0, const float (&f)[8]) { *(LAS u32x4*)(tile + tile_off(row, col0)) = pack8(f); }
DI void store_T8(ldsp tile, int s, int d0, const float (&f)[8]) {
#pragma unroll
    for (int i = 0; i < 8; ++i) *(LAS unsigned short*)(tile + tile_off(d0 + i, s)) = (unsigned short)f2bf(f[i]);
}
DI void store_T8_bits(ldsp tile, int s, int d0, const u32x4 w) {
    const unsigned ww[4] = {w.x, w.y, w.z, w.w};
#pragma unroll
    for (int i = 0; i < 4; ++i) { *(LAS unsigned short*)(tile + tile_off(d0 + 2 * i, s)) = (unsigned short)(ww[i] & 0xffffu); *(LAS unsigned short*)(tile + tile_off(d0 + 2 * i + 1, s)) = (unsigned short)(ww[i] >> 16); }
}
DI void load_tile8(ldsp tile, int row, int col0, float (&f)[8]) { unpack8(*(const LAS u32x4*)(tile + tile_off(row, col0)), f); }
DI void gload8(const bf16* p, float (&f)[8]) { unpack8(*(const GAS u32x4*)p, f); }
DI bf16x8 ldfrag(ldsp tile, int row, int col0) { return *(const LAS bf16x8*)(tile + tile_off(row, col0)); }

DI void mixer_gates(const Args& a, ldsp lds, int g, int c, int tid, int lane, int wave) {
    LAS float* rowv = (LAS float*)(lds + GATE_OFF); LAS float* colv = rowv + 128; LAS float* alog = rowv + 256;
    if (g < NHG) {
        if (wave == 0) {
            const float* PRE = (const float*)(a.ws + WS_PRE); const float bi = ((const float*)a.in[IN_BI])[g], bfg = ((const float*)a.in[IN_BF])[g];
            const int t0 = c * CH + 2 * lane;
            const float i0 = PRE[(size_t)t0 * 16 + g] + bi, i1 = PRE[(size_t)(t0 + 1) * 16 + g] + bi;
            const float f0 = PRE[(size_t)t0 * 16 + 8 + g] + bfg, f1 = PRE[(size_t)(t0 + 1) * 16 + 8 + g] + bfg;
            const float l0 = fminf(f0, 0.f) - log1pf(__expf(-fabsf(f0))), l1 = fminf(f1, 0.f) - log1pf(__expf(-fabsf(f1)));
            float p = l0 + l1;
#pragma unroll
            for (int o = 1; o < 64; o <<= 1) { const float y = __shfl_up(p, o); if (lane >= o) p += y; }
            const float b1 = p, b0 = p - l1;
            rowv[2 * lane] = b0; rowv[2 * lane + 1] = b1; alog[2 * lane] = b0; alog[2 * lane + 1] = b1; colv[2 * lane] = i0 - b0; colv[2 * lane + 1] = i1 - b1;
        }
    } else if (tid < 128) {
        const float lg = log1pf(-exp2f(-5.0f - (float)(g - NHG)));
        rowv[tid] = (float)tid * lg; colv[tid] = -(float)tid * lg; alog[tid] = (float)(tid + 1) * lg;
    }
    LDS_WAIT(); __syncthreads();
}
DI void conv8(const bf16* proj, const float* cw, const float* cb, int t, int col, float (&o)[8]) {
    float acc[8];
    { const f32x4 b0 = *(const GAS f32x4*)(cb + col), b1 = *(const GAS f32x4*)(cb + col + 4); acc[0] = b0.x; acc[1] = b0.y; acc[2] = b0.z; acc[3] = b0.w; acc[4] = b1.x; acc[5] = b1.y; acc[6] = b1.z; acc[7] = b1.w; }
#pragma unroll
    for (int j = 0; j < 4; ++j) { const int tt = t - 3 + j;
        if (tt >= 0) { float u[8]; gload8(proj + (size_t)tt * NPJ + col, u);
            const f32x4 w0 = *(const GAS f32x4*)(cw + j * 2048 + col), w1 = *(const GAS f32x4*)(cw + j * 2048 + col + 4);
            acc[0] += w0.x * u[0]; acc[1] += w0.y * u[1]; acc[2] += w0.z * u[2]; acc[3] += w0.w * u[3]; acc[4] += w1.x * u[4]; acc[5] += w1.y * u[5]; acc[6] += w1.z * u[6]; acc[7] += w1.w * u[7]; } }
#pragma unroll
    for (int i = 0; i < 8; ++i) o[i] = silu_f(acc[i]);
}
template <int MODE> DI void mixer_tiles(const Args& a, ldsp lds, int g, int c, int tid) {
    const bf16* proj = (const bf16*)(a.ws + WS_B);
    const LAS float* rowv = (const LAS float*)(lds + GATE_OFF); const LAS float* colv = rowv + 128;
    ldsp T0 = lds, T1 = lds + 32768, T2 = lds + 65536; ldsp TV = MODE == 1 ? T1 : T2;
    const float kscale = 0.08838834764831845f;
    if (g < NHG) {
        const float* cw = (const float*)a.in[IN_CW]; const float* cb = (const float*)a.in[IN_CB];
        for (int i = 0; i < 4; ++i) { const int item = tid + NTHR * i, s = item >> 4, dg = item & 15, t = c * CH + s;
            float kv[8]; conv8(proj, cw, cb, t, PC_MK + g * HD + 8 * dg, kv);
            const float sc = MODE == 1 ? kscale * __expf(rowv[127] + colv[s]) : kscale;
#pragma unroll
            for (int j = 0; j < 8; ++j) kv[j] *= sc;
            if (MODE == 1) store_T8(T0, s, 8 * dg, kv); else store_row8(T1, s, 8 * dg, kv);
            store_T8_bits(TV, s, 8 * dg, *(const GAS u32x4*)(proj + (size_t)t * NPJ + PC_MV + g * HD + 8 * dg));
            if (MODE == 3) { float qv[8]; conv8(proj, cw, cb, t, PC_MQ + g * HD + 8 * dg, qv); store_row8(T0, s, 8 * dg, qv); }
        }
    } else {
        const int gr = g - NHG; const float* COS = (const float*)(a.ws + WS_COS); const float* SIN = (const float*)(a.ws + WS_SIN);
        for (int i = 0; i < 2; ++i) { const int item = tid + NTHR * i, s = item >> 3, dg = item & 7, t = c * CH + s;
            float cs[8], sn[8];
            { const f32x4 c0 = *(const GAS f32x4*)(COS + (size_t)t * 64 + 8 * dg), c1 = *(const GAS f32x4*)(COS + (size_t)t * 64 + 8 * dg + 4), s0 = *(const GAS f32x4*)(SIN + (size_t)t * 64 + 8 * dg), s1 = *(const GAS f32x4*)(SIN + (size_t)t * 64 + 8 * dg + 4);
              cs[0] = c0.x; cs[1] = c0.y; cs[2] = c0.z; cs[3] = c0.w; cs[4] = c1.x; cs[5] = c1.y; cs[6] = c1.z; cs[7] = c1.w; sn[0] = s0.x; sn[1] = s0.y; sn[2] = s0.z; sn[3] = s0.w; sn[4] = s1.x; sn[5] = s1.y; sn[6] = s1.z; sn[7] = s1.w; }
            float lo[8], hi[8], olo[8], ohi[8];
            gload8(proj + (size_t)t * NPJ + PC_RK + gr * HD + 8 * dg, lo); gload8(proj + (size_t)t * NPJ + PC_RK + gr * HD + 64 + 8 * dg, hi);
            const float sc = MODE == 1 ? kscale * __expf(rowv[127] + colv[s]) : kscale;
#pragma unroll
            for (int j = 0; j < 8; ++j) { olo[j] = (lo[j] * cs[j] - hi[j] * sn[j]) * sc; ohi[j] = (hi[j] * cs[j] + lo[j] * sn[j]) * sc; }
            if (MODE == 1) { store_T8(T0, s, 8 * dg, olo); store_T8(T0, s, 64 + 8 * dg, ohi); } else { store_row8(T1, s, 8 * dg, olo); store_row8(T1, s, 64 + 8 * dg, ohi); }
            if (MODE == 3) {
                gload8(proj + (size_t)t * NPJ + PC_RQ + gr * HD + 8 * dg, lo); gload8(proj + (size_t)t * NPJ + PC_RQ + gr * HD + 64 + 8 * dg, hi);
#pragma unroll
                for (int j = 0; j < 8; ++j) { olo[j] = lo[j] * cs[j] - hi[j] * sn[j]; ohi[j] = hi[j] * cs[j] + lo[j] * sn[j]; }
                store_row8(T0, s, 8 * dg, olo); store_row8(T0, s, 64 + 8 * dg, ohi);
            }
        }
        for (int i = 0; i < 4; ++i) { const int item = tid + NTHR * i, s = item >> 4, dg = item & 15, t = c * CH + s;
            store_T8_bits(TV, s, 8 * dg, *(const GAS u32x4*)(proj + (size_t)t * NPJ + PC_RV + gr * HD + 8 * dg)); }
    }
    LDS_WAIT(); __syncthreads();
}

DI void phase_m1(const Args& a, ldsp lds, int tid_in, int wave, int vcu, int G) {
    float* UT = a.out; float* NLOC = (float*)(a.ws + WS_NLOC); float* DEC = (float*)(a.ws + WS_DEC);
    const LAS float* alog = (const LAS float*)(lds + GATE_OFF) + 256;
    for (int u = vcu; u < NHEADS * NCH; u += G) { const int g = u / NCH, c = u % NCH;
        int tid_o = tid_in; asm volatile("" : "+v"(tid_o));
        const int tid = tid_o, lane = tid & 63;
        mixer_gates(a, lds, g, c, tid, lane, wave);
        mixer_tiles<1>(a, lds, g, c, tid);
        ldsp KT = lds, VT = lds + 32768;
        if (tid == 0) DEC[g * NCH + c] = __expf(alog[127]);
        { const int r = lane & 31, h = lane >> 5, wi = wave >> 1, wj = wave & 1; const bool ml = g < NHG;
          f32x16 accU[2], accN[2];
#pragma unroll
          for (int i = 0; i < 16; ++i) { accU[0][i] = 0.f; accU[1][i] = 0.f; accN[0][i] = 0.f; accN[1][i] = 0.f; }
#pragma unroll
          for (int ks = 0; ks < 8; ++ks) {
              const bf16x8 af = ldfrag(VT, 32 * wi + r, 16 * ks + 8 * h), b0 = ldfrag(KT, 64 * wj + r, 16 * ks + 8 * h), b1 = ldfrag(KT, 64 * wj + 32 + r, 16 * ks + 8 * h);
              accU[0] = MFMA32(af, b0, accU[0]); accU[1] = MFMA32(af, b1, accU[1]);
              if (ml && wi == 0) { accN[0] = MFMA32(bf_ones(), b0, accN[0]); accN[1] = MFMA32(bf_ones(), b1, accN[1]); }
          }
          float* o = UT + ((size_t)(g * NCH + c) << 14);
#pragma unroll
          for (int n = 0; n < 2; ++n)
#pragma unroll
              for (int i = 0; i < 16; ++i) o[(32 * wi + crow(i, h)) * HD + 64 * wj + 32 * n + r] = accU[n][i];
          if (ml && wi == 0 && h == 0) { NLOC[((size_t)g * NCH + c) * HD + 64 * wj + r] = accN[0][0]; NLOC[((size_t)g * NCH + c) * HD + 64 * wj + 32 + r] = accN[1][0]; }
        }
        __syncthreads();
    }
}
DI void phase_m2(const Args& a, int tid, int vcu, int G) {
    const float* UT = a.out; bf16* C0T = (bf16*)(a.ws + WS_A); const float* DEC = (const float*)(a.ws + WS_DEC);
    const float* NLOC = (const float*)(a.ws + WS_NLOC); float* N0 = (float*)(a.ws + WS_N0);
    const int gt = vcu * NTHR + tid, NT = G * NTHR;
    for (int p = gt; p < NHEADS * 8192; p += NT) { const int e0 = p * 2, g = e0 >> 14, r = e0 & 16383;
        const float* dec = DEC + g * NCH; float c0 = 0.f, c1 = 0.f;
        for (int c = 0; c < NCH; c += 8) { f32x2 uu[8];
#pragma unroll
            for (int j = 0; j < 8; ++j) uu[j] = *(const GAS f32x2*)(UT + ((size_t)(g * NCH + c + j) << 14) + r);
#pragma unroll
            for (int j = 0; j < 8; ++j) { *(GAS unsigned*)(C0T + ((size_t)(g * NCH + c + j) << 14) + r) = pk2(c0, c1); const float d = dec[c + j]; c0 = d * c0 + uu[j].x; c1 = d * c1 + uu[j].y; } }
    }
    for (int p = gt; p < NHG * HD; p += NT) { const int g = p >> 7, d = p & 127; float n = 0.f;
        for (int c = 0; c < NCH; ++c) { N0[((size_t)g * NCH + c) * HD + d] = n; n = DEC[g * NCH + c] * n + NLOC[((size_t)g * NCH + c) * HD + d]; } }
}
DI void phase_m3(const Args& a, ldsp lds, int tid_in, int wave, int vcu, int G) {
    const bf16* proj = (const bf16*)(a.ws + WS_B); const bf16* C0T = (const bf16*)(a.ws + WS_A); const float* N0 = (const float*)(a.ws + WS_N0);
    bf16* mixb = (bf16*)a.out;
    const LAS float* rowv = (const LAS float*)(lds + GATE_OFF); const LAS float* colv = rowv + 128; const LAS float* alog = rowv + 256;
    LAS unsigned short* n0b = (LAS unsigned short*)(lds + GATE_OFF + 1536);
    ldsp Q = lds, K = lds + 32768, VT = lds + 65536, C0 = lds + 98304, P = lds + 98304; LAS float* H = (LAS float*)lds;
    const int wi = wave >> 1, wj = wave & 1;
    for (int u = vcu; u < NHEADS * NCH; u += G) { const int g = u / NCH, c = u % NCH; const bool ml = g < NHG;
        int tid_o = tid_in; asm volatile("" : "+v"(tid_o));
        const int tid = tid_o, lane = tid & 63, r = lane & 31, h = lane >> 5;
        mixer_gates(a, lds, g, c, tid, lane, wave);
        { const bf16* c0t = C0T + ((size_t)(g * NCH + c) << 14);
#pragma unroll
          for (int i = 0; i < 4; ++i) { const int item = tid + NTHR * i, e = item >> 4, ch = item & 15; *(LAS u32x4*)(C0 + tile_off(e, 8 * ch)) = *(const GAS u32x4*)(c0t + e * HD + 8 * ch); }
          if (tid < 128) n0b[tid] = ml ? (unsigned short)f2bf(N0[((size_t)g * NCH + c) * HD + tid]) : (unsigned short)0; }
        mixer_tiles<3>(a, lds, g, c, tid);
        f32x16 accO[2], accS[2], accD;
#pragma unroll
        for (int i = 0; i < 16; ++i) { accO[0][i] = 0.f; accO[1][i] = 0.f; accS[0][i] = 0.f; accS[1][i] = 0.f; accD[i] = 0.f; }
#pragma unroll
        for (int ks = 0; ks < 8; ++ks) {
            const bf16x8 af = ldfrag(Q, 32 * wi + r, 16 * ks + 8 * h), b0 = ldfrag(C0, 64 * wj + r, 16 * ks + 8 * h), b1 = ldfrag(C0, 64 * wj + 32 + r, 16 * ks + 8 * h);
            accO[0] = MFMA32(af, b0, accO[0]); accO[1] = MFMA32(af, b1, accO[1]);
            if (ml) { const bf16x8 bn = *(const LAS bf16x8*)(n0b + 16 * ks + 8 * h); accD = MFMA32(af, bn, accD); }
        }
        float rv[16];
#pragma unroll
        for (int i = 0; i < 16; ++i) { const int t = 32 * wi + crow(i, h); const float al = __expf(alog[t]); rv[i] = rowv[t]; accO[0][i] *= al; accO[1][i] *= al; accD[i] *= al; }
#pragma unroll
        for (int ks = 0; ks < 8; ++ks) {
            const bf16x8 af = ldfrag(Q, 32 * wi + r, 16 * ks + 8 * h), b0 = ldfrag(K, 64 * wj + r, 16 * ks + 8 * h), b1 = ldfrag(K, 64 * wj + 32 + r, 16 * ks + 8 * h);
            accS[0] = MFMA32(af, b0, accS[0]); accS[1] = MFMA32(af, b1, accS[1]);
        }
        __syncthreads();
#pragma unroll
        for (int n = 0; n < 2; ++n) { const int sidx = 64 * wj + 32 * n + r; const float cv = colv[sidx];
#pragma unroll
            for (int i = 0; i < 16; ++i) { const int t = 32 * wi + crow(i, h); const float val = (sidx <= t) ? accS[n][i] * __expf(rv[i] + cv) : 0.f;
                *(LAS unsigned short*)(P + tile_off(t, sidx)) = (unsigned short)f2bf(val); } }
        LDS_WAIT(); __syncthreads();
#pragma unroll
        for (int ks = 0; ks < 8; ++ks) {
            const bf16x8 af = ldfrag(P, 32 * wi + r, 16 * ks + 8 * h), b0 = ldfrag(VT, 64 * wj + r, 16 * ks + 8 * h), b1 = ldfrag(VT, 64 * wj + 32 + r, 16 * ks + 8 * h);
            accO[0] = MFMA32(af, b0, accO[0]); accO[1] = MFMA32(af, b1, accO[1]);
            if (ml) accD = MFMA32(af, bf_ones(), accD);
        }
#pragma unroll
        for (int i = 0; i < 16; ++i) { const int t = 32 * wi + crow(i, h); const float rden = ml ? 1.0f / fmaxf(fabsf(accD[i]), 1.0f) : 1.0f;
            H[t * HD + 64 * wj + r] = accO[0][i] * rden; H[t * HD + 64 * wj + 32 + r] = accO[1][i] * rden; }
        LDS_WAIT(); __syncthreads();
        for (int hh = 0; hh < 2; ++hh) {
            const int tl = tid >> 3, eg = tid & 7, t = 64 * hh + tl;
            float hv[16]; float ss = 0.f;
#pragma unroll
            for (int q = 0; q < 4; ++q) { const f32x4 x4 = *(const LAS f32x4*)(H + t * HD + 16 * eg + 4 * q); hv[4 * q] = x4.x; hv[4 * q + 1] = x4.y; hv[4 * q + 2] = x4.z; hv[4 * q + 3] = x4.w; }
#pragma unroll
            for (int i = 0; i < 16; ++i) ss += hv[i] * hv[i];
            ss += __shfl_xor(ss, 1); ss += __shfl_xor(ss, 2); ss += __shfl_xor(ss, 4);
            const float rn = 1.0f / sqrtf(ss * (1.0f / HD) + NORM_EPS);
            const int tg = c * CH + t; const int hc = ml ? g * HD + 16 * eg : (g - NHG) * HD + 16 * eg;
            const float* gh = (const float*)(a.ws + WS_GHEAD) + (ml ? 0 : 1024) + hc;
            const bf16* gp = proj + (size_t)tg * NPJ + (ml ? PC_MO : PC_RG) + hc;
            float ga[16]; { float t8[8]; gload8(gp, t8);
#pragma unroll
                for (int j = 0; j < 8; ++j) ga[j] = t8[j]; gload8(gp + 8, t8);
#pragma unroll
                for (int j = 0; j < 8; ++j) ga[8 + j] = t8[j]; }
            float o[16];
#pragma unroll
            for (int i = 0; i < 16; ++i) o[i] = hv[i] * rn * gh[i] * (ml ? sigmoid_f(ga[i]) : silu_f(ga[i]));
            bf16* op = mixb + (size_t)tg * DM + (ml ? 0 : 1024) + hc;
            u32x4 w0, w1; w0.x = pk2(o[0], o[1]); w0.y = pk2(o[2], o[3]); w0.z = pk2(o[4], o[5]); w0.w = pk2(o[6], o[7]); w1.x = pk2(o[8], o[9]); w1.y = pk2(o[10], o[11]); w1.z = pk2(o[12], o[13]); w1.w = pk2(o[14], o[15]);
            *(GAS u32x4*)op = w0; *(GAS u32x4*)(op + 8) = w1;
        }
        __syncthreads();
    }
}
DI void phase_r1(const Args& a, int lane, int wave, int vcu, int G) {
    const int gw = vcu * NWAVES + wave, NGW = G * NWAVES;
    const float* x = (const float*)a.in[IN_X]; const float* mix = (const float*)(a.ws + WS_B); float* x1 = a.out; bf16* h2 = (bf16*)(a.ws + WS_A);
    const GAS f32x4* gp = (const GAS f32x4*)a.in[IN_GPOST] + lane; const GAS f32x4* gf = (const GAS f32x4*)a.in[IN_GFPRE] + lane;
    for (int m = gw; m < SEQ; m += NGW) {
        const GAS f32x4* mr = (const GAS f32x4*)(mix + (size_t)m * DM) + lane; const GAS f32x4* xr = (const GAS f32x4*)(x + (size_t)m * DM) + lane;
        f32x4 v[8]; float s = 0.f;
#pragma unroll
        for (int j = 0; j < 8; ++j) { v[j] = mr[64 * j]; s += (v[j].x * v[j].x + v[j].y * v[j].y) + (v[j].z * v[j].z + v[j].w * v[j].w); }
        const float r = 1.0f / sqrtf(wave_sum(s) * (1.0f / DM) + NORM_EPS); float s2 = 0.f;
        GAS f32x4* xo = (GAS f32x4*)(x1 + (size_t)m * DM) + lane;
#pragma unroll
        for (int j = 0; j < 8; ++j) { const f32x4 xx = xr[64 * j], gg = gp[64 * j]; v[j] = xx + v[j] * r * gg; xo[64 * j] = v[j]; s2 += (v[j].x * v[j].x + v[j].y * v[j].y) + (v[j].z * v[j].z + v[j].w * v[j].w); }
        const float r2 = 1.0f / sqrtf(wave_sum(s2) * (1.0f / DM) + NORM_EPS);
        GAS u32x2* o = (GAS u32x2*)(h2 + (size_t)m * DM) + lane;
#pragma unroll
        for (int j = 0; j < 8; ++j) { const f32x4 gg = gf[64 * j]; u32x2 w; w.x = pk2(v[j].x * r2 * gg.x, v[j].y * r2 * gg.y); w.y = pk2(v[j].z * r2 * gg.z, v[j].w * r2 * gg.w); o[64 * j] = w; }
    }
}
DI void phase_r2(const Args& a, int lane, int wave, int vcu, int G, bool poison) {
    const int gw = vcu * NWAVES + wave, NGW = G * NWAVES;
    const float* ff = (const float*)(a.ws + WS_FF); float* out = a.out; const GAS f32x4* gp = (const GAS f32x4*)a.in[IN_GFPOST] + lane;
    const float qn = __builtin_nanf("");
    for (int m = gw; m < SEQ; m += NGW) {
        const GAS f32x4* fr = (const GAS f32x4*)(ff + (size_t)m * DM) + lane; GAS f32x4* xo = (GAS f32x4*)(out + (size_t)m * DM) + lane;
        f32x4 v[8]; float s = 0.f;
#pragma unroll
        for (int j = 0; j < 8; ++j) { v[j] = fr[64 * j]; s += (v[j].x * v[j].x + v[j].y * v[j].y) + (v[j].z * v[j].z + v[j].w * v[j].w); }
        const float r = 1.0f / sqrtf(wave_sum(s) * (1.0f / DM) + NORM_EPS);
#pragma unroll
        for (int j = 0; j < 8; ++j) { const f32x4 gg = gp[64 * j]; f32x4 o = xo[64 * j] + v[j] * r * gg; if (poison) o = (f32x4){qn, qn, qn, qn}; xo[64 * j] = o; }
    }
}

__global__ void __launch_bounds__(NTHR, 2) fwd(Args a) {
    extern __shared__ __attribute__((aligned(16))) unsigned char lds_raw[];
    ldsp lds = (ldsp)lds_raw;
    const int tid = threadIdx.x, lane = tid & 63, wave = __builtin_amdgcn_readfirstlane(tid >> 6);
    const int G = gridDim.x; const int bx = blockIdx.x; const int vcu = (G % 8 == 0) ? (bx % 8) * (G / 8) + bx / 8 : bx;
    volatile LAS unsigned* MISC = (volatile LAS unsigned*)(lds + MISC_OFF);
    if (tid < 32) MISC[tid] = 0u;
    __syncthreads();
    unsigned* ctl = (unsigned*)(a.ws + WS_CTL);
    XcdBarrier bar; bar.bar = ctl + CW_BAR; bar.x = 0; bar.st = nullptr;
    if (N_LAUNCHES == 1) bar = xcd_barrier_post(ctl + CW_BAR, MISC + 8);
    const int lo = a.ph_lo, hi = a.ph_hi;
#define IN(k) (lo <= (k) && (k) < hi)
#define SEAM(k) do { if (IN(k) && IN((k) + 1)) xcd_barrier(bar); } while (0)

    if (IN(0)) { phase_p0(a, lds, tid, lane, wave, vcu, G); SEAM(0); }
    if (IN(1)) {
        pg8::Gemm g{(const bf16*)(a.ws + WS_A), (const bf16*)(a.ws + WS_WIN), SEQ, NPJ, DM}; pg8::StaticOrder S; S.init(SEQ, NPJ, G, bx);
        pg8::EpiBf16 E{(bf16*)(a.ws + WS_B), NPJ};
        pg8::gemm_phase<pg8::EpiBf16, pg8::StaticOrder, true, true>(lds, g, S, E);
        SEAM(1);
    }
    if (IN(2)) { phase_m1(a, lds, tid, wave, vcu, G); SEAM(2); }
    if (IN(3)) { phase_m2(a, tid, vcu, G); SEAM(3); }
    if (IN(4)) { phase_m3(a, lds, tid, wave, vcu, G); SEAM(4); }
    if (IN(5)) {
        pg8::Gemm g{(const bf16*)a.out, (const bf16*)(a.ws + WS_WO), SEQ, DM, DM}; pg8::StaticOrder S; S.init(SEQ, DM, G, bx);
        pg8::EpiF32 E{(float*)(a.ws + WS_B), DM};
        pg8::gemm_phase<pg8::EpiF32, pg8::StaticOrder, true, true>(lds, g, S, E);
        SEAM(5);
    }
    if (IN(6)) { phase_r1(a, lane, wave, vcu, G); SEAM(6); }
    if (IN(7)) {
        pg8::Gemm g{(const bf16*)(a.ws + WS_A), (const bf16*)(a.ws + WS_WGU), SEQ, 2 * DFF, DM}; pg8::StaticOrder S; S.init(SEQ, 2 * DFF, G, bx);
        pg8::EpiSwiGLU E{(bf16*)(a.ws + WS_B), DFF};
        pg8::gemm_phase<pg8::EpiSwiGLU, pg8::StaticOrder, true, true>(lds, g, S, E);
        SEAM(7);
    }
    if (IN(8)) {
        pg8::Gemm g{(const bf16*)(a.ws + WS_B), (const bf16*)(a.ws + WS_WD), SEQ, DM, DFF}; pg8::StaticOrder S; S.init(SEQ, DM, G, bx);
        pg8::EpiF32 E{(float*)(a.ws + WS_FF), DM};
        pg8::gemm_phase<pg8::EpiF32, pg8::StaticOrder, true, true>(lds, g, S, E);
        SEAM(8);
    }
    if (IN(9)) {
        bool poison = false;
        if (N_LAUNCHES == 1) poison = __hip_atomic_load(ctl + CW_BAR + XB_TMO, __ATOMIC_RELAXED, __HIP_MEMORY_SCOPE_AGENT) != 0u;
        phase_r2(a, lane, wave, vcu, G, poison);
    }
#undef IN
#undef SEAM
}

extern "C" void kernel_launch(void* const* d_in, const int* in_sizes, int n_in, void* d_out, int out_size, void* d_ws, size_t ws_size, hipStream_t stream) {
    static int grid = 0;
    if (grid == 0) {
        if (n_in != 17 || in_sizes[0] != SEQ * DM || out_size != SEQ * DM || ws_size < WS_END) {
            fprintf(stderr, "kernel_launch: unexpected shapes (n_in %d, in0 %d, out %d, ws %zu); nothing launched\n", n_in, n_in > 0 ? in_sizes[0] : -1, out_size, ws_size); grid = -1; return; }
        int dev = 0, cus = 0, per_cu = 0;
        if (hipGetDevice(&dev) != hipSuccess || hipDeviceGetAttribute(&cus, hipDeviceAttributeMultiprocessorCount, dev) != hipSuccess) { grid = -1; return; }
        if (hipFuncSetAttribute((const void*)fwd, hipFuncAttributeMaxDynamicSharedMemorySize, LDS_BYTES) != hipSuccess) { fprintf(stderr, "kernel_launch: hipFuncSetAttribute failed\n"); grid = -1; return; }
        if (hipOccupancyMaxActiveBlocksPerMultiprocessor(&per_cu, (const void*)fwd, NTHR, LDS_BYTES) != hipSuccess || per_cu < 1)
            fprintf(stderr, "kernel_launch: note: occupancy query reports %d workgroups per CU\n", per_cu);
        (void)hipGetLastError();
        grid = cus;
    }
    if (grid < 0) return;
    if (hipMemsetAsync((char*)d_ws + WS_CTL, 0, CTL_ZERO_BYTES, stream) != hipSuccess) return;
    Args a{};
    for (int i = 0; i < 17; ++i) a.in[i] = d_in[i];
    a.out = (float*)d_out; a.ws = (unsigned char*)d_ws;
    if (N_LAUNCHES == 1) { a.ph_lo = 0; a.ph_hi = NPHASES; a.li = 0; hipLaunchKernelGGL(fwd, dim3(grid), dim3(NTHR), LDS_BYTES, stream, a); }
    else for (int li = 0; li < NPHASES; ++li) { a.ph_lo = li; a.ph_hi = li + 1; a.li = li; hipLaunchKernelGGL(fwd, dim3(grid), dim3(NTHR), LDS_BYTES, stream, a); }
}
```

```cpp
#include <hip/hip_runtime.h>
#include <cstdio>
#include <cstdint>

#ifndef PROBE_DUP
#define PROBE_DUP 0
#endif
#ifndef MK_N_LAUNCHES
#define MK_N_LAUNCHES 1
#endif

namespace pg8 {
#define PG8_LAS __attribute__((address_space(3)))
typedef unsigned short bf16_t;
typedef short bf16x8 __attribute__((ext_vector_type(8)));
typedef float f32x4 __attribute__((ext_vector_type(4)));
typedef unsigned u32x4 __attribute__((ext_vector_type(4)));
constexpr int BM = 256, BK = 64, HALF = 128, HTB = HALF * BK * 2  , STAGE_BYTES = 8 * HTB, NXCD = 8, WGM = 8;

__host__ __device__ __forceinline__ int lds_byte(int r, int c) { const int st = (r >> 4) * 2 + (c >> 5), rr = r & 15, cc = c & 31, ob = rr * 64 + cc * 2; return st * 1024 + (ob ^ (((ob >> 9) & 1) << 5)); }
__host__ __device__ __forceinline__ void stage_rc(int b, int& R, int& C) { const int st = b / 1024, sb = b % 1024, swz = sb ^ (((sb >> 9) & 1) << 5); R = (st >> 1) * 16 + swz / 64; C = (st & 1) * 32 + (swz % 64) / 2; }
__host__ __device__ __forceinline__ int perm32(int rho) { const int n = rho >> 4, i = rho & 15; return 8 * (i >> 2) + 4 * n + (i & 3); }

struct Unit { int pm, pn; };
struct Gemm { const bf16_t* A; const bf16_t* Bt; int M, N, K; };

struct StaticOrder {
    int nM, nN, nwg, G, c;
    __host__ __device__ void init(int M, int N, int G_, int c_) { nM = M / BM; nN = N / BM; nwg = nM * nN; G = G_; c = c_; }
    __host__ __device__ bool next(int i, Unit& u) const {
        const long L = (long)i * G + c; if (L >= nwg) return false;
        int wgid = (int)L; { const int q = nwg / NXCD, r = nwg % NXCD, xcd = wgid % NXCD, off = wgid / NXCD; wgid = (xcd < r ? xcd * (q + 1) : r * (q + 1) + (xcd - r) * q) + off; }
        const int nig = WGM * nN, gid = wgid / nig, fm = gid * WGM, gsz = (nM - fm) < WGM ? (nM - fm) : WGM;
        u.pm = fm + ((wgid % nig) % gsz); u.pn = (wgid % nig) / gsz; return true;
    }
    __device__ __forceinline__ void a_ready(const Unit&) const {}
    __device__ __forceinline__ void done(const Unit&) const {}
};

__device__ __forceinline__ unsigned cvt_pk_bf16(float lo, float hi) { unsigned r; asm volatile("v_cvt_pk_bf16_f32 %0, %1, %2" : "=v"(r) : "v"(lo), "v"(hi)); return r; }

struct EpiF32 {
    static constexpr bool PERM = false, AFTER_DRAIN = false;
    float* C; int ldc;
    __device__ __forceinline__ void operator()(const f32x4 (&acc)[2][2][4][2], const Unit& u, int wr, int wc, int fr, int fq) const {
        const int row0 = u.pm * BM + wr * 64 + fr, col0 = u.pn * BM + wc * 32 + 4 * fq;
#pragma unroll
        for (int ai = 0; ai < 2; ++ai)
#pragma unroll
            for (int m = 0; m < 4; ++m) { float* rowp = C + (size_t)(row0 + ai * HALF + m * 16) * ldc + col0;
#pragma unroll
                for (int bj = 0; bj < 2; ++bj)
#pragma unroll
                    for (int n = 0; n < 2; ++n) *(f32x4*)(rowp + bj * HALF + n * 16) = acc[ai][bj][m][n]; }
    }
};
struct EpiBf16 {
    static constexpr bool PERM = true, AFTER_DRAIN = false;
    bf16_t* O; int ldc;
    __device__ __forceinline__ void operator()(const f32x4 (&acc)[2][2][4][2], const Unit& u, int wr, int wc, int fr, int fq) const {
        const int row0 = u.pm * BM + wr * 64 + fr, col0 = u.pn * BM + wc * 32 + 8 * fq;
#pragma unroll
        for (int ai = 0; ai < 2; ++ai)
#pragma unroll
            for (int m = 0; m < 4; ++m) { bf16_t* rowp = O + (size_t)(row0 + ai * HALF + m * 16) * ldc + col0;
#pragma unroll
                for (int bj = 0; bj < 2; ++bj) { const f32x4 v0 = acc[ai][bj][m][0], v1 = acc[ai][bj][m][1];
                    u32x4 w; w.x = cvt_pk_bf16(v0[0], v0[1]); w.y = cvt_pk_bf16(v0[2], v0[3]); w.z = cvt_pk_bf16(v1[0], v1[1]); w.w = cvt_pk_bf16(v1[2], v1[3]);
                    *(u32x4*)(rowp + bj * HALF) = w; } }
    }
};
__device__ __forceinline__ float silu_f(float x) { return x / (1.0f + __expf(-x)); }
struct EpiSwiGLU {
    static constexpr bool PERM = true, AFTER_DRAIN = false;
    bf16_t* O; int ldc;
    __device__ __forceinline__ void operator()(const f32x4 (&acc)[2][2][4][2], const Unit& u, int wr, int wc, int fr, int fq) const {
        const int row0 = u.pm * BM + wr * 64 + fr, col0 = u.pn * HALF + wc * 32 + 8 * fq;
#pragma unroll
        for (int ai = 0; ai < 2; ++ai)
#pragma unroll
            for (int m = 0; m < 4; ++m) { bf16_t* rowp = O + (size_t)(row0 + ai * HALF + m * 16) * ldc + col0;
                const f32x4 g0 = acc[ai][0][m][0], g1 = acc[ai][0][m][1], u0 = acc[ai][1][m][0], u1 = acc[ai][1][m][1];
                u32x4 w; w.x = cvt_pk_bf16(silu_f(g0[0]) * u0[0], silu_f(g0[1]) * u0[1]); w.y = cvt_pk_bf16(silu_f(g0[2]) * u0[2], silu_f(g0[3]) * u0[3]);
                w.z = cvt_pk_bf16(silu_f(g1[0]) * u1[0], silu_f(g1[1]) * u1[1]); w.w = cvt_pk_bf16(silu_f(g1[2]) * u1[2], silu_f(g1[3]) * u1[3]);
                *(u32x4*)rowp = w; }
    }
};

template <class Epi, class Sched, bool ALIGN_EPI = false, bool SP2 = false>
__device__ __forceinline__ void gemm_phase(PG8_LAS unsigned char* lds, const Gemm g, const Sched& S, const Epi& E) {
    const int tid = threadIdx.x, wid = __builtin_amdgcn_readfirstlane(tid >> 6), lane = tid & 63, wr = wid >> 2, wc = wid & 3, fr = lane & 15, fq = lane >> 4;
    const int K = g.K, nt = K / BK;
    unsigned voffA[2], voffB[2];
#pragma unroll
    for (int i = 0; i < 2; ++i) { int R, C; stage_rc(tid * 16 + i * 8192, R, C); const int Rb = Epi::PERM ? ((R & ~31) + perm32(R & 31)) : R;
        voffA[i] = (unsigned)(R * K + C) * 2u; voffB[i] = (unsigned)(Rb * K + C) * 2u; }
    const size_t kstep = (size_t)(BK * 2);
    const size_t hstep = (size_t)HALF * K * 2;
    const size_t tstep = 2 * hstep;
    const unsigned ldsw = (unsigned)wid * 1024u;
    const int aoff = lds_byte(wr * 64 + fr, fq * 8), boff = lds_byte(wc * 32 + fr, fq * 8);
#define PG8_SA(b, h) (((b) * 2 + (h)) * HTB)
#define PG8_SB(b, h) ((4 + (b) * 2 + (h)) * HTB)
#define PG8_STAGE(bufoff, gbase, voff) do { _Pragma("unroll") for (int _i = 0; _i < 2; ++_i) \
        __builtin_amdgcn_global_load_lds((const unsigned*)((const char*)(gbase) + (voff)[_i]), (PG8_LAS unsigned*)(lds + (bufoff) + ldsw + _i * 8192), 16, 0, 0); } while (0)
#define PG8_LDA(dst, b, h) do { _Pragma("unroll") for (int m = 0; m < 4; ++m) _Pragma("unroll") for (int k = 0; k < 2; ++k) dst[m][k] = *(const PG8_LAS bf16x8*)(lds + PG8_SA(b, h) + aoff + m * 2048 + k * 1024); } while (0)
#define PG8_LDB(dst, b, h) do { _Pragma("unroll") for (int n = 0; n < 2; ++n) _Pragma("unroll") for (int k = 0; k < 2; ++k) dst[n][k] = *(const PG8_LAS bf16x8*)(lds + PG8_SB(b, h) + boff + n * 2048 + k * 1024); } while (0)
#define PG8_MMA(ai, bj, At, Bt) do { __builtin_amdgcn_s_setprio(1); _Pragma("unroll") for (int m = 0; m < 4; ++m) _Pragma("unroll") for (int n = 0; n < 2; ++n) _Pragma("unroll") for (int k = 0; k < 2; ++k) \
        acc[ai][bj][m][n] = __builtin_amdgcn_mfma_f32_16x16x32_bf16(Bt[n][k], At[m][k], acc[ai][bj][m][n], 0, 0, 0); __builtin_amdgcn_s_setprio(0); } while (0)
#define PG8_WAIT_V(n) asm volatile("s_waitcnt vmcnt(" #n ")" ::: "memory")
#define PG8_WAIT_L(n) asm volatile("s_waitcnt lgkmcnt(" #n ")" ::: "memory")
#define PG8_BAR __builtin_amdgcn_s_barrier()
#define PG8_SCHED __builtin_amdgcn_sched_barrier(0)
    Unit cur, nxt; int ui = 0;
    if (!S.next(0, cur)) return;
    f32x4 acc[2][2][4][2];
#pragma unroll
    for (int a = 0; a < 2; ++a)
#pragma unroll
        for (int b = 0; b < 2; ++b)
#pragma unroll
            for (int m = 0; m < 4; ++m)
#pragma unroll
                for (int n = 0; n < 2; ++n) acc[a][b][m][n] = (f32x4){0.f, 0.f, 0.f, 0.f};
    bf16x8 At[4][2], B0[2][2], B1[2][2];
    const char* cA = (const char*)g.A + (size_t)cur.pm * tstep; const char* cB = (const char*)g.Bt + (size_t)cur.pn * tstep;
    S.a_ready(cur);
    if constexpr (SP2) {
        PG8_STAGE(PG8_SB(0, 0), cB, voffB); PG8_STAGE(PG8_SB(0, 1), cB + hstep, voffB); PG8_STAGE(PG8_SA(0, 0), cA, voffA); PG8_STAGE(PG8_SA(0, 1), cA + hstep, voffA);
        if (wr == 1) PG8_BAR;
        PG8_WAIT_V(2); PG8_BAR;
        PG8_STAGE(PG8_SB(1, 0), cB + kstep, voffB); PG8_STAGE(PG8_SA(1, 0), cA + kstep, voffA); PG8_STAGE(PG8_SB(1, 1), cB + hstep + kstep, voffB);
        PG8_WAIT_V(6); PG8_BAR;
    } else {
        PG8_STAGE(PG8_SB(0, 0), cB, voffB); PG8_STAGE(PG8_SA(0, 0), cA, voffA); PG8_STAGE(PG8_SB(0, 1), cB + hstep, voffB); PG8_STAGE(PG8_SA(0, 1), cA + hstep, voffA);
        if (wr == 1) PG8_BAR;
        PG8_WAIT_V(4); PG8_BAR;
        PG8_STAGE(PG8_SB(1, 0), cB + kstep, voffB); PG8_STAGE(PG8_SA(1, 0), cA + kstep, voffA); PG8_STAGE(PG8_SB(1, 1), cB + hstep + kstep, voffB);
        PG8_WAIT_V(6); PG8_BAR;
    }
    for (;;) {
        const bool has_next = S.next(ui + 1, nxt);
        const char* nA = has_next ? (const char*)g.A + (size_t)nxt.pm * tstep : cA; const char* nB = has_next ? (const char*)g.Bt + (size_t)nxt.pn * tstep : cB;
        for (int t = 0; t < nt; t += 2) {
            const bool last = (t == nt - 2);
            const char* a1 = cA + (size_t)(t + 1) * kstep;
            const char* a2 = last ? nA : cA + (size_t)(t + 2) * kstep; const char* b2 = last ? nB : cB + (size_t)(t + 2) * kstep;
            const char* a3 = a2 + kstep; const char* b3 = b2 + kstep;
            if (last && has_next) S.a_ready(nxt);
            if constexpr (SP2) {
            PG8_LDB(B0, 0, 0); PG8_LDB(B1, 0, 1); PG8_SCHED; PG8_LDA(At, 0, 0); PG8_STAGE(PG8_SA(1, 1), a1 + hstep, voffA);
            PG8_WAIT_V(8); PG8_WAIT_L(0); PG8_BAR; PG8_MMA(0, 0, At, B0); PG8_MMA(0, 1, At, B1); PG8_BAR; PG8_SCHED;
            PG8_LDA(At, 0, 1); PG8_STAGE(PG8_SB(0, 0), b2, voffB); PG8_STAGE(PG8_SB(0, 1), b2 + hstep, voffB); PG8_STAGE(PG8_SA(0, 0), a2, voffA);
            PG8_WAIT_V(8); PG8_WAIT_L(0); PG8_BAR; PG8_MMA(1, 0, At, B0); PG8_MMA(1, 1, At, B1); PG8_BAR; PG8_SCHED;
            PG8_LDB(B0, 1, 0); PG8_LDB(B1, 1, 1); PG8_SCHED; PG8_LDA(At, 1, 0); PG8_STAGE(PG8_SA(0, 1), a2 + hstep, voffA);
            PG8_WAIT_V(8); PG8_WAIT_L(0); PG8_BAR; PG8_MMA(0, 0, At, B0); PG8_MMA(0, 1, At, B1); PG8_BAR; PG8_SCHED;
            PG8_LDA(At, 1, 1); PG8_STAGE(PG8_SB(1, 0), b3, voffB); PG8_STAGE(PG8_SB(1, 1), b3 + hstep, voffB); PG8_STAGE(PG8_SA(1, 0), a3, voffA);
            PG8_WAIT_V(8); PG8_WAIT_L(0); PG8_BAR; PG8_MMA(1, 0, At, B0); PG8_MMA(1, 1, At, B1); PG8_BAR; PG8_SCHED;
            } else {
            PG8_LDB(B0, 0, 0); PG8_SCHED; PG8_LDA(At, 0, 0); PG8_STAGE(PG8_SA(1, 1), a1 + hstep, voffA);
            PG8_WAIT_L(8); PG8_BAR; PG8_WAIT_L(0); PG8_MMA(0, 0, At, B0); PG8_BAR; PG8_SCHED;
            PG8_LDB(B1, 0, 1); PG8_STAGE(PG8_SB(0, 0), b2, voffB);
            PG8_BAR; PG8_WAIT_L(0); PG8_MMA(0, 1, At, B1); PG8_BAR;
            PG8_LDA(At, 0, 1); PG8_STAGE(PG8_SA(0, 0), a2, voffA);
            PG8_BAR; PG8_WAIT_L(0); PG8_MMA(1, 0, At, B0); PG8_BAR; PG8_SCHED;
            PG8_STAGE(PG8_SB(0, 1), b2 + hstep, voffB);
            PG8_WAIT_V(6); PG8_BAR; PG8_MMA(1, 1, At, B1); PG8_BAR;
            PG8_LDB(B0, 1, 0); PG8_SCHED; PG8_LDA(At, 1, 0); PG8_STAGE(PG8_SA(0, 1), a2 + hstep, voffA);
            PG8_WAIT_L(8); PG8_BAR; PG8_WAIT_L(0); PG8_MMA(0, 0, At, B0); PG8_BAR; PG8_SCHED;
            PG8_LDB(B1, 1, 1); PG8_STAGE(PG8_SB(1, 0), b3, voffB);
            PG8_BAR; PG8_WAIT_L(0); PG8_MMA(0, 1, At, B1); PG8_BAR;
            PG8_LDA(At, 1, 1); PG8_STAGE(PG8_SA(1, 0), a3, voffA);
            PG8_BAR; PG8_WAIT_L(0); PG8_MMA(1, 0, At, B0); PG8_BAR; PG8_SCHED;
            PG8_STAGE(PG8_SB(1, 1), b3 + hstep, voffB);
            PG8_WAIT_V(6); PG8_BAR; PG8_MMA(1, 1, At, B1); PG8_BAR;
            }
        }
        if constexpr (ALIGN_EPI) { if (wr == 0) PG8_BAR; }
        if constexpr (!Epi::AFTER_DRAIN) { E(acc, cur, wr, wc, fr, fq); S.done(cur); }
        if (!has_next) break;
#pragma unroll
        for (int a = 0; a < 2; ++a)
#pragma unroll
            for (int b = 0; b < 2; ++b)
#pragma unroll
                for (int m = 0; m < 4; ++m)
#pragma unroll
                    for (int n = 0; n < 2; ++n) acc[a][b][m][n] = (f32x4){0.f, 0.f, 0.f, 0.f};
        cur = nxt; cA = nA; cB = nB; ++ui;
        if constexpr (ALIGN_EPI) { if (wr == 1) PG8_BAR; }
    }
    PG8_WAIT_V(0);
    if constexpr (!ALIGN_EPI) { if (wr == 0) PG8_BAR; }
    PG8_BAR;
#undef PG8_SA
#undef PG8_SB
#undef PG8_STAGE
#undef PG8_LDA
#undef PG8_LDB
#undef PG8_MMA
#undef PG8_WAIT_V
#undef PG8_WAIT_L
#undef PG8_BAR
#undef PG8_SCHED
}
}

constexpr int NWAVES = 8, NTHR = 512;
constexpr int SEQ = 16384, DM = 2048, HD = 128, NHG = 8, DPROJ = 8208, NPJ = 8192, DFF = 5632, CH = 128, NCH = SEQ / CH, NHEADS = 16;
constexpr float NORM_EPS = 1e-6f;
constexpr int N_LAUNCHES = MK_N_LAUNCHES, NPHASES = 10;
constexpr int PC_MQ = 0, PC_MK = 1024, PC_MV = 2048, PC_MO = 3072, PC_RQ = 4096, PC_RK = 5120, PC_RV = 6144, PC_RG = 7168;

constexpr size_t MiB = 1u << 20;
constexpr size_t WS_CTL = 0, CTL_ZERO_BYTES = 64 * 1024;
constexpr size_t WS_WIN = 2 * MiB, WS_WO = 34 * MiB, WS_WGU = 42 * MiB, WS_WD = 86 * MiB;
constexpr size_t WS_PRE = 108 * MiB;
constexpr size_t WS_RS = 109 * MiB;
constexpr size_t WS_NLOC = 110 * MiB;
constexpr size_t WS_N0 = 110 * MiB + 512 * 1024;
constexpr size_t WS_DEC = 111 * MiB;
constexpr size_t WS_GHEAD = 111 * MiB + 65536;
constexpr size_t WS_COS = 112 * MiB, WS_SIN = 116 * MiB;
constexpr size_t WS_B = 128 * MiB;
constexpr size_t WS_A = 384 * MiB;
constexpr size_t WS_FF = WS_B + 176 * MiB;
constexpr size_t WS_END = 448 * MiB;
constexpr int CW_BAR = 1024;

constexpr int RING_BYTES = 131072;
constexpr int GATE_OFF = RING_BYTES;
constexpr int MISC_OFF = RING_BYTES + 2048;
constexpr int LDS_BYTES = 147456;

#define GAS __attribute__((address_space(1)))
#define LAS __attribute__((address_space(3)))
#define DI __device__ __forceinline__
typedef unsigned short bf16;
typedef unsigned u32x4 __attribute__((ext_vector_type(4)));
typedef unsigned u32x2 __attribute__((ext_vector_type(2)));
typedef float f32x4 __attribute__((ext_vector_type(4)));
typedef float f32x2 __attribute__((ext_vector_type(2)));
typedef LAS unsigned char* ldsp;
#define LDS_WAIT() asm volatile("s_waitcnt lgkmcnt(0)" ::: "memory")

DI unsigned f2bf(float f) { unsigned u = __builtin_bit_cast(unsigned, f); return (u + 0x7fffu + ((u >> 16) & 1u)) >> 16; }
DI unsigned pk2(float lo, float hi) { return f2bf(lo) | (f2bf(hi) << 16); }
DI float bflo(unsigned w) { return __builtin_bit_cast(float, w << 16); }
DI float bfhi(unsigned w) { return __builtin_bit_cast(float, w & 0xffff0000u); }
DI void unpack8(const u32x4 w, float (&f)[8]) { f[0] = bflo(w.x); f[1] = bfhi(w.x); f[2] = bflo(w.y); f[3] = bfhi(w.y); f[4] = bflo(w.z); f[5] = bfhi(w.z); f[6] = bflo(w.w); f[7] = bfhi(w.w); }
DI u32x4 pack8(const float (&f)[8]) { u32x4 w; w.x = pk2(f[0], f[1]); w.y = pk2(f[2], f[3]); w.z = pk2(f[4], f[5]); w.w = pk2(f[6], f[7]); return w; }
DI float sigmoid_f(float x) { return 1.0f / (1.0f + __expf(-x)); }
DI float silu_f(float x) { return x / (1.0f + __expf(-x)); }
DI float wave_sum(float v) {
#pragma unroll
    for (int o = 1; o < 64; o <<= 1) v += __shfl_xor(v, o);
    return v;
}

#define XB_TMO      128
#define XB_XCNT(j)  (256  + 64 * (j))
#define XB_XSUB(j)  (1280 + 64 * (j))
#define XB_XGEN(j)  (2304 + 64 * (j))
#define XB_TOP      3328
#define XB_TOPGEN   3392
#define XCD_BAR_WORDS 3456
#define XB_SPIN_CAP (1u << 18)
__device__ __forceinline__ unsigned xb_ld(unsigned* p)              { return __hip_atomic_load(p, __ATOMIC_RELAXED, __HIP_MEMORY_SCOPE_AGENT); }
__device__ __forceinline__ unsigned xb_add(unsigned* p, unsigned v) { return __hip_atomic_fetch_add(p, v, __ATOMIC_RELAXED, __HIP_MEMORY_SCOPE_AGENT); }
__device__ __forceinline__ unsigned xb_xcc_id() { return (unsigned)__builtin_amdgcn_s_getreg((3 << 11) | 20) & 0xFu; }
#define XB_SPIN(cond, bar) do { unsigned _sp = 0; while (cond) { __builtin_amdgcn_s_sleep(1); \
    if ((++_sp & 255u) == 0u) { if (xb_ld(&(bar)[XB_TMO])) break; if (_sp > XB_SPIN_CAP) { atomicAdd(&(bar)[XB_TMO], 1u); break; } } } } while (0)
struct XcdBarrier { unsigned* bar; unsigned x; volatile LAS unsigned* st; };
__device__ __forceinline__ XcdBarrier xcd_barrier_post(unsigned* bar, volatile LAS unsigned* st) {
    XcdBarrier b; b.bar = bar; b.x = xb_xcc_id(); b.st = st;
    if (threadIdx.x == 0) (void)xb_add(&bar[XB_XCNT(b.x)], 1u);
    return b;
}
__device__ __forceinline__ void xcd_barrier_complete(unsigned* bar, unsigned x, unsigned& nloc, unsigned& nx) {
    const unsigned G = gridDim.x * gridDim.y * gridDim.z;
    unsigned sum, cnt, mine, sp = 0u;
    for (;;) {
        sum = 0u; cnt = 0u; mine = 0u;
#pragma unroll
        for (unsigned j = 0; j < 16; ++j) { const unsigned c = xb_ld(&bar[XB_XCNT(j)]); sum += c; cnt += (c > 0u) ? 1u : 0u; mine = (j == x) ? c : mine; }
        if (sum == G) break;
        __builtin_amdgcn_s_sleep(1);
        if ((++sp & 255u) == 0u) { if (xb_ld(&bar[XB_TMO])) break; if (sp > XB_SPIN_CAP) { atomicAdd(&bar[XB_TMO], 1u); break; } }
    }
    nloc = mine > 0u ? mine : 1u; nx = cnt > 0u ? cnt : 1u;
}
__device__ __forceinline__ void xcd_barrier(const XcdBarrier& b) {
    asm volatile("s_waitcnt vmcnt(0)" ::: "memory");
    __syncthreads();
    if (threadIdx.x == 0) {
        unsigned* bar = b.bar;
        __builtin_amdgcn_s_waitcnt(0);
        unsigned nloc = b.st[0], nx = b.st[1];
        if (nloc == 0u) { xcd_barrier_complete(bar, b.x, nloc, nx); b.st[0] = nloc; b.st[1] = nx; }
        const unsigned old = xb_add(&bar[XB_XSUB(b.x)], 1u);
        const unsigned gen = old / nloc;
        if (old + 1u == (gen + 1u) * nloc) {
            __builtin_amdgcn_fence(__ATOMIC_RELEASE, "agent");
            asm volatile("s_waitcnt vmcnt(0)" ::: "memory");
            const unsigned og = xb_add(&bar[XB_TOP], 1u);
            const unsigned tg = og / nx;
            if (og + 1u == (tg + 1u) * nx) xb_add(&bar[XB_TOPGEN], 1u);
            else XB_SPIN(xb_ld(&bar[XB_TOPGEN]) == tg, bar);
            __builtin_amdgcn_fence(__ATOMIC_ACQUIRE, "agent");
            xb_add(&bar[XB_XGEN(b.x)], 1u);
            asm volatile("s_waitcnt vmcnt(0)" ::: "memory");
        } else {
            XB_SPIN(xb_ld(&bar[XB_XGEN(b.x)]) == gen, bar);
            __builtin_amdgcn_fence(__ATOMIC_ACQUIRE, "agent");
            asm volatile("s_waitcnt vmcnt(0)" ::: "memory");
        }
    }
    __syncthreads();
}

struct Args { const void* in[17]; float* out; unsigned char* ws; int ph_lo, ph_hi, li, pad; };
enum { IN_X = 0, IN_POS, IN_GPRE, IN_WIN, IN_CW, IN_CB, IN_BI, IN_BF, IN_GMH, IN_GRH, IN_WOUT, IN_GPOST, IN_GFPRE, IN_WG, IN_WU, IN_WDN, IN_GFPOST };

DI void p0_transpose_item(const float* W, int K, int ldw, int src_col, bf16* WT, int dst_row, LAS float* scr, int kb, int lane) {
    const int k0 = 64 * kb;
#pragma unroll 8
    for (int i = 0; i < 32; ++i) { const int kk = 2 * i + (lane >> 5); scr[kk * 33 + (lane & 31)] = W[(size_t)(k0 + kk) * ldw + src_col + (lane & 31)]; }
    LDS_WAIT(); asm volatile("" ::: "memory");
    const int c = lane & 7;
#pragma unroll
    for (int j = 0; j < 4; ++j) { const int n = (lane >> 3) + 8 * j; const LAS float* s = scr + (8 * c) * 33 + n;
        u32x4 o; o.x = pk2(s[0 * 33], s[1 * 33]); o.y = pk2(s[2 * 33], s[3 * 33]); o.z = pk2(s[4 * 33], s[5 * 33]); o.w = pk2(s[6 * 33], s[7 * 33]);
        *(GAS u32x4*)(WT + (size_t)(dst_row + n) * K + k0 + 8 * c) = o; }
    LDS_WAIT(); asm volatile("" ::: "memory");
}
typedef float f32x4g __attribute__((ext_vector_type(4)));
DI void p0_gates(const Args& a, ldsp lds, int tid, int lane, int wave, int vcu, int G) {
    const float* x = (const float*)a.in[IN_X]; const float* gpre = (const float*)a.in[IN_GPRE]; const float* w_in = (const float*)a.in[IN_WIN]; float* PRE = (float*)(a.ws + WS_PRE);
    LAS float* Wl = (LAS float*)lds;
    LAS float* part = (LAS float*)(lds + MISC_OFF + 1024);
#pragma unroll 4
    for (int i = 0; i < 16; ++i) { const int idx = tid + NTHR * i, k = idx >> 2, c4 = idx & 3;
        f32x4 w = *(const GAS f32x4*)(w_in + (size_t)k * DPROJ + 4096 + 4 * c4); w = w * gpre[k];
        const int row = (k & ~15) + 4 * (k & 3) + ((k >> 2) & 3);
        *(LAS f32x4*)(Wl + row * 16 + 4 * c4) = w; }
    LDS_WAIT(); __syncthreads();
    for (int rb = vcu; rb < SEQ / 64; rb += G) {
        const int tile = wave & 3, kh = wave >> 2, row = lane & 15, q = lane >> 4, t0 = rb * 64 + tile * 16;
        const GAS f32x4* xr = (const GAS f32x4*)(x + (size_t)(t0 + row) * DM + kh * 1024 + 4 * q);
        const LAS float* wl = Wl + (kh * 1024 + q) * 16 + row;
        f32x4g acc = {0.f, 0.f, 0.f, 0.f}; float ss = 0.f;
        for (int sp = 0; sp < 64; sp += 4) { f32x4 xv[4];
#pragma unroll
            for (int j = 0; j < 4; ++j) xv[j] = xr[4 * (sp + j)];
#pragma unroll
            for (int j = 0; j < 4; ++j) { ss += (xv[j].x * xv[j].x + xv[j].y * xv[j].y) + (xv[j].z * xv[j].z + xv[j].w * xv[j].w);
                const LAS float* wp = wl + (sp + j) * 256;
                acc = __builtin_amdgcn_mfma_f32_16x16x4f32(xv[j].x, wp[0], acc, 0, 0, 0); acc = __builtin_amdgcn_mfma_f32_16x16x4f32(xv[j].y, wp[64], acc, 0, 0, 0);
                acc = __builtin_amdgcn_mfma_f32_16x16x4f32(xv[j].z, wp[128], acc, 0, 0, 0); acc = __builtin_amdgcn_mfma_f32_16x16x4f32(xv[j].w, wp[192], acc, 0, 0, 0); } }
        if (kh == 1) {
#pragma unroll
            for (int j = 0; j < 4; ++j) part[(tile * 4 + j) * 64 + lane] = acc[j];
            part[1024 + tile * 64 + lane] = ss; }
        LDS_WAIT(); __syncthreads();
        if (kh == 0) {
#pragma unroll
            for (int j = 0; j < 4; ++j) acc[j] += part[(tile * 4 + j) * 64 + lane];
            ss += part[1024 + tile * 64 + lane];
            ss += __shfl_xor(ss, 16); ss += __shfl_xor(ss, 32);
            const float rs = 1.0f / sqrtf(ss * (1.0f / DM) + NORM_EPS);
#pragma unroll
            for (int j = 0; j < 4; ++j) { const int ri = 4 * q + j; const float rsi = __shfl(rs, ri); PRE[(size_t)(t0 + ri) * 16 + row] = acc[j] * rsi; } }
        __syncthreads();
    }
}
DI void phase_p0(const Args& a, ldsp lds, int tid, int lane, int wave, int vcu, int G) {
    p0_gates(a, lds, tid, lane, wave, vcu, G);
    const int gw = vcu * NWAVES + wave, NGW = G * NWAVES;
    LAS float* scr = (LAS float*)(lds + wave * 16384);
    const float* w_in = (const float*)a.in[IN_WIN]; const float* w_out = (const float*)a.in[IN_WOUT];
    const float* w_g = (const float*)a.in[IN_WG]; const float* w_u = (const float*)a.in[IN_WU]; const float* w_d = (const float*)a.in[IN_WDN];
    bf16* WinT = (bf16*)(a.ws + WS_WIN); bf16* WoT = (bf16*)(a.ws + WS_WO); bf16* WguT = (bf16*)(a.ws + WS_WGU); bf16* WdT = (bf16*)(a.ws + WS_WD);
    constexpr int I_IN = 32 * 256, I_O = 32 * 64, I_G = 32 * 176, I_D = 88 * 64, NITEMS = I_IN + I_O + 2 * I_G + I_D;
    for (int it = gw; it < NITEMS; it += NGW) {
        int r = it;
        if (r < I_IN) { const int kb = r / 256, nb = r % 256; const int sc = nb < 128 ? 32 * nb : 4112 + 32 * (nb - 128);
            p0_transpose_item(w_in, DM, DPROJ, sc, WinT, 32 * nb, scr, kb, lane); continue; } r -= I_IN;
        if (r < I_O) { const int kb = r / 64, nb = r % 64; p0_transpose_item(w_out, DM, DM, 32 * nb, WoT, 32 * nb, scr, kb, lane); continue; } r -= I_O;
        if (r < I_G) { const int kb = r / 176, nb = r % 176; p0_transpose_item(w_g, DM, DFF, 32 * nb, WguT, 256 * (nb >> 2) + 32 * (nb & 3), scr, kb, lane); continue; } r -= I_G;
        if (r < I_G) { const int kb = r / 176, nb = r % 176; p0_transpose_item(w_u, DM, DFF, 32 * nb, WguT, 256 * (nb >> 2) + 128 + 32 * (nb & 3), scr, kb, lane); continue; } r -= I_G;
        { const int kb = r / 64, nb = r % 64; p0_transpose_item(w_d, DFF, DM, 32 * nb, WdT, 32 * nb, scr, kb, lane); }
    }
    const float* x = (const float*)a.in[IN_X]; const float* gpre = (const float*)a.in[IN_GPRE];
    bf16* hb = (bf16*)(a.ws + WS_A);
    for (int m = gw; m < SEQ; m += NGW) {
        const GAS f32x4* xr = (const GAS f32x4*)(x + (size_t)m * DM) + lane; const GAS f32x4* gr = (const GAS f32x4*)gpre + lane;
        f32x4 v[8]; float s = 0.f;
#pragma unroll
        for (int j = 0; j < 8; ++j) { v[j] = xr[64 * j]; s += (v[j].x * v[j].x + v[j].y * v[j].y) + (v[j].z * v[j].z + v[j].w * v[j].w); }
        const float r = 1.0f / sqrtf(wave_sum(s) * (1.0f / DM) + NORM_EPS);
        GAS u32x2* o = (GAS u32x2*)(hb + (size_t)m * DM) + lane;
#pragma unroll
        for (int j = 0; j < 8; ++j) { const f32x4 gg = gr[64 * j]; u32x2 w; w.x = pk2(v[j].x * r * gg.x, v[j].y * r * gg.y); w.y = pk2(v[j].z * r * gg.z, v[j].w * r * gg.w); o[64 * j] = w; }
    }
    { float* GH = (float*)(a.ws + WS_GHEAD); const float* gmh = (const float*)a.in[IN_GMH]; const float* grh = (const float*)a.in[IN_GRH];
      for (int i = vcu * NTHR + tid; i < 1024; i += G * NTHR) GH[i] = gmh[i];
      for (int i = vcu * NTHR + tid; i < 1024; i += G * NTHR) GH[1024 + i] = grh[i]; }
    const int* pos = (const int*)a.in[IN_POS]; float* COS = (float*)(a.ws + WS_COS); float* SIN = (float*)(a.ws + WS_SIN);
    for (int i = vcu * NTHR + tid; i < SEQ * 64; i += G * NTHR) { const int t = i >> 6, j = i & 63;
        const float inv = (float)pow(10000.0, -(double)(2 * j) / 128.0); const float ang = (float)pos[t] * inv; float sn, cs; sincosf(ang, &sn, &cs); COS[i] = cs; SIN[i] = sn; }
}

typedef short bf16x8 __attribute__((ext_vector_type(8)));
typedef float f32x16 __attribute__((ext_vector_type(16)));
#define MFMA32(a, b, c) __builtin_amdgcn_mfma_f32_32x32x16_bf16((a), (b), (c), 0, 0, 0)
DI int crow(int reg, int h) { return (reg & 3) + 8 * (reg >> 2) + 4 * h; }
DI bf16x8 bf_ones() { return (bf16x8){16256, 16256, 16256, 16256, 16256, 16256, 16256, 16256}; }
DI int tile_off(int row, int col) { return row * 256 + ((((col >> 3) ^ row) & 15) << 4) + ((col & 7) << 1); }
DI void store_row8(ldsp tile, int row, int col0, const float (&f)[8]) { *(LAS u32x4*)(tile + tile_off(row, col0)) = pack8(f); }
DI void store_T8(ldsp tile, int s, int d0, const float (&f)[8]) {
#pragma unroll
    for (int i = 0; i < 8; ++i) *(LAS unsigned short*)(tile + tile_off(d0 + i, s)) = (unsigned short)f2bf(f[i]);
}
DI void store_T8_bits(ldsp tile, int s, int d0, const u32x4 w) {
    const unsigned ww[4] = {w.x, w.y, w.z, w.w};
#pragma unroll
    for (int i = 0; i < 4; ++i) { *(LAS unsigned short*)(tile + tile_off(d0 + 2 * i, s)) = (unsigned short)(ww[i] & 0xffffu); *(LAS unsigned short*)(tile + tile_off(d0 + 2 * i + 1, s)) = (unsigned short)(ww[i] >> 16); }
}
DI void load_tile8(ldsp tile, int row, int col0, float (&f)[8]) { unpack8(*(const LAS u32x4*)(tile + tile_off(row, col0)), f); }
DI void gload8(const bf16* p, float (&f)[8]) { unpack8(*(const GAS u32x4*)p, f); }
DI bf16x8 ldfrag(ldsp tile, int row, int col0) { return *(const LAS bf16x8*)(tile + tile_off(row, col0)); }

DI void mixer_gates(const Args& a, ldsp lds, int g, int c, int tid, int lane, int wave) {
    LAS float* rowv = (LAS float*)(lds + GATE_OFF); LAS float* colv = rowv + 128; LAS float* alog = rowv + 256;
    if (g < NHG) {
        if (wave == 0) {
            const float* PRE = (const float*)(a.ws + WS_PRE); const float bi = ((const float*)a.in[IN_BI])[g], bfg = ((const float*)a.in[IN_BF])[g];
            const int t0 = c * CH + 2 * lane;
            const float i0 = PRE[(size_t)t0 * 16 + g] + bi, i1 = PRE[(size_t)(t0 + 1) * 16 + g] + bi;
            const float f0 = PRE[(size_t)t0 * 16 + 8 + g] + bfg, f1 = PRE[(size_t)(t0 + 1) * 16 + 8 + g] + bfg;
            const float l0 = fminf(f0, 0.f) - log1pf(__expf(-fabsf(f0))), l1 = fminf(f1, 0.f) - log1pf(__expf(-fabsf(f1)));
            float p = l0 + l1;
#pragma unroll
            for (int o = 1; o < 64; o <<= 1) { const float y = __shfl_up(p, o); if (lane >= o) p += y; }
            const float b1 = p, b0 = p - l1;
            rowv[2 * lane] = b0; rowv[2 * lane + 1] = b1; alog[2 * lane] = b0; alog[2 * lane + 1] = b1; colv[2 * lane] = i0 - b0; colv[2 * lane + 1] = i1 - b1;
        }
    } else if (tid < 128) {
        const float lg = log1pf(-exp2f(-5.0f - (float)(g - NHG)));
        rowv[tid] = (float)tid * lg; colv[tid] = -(float)tid * lg; alog[tid] = (float)(tid + 1) * lg;
    }
    LDS_WAIT(); __syncthreads();
}
DI void conv8(const bf16* proj, const float* cw, const float* cb, int t, int col, float (&o)[8]) {
    float acc[8];
    { const f32x4 b0 = *(const GAS f32x4*)(cb + col), b1 = *(const GAS f32x4*)(cb + col + 4); acc[0] = b0.x; acc[1] = b0.y; acc[2] = b0.z; acc[3] = b0.w; acc[4] = b1.x; acc[5] = b1.y; acc[6] = b1.z; acc[7] = b1.w; }
#pragma unroll
    for (int j = 0; j < 4; ++j) { const int tt = t - 3 + j;
        if (tt >= 0) { float u[8]; gload8(proj + (size_t)tt * NPJ + col, u);
            const f32x4 w0 = *(const GAS f32x4*)(cw + j * 2048 + col), w1 = *(const GAS f32x4*)(cw + j * 2048 + col + 4);
            acc[0] += w0.x * u[0]; acc[1] += w0.y * u[1]; acc[2] += w0.z * u[2]; acc[3] += w0.w * u[3]; acc[4] += w1.x * u[4]; acc[5] += w1.y * u[5]; acc[6] += w1.z * u[6]; acc[7] += w1.w * u[7]; } }
#pragma unroll
    for (int i = 0; i < 8; ++i) o[i] = silu_f(acc[i]);
}
template <int MODE> DI void mixer_tiles(const Args& a, ldsp lds, int g, int c, int tid) {
    const bf16* proj = (const bf16*)(a.ws + WS_B);
    const LAS float* rowv = (const LAS float*)(lds + GATE_OFF); const LAS float* colv = rowv + 128;
    ldsp T0 = lds, T1 = lds + 32768, T2 = lds + 65536; ldsp TV = MODE == 1 ? T1 : T2;
    const float kscale = 0.08838834764831845f;
    if (g < NHG) {
        const float* cw = (const float*)a.in[IN_CW]; const float* cb = (const float*)a.in[IN_CB];
        for (int i = 0; i < 4; ++i) { const int item = tid + NTHR * i, s = item >> 4, dg = item & 15, t = c * CH + s;
            float kv[8]; conv8(proj, cw, cb, t, PC_MK + g * HD + 8 * dg, kv);
            const float sc = MODE == 1 ? kscale * __expf(rowv[127] + colv[s]) : kscale;
#pragma unroll
            for (int j = 0; j < 8; ++j) kv[j] *= sc;
            if (MODE == 1) store_T8(T0, s, 8 * dg, kv); else store_row8(T1, s, 8 * dg, kv);
            store_T8_bits(TV, s, 8 * dg, *(const GAS u32x4*)(proj + (size_t)t * NPJ + PC_MV + g * HD + 8 * dg));
            if (MODE == 3) { float qv[8]; conv8(proj, cw, cb, t, PC_MQ + g * HD + 8 * dg, qv); store_row8(T0, s, 8 * dg, qv); }
        }
    } else {
        const int gr = g - NHG; const float* COS = (const float*)(a.ws + WS_COS); const float* SIN = (const float*)(a.ws + WS_SIN);
        for (int i = 0; i < 2; ++i) { const int item = tid + NTHR * i, s = item >> 3, dg = item & 7, t = c * CH + s;
            float cs[8], sn[8];
            { const f32x4 c0 = *(const GAS f32x4*)(COS + (size_t)t * 64 + 8 * dg), c1 = *(const GAS f32x4*)(COS + (size_t)t * 64 + 8 * dg + 4), s0 = *(const GAS f32x4*)(SIN + (size_t)t * 64 + 8 * dg), s1 = *(const GAS f32x4*)(SIN + (size_t)t * 64 + 8 * dg + 4);
              cs[0] = c0.x; cs[1] = c0.y; cs[2] = c0.z; cs[3] = c0.w; cs[4] = c1.x; cs[5] = c1.y; cs[6] = c1.z; cs[7] = c1.w; sn[0] = s0.x; sn[1] = s0.y; sn[2] = s0.z; sn[3] = s0.w; sn[4] = s1.x; sn[5] = s1.y; sn[6] = s1.z; sn[7] = s1.w; }
            float lo[8], hi[8], olo[8], ohi[8];
            gload8(proj + (size_t)t * NPJ + PC_RK + gr * HD + 8 * dg, lo); gload8(proj + (size_t)t * NPJ + PC_RK + gr * HD + 64 + 8 * dg, hi);
            const float sc = MODE == 1 ? kscale * __expf(rowv[127] + colv[s]) : kscale;
#pragma unroll
            for (int j = 0; j < 8; ++j) { olo[j] = (lo[j] * cs[j] - hi[j] * sn[j]) * sc; ohi[j] = (hi[j] * cs[j] + lo[j] * sn[j]) * sc; }
            if (MODE == 1) { store_T8(T0, s, 8 * dg, olo); store_T8(T0, s, 64 + 8 * dg, ohi); } else { store_row8(T1, s, 8 * dg, olo); store_row8(T1, s, 64 + 8 * dg, ohi); }
            if (MODE == 3) {
                gload8(proj + (size_t)t * NPJ + PC_RQ + gr * HD + 8 * dg, lo); gload8(proj + (size_t)t * NPJ + PC_RQ + gr * HD + 64 + 8 * dg, hi);
#pragma unroll
                for (int j = 0; j < 8; ++j) { olo[j] = lo[j] * cs[j] - hi[j] * sn[j]; ohi[j] = hi[j] * cs[j] + lo[j] * sn[j]; }
                store_row8(T0, s, 8 * dg, olo); store_row8(T0, s, 64 + 8 * dg, ohi);
            }
        }
        for (int i = 0; i < 4; ++i) { const int item = tid + NTHR * i, s = item >> 4, dg = item & 15, t = c * CH + s;
            store_T8_bits(TV, s, 8 * dg, *(const GAS u32x4*)(proj + (size_t)t * NPJ + PC_RV + gr * HD + 8 * dg)); }
    }
    LDS_WAIT(); __syncthreads();
}

DI void phase_m1(const Args& a, ldsp lds, int tid_in, int wave, int vcu, int G) {
    float* UT = a.out; float* NLOC = (float*)(a.ws + WS_NLOC); float* DEC = (float*)(a.ws + WS_DEC);
    const LAS float* alog = (const LAS float*)(lds + GATE_OFF) + 256;
    for (int u = vcu; u < NHEADS * NCH; u += G) { const int g = u / NCH, c = u % NCH;
        int tid_o = tid_in; asm volatile("" : "+v"(tid_o));
        const int tid = tid_o, lane = tid & 63;
        mixer_gates(a, lds, g, c, tid, lane, wave);
        mixer_tiles<1>(a, lds, g, c, tid);
        ldsp KT = lds, VT = lds + 32768;
        if (tid == 0) DEC[g * NCH + c] = __expf(alog[127]);
        { const int r = lane & 31, h = lane >> 5, wi = wave >> 1, wj = wave & 1; const bool ml = g < NHG;
          f32x16 accU[2], accN[2];
#pragma unroll
          for (int i = 0; i < 16; ++i) { accU[0][i] = 0.f; accU[1][i] = 0.f; accN[0][i] = 0.f; accN[1][i] = 0.f; }
#pragma unroll
          for (int ks = 0; ks < 8; ++ks) {
              const bf16x8 af = ldfrag(VT, 32 * wi + r, 16 * ks + 8 * h), b0 = ldfrag(KT, 64 * wj + r, 16 * ks + 8 * h), b1 = ldfrag(KT, 64 * wj + 32 + r, 16 * ks + 8 * h);
              accU[0] = MFMA32(af, b0, accU[0]); accU[1] = MFMA32(af, b1, accU[1]);
              if (ml && wi == 0) { accN[0] = MFMA32(bf_ones(), b0, accN[0]); accN[1] = MFMA32(bf_ones(), b1, accN[1]); }
          }
          float* o = UT + ((size_t)(g * NCH + c) << 14);
#pragma unroll
          for (int n = 0; n < 2; ++n)
#pragma unroll
              for (int i = 0; i < 16; ++i) o[(32 * wi + crow(i, h)) * HD + 64 * wj + 32 * n + r] = accU[n][i];
          if (ml && wi == 0 && h == 0) { NLOC[((size_t)g * NCH + c) * HD + 64 * wj + r] = accN[0][0]; NLOC[((size_t)g * NCH + c) * HD + 64 * wj + 32 + r] = accN[1][0]; }
        }
        __syncthreads();
    }
}
DI void phase_m2(const Args& a, int tid, int vcu, int G) {
    const float* UT = a.out; bf16* C0T = (bf16*)(a.ws + WS_A); const float* DEC = (const float*)(a.ws + WS_DEC);
    const float* NLOC = (const float*)(a.ws + WS_NLOC); float* N0 = (float*)(a.ws + WS_N0);
    const int gt = vcu * NTHR + tid, NT = G * NTHR;
    for (int p = gt; p < NHEADS * 8192; p += NT) { const int e0 = p * 2, g = e0 >> 14, r = e0 & 16383;
        const float* dec = DEC + g * NCH; float c0 = 0.f, c1 = 0.f;
        for (int c = 0; c < NCH; c += 8) { f32x2 uu[8];
#pragma unroll
            for (int j = 0; j < 8; ++j) uu[j] = *(const GAS f32x2*)(UT + ((size_t)(g * NCH + c + j) << 14) + r);
#pragma unroll
            for (int j = 0; j < 8; ++j) { *(GAS unsigned*)(C0T + ((size_t)(g * NCH + c + j) << 14) + r) = pk2(c0, c1); const float d = dec[c + j]; c0 = d * c0 + uu[j].x; c1 = d * c1 + uu[j].y; } }
    }
    for (int p = gt; p < NHG * HD; p += NT) { const int g = p >> 7, d = p & 127; float n = 0.f;
        for (int c = 0; c < NCH; ++c) { N0[((size_t)g * NCH + c) * HD + d] = n; n = DEC[g * NCH + c] * n + NLOC[((size_t)g * NCH + c) * HD + d]; } }
}
DI void phase_m3(const Args& a, ldsp lds, int tid_in, int wave, int vcu, int G) {
    const bf16* proj = (const bf16*)(a.ws + WS_B); const bf16* C0T = (const bf16*)(a.ws + WS_A); const float* N0 = (const float*)(a.ws + WS_N0);
    bf16* mixb = (bf16*)a.out;
    const LAS float* rowv = (const LAS float*)(lds + GATE_OFF); const LAS float* colv = rowv + 128; const LAS float* alog = rowv + 256;
    LAS unsigned short* n0b = (LAS unsigned short*)(lds + GATE_OFF + 1536);
    ldsp Q = lds, K = lds + 32768, VT = lds + 65536, C0 = lds + 98304, P = lds + 98304; LAS float* H = (LAS float*)lds;
    const int wi = wave >> 1, wj = wave & 1;
    for (int u = vcu; u < NHEADS * NCH; u += G) { const int g = u / NCH, c = u % NCH; const bool ml = g < NHG;
        int tid_o = tid_in; asm volatile("" : "+v"(tid_o));
        const int tid = tid_o, lane = tid & 63, r = lane & 31, h = lane >> 5;
        mixer_gates(a, lds, g, c, tid, lane, wave);
        { const bf16* c0t = C0T + ((size_t)(g * NCH + c) << 14);
#pragma unroll
          for (int i = 0; i < 4; ++i) { const int item = tid + NTHR * i, e = item >> 4, ch = item & 15; *(LAS u32x4*)(C0 + tile_off(e, 8 * ch)) = *(const GAS u32x4*)(c0t + e * HD + 8 * ch); }
          if (tid < 128) n0b[tid] = ml ? (unsigned short)f2bf(N0[((size_t)g * NCH + c) * HD + tid]) : (unsigned short)0; }
        mixer_tiles<3>(a, lds, g, c, tid);
        f32x16 accO[2], accS[2], accD;
#pragma unroll
        for (int i = 0; i < 16; ++i) { accO[0][i] = 0.f; accO[1][i] = 0.f; accS[0][i] = 0.f; accS[1][i] = 0.f; accD[i] = 0.f; }
#pragma unroll
        for (int ks = 0; ks < 8; ++ks) {
            const bf16x8 af = ldfrag(Q, 32 * wi + r, 16 * ks + 8 * h), b0 = ldfrag(C0, 64 * wj + r, 16 * ks + 8 * h), b1 = ldfrag(C0, 64 * wj + 32 + r, 16 * ks + 8 * h);
            accO[0] = MFMA32(af, b0, accO[0]); accO[1] = MFMA32(af, b1, accO[1]);
            if (ml) { const bf16x8 bn = *(const LAS bf16x8*)(n0b + 16 * ks + 8 * h); accD = MFMA32(af, bn, accD); }
        }
        float rv[16];
#pragma unroll
        for (int i = 0; i < 16; ++i) { const int t = 32 * wi + crow(i, h); const float al = __expf(alog[t]); rv[i] = rowv[t]; accO[0][i] *= al; accO[1][i] *= al; accD[i] *= al; }
#pragma unroll
        for (int ks = 0; ks < 8; ++ks) {
            const bf16x8 af = ldfrag(Q, 32 * wi + r, 16 * ks + 8 * h), b0 = ldfrag(K, 64 * wj + r, 16 * ks + 8 * h), b1 = ldfrag(K, 64 * wj + 32 + r, 16 * ks + 8 * h);
            accS[0] = MFMA32(af, b0, accS[0]); accS[1] = MFMA32(af, b1, accS[1]);
        }
        __syncthreads();
#pragma unroll
        for (int n = 0; n < 2; ++n) { const int sidx = 64 * wj + 32 * n + r; const float cv = colv[sidx];
#pragma unroll
            for (int i = 0; i < 16; ++i) { const int t = 32 * wi + crow(i, h); const float val = (sidx <= t) ? accS[n][i] * __expf(rv[i] + cv) : 0.f;
                *(LAS unsigned short*)(P + tile_off(t, sidx)) = (unsigned short)f2bf(val); } }
        LDS_WAIT(); __syncthreads();
#pragma unroll
        for (int ks = 0; ks < 8; ++ks) {
            const bf16x8 af = ldfrag(P, 32 * wi + r, 16 * ks + 8 * h), b0 = ldfrag(VT, 64 * wj + r, 16 * ks + 8 * h), b1 = ldfrag(VT, 64 * wj + 32 + r, 16 * ks + 8 * h);
            accO[0] = MFMA32(af, b0, accO[0]); accO[1] = MFMA32(af, b1, accO[1]);
            if (ml) accD = MFMA32(af, bf_ones(), accD);
        }
#pragma unroll
        for (int i = 0; i < 16; ++i) { const int t = 32 * wi + crow(i, h); const float rden = ml ? 1.0f / fmaxf(fabsf(accD[i]), 1.0f) : 1.0f;
            H[t * HD + 64 * wj + r] = accO[0][i] * rden; H[t * HD + 64 * wj + 32 + r] = accO[1][i] * rden; }
        LDS_WAIT(); __syncthreads();
        for (int hh = 0; hh < 2; ++hh) {
            const int tl = tid >> 3, eg = tid & 7, t = 64 * hh + tl;
            float hv[16]; float ss = 0.f;
#pragma unroll
            for (int q = 0; q < 4; ++q) { const f32x4 x4 = *(const LAS f32x4*)(H + t * HD + 16 * eg + 4 * q); hv[4 * q] = x4.x; hv[4 * q + 1] = x4.y; hv[4 * q + 2] = x4.z; hv[4 * q + 3] = x4.w; }
#pragma unroll
            for (int i = 0; i < 16; ++i) ss += hv[i] * hv[i];
            ss += __shfl_xor(ss, 1); ss += __shfl_xor(ss, 2); ss += __shfl_xor(ss, 4);
            const float rn = 1.0f / sqrtf(ss * (1.0f / HD) + NORM_EPS);
            const int tg = c * CH + t; const int hc = ml ? g * HD + 16 * eg : (g - NHG) * HD + 16 * eg;
            const float* gh = (const float*)(a.ws + WS_GHEAD) + (ml ? 0 : 1024) + hc;
            const bf16* gp = proj + (size_t)tg * NPJ + (ml ? PC_MO : PC_RG) + hc;
            float ga[16]; { float t8[8]; gload8(gp, t8);
#pragma unroll
                for (int j = 0; j < 8; ++j) ga[j] = t8[j]; gload8(gp + 8, t8);
#pragma unroll
                for (int j = 0; j < 8; ++j) ga[8 + j] = t8[j]; }
            float o[16];
#pragma unroll
            for (int i = 0; i < 16; ++i) o[i] = hv[i] * rn * gh[i] * (ml ? sigmoid_f(ga[i]) : silu_f(ga[i]));
            bf16* op = mixb + (size_t)tg * DM + (ml ? 0 : 1024) + hc;
            u32x4 w0, w1; w0.x = pk2(o[0], o[1]); w0.y = pk2(o[2], o[3]); w0.z = pk2(o[4], o[5]); w0.w = pk2(o[6], o[7]); w1.x = pk2(o[8], o[9]); w1.y = pk2(o[10], o[11]); w1.z = pk2(o[12], o[13]); w1.w = pk2(o[14], o[15]);
            *(GAS u32x4*)op = w0; *(GAS u32x4*)(op + 8) = w1;
        }
        __syncthreads();
    }
}
DI void phase_r1(const Args& a, int lane, int wave, int vcu, int G) {
    const int gw = vcu * NWAVES + wave, NGW = G * NWAVES;
    const float* x = (const float*)a.in[IN_X]; const bf16* mix = (const bf16*)(a.ws + WS_B); float* x1 = a.out; bf16* h2 = (bf16*)(a.ws + WS_A);
    const GAS f32x4* gp = (const GAS f32x4*)a.in[IN_GPOST] + lane; const GAS f32x4* gf = (const GAS f32x4*)a.in[IN_GFPRE] + lane;
    for (int m = gw; m < SEQ; m += NGW) {
        const GAS u32x2* mr = (const GAS u32x2*)(mix + (size_t)m * DM) + lane; const GAS f32x4* xr = (const GAS f32x4*)(x + (size_t)m * DM) + lane;
        f32x4 v[8]; float s = 0.f;
#pragma unroll
        for (int j = 0; j < 8; ++j) { const u32x2 w = mr[64 * j]; v[j] = (f32x4){bflo(w.x), bfhi(w.x), bflo(w.y), bfhi(w.y)}; s += (v[j].x * v[j].x + v[j].y * v[j].y) + (v[j].z * v[j].z + v[j].w * v[j].w); }
        const float r = 1.0f / sqrtf(wave_sum(s) * (1.0f / DM) + NORM_EPS); float s2 = 0.f;
        GAS f32x4* xo = (GAS f32x4*)(x1 + (size_t)m * DM) + lane;
#pragma unroll
        for (int j = 0; j < 8; ++j) { const f32x4 xx = xr[64 * j], gg = gp[64 * j]; v[j] = xx + v[j] * r * gg; xo[64 * j] = v[j]; s2 += (v[j].x * v[j].x + v[j].y * v[j].y) + (v[j].z * v[j].z + v[j].w * v[j].w); }
        const float r2 = 1.0f / sqrtf(wave_sum(s2) * (1.0f / DM) + NORM_EPS);
        GAS u32x2* o = (GAS u32x2*)(h2 + (size_t)m * DM) + lane;
#pragma unroll
        for (int j = 0; j < 8; ++j) { const f32x4 gg = gf[64 * j]; u32x2 w; w.x = pk2(v[j].x * r2 * gg.x, v[j].y * r2 * gg.y); w.y = pk2(v[j].z * r2 * gg.z, v[j].w * r2 * gg.w); o[64 * j] = w; }
    }
}
DI void phase_r2(const Args& a, int lane, int wave, int vcu, int G, bool poison) {
    const int gw = vcu * NWAVES + wave, NGW = G * NWAVES;
    const bf16* ff = (const bf16*)(a.ws + WS_FF); float* out = a.out; const GAS f32x4* gp = (const GAS f32x4*)a.in[IN_GFPOST] + lane;
    const float qn = __builtin_nanf("");
    for (int m = gw; m < SEQ; m += NGW) {
        const GAS u32x2* fr = (const GAS u32x2*)(ff + (size_t)m * DM) + lane; GAS f32x4* xo = (GAS f32x4*)(out + (size_t)m * DM) + lane;
        f32x4 v[8]; float s = 0.f;
#pragma unroll
        for (int j = 0; j < 8; ++j) { const u32x2 w = fr[64 * j]; v[j] = (f32x4){bflo(w.x), bfhi(w.x), bflo(w.y), bfhi(w.y)}; s += (v[j].x * v[j].x + v[j].y * v[j].y) + (v[j].z * v[j].z + v[j].w * v[j].w); }
        const float r = 1.0f / sqrtf(wave_sum(s) * (1.0f / DM) + NORM_EPS);
#pragma unroll
        for (int j = 0; j < 8; ++j) { const f32x4 gg = gp[64 * j]; f32x4 o = xo[64 * j] + v[j] * r * gg; if (poison) o = (f32x4){qn, qn, qn, qn}; xo[64 * j] = o; }
    }
}

__global__ void __launch_bounds__(NTHR, 2) fwd(Args a) {
    extern __shared__ __attribute__((aligned(16))) unsigned char lds_raw[];
    ldsp lds = (ldsp)lds_raw;
    const int tid = threadIdx.x, lane = tid & 63, wave = __builtin_amdgcn_readfirstlane(tid >> 6);
    const int G = gridDim.x; const int bx = blockIdx.x; const int vcu = (G % 8 == 0) ? (bx % 8) * (G / 8) + bx / 8 : bx;
    volatile LAS unsigned* MISC = (volatile LAS unsigned*)(lds + MISC_OFF);
    if (tid < 32) MISC[tid] = 0u;
    __syncthreads();
    unsigned* ctl = (unsigned*)(a.ws + WS_CTL);
    XcdBarrier bar; bar.bar = ctl + CW_BAR; bar.x = 0; bar.st = nullptr;
    if (N_LAUNCHES == 1) bar = xcd_barrier_post(ctl + CW_BAR, MISC + 8);
    const int lo = a.ph_lo, hi = a.ph_hi;
#define IN(k) (lo <= (k) && (k) < hi)
#define SEAM(k) do { if (IN(k) && IN((k) + 1)) xcd_barrier(bar); } while (0)

#define PH1_BODY { pg8::Gemm g{(const bf16*)(a.ws + WS_A), (const bf16*)(a.ws + WS_WIN), SEQ, NPJ, DM}; pg8::StaticOrder S; S.init(SEQ, NPJ, G, bx); \
        pg8::EpiBf16 E{(bf16*)(a.ws + WS_B), NPJ}; pg8::gemm_phase<pg8::EpiBf16, pg8::StaticOrder, true, true>(lds, g, S, E); }
#define PH5_BODY { pg8::Gemm g{(const bf16*)a.out, (const bf16*)(a.ws + WS_WO), SEQ, DM, DM}; pg8::StaticOrder S; S.init(SEQ, DM, G, bx); \
        pg8::EpiBf16 E{(bf16*)(a.ws + WS_B), DM}; pg8::gemm_phase<pg8::EpiBf16, pg8::StaticOrder, true, true>(lds, g, S, E); }
#define PH7_BODY { pg8::Gemm g{(const bf16*)(a.ws + WS_A), (const bf16*)(a.ws + WS_WGU), SEQ, 2 * DFF, DM}; pg8::StaticOrder S; S.init(SEQ, 2 * DFF, G, bx); \
        pg8::EpiSwiGLU E{(bf16*)(a.ws + WS_B), DFF}; pg8::gemm_phase<pg8::EpiSwiGLU, pg8::StaticOrder, true, true>(lds, g, S, E); }
#define PH8_BODY { pg8::Gemm g{(const bf16*)(a.ws + WS_B), (const bf16*)(a.ws + WS_WD), SEQ, DM, DFF}; pg8::StaticOrder S; S.init(SEQ, DM, G, bx); \
        pg8::EpiBf16 E{(bf16*)(a.ws + WS_FF), DM}; pg8::gemm_phase<pg8::EpiBf16, pg8::StaticOrder, true, true>(lds, g, S, E); }
#define DUP(k) (((PROBE_DUP) >> (k)) & 1)
    if (IN(0)) { phase_p0(a, lds, tid, lane, wave, vcu, G); if (DUP(0)) { __syncthreads(); phase_p0(a, lds, tid, lane, wave, vcu, G); } SEAM(0); }
    if (IN(1)) { PH1_BODY if (DUP(1)) PH1_BODY SEAM(1); }
    if (IN(2)) { phase_m1(a, lds, tid, wave, vcu, G); if (DUP(2)) phase_m1(a, lds, tid, wave, vcu, G); SEAM(2); }
    if (IN(3)) { phase_m2(a, tid, vcu, G); if (DUP(3)) phase_m2(a, tid, vcu, G); SEAM(3); }
    if (IN(4)) { phase_m3(a, lds, tid, wave, vcu, G); if (DUP(4)) phase_m3(a, lds, tid, wave, vcu, G); SEAM(4); }
    if (IN(5)) { PH5_BODY if (DUP(5)) PH5_BODY SEAM(5); }
    if (IN(6)) { phase_r1(a, lane, wave, vcu, G); if (DUP(6)) phase_r1(a, lane, wave, vcu, G); SEAM(6); }
    if (IN(7)) { PH7_BODY if (DUP(7)) PH7_BODY SEAM(7); }
    if (IN(8)) { PH8_BODY if (DUP(8)) PH8_BODY SEAM(8); }
    if (IN(9)) {
        bool poison = false;
        if (N_LAUNCHES == 1) poison = __hip_atomic_load(ctl + CW_BAR + XB_TMO, __ATOMIC_RELAXED, __HIP_MEMORY_SCOPE_AGENT) != 0u;
        phase_r2(a, lane, wave, vcu, G, poison);
    }
#undef PH1_BODY
#undef PH5_BODY
#undef PH7_BODY
#undef PH8_BODY
#undef DUP
#undef IN
#undef SEAM
}

extern "C" void kernel_launch(void* const* d_in, const int* in_sizes, int n_in, void* d_out, int out_size, void* d_ws, size_t ws_size, hipStream_t stream) {
    static int grid = 0;
    if (grid == 0) {
        if (n_in != 17 || in_sizes[0] != SEQ * DM || out_size != SEQ * DM || ws_size < WS_END) {
            fprintf(stderr, "kernel_launch: unexpected shapes (n_in %d, in0 %d, out %d, ws %zu); nothing launched\n", n_in, n_in > 0 ? in_sizes[0] : -1, out_size, ws_size); grid = -1; return; }
        int dev = 0, cus = 0, per_cu = 0;
        if (hipGetDevice(&dev) != hipSuccess || hipDeviceGetAttribute(&cus, hipDeviceAttributeMultiprocessorCount, dev) != hipSuccess) { grid = -1; return; }
        if (hipFuncSetAttribute((const void*)fwd, hipFuncAttributeMaxDynamicSharedMemorySize, LDS_BYTES) != hipSuccess) { fprintf(stderr, "kernel_launch: hipFuncSetAttribute failed\n"); grid = -1; return; }
        if (hipOccupancyMaxActiveBlocksPerMultiprocessor(&per_cu, (const void*)fwd, NTHR, LDS_BYTES) != hipSuccess || per_cu < 1)
            fprintf(stderr, "kernel_launch: note: occupancy query reports %d workgroups per CU\n", per_cu);
        (void)hipGetLastError();
        grid = cus;
    }
    if (grid < 0) return;
    if (hipMemsetAsync((char*)d_ws + WS_CTL, 0, CTL_ZERO_BYTES, stream) != hipSuccess) return;
    Args a{};
    for (int i = 0; i < 17; ++i) a.in[i] = d_in[i];
    a.out = (float*)d_out; a.ws = (unsigned char*)d_ws;
    if (N_LAUNCHES == 1) { a.ph_lo = 0; a.ph_hi = NPHASES; a.li = 0; hipLaunchKernelGGL(fwd, dim3(grid), dim3(NTHR), LDS_BYTES, stream, a); }
    else for (int li = 0; li < NPHASES; ++li) { a.ph_lo = li; a.ph_hi = li + 1; a.li = li; hipLaunchKernelGGL(fwd, dim3(grid), dim3(NTHR), LDS_BYTES, stream, a); }
}
```

```cpp
#include <hip/hip_runtime.h>
#include <cstdio>
#include <cstdint>

#ifndef PROBE_DUP
#define PROBE_DUP 0
#endif
#ifndef MK_N_LAUNCHES
#define MK_N_LAUNCHES 1
#endif

namespace pg8 {
#define PG8_LAS __attribute__((address_space(3)))
typedef unsigned short bf16_t;
typedef short bf16x8 __attribute__((ext_vector_type(8)));
typedef float f32x4 __attribute__((ext_vector_type(4)));
typedef unsigned u32x4 __attribute__((ext_vector_type(4)));
constexpr int BM = 256, BK = 64, HALF = 128, HTB = HALF * BK * 2  , STAGE_BYTES = 8 * HTB, NXCD = 8, WGM = 8;

__host__ __device__ __forceinline__ int lds_byte(int r, int c) { const int st = (r >> 4) * 2 + (c >> 5), rr = r & 15, cc = c & 31, ob = rr * 64 + cc * 2; return st * 1024 + (ob ^ (((ob >> 9) & 1) << 5)); }
__host__ __device__ __forceinline__ void stage_rc(int b, int& R, int& C) { const int st = b / 1024, sb = b % 1024, swz = sb ^ (((sb >> 9) & 1) << 5); R = (st >> 1) * 16 + swz / 64; C = (st & 1) * 32 + (swz % 64) / 2; }
__host__ __device__ __forceinline__ int perm32(int rho) { const int n = rho >> 4, i = rho & 15; return 8 * (i >> 2) + 4 * n + (i & 3); }

struct Unit { int pm, pn; };
struct Gemm { const bf16_t* A; const bf16_t* Bt; int M, N, K; };

struct StaticOrder {
    int nM, nN, nwg, G, c;
    __host__ __device__ void init(int M, int N, int G_, int c_) { nM = M / BM; nN = N / BM; nwg = nM * nN; G = G_; c = c_; }
    __host__ __device__ bool next(int i, Unit& u) const {
        const long L = (long)i * G + c; if (L >= nwg) return false;
        int wgid = (int)L; { const int q = nwg / NXCD, r = nwg % NXCD, xcd = wgid % NXCD, off = wgid / NXCD; wgid = (xcd < r ? xcd * (q + 1) : r * (q + 1) + (xcd - r) * q) + off; }
        const int nig = WGM * nN, gid = wgid / nig, fm = gid * WGM, gsz = (nM - fm) < WGM ? (nM - fm) : WGM;
        u.pm = fm + ((wgid % nig) % gsz); u.pn = (wgid % nig) / gsz; return true;
    }
    __device__ __forceinline__ void a_ready(const Unit&) const {}
    __device__ __forceinline__ void done(const Unit&) const {}
};

__device__ __forceinline__ unsigned cvt_pk_bf16(float lo, float hi) { unsigned r; asm volatile("v_cvt_pk_bf16_f32 %0, %1, %2" : "=v"(r) : "v"(lo), "v"(hi)); return r; }

struct EpiF32 {
    static constexpr bool PERM = false, AFTER_DRAIN = false;
    float* C; int ldc;
    __device__ __forceinline__ void operator()(const f32x4 (&acc)[2][2][4][2], const Unit& u, int wr, int wc, int fr, int fq) const {
        const int row0 = u.pm * BM + wr * 64 + fr, col0 = u.pn * BM + wc * 32 + 4 * fq;
#pragma unroll
        for (int ai = 0; ai < 2; ++ai)
#pragma unroll
            for (int m = 0; m < 4; ++m) { float* rowp = C + (size_t)(row0 + ai * HALF + m * 16) * ldc + col0;
#pragma unroll
                for (int bj = 0; bj < 2; ++bj)
#pragma unroll
                    for (int n = 0; n < 2; ++n) *(f32x4*)(rowp + bj * HALF + n * 16) = acc[ai][bj][m][n]; }
    }
};
struct EpiBf16 {
    static constexpr bool PERM = true, AFTER_DRAIN = false;
    bf16_t* O; int ldc;
    __device__ __forceinline__ void operator()(const f32x4 (&acc)[2][2][4][2], const Unit& u, int wr, int wc, int fr, int fq) const {
        const int row0 = u.pm * BM + wr * 64 + fr, col0 = u.pn * BM + wc * 32 + 8 * fq;
#pragma unroll
        for (int ai = 0; ai < 2; ++ai)
#pragma unroll
            for (int m = 0; m < 4; ++m) { bf16_t* rowp = O + (size_t)(row0 + ai * HALF + m * 16) * ldc + col0;
#pragma unroll
                for (int bj = 0; bj < 2; ++bj) { const f32x4 v0 = acc[ai][bj][m][0], v1 = acc[ai][bj][m][1];
                    u32x4 w; w.x = cvt_pk_bf16(v0[0], v0[1]); w.y = cvt_pk_bf16(v0[2], v0[3]); w.z = cvt_pk_bf16(v1[0], v1[1]); w.w = cvt_pk_bf16(v1[2], v1[3]);
                    *(u32x4*)(rowp + bj * HALF) = w; } }
    }
};
__device__ __forceinline__ float silu_f(float x) { return x / (1.0f + __expf(-x)); }
struct EpiSwiGLU {
    static constexpr bool PERM = true, AFTER_DRAIN = false;
    bf16_t* O; int ldc;
    __device__ __forceinline__ void operator()(const f32x4 (&acc)[2][2][4][2], const Unit& u, int wr, int wc, int fr, int fq) const {
        const int row0 = u.pm * BM + wr * 64 + fr, col0 = u.pn * HALF + wc * 32 + 8 * fq;
#pragma unroll
        for (int ai = 0; ai < 2; ++ai)
#pragma unroll
            for (int m = 0; m < 4; ++m) { bf16_t* rowp = O + (size_t)(row0 + ai * HALF + m * 16) * ldc + col0;
                const f32x4 g0 = acc[ai][0][m][0], g1 = acc[ai][0][m][1], u0 = acc[ai][1][m][0], u1 = acc[ai][1][m][1];
                u32x4 w; w.x = cvt_pk_bf16(silu_f(g0[0]) * u0[0], silu_f(g0[1]) * u0[1]); w.y = cvt_pk_bf16(silu_f(g0[2]) * u0[2], silu_f(g0[3]) * u0[3]);
                w.z = cvt_pk_bf16(silu_f(g1[0]) * u1[0], silu_f(g1[1]) * u1[1]); w.w = cvt_pk_bf16(silu_f(g1[2]) * u1[2], silu_f(g1[3]) * u1[3]);
                *(u32x4*)rowp = w; }
    }
};

template <class Epi, class Sched, bool ALIGN_EPI = false, bool SP2 = false>
__device__ __forceinline__ void gemm_phase(PG8_LAS unsigned char* lds, const Gemm g, const Sched& S, const Epi& E) {
    const int tid = threadIdx.x, wid = __builtin_amdgcn_readfirstlane(tid >> 6), lane = tid & 63, wr = wid >> 2, wc = wid & 3, fr = lane & 15, fq = lane >> 4;
    const int K = g.K, nt = K / BK;
    unsigned voffA[2], voffB[2];
#pragma unroll
    for (int i = 0; i < 2; ++i) { int R, C; stage_rc(tid * 16 + i * 8192, R, C); const int Rb = Epi::PERM ? ((R & ~31) + perm32(R & 31)) : R;
        voffA[i] = (unsigned)(R * K + C) * 2u; voffB[i] = (unsigned)(Rb * K + C) * 2u; }
    const size_t kstep = (size_t)(BK * 2);
    const size_t hstep = (size_t)HALF * K * 2;
    const size_t tstep = 2 * hstep;
    const unsigned ldsw = (unsigned)wid * 1024u;
    const int aoff = lds_byte(wr * 64 + fr, fq * 8), boff = lds_byte(wc * 32 + fr, fq * 8);
#define PG8_SA(b, h) (((b) * 2 + (h)) * HTB)
#define PG8_SB(b, h) ((4 + (b) * 2 + (h)) * HTB)
#define PG8_STAGE(bufoff, gbase, voff) do { _Pragma("unroll") for (int _i = 0; _i < 2; ++_i) \
        __builtin_amdgcn_global_load_lds((const unsigned*)((const char*)(gbase) + (voff)[_i]), (PG8_LAS unsigned*)(lds + (bufoff) + ldsw + _i * 8192), 16, 0, 0); } while (0)
#define PG8_LDA(dst, b, h) do { _Pragma("unroll") for (int m = 0; m < 4; ++m) _Pragma("unroll") for (int k = 0; k < 2; ++k) dst[m][k] = *(const PG8_LAS bf16x8*)(lds + PG8_SA(b, h) + aoff + m * 2048 + k * 1024); } while (0)
#define PG8_LDB(dst, b, h) do { _Pragma("unroll") for (int n = 0; n < 2; ++n) _Pragma("unroll") for (int k = 0; k < 2; ++k) dst[n][k] = *(const PG8_LAS bf16x8*)(lds + PG8_SB(b, h) + boff + n * 2048 + k * 1024); } while (0)
#define PG8_MMA(ai, bj, At, Bt) do { __builtin_amdgcn_s_setprio(1); _Pragma("unroll") for (int m = 0; m < 4; ++m) _Pragma("unroll") for (int n = 0; n < 2; ++n) _Pragma("unroll") for (int k = 0; k < 2; ++k) \
        acc[ai][bj][m][n] = __builtin_amdgcn_mfma_f32_16x16x32_bf16(Bt[n][k], At[m][k], acc[ai][bj][m][n], 0, 0, 0); __builtin_amdgcn_s_setprio(0); } while (0)
#define PG8_WAIT_V(n) asm volatile("s_waitcnt vmcnt(" #n ")" ::: "memory")
#define PG8_WAIT_L(n) asm volatile("s_waitcnt lgkmcnt(" #n ")" ::: "memory")
#define PG8_BAR __builtin_amdgcn_s_barrier()
#define PG8_SCHED __builtin_amdgcn_sched_barrier(0)
    Unit cur, nxt; int ui = 0;
    if (!S.next(0, cur)) return;
    f32x4 acc[2][2][4][2];
#pragma unroll
    for (int a = 0; a < 2; ++a)
#pragma unroll
        for (int b = 0; b < 2; ++b)
#pragma unroll
            for (int m = 0; m < 4; ++m)
#pragma unroll
                for (int n = 0; n < 2; ++n) acc[a][b][m][n] = (f32x4){0.f, 0.f, 0.f, 0.f};
    bf16x8 At[4][2], B0[2][2], B1[2][2];
    const char* cA = (const char*)g.A + (size_t)cur.pm * tstep; const char* cB = (const char*)g.Bt + (size_t)cur.pn * tstep;
    S.a_ready(cur);
    if constexpr (SP2) {
        PG8_STAGE(PG8_SB(0, 0), cB, voffB); PG8_STAGE(PG8_SB(0, 1), cB + hstep, voffB); PG8_STAGE(PG8_SA(0, 0), cA, voffA); PG8_STAGE(PG8_SA(0, 1), cA + hstep, voffA);
        if (wr == 1) PG8_BAR;
        PG8_WAIT_V(2); PG8_BAR;
        PG8_STAGE(PG8_SB(1, 0), cB + kstep, voffB); PG8_STAGE(PG8_SA(1, 0), cA + kstep, voffA); PG8_STAGE(PG8_SB(1, 1), cB + hstep + kstep, voffB);
        PG8_WAIT_V(6); PG8_BAR;
    } else {
        PG8_STAGE(PG8_SB(0, 0), cB, voffB); PG8_STAGE(PG8_SA(0, 0), cA, voffA); PG8_STAGE(PG8_SB(0, 1), cB + hstep, voffB); PG8_STAGE(PG8_SA(0, 1), cA + hstep, voffA);
        if (wr == 1) PG8_BAR;
        PG8_WAIT_V(4); PG8_BAR;
        PG8_STAGE(PG8_SB(1, 0), cB + kstep, voffB); PG8_STAGE(PG8_SA(1, 0), cA + kstep, voffA); PG8_STAGE(PG8_SB(1, 1), cB + hstep + kstep, voffB);
        PG8_WAIT_V(6); PG8_BAR;
    }
    for (;;) {
        const bool has_next = S.next(ui + 1, nxt);
        const char* nA = has_next ? (const char*)g.A + (size_t)nxt.pm * tstep : cA; const char* nB = has_next ? (const char*)g.Bt + (size_t)nxt.pn * tstep : cB;
        for (int t = 0; t < nt; t += 2) {
            const bool last = (t == nt - 2);
            const char* a1 = cA + (size_t)(t + 1) * kstep;
            const char* a2 = last ? nA : cA + (size_t)(t + 2) * kstep; const char* b2 = last ? nB : cB + (size_t)(t + 2) * kstep;
            const char* a3 = a2 + kstep; const char* b3 = b2 + kstep;
            if (last && has_next) S.a_ready(nxt);
            if constexpr (SP2) {
            PG8_LDB(B0, 0, 0); PG8_LDB(B1, 0, 1); PG8_SCHED; PG8_LDA(At, 0, 0); PG8_STAGE(PG8_SA(1, 1), a1 + hstep, voffA);
            PG8_WAIT_V(8); PG8_WAIT_L(0); PG8_BAR; PG8_MMA(0, 0, At, B0); PG8_MMA(0, 1, At, B1); PG8_BAR; PG8_SCHED;
            PG8_LDA(At, 0, 1); PG8_STAGE(PG8_SB(0, 0), b2, voffB); PG8_STAGE(PG8_SB(0, 1), b2 + hstep, voffB); PG8_STAGE(PG8_SA(0, 0), a2, voffA);
            PG8_WAIT_V(8); PG8_WAIT_L(0); PG8_BAR; PG8_MMA(1, 0, At, B0); PG8_MMA(1, 1, At, B1); PG8_BAR; PG8_SCHED;
            PG8_LDB(B0, 1, 0); PG8_LDB(B1, 1, 1); PG8_SCHED; PG8_LDA(At, 1, 0); PG8_STAGE(PG8_SA(0, 1), a2 + hstep, voffA);
            PG8_WAIT_V(8); PG8_WAIT_L(0); PG8_BAR; PG8_MMA(0, 0, At, B0); PG8_MMA(0, 1, At, B1); PG8_BAR; PG8_SCHED;
            PG8_LDA(At, 1, 1); PG8_STAGE(PG8_SB(1, 0), b3, voffB); PG8_STAGE(PG8_SB(1, 1), b3 + hstep, voffB); PG8_STAGE(PG8_SA(1, 0), a3, voffA);
            PG8_WAIT_V(8); PG8_WAIT_L(0); PG8_BAR; PG8_MMA(1, 0, At, B0); PG8_MMA(1, 1, At, B1); PG8_BAR; PG8_SCHED;
            } else {
            PG8_LDB(B0, 0, 0); PG8_SCHED; PG8_LDA(At, 0, 0); PG8_STAGE(PG8_SA(1, 1), a1 + hstep, voffA);
            PG8_WAIT_L(8); PG8_BAR; PG8_WAIT_L(0); PG8_MMA(0, 0, At, B0); PG8_BAR; PG8_SCHED;
            PG8_LDB(B1, 0, 1); PG8_STAGE(PG8_SB(0, 0), b2, voffB);
            PG8_BAR; PG8_WAIT_L(0); PG8_MMA(0, 1, At, B1); PG8_BAR;
            PG8_LDA(At, 0, 1); PG8_STAGE(PG8_SA(0, 0), a2, voffA);
            PG8_BAR; PG8_WAIT_L(0); PG8_MMA(1, 0, At, B0); PG8_BAR; PG8_SCHED;
            PG8_STAGE(PG8_SB(0, 1), b2 + hstep, voffB);
            PG8_WAIT_V(6); PG8_BAR; PG8_MMA(1, 1, At, B1); PG8_BAR;
            PG8_LDB(B0, 1, 0); PG8_SCHED; PG8_LDA(At, 1, 0); PG8_STAGE(PG8_SA(0, 1), a2 + hstep, voffA);
            PG8_WAIT_L(8); PG8_BAR; PG8_WAIT_L(0); PG8_MMA(0, 0, At, B0); PG8_BAR; PG8_SCHED;
            PG8_LDB(B1, 1, 1); PG8_STAGE(PG8_SB(1, 0), b3, voffB);
            PG8_BAR; PG8_WAIT_L(0); PG8_MMA(0, 1, At, B1); PG8_BAR;
            PG8_LDA(At, 1, 1); PG8_STAGE(PG8_SA(1, 0), a3, voffA);
            PG8_BAR; PG8_WAIT_L(0); PG8_MMA(1, 0, At, B0); PG8_BAR; PG8_SCHED;
            PG8_STAGE(PG8_SB(1, 1), b3 + hstep, voffB);
            PG8_WAIT_V(6); PG8_BAR; PG8_MMA(1, 1, At, B1); PG8_BAR;
            }
        }
        if constexpr (ALIGN_EPI) { if (wr == 0) PG8_BAR; }
        if constexpr (!Epi::AFTER_DRAIN) { E(acc, cur, wr, wc, fr, fq); S.done(cur); }
        if (!has_next) break;
#pragma unroll
        for (int a = 0; a < 2; ++a)
#pragma unroll
            for (int b = 0; b < 2; ++b)
#pragma unroll
                for (int m = 0; m < 4; ++m)
#pragma unroll
                    for (int n = 0; n < 2; ++n) acc[a][b][m][n] = (f32x4){0.f, 0.f, 0.f, 0.f};
        cur = nxt; cA = nA; cB = nB; ++ui;
        if constexpr (ALIGN_EPI) { if (wr == 1) PG8_BAR; }
    }
    PG8_WAIT_V(0);
    if constexpr (!ALIGN_EPI) { if (wr == 0) PG8_BAR; }
    PG8_BAR;
#undef PG8_SA
#undef PG8_SB
#undef PG8_STAGE
#undef PG8_LDA
#undef PG8_LDB
#undef PG8_MMA
#undef PG8_WAIT_V
#undef PG8_WAIT_L
#undef PG8_BAR
#undef PG8_SCHED
}
}

constexpr int NWAVES = 8, NTHR = 512;
constexpr int SEQ = 16384, DM = 2048, HD = 128, NHG = 8, DPROJ = 8208, NPJ = 8192, DFF = 5632, CH = 128, NCH = SEQ / CH, NHEADS = 16;
constexpr float NORM_EPS = 1e-6f;
constexpr int N_LAUNCHES = MK_N_LAUNCHES, NPHASES = 10;
constexpr int PC_MQ = 0, PC_MK = 1024, PC_MV = 2048, PC_MO = 3072, PC_RQ = 4096, PC_RK = 5120, PC_RV = 6144, PC_RG = 7168;

constexpr size_t MiB = 1u << 20;
constexpr size_t WS_CTL = 0, CTL_ZERO_BYTES = 64 * 1024;
constexpr size_t WS_WIN = 2 * MiB, WS_WO = 34 * MiB, WS_WGU = 42 * MiB, WS_WD = 86 * MiB;
constexpr size_t WS_PRE = 108 * MiB;
constexpr size_t WS_RS = 109 * MiB;
constexpr size_t WS_NLOC = 110 * MiB;
constexpr size_t WS_N0 = 110 * MiB + 512 * 1024;
constexpr size_t WS_DEC = 111 * MiB;
constexpr size_t WS_GHEAD = 111 * MiB + 65536;
constexpr size_t WS_COS = 112 * MiB, WS_SIN = 116 * MiB;
constexpr size_t WS_B = 128 * MiB;
constexpr size_t WS_A = 384 * MiB;
constexpr size_t WS_FF = WS_B + 176 * MiB;
constexpr size_t WS_END = 448 * MiB;
constexpr int CW_BAR = 1024;

constexpr int RING_BYTES = 131072;
constexpr int GATE_OFF = RING_BYTES;
constexpr int N0B_OFF = GATE_OFF + 8 * 1536;
constexpr int CONVW_OFF = N0B_OFF + 256;
constexpr int MISC_OFF = CONVW_OFF + 5120;
constexpr int LDS_BYTES = 163840;
static_assert(MISC_OFF + 1024 + 5120 <= LDS_BYTES, "LDS map");

#define GAS __attribute__((address_space(1)))
#define LAS __attribute__((address_space(3)))
#define DI __device__ __forceinline__
typedef unsigned short bf16;
typedef unsigned u32x4 __attribute__((ext_vector_type(4)));
typedef unsigned u32x2 __attribute__((ext_vector_type(2)));
typedef float f32x4 __attribute__((ext_vector_type(4)));
typedef float f32x2 __attribute__((ext_vector_type(2)));
typedef LAS unsigned char* ldsp;
#define LDS_WAIT() asm volatile("s_waitcnt lgkmcnt(0)" ::: "memory")

DI unsigned f2bf(float f) { unsigned u = __builtin_bit_cast(unsigned, f); return (u + 0x7fffu + ((u >> 16) & 1u)) >> 16; }
DI unsigned pk2(float lo, float hi) { return f2bf(lo) | (f2bf(hi) << 16); }
DI float bflo(unsigned w) { return __builtin_bit_cast(float, w << 16); }
DI float bfhi(unsigned w) { return __builtin_bit_cast(float, w & 0xffff0000u); }
DI void unpack8(const u32x4 w, float (&f)[8]) { f[0] = bflo(w.x); f[1] = bfhi(w.x); f[2] = bflo(w.y); f[3] = bfhi(w.y); f[4] = bflo(w.z); f[5] = bfhi(w.z); f[6] = bflo(w.w); f[7] = bfhi(w.w); }
DI u32x4 pack8(const float (&f)[8]) { u32x4 w; w.x = pk2(f[0], f[1]); w.y = pk2(f[2], f[3]); w.z = pk2(f[4], f[5]); w.w = pk2(f[6], f[7]); return w; }
DI float sigmoid_f(float x) { return 1.0f / (1.0f + __expf(-x)); }
DI float silu_f(float x) { return x / (1.0f + __expf(-x)); }
DI float wave_sum(float v) {
#pragma unroll
    for (int o = 1; o < 64; o <<= 1) v += __shfl_xor(v, o);
    return v;
}

#define XB_TMO      128
#define XB_XCNT(j)  (256  + 64 * (j))
#define XB_XSUB(j)  (1280 + 64 * (j))
#define XB_XGEN(j)  (2304 + 64 * (j))
#define XB_TOP      3328
#define XB_TOPGEN   3392
#define XCD_BAR_WORDS 3456
#define XB_SPIN_CAP (1u << 18)
__device__ __forceinline__ unsigned xb_ld(unsigned* p)              { return __hip_atomic_load(p, __ATOMIC_RELAXED, __HIP_MEMORY_SCOPE_AGENT); }
__device__ __forceinline__ unsigned xb_add(unsigned* p, unsigned v) { return __hip_atomic_fetch_add(p, v, __ATOMIC_RELAXED, __HIP_MEMORY_SCOPE_AGENT); }
__device__ __forceinline__ unsigned xb_xcc_id() { return (unsigned)__builtin_amdgcn_s_getreg((3 << 11) | 20) & 0xFu; }
#define XB_SPIN(cond, bar) do { unsigned _sp = 0; while (cond) { __builtin_amdgcn_s_sleep(1); \
    if ((++_sp & 255u) == 0u) { if (xb_ld(&(bar)[XB_TMO])) break; if (_sp > XB_SPIN_CAP) { atomicAdd(&(bar)[XB_TMO], 1u); break; } } } } while (0)
struct XcdBarrier { unsigned* bar; unsigned x; volatile LAS unsigned* st; };
__device__ __forceinline__ XcdBarrier xcd_barrier_post(unsigned* bar, volatile LAS unsigned* st) {
    XcdBarrier b; b.bar = bar; b.x = xb_xcc_id(); b.st = st;
    if (threadIdx.x == 0) (void)xb_add(&bar[XB_XCNT(b.x)], 1u);
    return b;
}
__device__ __forceinline__ void xcd_barrier_complete(unsigned* bar, unsigned x, unsigned& nloc, unsigned& nx) {
    const unsigned G = gridDim.x * gridDim.y * gridDim.z;
    unsigned sum, cnt, mine, sp = 0u;
    for (;;) {
        sum = 0u; cnt = 0u; mine = 0u;
#pragma unroll
        for (unsigned j = 0; j < 16; ++j) { const unsigned c = xb_ld(&bar[XB_XCNT(j)]); sum += c; cnt += (c > 0u) ? 1u : 0u; mine = (j == x) ? c : mine; }
        if (sum == G) break;
        __builtin_amdgcn_s_sleep(1);
        if ((++sp & 255u) == 0u) { if (xb_ld(&bar[XB_TMO])) break; if (sp > XB_SPIN_CAP) { atomicAdd(&bar[XB_TMO], 1u); break; } }
    }
    nloc = mine > 0u ? mine : 1u; nx = cnt > 0u ? cnt : 1u;
}
__device__ __forceinline__ void xcd_barrier(const XcdBarrier& b) {
    asm volatile("s_waitcnt vmcnt(0)" ::: "memory");
    __syncthreads();
    if (threadIdx.x == 0) {
        unsigned* bar = b.bar;
        __builtin_amdgcn_s_waitcnt(0);
        unsigned nloc = b.st[0], nx = b.st[1];
        if (nloc == 0u) { xcd_barrier_complete(bar, b.x, nloc, nx); b.st[0] = nloc; b.st[1] = nx; }
        const unsigned old = xb_add(&bar[XB_XSUB(b.x)], 1u);
        const unsigned gen = old / nloc;
        if (old + 1u == (gen + 1u) * nloc) {
            __builtin_amdgcn_fence(__ATOMIC_RELEASE, "agent");
            asm volatile("s_waitcnt vmcnt(0)" ::: "memory");
            const unsigned og = xb_add(&bar[XB_TOP], 1u);
            const unsigned tg = og / nx;
            if (og + 1u == (tg + 1u) * nx) xb_add(&bar[XB_TOPGEN], 1u);
            else XB_SPIN(xb_ld(&bar[XB_TOPGEN]) == tg, bar);
            __builtin_amdgcn_fence(__ATOMIC_ACQUIRE, "agent");
            xb_add(&bar[XB_XGEN(b.x)], 1u);
            asm volatile("s_waitcnt vmcnt(0)" ::: "memory");
        } else {
            XB_SPIN(xb_ld(&bar[XB_XGEN(b.x)]) == gen, bar);
            __builtin_amdgcn_fence(__ATOMIC_ACQUIRE, "agent");
            asm volatile("s_waitcnt vmcnt(0)" ::: "memory");
        }
    }
    __syncthreads();
}

struct Args { const void* in[17]; float* out; unsigned char* ws; int ph_lo, ph_hi, li, pad; };
enum { IN_X = 0, IN_POS, IN_GPRE, IN_WIN, IN_CW, IN_CB, IN_BI, IN_BF, IN_GMH, IN_GRH, IN_WOUT, IN_GPOST, IN_GFPRE, IN_WG, IN_WU, IN_WDN, IN_GFPOST };

DI void p0_transpose_item(const float* W, int K, int ldw, int src_col, bf16* WT, int dst_row, LAS float* scr, int kb, int lane) {
    const int k0 = 64 * kb;
#pragma unroll 8
    for (int i = 0; i < 32; ++i) { const int kk = 2 * i + (lane >> 5); scr[kk * 33 + (lane & 31)] = W[(size_t)(k0 + kk) * ldw + src_col + (lane & 31)]; }
    LDS_WAIT(); asm volatile("" ::: "memory");
    const int c = lane & 7;
#pragma unroll
    for (int j = 0; j < 4; ++j) { const int n = (lane >> 3) + 8 * j; const LAS float* s = scr + (8 * c) * 33 + n;
        u32x4 o; o.x = pk2(s[0 * 33], s[1 * 33]); o.y = pk2(s[2 * 33], s[3 * 33]); o.z = pk2(s[4 * 33], s[5 * 33]); o.w = pk2(s[6 * 33], s[7 * 33]);
        *(GAS u32x4*)(WT + (size_t)(dst_row + n) * K + k0 + 8 * c) = o; }
    LDS_WAIT(); asm volatile("" ::: "memory");
}
typedef float f32x4g __attribute__((ext_vector_type(4)));
DI void p0_gates(const Args& a, ldsp lds, int tid, int lane, int wave, int vcu, int G) {
    const float* x = (const float*)a.in[IN_X]; const float* gpre = (const float*)a.in[IN_GPRE]; const float* w_in = (const float*)a.in[IN_WIN]; float* PRE = (float*)(a.ws + WS_PRE);
    LAS float* Wl = (LAS float*)lds;
    LAS float* part = (LAS float*)(lds + MISC_OFF + 1024);
#pragma unroll 4
    for (int i = 0; i < 16; ++i) { const int idx = tid + NTHR * i, k = idx >> 2, c4 = idx & 3;
        f32x4 w = *(const GAS f32x4*)(w_in + (size_t)k * DPROJ + 4096 + 4 * c4); w = w * gpre[k];
        const int row = (k & ~15) + 4 * (k & 3) + ((k >> 2) & 3);
        *(LAS f32x4*)(Wl + row * 16 + 4 * c4) = w; }
    LDS_WAIT(); __syncthreads();
    for (int rb = vcu; rb < SEQ / 64; rb += G) {
        const int tile = wave & 3, kh = wave >> 2, row = lane & 15, q = lane >> 4, t0 = rb * 64 + tile * 16;
        const GAS f32x4* xr = (const GAS f32x4*)(x + (size_t)(t0 + row) * DM + kh * 1024 + 4 * q);
        const LAS float* wl = Wl + (kh * 1024 + q) * 16 + row;
        f32x4g acc = {0.f, 0.f, 0.f, 0.f}; float ss = 0.f;
        for (int sp = 0; sp < 64; sp += 4) { f32x4 xv[4];
#pragma unroll
            for (int j = 0; j < 4; ++j) xv[j] = xr[4 * (sp + j)];
#pragma unroll
            for (int j = 0; j < 4; ++j) { ss += (xv[j].x * xv[j].x + xv[j].y * xv[j].y) + (xv[j].z * xv[j].z + xv[j].w * xv[j].w);
                const LAS float* wp = wl + (sp + j) * 256;
                acc = __builtin_amdgcn_mfma_f32_16x16x4f32(xv[j].x, wp[0], acc, 0, 0, 0); acc = __builtin_amdgcn_mfma_f32_16x16x4f32(xv[j].y, wp[64], acc, 0, 0, 0);
                acc = __builtin_amdgcn_mfma_f32_16x16x4f32(xv[j].z, wp[128], acc, 0, 0, 0); acc = __builtin_amdgcn_mfma_f32_16x16x4f32(xv[j].w, wp[192], acc, 0, 0, 0); } }
        if (kh == 1) {
#pragma unroll
            for (int j = 0; j < 4; ++j) part[(tile * 4 + j) * 64 + lane] = acc[j];
            part[1024 + tile * 64 + lane] = ss; }
        LDS_WAIT(); __syncthreads();
        if (kh == 0) {
#pragma unroll
            for (int j = 0; j < 4; ++j) acc[j] += part[(tile * 4 + j) * 64 + lane];
            ss += part[1024 + tile * 64 + lane];
            ss += __shfl_xor(ss, 16); ss += __shfl_xor(ss, 32);
            const float rs = 1.0f / sqrtf(ss * (1.0f / DM) + NORM_EPS);
#pragma unroll
            for (int j = 0; j < 4; ++j) { const int ri = 4 * q + j; const float rsi = __shfl(rs, ri); PRE[(size_t)(t0 + ri) * 16 + row] = acc[j] * rsi; } }
        __syncthreads();
    }
}
DI void phase_p0(const Args& a, ldsp lds, int tid, int lane, int wave, int vcu, int G) {
    p0_gates(a, lds, tid, lane, wave, vcu, G);
    const int gw = vcu * NWAVES + wave, NGW = G * NWAVES;
    LAS float* scr = (LAS float*)(lds + wave * 16384);
    const float* w_in = (const float*)a.in[IN_WIN]; const float* w_out = (const float*)a.in[IN_WOUT];
    const float* w_g = (const float*)a.in[IN_WG]; const float* w_u = (const float*)a.in[IN_WU]; const float* w_d = (const float*)a.in[IN_WDN];
    bf16* WinT = (bf16*)(a.ws + WS_WIN); bf16* WoT = (bf16*)(a.ws + WS_WO); bf16* WguT = (bf16*)(a.ws + WS_WGU); bf16* WdT = (bf16*)(a.ws + WS_WD);
    constexpr int I_IN = 32 * 256, I_O = 32 * 64, I_G = 32 * 176, I_D = 88 * 64, NITEMS = I_IN + I_O + 2 * I_G + I_D;
    for (int it = gw; it < NITEMS; it += NGW) {
        int r = it;
        if (r < I_IN) { const int kb = r / 256, nb = r % 256; const int sc = nb < 128 ? 32 * nb : 4112 + 32 * (nb - 128);
            p0_transpose_item(w_in, DM, DPROJ, sc, WinT, 32 * nb, scr, kb, lane); continue; } r -= I_IN;
        if (r < I_O) { const int kb = r / 64, nb = r % 64; p0_transpose_item(w_out, DM, DM, 32 * nb, WoT, 32 * nb, scr, kb, lane); continue; } r -= I_O;
        if (r < I_G) { const int kb = r / 176, nb = r % 176; p0_transpose_item(w_g, DM, DFF, 32 * nb, WguT, 256 * (nb >> 2) + 32 * (nb & 3), scr, kb, lane); continue; } r -= I_G;
        if (r < I_G) { const int kb = r / 176, nb = r % 176; p0_transpose_item(w_u, DM, DFF, 32 * nb, WguT, 256 * (nb >> 2) + 128 + 32 * (nb & 3), scr, kb, lane); continue; } r -= I_G;
        { const int kb = r / 64, nb = r % 64; p0_transpose_item(w_d, DFF, DM, 32 * nb, WdT, 32 * nb, scr, kb, lane); }
    }
    const float* x = (const float*)a.in[IN_X]; const float* gpre = (const float*)a.in[IN_GPRE];
    bf16* hb = (bf16*)(a.ws + WS_A);
    for (int m = gw; m < SEQ; m += NGW) {
        const GAS f32x4* xr = (const GAS f32x4*)(x + (size_t)m * DM) + lane; const GAS f32x4* gr = (const GAS f32x4*)gpre + lane;
        f32x4 v[8]; float s = 0.f;
#pragma unroll
        for (int j = 0; j < 8; ++j) { v[j] = xr[64 * j]; s += (v[j].x * v[j].x + v[j].y * v[j].y) + (v[j].z * v[j].z + v[j].w * v[j].w); }
        const float r = 1.0f / sqrtf(wave_sum(s) * (1.0f / DM) + NORM_EPS);
        GAS u32x2* o = (GAS u32x2*)(hb + (size_t)m * DM) + lane;
#pragma unroll
        for (int j = 0; j < 8; ++j) { const f32x4 gg = gr[64 * j]; u32x2 w; w.x = pk2(v[j].x * r * gg.x, v[j].y * r * gg.y); w.y = pk2(v[j].z * r * gg.z, v[j].w * r * gg.w); o[64 * j] = w; }
    }
    { float* GH = (float*)(a.ws + WS_GHEAD); const float* gmh = (const float*)a.in[IN_GMH]; const float* grh = (const float*)a.in[IN_GRH];
      for (int i = vcu * NTHR + tid; i < 1024; i += G * NTHR) GH[i] = gmh[i];
      for (int i = vcu * NTHR + tid; i < 1024; i += G * NTHR) GH[1024 + i] = grh[i]; }
    const int* pos = (const int*)a.in[IN_POS]; float* COS = (float*)(a.ws + WS_COS); float* SIN = (float*)(a.ws + WS_SIN);
    for (int i = vcu * NTHR + tid; i < SEQ * 64; i += G * NTHR) { const int t = i >> 6, j = i & 63;
        const float inv = (float)pow(10000.0, -(double)(2 * j) / 128.0); const float ang = (float)pos[t] * inv; float sn, cs; sincosf(ang, &sn, &cs); COS[i] = cs; SIN[i] = sn; }
}

typedef short bf16x8 __attribute__((ext_vector_type(8)));
typedef short s16x4 __attribute__((ext_vector_type(4)));
typedef float f32x16 __attribute__((ext_vector_type(16)));
#define MFMA32(a, b, c) __builtin_amdgcn_mfma_f32_32x32x16_bf16((a), (b), (c), 0, 0, 0)
DI int crow(int reg, int h) { return (reg & 3) + 8 * (reg >> 2) + 4 * h; }
DI bf16x8 bf_ones() { return (bf16x8){16256, 16256, 16256, 16256, 16256, 16256, 16256, 16256}; }
DI int offb(int row, int ch) { return 256 * row + 16 * (ch ^ (((row & 3) << 2) | ((row >> 2) & 3))); }
DI bf16x8 rowfrag(ldsp tile, int row, int ks, int h) { return *(const LAS bf16x8*)(tile + offb(row, 2 * ks + h)); }
DI s16x4 tr_rd(ldsp p) { return __builtin_bit_cast(s16x4, __builtin_amdgcn_ds_read_tr16_b64_v4i16((LAS s16x4*)p)); }
DI bf16x8 trfrag(ldsp tile, int c, int ks, int lane) {
    const int h = lane >> 5, blk = (lane >> 4) & 1, q = (lane & 15) >> 2, p = lane & 3, ch = 4 * c + 2 * blk + (p >> 1);
    const s16x4 lo = tr_rd(tile + offb(16 * ks + 8 * h + q, ch) + 8 * (p & 1)), hi = tr_rd(tile + offb(16 * ks + 8 * h + 4 + q, ch) + 8 * (p & 1));
    return __builtin_shufflevector(lo, hi, 0, 1, 2, 3, 4, 5, 6, 7);
}
DI void gload8(const bf16* p, float (&f)[8]) { unpack8(*(const GAS u32x4*)p, f); }

DI void mixer_setup(const Args& a, ldsp lds, int g, int grp, int tid, int lane, int wave) {
    if (g < NHG) {
        LAS float* rowv = (LAS float*)(lds + GATE_OFF + wave * 1536); LAS float* colv = rowv + 128; LAS float* alog = rowv + 256;
        const float* PRE = (const float*)(a.ws + WS_PRE); const float bi = ((const float*)a.in[IN_BI])[g], bfg = ((const float*)a.in[IN_BF])[g];
        const int t0 = (8 * grp + wave) * CH + 2 * lane;
        const float i0 = PRE[(size_t)t0 * 16 + g] + bi, i1 = PRE[(size_t)(t0 + 1) * 16 + g] + bi;
        const float f0 = PRE[(size_t)t0 * 16 + 8 + g] + bfg, f1 = PRE[(size_t)(t0 + 1) * 16 + 8 + g] + bfg;
        const float l0 = fminf(f0, 0.f) - log1pf(__expf(-fabsf(f0))), l1 = fminf(f1, 0.f) - log1pf(__expf(-fabsf(f1)));
        float p = l0 + l1;
#pragma unroll
        for (int o = 1; o < 64; o <<= 1) { const float y = __shfl_up(p, o); if (lane >= o) p += y; }
        const float b1 = p, b0 = p - l1;
        rowv[2 * lane] = b0; rowv[2 * lane + 1] = b1; alog[2 * lane] = b0; alog[2 * lane + 1] = b1; colv[2 * lane] = i0 - b0; colv[2 * lane + 1] = i1 - b1;
        if (tid < 128) { LAS float* cwl = (LAS float*)(lds + CONVW_OFF); const float* cw = (const float*)a.in[IN_CW]; const float* cb = (const float*)a.in[IN_CB];
#pragma unroll
            for (int j = 0; j < 4; ++j) { cwl[j * 128 + tid] = cw[j * 2048 + g * HD + tid]; cwl[640 + j * 128 + tid] = cw[j * 2048 + 1024 + g * HD + tid]; }
            cwl[512 + tid] = cb[g * HD + tid]; cwl[640 + 512 + tid] = cb[1024 + g * HD + tid]; }
    } else if (tid < 128) {
        LAS float* rowv = (LAS float*)(lds + GATE_OFF); LAS float* colv = rowv + 128; LAS float* alog = rowv + 256;
        const float lg = log1pf(-exp2f(-5.0f - (float)(g - NHG)));
        rowv[tid] = (float)tid * lg; colv[tid] = -(float)tid * lg; alog[tid] = (float)(tid + 1) * lg;
    }
    LDS_WAIT(); __syncthreads();
}
template <bool WITHQ> DI void mixer_tiles(const Args& a, ldsp lds, int g, int c, const LAS float* gt, int tid) {
    const bf16* proj = (const bf16*)(a.ws + WS_B);
    const LAS float* colv = gt + 128; const float rv127 = gt[127];
    ldsp Q = lds, K = lds + 32768, V = lds + 65536;
    const float kscale = 0.08838834764831845f;
    const int sq = tid >> 4, dg = tid & 15, tb = c * CH + 4 * sq;
    u32x4 vv[4];
    if (g < NHG) {
        const bf16* pk = proj + PC_MK + g * HD + 8 * dg; const bf16* pq = proj + PC_MQ + g * HD + 8 * dg; const bf16* pv = proj + PC_MV + g * HD + 8 * dg;
        u32x4 rk[7], rq[7];
#pragma unroll
        for (int j = 0; j < 7; ++j) { const int tt = tb - 3 + j, tc = tt < 0 ? 0 : tt; rk[j] = *(const GAS u32x4*)(pk + (size_t)tc * NPJ); if (WITHQ) rq[j] = *(const GAS u32x4*)(pq + (size_t)tc * NPJ);
            if (tt < 0) { rk[j] = (u32x4){0u, 0u, 0u, 0u}; if (WITHQ) rq[j] = (u32x4){0u, 0u, 0u, 0u}; } }
#pragma unroll
        for (int i = 0; i < 4; ++i) vv[i] = *(const GAS u32x4*)(pv + (size_t)(tb + i) * NPJ);
        const LAS float* cwl = (const LAS float*)(lds + CONVW_OFF);
#pragma unroll
        for (int qk = 0; qk < (WITHQ ? 2 : 1); ++qk) {
            const LAS float* wl = cwl + (qk == 0 ? 640 : 0) + 8 * dg;
            float w[5][8];
#pragma unroll
            for (int j = 0; j < 5; ++j) { const f32x4 w0 = *(const LAS f32x4*)(wl + j * 128), w1 = *(const LAS f32x4*)(wl + j * 128 + 4); w[j][0] = w0.x; w[j][1] = w0.y; w[j][2] = w0.z; w[j][3] = w0.w; w[j][4] = w1.x; w[j][5] = w1.y; w[j][6] = w1.z; w[j][7] = w1.w; }
#pragma unroll
            for (int i = 0; i < 4; ++i) { float acc[8];
#pragma unroll
                for (int e = 0; e < 8; ++e) acc[e] = w[4][e];
#pragma unroll
                for (int j = 0; j < 4; ++j) { float uu[8]; unpack8(qk == 0 ? rk[i + j] : rq[i + j], uu);
#pragma unroll
                    for (int e = 0; e < 8; ++e) acc[e] += w[j][e] * uu[e]; }
                const int srow = 4 * sq + i; const float sc = qk == 0 ? kscale * __expf(rv127 + colv[srow]) : 1.0f;
#pragma unroll
                for (int e = 0; e < 8; ++e) acc[e] = silu_f(acc[e]) * sc;
                *(LAS u32x4*)((qk == 0 ? K : Q) + offb(srow, dg)) = pack8(acc); }
        }
    } else {
        const int gr = g - NHG; const float* COS = (const float*)(a.ws + WS_COS); const float* SIN = (const float*)(a.ws + WS_SIN);
        const int s2 = tid >> 3, dgp = tid & 7;
        const bf16* pv = proj + PC_RV + gr * HD + 8 * dg;
        u32x4 klo[2], khi[2], qlo[2], qhi[2]; f32x4 cs[2][2], sn[2][2];
#pragma unroll
        for (int i = 0; i < 2; ++i) { const size_t t = (size_t)(c * CH + 2 * s2 + i); const bf16* pr = proj + t * NPJ + gr * HD + 8 * dgp;
            klo[i] = *(const GAS u32x4*)(pr + PC_RK); khi[i] = *(const GAS u32x4*)(pr + PC_RK + 64);
            if (WITHQ) { qlo[i] = *(const GAS u32x4*)(pr + PC_RQ); qhi[i] = *(const GAS u32x4*)(pr + PC_RQ + 64); }
            cs[i][0] = *(const GAS f32x4*)(COS + t * 64 + 8 * dgp); cs[i][1] = *(const GAS f32x4*)(COS + t * 64 + 8 * dgp + 4);
            sn[i][0] = *(const GAS f32x4*)(SIN + t * 64 + 8 * dgp); sn[i][1] = *(const GAS f32x4*)(SIN + t * 64 + 8 * dgp + 4); }
#pragma unroll
        for (int i = 0; i < 4; ++i) vv[i] = *(const GAS u32x4*)(pv + (size_t)(tb + i) * NPJ);
#pragma unroll
        for (int i = 0; i < 2; ++i) { const int srow = 2 * s2 + i;
            const float c8[8] = {cs[i][0].x, cs[i][0].y, cs[i][0].z, cs[i][0].w, cs[i][1].x, cs[i][1].y, cs[i][1].z, cs[i][1].w};
            const float s8[8] = {sn[i][0].x, sn[i][0].y, sn[i][0].z, sn[i][0].w, sn[i][1].x, sn[i][1].y, sn[i][1].z, sn[i][1].w};
            float lo[8], hi[8], olo[8], ohi[8]; unpack8(klo[i], lo); unpack8(khi[i], hi);
            const float sc = kscale * __expf(rv127 + colv[srow]);
#pragma unroll
            for (int e = 0; e < 8; ++e) { olo[e] = (lo[e] * c8[e] - hi[e] * s8[e]) * sc; ohi[e] = (hi[e] * c8[e] + lo[e] * s8[e]) * sc; }
            *(LAS u32x4*)(K + offb(srow, dgp)) = pack8(olo); *(LAS u32x4*)(K + offb(srow, 8 + dgp)) = pack8(ohi);
            if (WITHQ) { unpack8(qlo[i], lo); unpack8(qhi[i], hi);
#pragma unroll
                for (int e = 0; e < 8; ++e) { olo[e] = lo[e] * c8[e] - hi[e] * s8[e]; ohi[e] = hi[e] * c8[e] + lo[e] * s8[e]; }
                *(LAS u32x4*)(Q + offb(srow, dgp)) = pack8(olo); *(LAS u32x4*)(Q + offb(srow, 8 + dgp)) = pack8(ohi); }
        }
    }
#pragma unroll
    for (int i = 0; i < 4; ++i) *(LAS u32x4*)(V + offb(4 * sq + i, dg)) = vv[i];
    LDS_WAIT(); __syncthreads();
}

DI void phase_m1(const Args& a, ldsp lds, int tid_in, int wave, int vcu, int G) {
    float* U = a.out; float* NLOC = (float*)(a.ws + WS_NLOC); float* DEC = (float*)(a.ws + WS_DEC);
    ldsp K = lds + 32768, V = lds + 65536; const int wi = wave >> 1, wj = wave & 1;
    for (int cg = vcu; cg < NHEADS * 16; cg += G) { const int g = cg >> 4, grp = cg & 15; const bool ml = g < NHG;
        mixer_setup(a, lds, g, grp, tid_in, tid_in & 63, wave);
        for (int ci = 0; ci < 8; ++ci) { const int c = 8 * grp + ci;
            int tid_o = tid_in; asm volatile("" : "+v"(tid_o));
            const int tid = tid_o, lane = tid & 63, r = lane & 31, h = lane >> 5;
            const LAS float* gt = (const LAS float*)(lds + GATE_OFF + (ml ? ci : 0) * 1536);
            mixer_tiles<false>(a, lds, g, c, gt, tid);
            if (tid == 0) DEC[g * NCH + c] = __expf(gt[256 + 127]);
            f32x16 accU[2], accN;
#pragma unroll
            for (int i = 0; i < 16; ++i) { accU[0][i] = 0.f; accU[1][i] = 0.f; accN[i] = 0.f; }
#pragma unroll
            for (int ks = 0; ks < 8; ++ks) {
                const bf16x8 af = trfrag(K, wi, ks, lane), b0 = trfrag(V, 2 * wj, ks, lane), b1 = trfrag(V, 2 * wj + 1, ks, lane);
                accU[0] = MFMA32(af, b0, accU[0]); accU[1] = MFMA32(af, b1, accU[1]);
                if (ml && wj == 0) accN = MFMA32(af, bf_ones(), accN);
            }
            float* o = U + ((size_t)(g * NCH + c) << 14);
#pragma unroll
            for (int n = 0; n < 2; ++n)
#pragma unroll
                for (int i = 0; i < 16; ++i) o[(32 * wi + crow(i, h)) * HD + 64 * wj + 32 * n + r] = accU[n][i];
            if (ml && wj == 0 && r == 0) {
#pragma unroll
                for (int i = 0; i < 16; ++i) NLOC[((size_t)g * NCH + c) * HD + 32 * wi + crow(i, h)] = accN[i]; }
            __syncthreads();
        }
    }
}
DI void phase_m2(const Args& a, int tid, int vcu, int G) {
    const float* UT = a.out; bf16* C0T = (bf16*)(a.ws + WS_A); const float* DEC = (const float*)(a.ws + WS_DEC);
    const float* NLOC = (const float*)(a.ws + WS_NLOC); float* N0 = (float*)(a.ws + WS_N0);
    const int gt = vcu * NTHR + tid, NT = G * NTHR;
    for (int p = gt; p < NHEADS * 8192; p += NT) { const int e0 = p * 2, g = e0 >> 14, r = e0 & 16383;
        const float* dec = DEC + g * NCH; float c0 = 0.f, c1 = 0.f;
        for (int c = 0; c < NCH; c += 8) { f32x2 uu[8];
#pragma unroll
            for (int j = 0; j < 8; ++j) uu[j] = *(const GAS f32x2*)(UT + ((size_t)(g * NCH + c + j) << 14) + r);
#pragma unroll
            for (int j = 0; j < 8; ++j) { *(GAS unsigned*)(C0T + ((size_t)(g * NCH + c + j) << 14) + r) = pk2(c0, c1); const float d = dec[c + j]; c0 = d * c0 + uu[j].x; c1 = d * c1 + uu[j].y; } }
    }
    for (int p = gt; p < NHG * HD; p += NT) { const int g = p >> 7, d = p & 127; float n = 0.f;
        for (int c = 0; c < NCH; ++c) { N0[((size_t)g * NCH + c) * HD + d] = n; n = DEC[g * NCH + c] * n + NLOC[((size_t)g * NCH + c) * HD + d]; } }
}
DI void phase_m3(const Args& a, ldsp lds, int tid_in, int wave, int vcu, int G) {
    const bf16* proj = (const bf16*)(a.ws + WS_B); const bf16* C0G = (const bf16*)(a.ws + WS_A); const float* N0 = (const float*)(a.ws + WS_N0);
    bf16* mixb = (bf16*)a.out;
    LAS unsigned short* n0b = (LAS unsigned short*)(lds + N0B_OFF);
    ldsp Q = lds, K = lds + 32768, V = lds + 65536, C0 = lds + 98304, P = lds + 98304; LAS float* H = (LAS float*)lds;
    const int wi = wave >> 1, wj = wave & 1;
    for (int cg = vcu; cg < NHEADS * 16; cg += G) { const int g = cg >> 4, grp = cg & 15; const bool ml = g < NHG;
        mixer_setup(a, lds, g, grp, tid_in, tid_in & 63, wave);
        for (int ci = 0; ci < 8; ++ci) { const int c = 8 * grp + ci;
            int tid_o = tid_in; asm volatile("" : "+v"(tid_o));
            const int tid = tid_o, lane = tid & 63, r = lane & 31, h = lane >> 5;
            const LAS float* gt = (const LAS float*)(lds + GATE_OFF + (ml ? ci : 0) * 1536);
            { const bf16* c0g = C0G + ((size_t)(g * NCH + c) << 14);
#pragma unroll
              for (int i = 0; i < 4; ++i) { const int item = tid + NTHR * i, d = item >> 4, ch = item & 15; *(LAS u32x4*)(C0 + offb(d, ch)) = *(const GAS u32x4*)(c0g + d * HD + 8 * ch); }
              if (tid < 128) n0b[tid] = ml ? (unsigned short)f2bf(N0[((size_t)g * NCH + c) * HD + tid]) : (unsigned short)0; }
            mixer_tiles<true>(a, lds, g, c, gt, tid);
            f32x16 accO[2], accS[2], accD;
#pragma unroll
            for (int i = 0; i < 16; ++i) { accO[0][i] = 0.f; accO[1][i] = 0.f; accS[0][i] = 0.f; accS[1][i] = 0.f; accD[i] = 0.f; }
#pragma unroll
            for (int ks = 0; ks < 8; ++ks) {
                const bf16x8 af = rowfrag(Q, 32 * wi + r, ks, h), b0 = trfrag(C0, 2 * wj, ks, lane), b1 = trfrag(C0, 2 * wj + 1, ks, lane);
                accO[0] = MFMA32(af, b0, accO[0]); accO[1] = MFMA32(af, b1, accO[1]);
                if (ml) { const bf16x8 bn = *(const LAS bf16x8*)(n0b + 16 * ks + 8 * h); accD = MFMA32(af, bn, accD); }
            }
            float fac[16]; const float rv127 = gt[127];
#pragma unroll
            for (int i = 0; i < 16; ++i) { const int t = 32 * wi + crow(i, h); const float al = __expf(gt[256 + t]); fac[i] = __expf(gt[t] - rv127); accO[0][i] *= al; accO[1][i] *= al; accD[i] *= al; }
#pragma unroll
            for (int ks = 0; ks < 8; ++ks) {
                const bf16x8 af = rowfrag(Q, 32 * wi + r, ks, h), b0 = rowfrag(K, 64 * wj + r, ks, h), b1 = rowfrag(K, 64 * wj + 32 + r, ks, h);
                accS[0] = MFMA32(af, b0, accS[0]); accS[1] = MFMA32(af, b1, accS[1]);
            }
            __syncthreads();
#pragma unroll
            for (int n = 0; n < 2; ++n) { const int sidx = 64 * wj + 32 * n + r;
#pragma unroll
                for (int i = 0; i < 16; ++i) { const int t = 32 * wi + crow(i, h); const float val = (sidx <= t) ? accS[n][i] * fac[i] : 0.f;
                    *(LAS unsigned short*)(P + offb(t, sidx >> 3) + 2 * (sidx & 7)) = (unsigned short)f2bf(val); } }
            LDS_WAIT(); __syncthreads();
#pragma unroll
            for (int ks = 0; ks < 8; ++ks) {
                const bf16x8 af = rowfrag(P, 32 * wi + r, ks, h), b0 = trfrag(V, 2 * wj, ks, lane), b1 = trfrag(V, 2 * wj + 1, ks, lane);
                accO[0] = MFMA32(af, b0, accO[0]); accO[1] = MFMA32(af, b1, accO[1]);
                if (ml) accD = MFMA32(af, bf_ones(), accD);
            }
#pragma unroll
            for (int i = 0; i < 16; ++i) { const int t = 32 * wi + crow(i, h); const float rden = ml ? 1.0f / fmaxf(fabsf(accD[i]), 1.0f) : 1.0f;
                H[t * HD + 64 * wj + r] = accO[0][i] * rden; H[t * HD + 64 * wj + 32 + r] = accO[1][i] * rden; }
            LDS_WAIT(); __syncthreads();
            for (int hh = 0; hh < 2; ++hh) {
                const int tl = tid >> 3, eg = tid & 7, t = 64 * hh + tl;
                float hv[16]; float ss = 0.f;
#pragma unroll
                for (int q = 0; q < 4; ++q) { const f32x4 x4 = *(const LAS f32x4*)(H + t * HD + 16 * eg + 4 * q); hv[4 * q] = x4.x; hv[4 * q + 1] = x4.y; hv[4 * q + 2] = x4.z; hv[4 * q + 3] = x4.w; }
#pragma unroll
                for (int i = 0; i < 16; ++i) ss += hv[i] * hv[i];
                ss += __shfl_xor(ss, 1); ss += __shfl_xor(ss, 2); ss += __shfl_xor(ss, 4);
                const float rn = 1.0f / sqrtf(ss * (1.0f / HD) + NORM_EPS);
                const int tg = c * CH + t; const int hc = ml ? g * HD + 16 * eg : (g - NHG) * HD + 16 * eg;
                const float* gh = (const float*)(a.ws + WS_GHEAD) + (ml ? 0 : 1024) + hc;
                const bf16* gp = proj + (size_t)tg * NPJ + (ml ? PC_MO : PC_RG) + hc;
                float ga[16]; { float t8[8]; gload8(gp, t8);
#pragma unroll
                    for (int j = 0; j < 8; ++j) ga[j] = t8[j]; gload8(gp + 8, t8);
#pragma unroll
                    for (int j = 0; j < 8; ++j) ga[8 + j] = t8[j]; }
                float o[16];
#pragma unroll
                for (int i = 0; i < 16; ++i) o[i] = hv[i] * rn * gh[i] * (ml ? sigmoid_f(ga[i]) : silu_f(ga[i]));
                bf16* op = mixb + (size_t)tg * DM + (ml ? 0 : 1024) + hc;
                u32x4 w0, w1; w0.x = pk2(o[0], o[1]); w0.y = pk2(o[2], o[3]); w0.z = pk2(o[4], o[5]); w0.w = pk2(o[6], o[7]); w1.x = pk2(o[8], o[9]); w1.y = pk2(o[10], o[11]); w1.z = pk2(o[12], o[13]); w1.w = pk2(o[14], o[15]);
                *(GAS u32x4*)op = w0; *(GAS u32x4*)(op + 8) = w1;
            }
            __syncthreads();
        }
    }
}
DI void phase_r1(const Args& a, int lane, int wave, int vcu, int G) {
    const int gw = vcu * NWAVES + wave, NGW = G * NWAVES;
    const float* x = (const float*)a.in[IN_X]; const bf16* mix = (const bf16*)(a.ws + WS_B); float* x1 = a.out; bf16* h2 = (bf16*)(a.ws + WS_A);
    const GAS f32x4* gp = (const GAS f32x4*)a.in[IN_GPOST] + lane; const GAS f32x4* gf = (const GAS f32x4*)a.in[IN_GFPRE] + lane;
    for (int m = gw; m < SEQ; m += NGW) {
        const GAS u32x2* mr = (const GAS u32x2*)(mix + (size_t)m * DM) + lane; const GAS f32x4* xr = (const GAS f32x4*)(x + (size_t)m * DM) + lane;
        f32x4 v[8]; float s = 0.f;
#pragma unroll
        for (int j = 0; j < 8; ++j) { const u32x2 w = mr[64 * j]; v[j] = (f32x4){bflo(w.x), bfhi(w.x), bflo(w.y), bfhi(w.y)}; s += (v[j].x * v[j].x + v[j].y * v[j].y) + (v[j].z * v[j].z + v[j].w * v[j].w); }
        const float r = 1.0f / sqrtf(wave_sum(s) * (1.0f / DM) + NORM_EPS); float s2 = 0.f;
        GAS f32x4* xo = (GAS f32x4*)(x1 + (size_t)m * DM) + lane;
#pragma unroll
        for (int j = 0; j < 8; ++j) { const f32x4 xx = xr[64 * j], gg = gp[64 * j]; v[j] = xx + v[j] * r * gg; xo[64 * j] = v[j]; s2 += (v[j].x * v[j].x + v[j].y * v[j].y) + (v[j].z * v[j].z + v[j].w * v[j].w); }
        const float r2 = 1.0f / sqrtf(wave_sum(s2) * (1.0f / DM) + NORM_EPS);
        GAS u32x2* o = (GAS u32x2*)(h2 + (size_t)m * DM) + lane;
#pragma unroll
        for (int j = 0; j < 8; ++j) { const f32x4 gg = gf[64 * j]; u32x2 w; w.x = pk2(v[j].x * r2 * gg.x, v[j].y * r2 * gg.y); w.y = pk2(v[j].z * r2 * gg.z, v[j].w * r2 * gg.w); o[64 * j] = w; }
    }
}
DI void phase_r2(const Args& a, int lane, int wave, int vcu, int G, bool poison) {
    const int gw = vcu * NWAVES + wave, NGW = G * NWAVES;
    const bf16* ff = (const bf16*)(a.ws + WS_FF); float* out = a.out; const GAS f32x4* gp = (const GAS f32x4*)a.in[IN_GFPOST] + lane;
    const float qn = __builtin_nanf("");
    for (int m = gw; m < SEQ; m += NGW) {
        const GAS u32x2* fr = (const GAS u32x2*)(ff + (size_t)m * DM) + lane; GAS f32x4* xo = (GAS f32x4*)(out + (size_t)m * DM) + lane;
        f32x4 v[8]; float s = 0.f;
#pragma unroll
        for (int j = 0; j < 8; ++j) { const u32x2 w = fr[64 * j]; v[j] = (f32x4){bflo(w.x), bfhi(w.x), bflo(w.y), bfhi(w.y)}; s += (v[j].x * v[j].x + v[j].y * v[j].y) + (v[j].z * v[j].z + v[j].w * v[j].w); }
        const float r = 1.0f / sqrtf(wave_sum(s) * (1.0f / DM) + NORM_EPS);
#pragma unroll
        for (int j = 0; j < 8; ++j) { const f32x4 gg = gp[64 * j]; f32x4 o = xo[64 * j] + v[j] * r * gg; if (poison) o = (f32x4){qn, qn, qn, qn}; xo[64 * j] = o; }
    }
}

__global__ void __launch_bounds__(NTHR, 2) fwd(Args a) {
    extern __shared__ __attribute__((aligned(16))) unsigned char lds_raw[];
    ldsp lds = (ldsp)lds_raw;
    const int tid = threadIdx.x, lane = tid & 63, wave = __builtin_amdgcn_readfirstlane(tid >> 6);
    const int G = gridDim.x; const int bx = blockIdx.x; const int vcu = (G % 8 == 0) ? (bx % 8) * (G / 8) + bx / 8 : bx;
    volatile LAS unsigned* MISC = (volatile LAS unsigned*)(lds + MISC_OFF);
    if (tid < 32) MISC[tid] = 0u;
    __syncthreads();
    unsigned* ctl = (unsigned*)(a.ws + WS_CTL);
    XcdBarrier bar; bar.bar = ctl + CW_BAR; bar.x = 0; bar.st = nullptr;
    if (N_LAUNCHES == 1) bar = xcd_barrier_post(ctl + CW_BAR, MISC + 8);
    const int lo = a.ph_lo, hi = a.ph_hi;
#define IN(k) (lo <= (k) && (k) < hi)
#define SEAM(k) do { if (IN(k) && IN((k) + 1)) xcd_barrier(bar); } while (0)

#define PH1_BODY { pg8::Gemm g{(const bf16*)(a.ws + WS_A), (const bf16*)(a.ws + WS_WIN), SEQ, NPJ, DM}; pg8::StaticOrder S; S.init(SEQ, NPJ, G, bx); \
        pg8::EpiBf16 E{(bf16*)(a.ws + WS_B), NPJ}; pg8::gemm_phase<pg8::EpiBf16, pg8::StaticOrder, true, true>(lds, g, S, E); }
#define PH5_BODY { pg8::Gemm g{(const bf16*)a.out, (const bf16*)(a.ws + WS_WO), SEQ, DM, DM}; pg8::StaticOrder S; S.init(SEQ, DM, G, bx); \
        pg8::EpiBf16 E{(bf16*)(a.ws + WS_B), DM}; pg8::gemm_phase<pg8::EpiBf16, pg8::StaticOrder, true, true>(lds, g, S, E); }
#define PH7_BODY { pg8::Gemm g{(const bf16*)(a.ws + WS_A), (const bf16*)(a.ws + WS_WGU), SEQ, 2 * DFF, DM}; pg8::StaticOrder S; S.init(SEQ, 2 * DFF, G, bx); \
        pg8::EpiSwiGLU E{(bf16*)(a.ws + WS_B), DFF}; pg8::gemm_phase<pg8::EpiSwiGLU, pg8::StaticOrder, true, true>(lds, g, S, E); }
#define PH8_BODY { pg8::Gemm g{(const bf16*)(a.ws + WS_B), (const bf16*)(a.ws + WS_WD), SEQ, DM, DFF}; pg8::StaticOrder S; S.init(SEQ, DM, G, bx); \
        pg8::EpiBf16 E{(bf16*)(a.ws + WS_FF), DM}; pg8::gemm_phase<pg8::EpiBf16, pg8::StaticOrder, true, true>(lds, g, S, E); }
#define DUP(k) (((PROBE_DUP) >> (k)) & 1)
    if (IN(0)) { phase_p0(a, lds, tid, lane, wave, vcu, G); if (DUP(0)) { __syncthreads(); phase_p0(a, lds, tid, lane, wave, vcu, G); } SEAM(0); }
    if (IN(1)) { PH1_BODY if (DUP(1)) PH1_BODY SEAM(1); }
    if (IN(2)) { phase_m1(a, lds, tid, wave, vcu, G); if (DUP(2)) phase_m1(a, lds, tid, wave, vcu, G); SEAM(2); }
    if (IN(3)) { phase_m2(a, tid, vcu, G); if (DUP(3)) phase_m2(a, tid, vcu, G); SEAM(3); }
    if (IN(4)) { phase_m3(a, lds, tid, wave, vcu, G); if (DUP(4)) phase_m3(a, lds, tid, wave, vcu, G); SEAM(4); }
    if (IN(5)) { PH5_BODY if (DUP(5)) PH5_BODY SEAM(5); }
    if (IN(6)) { phase_r1(a, lane, wave, vcu, G); if (DUP(6)) phase_r1(a, lane, wave, vcu, G); SEAM(6); }
    if (IN(7)) { PH7_BODY if (DUP(7)) PH7_BODY SEAM(7); }
    if (IN(8)) { PH8_BODY if (DUP(8)) PH8_BODY SEAM(8); }
    if (IN(9)) {
        bool poison = false;
        if (N_LAUNCHES == 1) poison = __hip_atomic_load(ctl + CW_BAR + XB_TMO, __ATOMIC_RELAXED, __HIP_MEMORY_SCOPE_AGENT) != 0u;
        phase_r2(a, lane, wave, vcu, G, poison);
    }
#undef PH1_BODY
#undef PH5_BODY
#undef PH7_BODY
#undef PH8_BODY
#undef DUP
#undef IN
#undef SEAM
}

extern "C" void kernel_launch(void* const* d_in, const int* in_sizes, int n_in, void* d_out, int out_size, void* d_ws, size_t ws_size, hipStream_t stream) {
    static int grid = 0;
    if (grid == 0) {
        if (n_in != 17 || in_sizes[0] != SEQ * DM || out_size != SEQ * DM || ws_size < WS_END) {
            fprintf(stderr, "kernel_launch: unexpected shapes (n_in %d, in0 %d, out %d, ws %zu); nothing launched\n", n_in, n_in > 0 ? in_sizes[0] : -1, out_size, ws_size); grid = -1; return; }
        int dev = 0, cus = 0, per_cu = 0;
        if (hipGetDevice(&dev) != hipSuccess || hipDeviceGetAttribute(&cus, hipDeviceAttributeMultiprocessorCount, dev) != hipSuccess) { grid = -1; return; }
        if (hipFuncSetAttribute((const void*)fwd, hipFuncAttributeMaxDynamicSharedMemorySize, LDS_BYTES) != hipSuccess) { fprintf(stderr, "kernel_launch: hipFuncSetAttribute failed\n"); grid = -1; return; }
        if (hipOccupancyMaxActiveBlocksPerMultiprocessor(&per_cu, (const void*)fwd, NTHR, LDS_BYTES) != hipSuccess || per_cu < 1)
            fprintf(stderr, "kernel_launch: note: occupancy query reports %d workgroups per CU\n", per_cu);
        (void)hipGetLastError();
        grid = cus;
    }
    if (grid < 0) return;
    if (hipMemsetAsync((char*)d_ws + WS_CTL, 0, CTL_ZERO_BYTES, stream) != hipSuccess) return;
    Args a{};
    for (int i = 0; i < 17; ++i) a.in[i] = d_in[i];
    a.out = (float*)d_out; a.ws = (unsigned char*)d_ws;
    if (N_LAUNCHES == 1) { a.ph_lo = 0; a.ph_hi = NPHASES; a.li = 0; hipLaunchKernelGGL(fwd, dim3(grid), dim3(NTHR), LDS_BYTES, stream, a); }
    else for (int li = 0; li < NPHASES; ++li) { a.ph_lo = li; a.ph_hi = li + 1; a.li = li; hipLaunchKernelGGL(fwd, dim3(grid), dim3(NTHR), LDS_BYTES, stream, a); }
}
```

```cpp
#include <hip/hip_runtime.h>
#include <cstdio>
#include <cstdint>

#ifndef PROBE_DUP
#define PROBE_DUP 0
#endif
#ifndef MK_N_LAUNCHES
#define MK_N_LAUNCHES 1
#endif

namespace pg8 {
#define PG8_LAS __attribute__((address_space(3)))
typedef unsigned short bf16_t;
typedef short bf16x8 __attribute__((ext_vector_type(8)));
typedef float f32x4 __attribute__((ext_vector_type(4)));
typedef unsigned u32x4 __attribute__((ext_vector_type(4)));
constexpr int BM = 256, BK = 64, HALF = 128, HTB = HALF * BK * 2  , STAGE_BYTES = 8 * HTB, NXCD = 8, WGM = 8;

__host__ __device__ __forceinline__ int lds_byte(int r, int c) { const int st = (r >> 4) * 2 + (c >> 5), rr = r & 15, cc = c & 31, ob = rr * 64 + cc * 2; return st * 1024 + (ob ^ (((ob >> 9) & 1) << 5)); }
__host__ __device__ __forceinline__ void stage_rc(int b, int& R, int& C) { const int st = b / 1024, sb = b % 1024, swz = sb ^ (((sb >> 9) & 1) << 5); R = (st >> 1) * 16 + swz / 64; C = (st & 1) * 32 + (swz % 64) / 2; }
__host__ __device__ __forceinline__ int perm32(int rho) { const int n = rho >> 4, i = rho & 15; return 8 * (i >> 2) + 4 * n + (i & 3); }

struct Unit { int pm, pn; };
struct Gemm { const bf16_t* A; const bf16_t* Bt; int M, N, K; };

struct StaticOrder {
    int nM, nN, nwg, G, c;
    __host__ __device__ void init(int M, int N, int G_, int c_) { nM = M / BM; nN = N / BM; nwg = nM * nN; G = G_; c = c_; }
    __host__ __device__ bool next(int i, Unit& u) const {
        const long L = (long)i * G + c; if (L >= nwg) return false;
        int wgid = (int)L; { const int q = nwg / NXCD, r = nwg % NXCD, xcd = wgid % NXCD, off = wgid / NXCD; wgid = (xcd < r ? xcd * (q + 1) : r * (q + 1) + (xcd - r) * q) + off; }
        const int nig = WGM * nN, gid = wgid / nig, fm = gid * WGM, gsz = (nM - fm) < WGM ? (nM - fm) : WGM;
        u.pm = fm + ((wgid % nig) % gsz); u.pn = (wgid % nig) / gsz; return true;
    }
    __device__ __forceinline__ void a_ready(const Unit&) const {}
    __device__ __forceinline__ void done(const Unit&) const {}
};

__device__ __forceinline__ unsigned cvt_pk_bf16(float lo, float hi) { unsigned r; asm volatile("v_cvt_pk_bf16_f32 %0, %1, %2" : "=v"(r) : "v"(lo), "v"(hi)); return r; }

struct EpiF32 {
    static constexpr bool PERM = false, AFTER_DRAIN = false;
    float* C; int ldc;
    __device__ __forceinline__ void operator()(const f32x4 (&acc)[2][2][4][2], const Unit& u, int wr, int wc, int fr, int fq) const {
        const int row0 = u.pm * BM + wr * 64 + fr, col0 = u.pn * BM + wc * 32 + 4 * fq;
#pragma unroll
        for (int ai = 0; ai < 2; ++ai)
#pragma unroll
            for (int m = 0; m < 4; ++m) { float* rowp = C + (size_t)(row0 + ai * HALF + m * 16) * ldc + col0;
#pragma unroll
                for (int bj = 0; bj < 2; ++bj)
#pragma unroll
                    for (int n = 0; n < 2; ++n) *(f32x4*)(rowp + bj * HALF + n * 16) = acc[ai][bj][m][n]; }
    }
};
struct EpiBf16 {
    static constexpr bool PERM = true, AFTER_DRAIN = false;
    bf16_t* O; int ldc;
    __device__ __forceinline__ void operator()(const f32x4 (&acc)[2][2][4][2], const Unit& u, int wr, int wc, int fr, int fq) const {
        const int row0 = u.pm * BM + wr * 64 + fr, col0 = u.pn * BM + wc * 32 + 8 * fq;
#pragma unroll
        for (int ai = 0; ai < 2; ++ai)
#pragma unroll
            for (int m = 0; m < 4; ++m) { bf16_t* rowp = O + (size_t)(row0 + ai * HALF + m * 16) * ldc + col0;
#pragma unroll
                for (int bj = 0; bj < 2; ++bj) { const f32x4 v0 = acc[ai][bj][m][0], v1 = acc[ai][bj][m][1];
                    u32x4 w; w.x = cvt_pk_bf16(v0[0], v0[1]); w.y = cvt_pk_bf16(v0[2], v0[3]); w.z = cvt_pk_bf16(v1[0], v1[1]); w.w = cvt_pk_bf16(v1[2], v1[3]);
                    *(u32x4*)(rowp + bj * HALF) = w; } }
    }
};
__device__ __forceinline__ float silu_f(float x) { return x * __builtin_amdgcn_rcpf(1.0f + __expf(-x)); }
struct EpiSwiGLU {
    static constexpr bool PERM = true, AFTER_DRAIN = false;
    bf16_t* O; int ldc;
    __device__ __forceinline__ void operator()(const f32x4 (&acc)[2][2][4][2], const Unit& u, int wr, int wc, int fr, int fq) const {
        const int row0 = u.pm * BM + wr * 64 + fr, col0 = u.pn * HALF + wc * 32 + 8 * fq;
#pragma unroll
        for (int ai = 0; ai < 2; ++ai)
#pragma unroll
            for (int m = 0; m < 4; ++m) { bf16_t* rowp = O + (size_t)(row0 + ai * HALF + m * 16) * ldc + col0;
                const f32x4 g0 = acc[ai][0][m][0], g1 = acc[ai][0][m][1], u0 = acc[ai][1][m][0], u1 = acc[ai][1][m][1];
                u32x4 w; w.x = cvt_pk_bf16(silu_f(g0[0]) * u0[0], silu_f(g0[1]) * u0[1]); w.y = cvt_pk_bf16(silu_f(g0[2]) * u0[2], silu_f(g0[3]) * u0[3]);
                w.z = cvt_pk_bf16(silu_f(g1[0]) * u1[0], silu_f(g1[1]) * u1[1]); w.w = cvt_pk_bf16(silu_f(g1[2]) * u1[2], silu_f(g1[3]) * u1[3]);
                *(u32x4*)rowp = w; }
    }
};

template <class Epi, class Sched, bool ALIGN_EPI = false, bool SP2 = false>
__device__ __forceinline__ void gemm_phase(PG8_LAS unsigned char* lds, const Gemm g, const Sched& S, const Epi& E) {
    const int tid = threadIdx.x, wid = __builtin_amdgcn_readfirstlane(tid >> 6), lane = tid & 63, wr = wid >> 2, wc = wid & 3, fr = lane & 15, fq = lane >> 4;
    const int K = g.K, nt = K / BK;
    unsigned voffA[2], voffB[2];
#pragma unroll
    for (int i = 0; i < 2; ++i) { int R, C; stage_rc(tid * 16 + i * 8192, R, C); const int Rb = Epi::PERM ? ((R & ~31) + perm32(R & 31)) : R;
        voffA[i] = (unsigned)(R * K + C) * 2u; voffB[i] = (unsigned)(Rb * K + C) * 2u; }
    const size_t kstep = (size_t)(BK * 2);
    const size_t hstep = (size_t)HALF * K * 2;
    const size_t tstep = 2 * hstep;
    const unsigned ldsw = (unsigned)wid * 1024u;
    const int aoff = lds_byte(wr * 64 + fr, fq * 8), boff = lds_byte(wc * 32 + fr, fq * 8);
#define PG8_SA(b, h) (((b) * 2 + (h)) * HTB)
#define PG8_SB(b, h) ((4 + (b) * 2 + (h)) * HTB)
#define PG8_STAGE(bufoff, gbase, voff) do { _Pragma("unroll") for (int _i = 0; _i < 2; ++_i) \
        __builtin_amdgcn_global_load_lds((const unsigned*)((const char*)(gbase) + (voff)[_i]), (PG8_LAS unsigned*)(lds + (bufoff) + ldsw + _i * 8192), 16, 0, 0); } while (0)
#define PG8_LDA(dst, b, h) do { _Pragma("unroll") for (int m = 0; m < 4; ++m) _Pragma("unroll") for (int k = 0; k < 2; ++k) dst[m][k] = *(const PG8_LAS bf16x8*)(lds + PG8_SA(b, h) + aoff + m * 2048 + k * 1024); } while (0)
#define PG8_LDB(dst, b, h) do { _Pragma("unroll") for (int n = 0; n < 2; ++n) _Pragma("unroll") for (int k = 0; k < 2; ++k) dst[n][k] = *(const PG8_LAS bf16x8*)(lds + PG8_SB(b, h) + boff + n * 2048 + k * 1024); } while (0)
#define PG8_MMA(ai, bj, At, Bt) do { __builtin_amdgcn_s_setprio(1); _Pragma("unroll") for (int m = 0; m < 4; ++m) _Pragma("unroll") for (int n = 0; n < 2; ++n) _Pragma("unroll") for (int k = 0; k < 2; ++k) \
        acc[ai][bj][m][n] = __builtin_amdgcn_mfma_f32_16x16x32_bf16(Bt[n][k], At[m][k], acc[ai][bj][m][n], 0, 0, 0); __builtin_amdgcn_s_setprio(0); } while (0)
#define PG8_WAIT_V(n) asm volatile("s_waitcnt vmcnt(" #n ")" ::: "memory")
#define PG8_WAIT_L(n) asm volatile("s_waitcnt lgkmcnt(" #n ")" ::: "memory")
#define PG8_BAR __builtin_amdgcn_s_barrier()
#define PG8_SCHED __builtin_amdgcn_sched_barrier(0)
    Unit cur, nxt; int ui = 0;
    if (!S.next(0, cur)) return;
    f32x4 acc[2][2][4][2];
#pragma unroll
    for (int a = 0; a < 2; ++a)
#pragma unroll
        for (int b = 0; b < 2; ++b)
#pragma unroll
            for (int m = 0; m < 4; ++m)
#pragma unroll
                for (int n = 0; n < 2; ++n) acc[a][b][m][n] = (f32x4){0.f, 0.f, 0.f, 0.f};
    bf16x8 At[4][2], B0[2][2], B1[2][2];
    const char* cA = (const char*)g.A + (size_t)cur.pm * tstep; const char* cB = (const char*)g.Bt + (size_t)cur.pn * tstep;
    S.a_ready(cur);
    if constexpr (SP2) {
        PG8_STAGE(PG8_SB(0, 0), cB, voffB); PG8_STAGE(PG8_SB(0, 1), cB + hstep, voffB); PG8_STAGE(PG8_SA(0, 0), cA, voffA); PG8_STAGE(PG8_SA(0, 1), cA + hstep, voffA);
        if (wr == 1) PG8_BAR;
        PG8_WAIT_V(2); PG8_BAR;
        PG8_STAGE(PG8_SB(1, 0), cB + kstep, voffB); PG8_STAGE(PG8_SA(1, 0), cA + kstep, voffA); PG8_STAGE(PG8_SB(1, 1), cB + hstep + kstep, voffB);
        PG8_WAIT_V(6); PG8_BAR;
    } else {
        PG8_STAGE(PG8_SB(0, 0), cB, voffB); PG8_STAGE(PG8_SA(0, 0), cA, voffA); PG8_STAGE(PG8_SB(0, 1), cB + hstep, voffB); PG8_STAGE(PG8_SA(0, 1), cA + hstep, voffA);
        if (wr == 1) PG8_BAR;
        PG8_WAIT_V(4); PG8_BAR;
        PG8_STAGE(PG8_SB(1, 0), cB + kstep, voffB); PG8_STAGE(PG8_SA(1, 0), cA + kstep, voffA); PG8_STAGE(PG8_SB(1, 1), cB + hstep + kstep, voffB);
        PG8_WAIT_V(6); PG8_BAR;
    }
    for (;;) {
        const bool has_next = S.next(ui + 1, nxt);
        const char* nA = has_next ? (const char*)g.A + (size_t)nxt.pm * tstep : cA; const char* nB = has_next ? (const char*)g.Bt + (size_t)nxt.pn * tstep : cB;
        for (int t = 0; t < nt; t += 2) {
            const bool last = (t == nt - 2);
            const char* a1 = cA + (size_t)(t + 1) * kstep;
            const char* a2 = last ? nA : cA + (size_t)(t + 2) * kstep; const char* b2 = last ? nB : cB + (size_t)(t + 2) * kstep;
            const char* a3 = a2 + kstep; const char* b3 = b2 + kstep;
            if (last && has_next) S.a_ready(nxt);
            if constexpr (SP2) {
            PG8_LDB(B0, 0, 0); PG8_LDB(B1, 0, 1); PG8_SCHED; PG8_LDA(At, 0, 0); PG8_STAGE(PG8_SA(1, 1), a1 + hstep, voffA);
            PG8_WAIT_V(8); PG8_WAIT_L(0); PG8_BAR; PG8_MMA(0, 0, At, B0); PG8_MMA(0, 1, At, B1); PG8_BAR; PG8_SCHED;
            PG8_LDA(At, 0, 1); PG8_STAGE(PG8_SB(0, 0), b2, voffB); PG8_STAGE(PG8_SB(0, 1), b2 + hstep, voffB); PG8_STAGE(PG8_SA(0, 0), a2, voffA);
            PG8_WAIT_V(8); PG8_WAIT_L(0); PG8_BAR; PG8_MMA(1, 0, At, B0); PG8_MMA(1, 1, At, B1); PG8_BAR; PG8_SCHED;
            PG8_LDB(B0, 1, 0); PG8_LDB(B1, 1, 1); PG8_SCHED; PG8_LDA(At, 1, 0); PG8_STAGE(PG8_SA(0, 1), a2 + hstep, voffA);
            PG8_WAIT_V(8); PG8_WAIT_L(0); PG8_BAR; PG8_MMA(0, 0, At, B0); PG8_MMA(0, 1, At, B1); PG8_BAR; PG8_SCHED;
            PG8_LDA(At, 1, 1); PG8_STAGE(PG8_SB(1, 0), b3, voffB); PG8_STAGE(PG8_SB(1, 1), b3 + hstep, voffB); PG8_STAGE(PG8_SA(1, 0), a3, voffA);
            PG8_WAIT_V(8); PG8_WAIT_L(0); PG8_BAR; PG8_MMA(1, 0, At, B0); PG8_MMA(1, 1, At, B1); PG8_BAR; PG8_SCHED;
            } else {
            PG8_LDB(B0, 0, 0); PG8_SCHED; PG8_LDA(At, 0, 0); PG8_STAGE(PG8_SA(1, 1), a1 + hstep, voffA);
            PG8_WAIT_L(8); PG8_BAR; PG8_WAIT_L(0); PG8_MMA(0, 0, At, B0); PG8_BAR; PG8_SCHED;
            PG8_LDB(B1, 0, 1); PG8_STAGE(PG8_SB(0, 0), b2, voffB);
            PG8_BAR; PG8_WAIT_L(0); PG8_MMA(0, 1, At, B1); PG8_BAR;
            PG8_LDA(At, 0, 1); PG8_STAGE(PG8_SA(0, 0), a2, voffA);
            PG8_BAR; PG8_WAIT_L(0); PG8_MMA(1, 0, At, B0); PG8_BAR; PG8_SCHED;
            PG8_STAGE(PG8_SB(0, 1), b2 + hstep, voffB);
            PG8_WAIT_V(6); PG8_BAR; PG8_MMA(1, 1, At, B1); PG8_BAR;
            PG8_LDB(B0, 1, 0); PG8_SCHED; PG8_LDA(At, 1, 0); PG8_STAGE(PG8_SA(0, 1), a2 + hstep, voffA);
            PG8_WAIT_L(8); PG8_BAR; PG8_WAIT_L(0); PG8_MMA(0, 0, At, B0); PG8_BAR; PG8_SCHED;
            PG8_LDB(B1, 1, 1); PG8_STAGE(PG8_SB(1, 0), b3, voffB);
            PG8_BAR; PG8_WAIT_L(0); PG8_MMA(0, 1, At, B1); PG8_BAR;
            PG8_LDA(At, 1, 1); PG8_STAGE(PG8_SA(1, 0), a3, voffA);
            PG8_BAR; PG8_WAIT_L(0); PG8_MMA(1, 0, At, B0); PG8_BAR; PG8_SCHED;
            PG8_STAGE(PG8_SB(1, 1), b3 + hstep, voffB);
            PG8_WAIT_V(6); PG8_BAR; PG8_MMA(1, 1, At, B1); PG8_BAR;
            }
        }
        if constexpr (ALIGN_EPI) { if (wr == 0) PG8_BAR; }
        if constexpr (!Epi::AFTER_DRAIN) { E(acc, cur, wr, wc, fr, fq); S.done(cur); }
        if (!has_next) break;
#pragma unroll
        for (int a = 0; a < 2; ++a)
#pragma unroll
            for (int b = 0; b < 2; ++b)
#pragma unroll
                for (int m = 0; m < 4; ++m)
#pragma unroll
                    for (int n = 0; n < 2; ++n) acc[a][b][m][n] = (f32x4){0.f, 0.f, 0.f, 0.f};
        cur = nxt; cA = nA; cB = nB; ++ui;
        if constexpr (ALIGN_EPI) { if (wr == 1) PG8_BAR; }
    }
    PG8_WAIT_V(0);
    if constexpr (!ALIGN_EPI) { if (wr == 0) PG8_BAR; }
    PG8_BAR;
#undef PG8_SA
#undef PG8_SB
#undef PG8_STAGE
#undef PG8_LDA
#undef PG8_LDB
#undef PG8_MMA
#undef PG8_WAIT_V
#undef PG8_WAIT_L
#undef PG8_BAR
#undef PG8_SCHED
}
}

constexpr int NWAVES = 8, NTHR = 512;
constexpr int SEQ = 16384, DM = 2048, HD = 128, NHG = 8, DPROJ = 8208, NPJ = 8192, DFF = 5632, CH = 128, NCH = SEQ / CH, NHEADS = 16;
constexpr float NORM_EPS = 1e-6f;
constexpr int N_LAUNCHES = MK_N_LAUNCHES, NPHASES = 10;
constexpr int PC_MQ = 0, PC_MK = 1024, PC_MV = 2048, PC_MO = 3072, PC_RQ = 4096, PC_RK = 5120, PC_RV = 6144, PC_RG = 7168;

constexpr size_t MiB = 1u << 20;
constexpr size_t WS_CTL = 0, CTL_ZERO_BYTES = 64 * 1024;
constexpr size_t WS_WIN = 2 * MiB, WS_WO = 34 * MiB, WS_WGU = 42 * MiB, WS_WD = 86 * MiB;
constexpr size_t WS_PRE = 108 * MiB;
constexpr size_t WS_RS = 109 * MiB;
constexpr size_t WS_NLOC = 110 * MiB;
constexpr size_t WS_N0 = 110 * MiB + 512 * 1024;
constexpr size_t WS_DEC = 111 * MiB;
constexpr size_t WS_GHEAD = 111 * MiB + 65536;
constexpr size_t WS_COS = 112 * MiB, WS_SIN = 116 * MiB;
constexpr size_t WS_B = 128 * MiB;
constexpr size_t WS_A = 384 * MiB;
constexpr size_t WS_FF = WS_B + 176 * MiB;
constexpr size_t WS_END = 448 * MiB;
constexpr int CW_BAR = 1024;

constexpr int RING_BYTES = 131072;
constexpr int GATE_OFF = RING_BYTES;
constexpr int N0B_OFF = GATE_OFF + 8 * 1536;
constexpr int CONVW_OFF = N0B_OFF + 256;
constexpr int MISC_OFF = CONVW_OFF + 5120;
constexpr int LDS_BYTES = 163840;
static_assert(MISC_OFF + 1024 + 5120 <= LDS_BYTES, "LDS map");

#define GAS __attribute__((address_space(1)))
#define LAS __attribute__((address_space(3)))
#define DI __device__ __forceinline__
typedef unsigned short bf16;
typedef unsigned u32x4 __attribute__((ext_vector_type(4)));
typedef unsigned u32x2 __attribute__((ext_vector_type(2)));
typedef float f32x4 __attribute__((ext_vector_type(4)));
typedef float f32x2 __attribute__((ext_vector_type(2)));
typedef LAS unsigned char* ldsp;
#define LDS_WAIT() asm volatile("s_waitcnt lgkmcnt(0)" ::: "memory")

DI unsigned f2bf(float f) { unsigned u = __builtin_bit_cast(unsigned, f); return (u + 0x7fffu + ((u >> 16) & 1u)) >> 16; }
DI unsigned pk2(float lo, float hi) { unsigned r; asm volatile("v_cvt_pk_bf16_f32 %0, %1, %2" : "=v"(r) : "v"(lo), "v"(hi)); return r; }
DI float bflo(unsigned w) { return __builtin_bit_cast(float, w << 16); }
DI float bfhi(unsigned w) { return __builtin_bit_cast(float, w & 0xffff0000u); }
DI void unpack8(const u32x4 w, float (&f)[8]) { f[0] = bflo(w.x); f[1] = bfhi(w.x); f[2] = bflo(w.y); f[3] = bfhi(w.y); f[4] = bflo(w.z); f[5] = bfhi(w.z); f[6] = bflo(w.w); f[7] = bfhi(w.w); }
DI u32x4 pack8(const float (&f)[8]) { u32x4 w; w.x = pk2(f[0], f[1]); w.y = pk2(f[2], f[3]); w.z = pk2(f[4], f[5]); w.w = pk2(f[6], f[7]); return w; }
DI float sigmoid_f(float x) { return __builtin_amdgcn_rcpf(1.0f + __expf(-x)); }
DI float silu_f(float x) { return x * __builtin_amdgcn_rcpf(1.0f + __expf(-x)); }
DI float wave_sum(float v) {
#pragma unroll
    for (int o = 1; o < 64; o <<= 1) v += __shfl_xor(v, o);
    return v;
}

#define XB_TMO      128
#define XB_XCNT(j)  (256  + 64 * (j))
#define XB_XSUB(j)  (1280 + 64 * (j))
#define XB_XGEN(j)  (2304 + 64 * (j))
#define XB_TOP      3328
#define XB_TOPGEN   3392
#define XCD_BAR_WORDS 3456
#define XB_SPIN_CAP (1u << 18)
__device__ __forceinline__ unsigned xb_ld(unsigned* p)              { return __hip_atomic_load(p, __ATOMIC_RELAXED, __HIP_MEMORY_SCOPE_AGENT); }
__device__ __forceinline__ unsigned xb_add(unsigned* p, unsigned v) { return __hip_atomic_fetch_add(p, v, __ATOMIC_RELAXED, __HIP_MEMORY_SCOPE_AGENT); }
__device__ __forceinline__ unsigned xb_xcc_id() { return (unsigned)__builtin_amdgcn_s_getreg((3 << 11) | 20) & 0xFu; }
#define XB_SPIN(cond, bar) do { unsigned _sp = 0; while (cond) { __builtin_amdgcn_s_sleep(1); \
    if ((++_sp & 255u) == 0u) { if (xb_ld(&(bar)[XB_TMO])) break; if (_sp > XB_SPIN_CAP) { atomicAdd(&(bar)[XB_TMO], 1u); break; } } } } while (0)
struct XcdBarrier { unsigned* bar; unsigned x; volatile LAS unsigned* st; };
__device__ __forceinline__ XcdBarrier xcd_barrier_post(unsigned* bar, volatile LAS unsigned* st) {
    XcdBarrier b; b.bar = bar; b.x = xb_xcc_id(); b.st = st;
    if (threadIdx.x == 0) (void)xb_add(&bar[XB_XCNT(b.x)], 1u);
    return b;
}
__device__ __forceinline__ void xcd_barrier_complete(unsigned* bar, unsigned x, unsigned& nloc, unsigned& nx) {
    const unsigned G = gridDim.x * gridDim.y * gridDim.z;
    unsigned sum, cnt, mine, sp = 0u;
    for (;;) {
        sum = 0u; cnt = 0u; mine = 0u;
#pragma unroll
        for (unsigned j = 0; j < 16; ++j) { const unsigned c = xb_ld(&bar[XB_XCNT(j)]); sum += c; cnt += (c > 0u) ? 1u : 0u; mine = (j == x) ? c : mine; }
        if (sum == G) break;
        __builtin_amdgcn_s_sleep(1);
        if ((++sp & 255u) == 0u) { if (xb_ld(&bar[XB_TMO])) break; if (sp > XB_SPIN_CAP) { atomicAdd(&bar[XB_TMO], 1u); break; } }
    }
    nloc = mine > 0u ? mine : 1u; nx = cnt > 0u ? cnt : 1u;
}
__device__ __forceinline__ void xcd_barrier(const XcdBarrier& b) {
    asm volatile("s_waitcnt vmcnt(0)" ::: "memory");
    __syncthreads();
    if (threadIdx.x == 0) {
        unsigned* bar = b.bar;
        __builtin_amdgcn_s_waitcnt(0);
        unsigned nloc = b.st[0], nx = b.st[1];
        if (nloc == 0u) { xcd_barrier_complete(bar, b.x, nloc, nx); b.st[0] = nloc; b.st[1] = nx; }
        const unsigned old = xb_add(&bar[XB_XSUB(b.x)], 1u);
        const unsigned gen = old / nloc;
        if (old + 1u == (gen + 1u) * nloc) {
            __builtin_amdgcn_fence(__ATOMIC_RELEASE, "agent");
            asm volatile("s_waitcnt vmcnt(0)" ::: "memory");
            const unsigned og = xb_add(&bar[XB_TOP], 1u);
            const unsigned tg = og / nx;
            if (og + 1u == (tg + 1u) * nx) xb_add(&bar[XB_TOPGEN], 1u);
            else XB_SPIN(xb_ld(&bar[XB_TOPGEN]) == tg, bar);
            __builtin_amdgcn_fence(__ATOMIC_ACQUIRE, "agent");
            xb_add(&bar[XB_XGEN(b.x)], 1u);
            asm volatile("s_waitcnt vmcnt(0)" ::: "memory");
        } else {
            XB_SPIN(xb_ld(&bar[XB_XGEN(b.x)]) == gen, bar);
            __builtin_amdgcn_fence(__ATOMIC_ACQUIRE, "agent");
            asm volatile("s_waitcnt vmcnt(0)" ::: "memory");
        }
    }
    __syncthreads();
}

struct Args { const void* in[17]; float* out; unsigned char* ws; int ph_lo, ph_hi, li, pad; };
enum { IN_X = 0, IN_POS, IN_GPRE, IN_WIN, IN_CW, IN_CB, IN_BI, IN_BF, IN_GMH, IN_GRH, IN_WOUT, IN_GPOST, IN_GFPRE, IN_WG, IN_WU, IN_WDN, IN_GFPOST };

DI void p0_transpose_item(const float* W, int K, int ldw, int src_col, bf16* WT, int dst_row, LAS float* scr, int kb, int lane) {
    const int k0 = 64 * kb;
#pragma unroll 8
    for (int i = 0; i < 32; ++i) { const int kk = 2 * i + (lane >> 5); scr[kk * 33 + (lane & 31)] = W[(size_t)(k0 + kk) * ldw + src_col + (lane & 31)]; }
    LDS_WAIT(); asm volatile("" ::: "memory");
    const int c = lane & 7;
#pragma unroll
    for (int j = 0; j < 4; ++j) { const int n = (lane >> 3) + 8 * j; const LAS float* s = scr + (8 * c) * 33 + n;
        u32x4 o; o.x = pk2(s[0 * 33], s[1 * 33]); o.y = pk2(s[2 * 33], s[3 * 33]); o.z = pk2(s[4 * 33], s[5 * 33]); o.w = pk2(s[6 * 33], s[7 * 33]);
        *(GAS u32x4*)(WT + (size_t)(dst_row + n) * K + k0 + 8 * c) = o; }
    LDS_WAIT(); asm volatile("" ::: "memory");
}
typedef float f32x4g __attribute__((ext_vector_type(4)));
DI void p0_gates(const Args& a, ldsp lds, int tid, int lane, int wave, int vcu, int G) {
    const float* x = (const float*)a.in[IN_X]; const float* gpre = (const float*)a.in[IN_GPRE]; const float* w_in = (const float*)a.in[IN_WIN]; float* PRE = (float*)(a.ws + WS_PRE);
    LAS float* Wl = (LAS float*)lds;
    LAS float* part = (LAS float*)(lds + MISC_OFF + 1024);
#pragma unroll 4
    for (int i = 0; i < 16; ++i) { const int idx = tid + NTHR * i, k = idx >> 2, c4 = idx & 3;
        f32x4 w = *(const GAS f32x4*)(w_in + (size_t)k * DPROJ + 4096 + 4 * c4); w = w * gpre[k];
        const int row = (k & ~15) + 4 * (k & 3) + ((k >> 2) & 3);
        *(LAS f32x4*)(Wl + row * 16 + 4 * c4) = w; }
    LDS_WAIT(); __syncthreads();
    for (int rb = vcu; rb < SEQ / 64; rb += G) {
        const int tile = wave & 3, kh = wave >> 2, row = lane & 15, q = lane >> 4, t0 = rb * 64 + tile * 16;
        const GAS f32x4* xr = (const GAS f32x4*)(x + (size_t)(t0 + row) * DM + kh * 1024 + 4 * q);
        const LAS float* wl = Wl + (kh * 1024 + q) * 16 + row;
        f32x4g acc = {0.f, 0.f, 0.f, 0.f}; float ss = 0.f;
        for (int sp = 0; sp < 64; sp += 4) { f32x4 xv[4];
#pragma unroll
            for (int j = 0; j < 4; ++j) xv[j] = xr[4 * (sp + j)];
#pragma unroll
            for (int j = 0; j < 4; ++j) { ss += (xv[j].x * xv[j].x + xv[j].y * xv[j].y) + (xv[j].z * xv[j].z + xv[j].w * xv[j].w);
                const LAS float* wp = wl + (sp + j) * 256;
                acc = __builtin_amdgcn_mfma_f32_16x16x4f32(xv[j].x, wp[0], acc, 0, 0, 0); acc = __builtin_amdgcn_mfma_f32_16x16x4f32(xv[j].y, wp[64], acc, 0, 0, 0);
                acc = __builtin_amdgcn_mfma_f32_16x16x4f32(xv[j].z, wp[128], acc, 0, 0, 0); acc = __builtin_amdgcn_mfma_f32_16x16x4f32(xv[j].w, wp[192], acc, 0, 0, 0); } }
        if (kh == 1) {
#pragma unroll
            for (int j = 0; j < 4; ++j) part[(tile * 4 + j) * 64 + lane] = acc[j];
            part[1024 + tile * 64 + lane] = ss; }
        LDS_WAIT(); __syncthreads();
        if (kh == 0) {
#pragma unroll
            for (int j = 0; j < 4; ++j) acc[j] += part[(tile * 4 + j) * 64 + lane];
            ss += part[1024 + tile * 64 + lane];
            ss += __shfl_xor(ss, 16); ss += __shfl_xor(ss, 32);
            const float rs = 1.0f / sqrtf(ss * (1.0f / DM) + NORM_EPS);
#pragma unroll
            for (int j = 0; j < 4; ++j) { const int ri = 4 * q + j; const float rsi = __shfl(rs, ri); PRE[(size_t)(t0 + ri) * 16 + row] = acc[j] * rsi; } }
        __syncthreads();
    }
}
DI void phase_p0(const Args& a, ldsp lds, int tid, int lane, int wave, int vcu, int G) {
    p0_gates(a, lds, tid, lane, wave, vcu, G);
    const int gw = vcu * NWAVES + wave, NGW = G * NWAVES;
    LAS float* scr = (LAS float*)(lds + wave * 16384);
    const float* w_in = (const float*)a.in[IN_WIN]; const float* w_out = (const float*)a.in[IN_WOUT];
    const float* w_g = (const float*)a.in[IN_WG]; const float* w_u = (const float*)a.in[IN_WU]; const float* w_d = (const float*)a.in[IN_WDN];
    bf16* WinT = (bf16*)(a.ws + WS_WIN); bf16* WoT = (bf16*)(a.ws + WS_WO); bf16* WguT = (bf16*)(a.ws + WS_WGU); bf16* WdT = (bf16*)(a.ws + WS_WD);
    constexpr int I_IN = 32 * 256, I_O = 32 * 64, I_G = 32 * 176, I_D = 88 * 64, NITEMS = I_IN + I_O + 2 * I_G + I_D;
    for (int it = gw; it < NITEMS; it += NGW) {
        int r = it;
        if (r < I_IN) { const int kb = r / 256, nb = r % 256; const int sc = nb < 128 ? 32 * nb : 4112 + 32 * (nb - 128);
            p0_transpose_item(w_in, DM, DPROJ, sc, WinT, 32 * nb, scr, kb, lane); continue; } r -= I_IN;
        if (r < I_O) { const int kb = r / 64, nb = r % 64; p0_transpose_item(w_out, DM, DM, 32 * nb, WoT, 32 * nb, scr, kb, lane); continue; } r -= I_O;
        if (r < I_G) { const int kb = r / 176, nb = r % 176; p0_transpose_item(w_g, DM, DFF, 32 * nb, WguT, 256 * (nb >> 2) + 32 * (nb & 3), scr, kb, lane); continue; } r -= I_G;
        if (r < I_G) { const int kb = r / 176, nb = r % 176; p0_transpose_item(w_u, DM, DFF, 32 * nb, WguT, 256 * (nb >> 2) + 128 + 32 * (nb & 3), scr, kb, lane); continue; } r -= I_G;
        { const int kb = r / 64, nb = r % 64; p0_transpose_item(w_d, DFF, DM, 32 * nb, WdT, 32 * nb, scr, kb, lane); }
    }
    const float* x = (const float*)a.in[IN_X]; const float* gpre = (const float*)a.in[IN_GPRE];
    bf16* hb = (bf16*)(a.ws + WS_A);
    for (int m = gw; m < SEQ; m += NGW) {
        const GAS f32x4* xr = (const GAS f32x4*)(x + (size_t)m * DM) + lane; const GAS f32x4* gr = (const GAS f32x4*)gpre + lane;
        f32x4 v[8]; float s = 0.f;
#pragma unroll
        for (int j = 0; j < 8; ++j) { v[j] = xr[64 * j]; s += (v[j].x * v[j].x + v[j].y * v[j].y) + (v[j].z * v[j].z + v[j].w * v[j].w); }
        const float r = 1.0f / sqrtf(wave_sum(s) * (1.0f / DM) + NORM_EPS);
        GAS u32x2* o = (GAS u32x2*)(hb + (size_t)m * DM) + lane;
#pragma unroll
        for (int j = 0; j < 8; ++j) { const f32x4 gg = gr[64 * j]; u32x2 w; w.x = pk2(v[j].x * r * gg.x, v[j].y * r * gg.y); w.y = pk2(v[j].z * r * gg.z, v[j].w * r * gg.w); o[64 * j] = w; }
    }
    { float* GH = (float*)(a.ws + WS_GHEAD); const float* gmh = (const float*)a.in[IN_GMH]; const float* grh = (const float*)a.in[IN_GRH];
      for (int i = vcu * NTHR + tid; i < 1024; i += G * NTHR) GH[i] = gmh[i];
      for (int i = vcu * NTHR + tid; i < 1024; i += G * NTHR) GH[1024 + i] = grh[i]; }
    const int* pos = (const int*)a.in[IN_POS]; float* COS = (float*)(a.ws + WS_COS); float* SIN = (float*)(a.ws + WS_SIN);
    for (int i = vcu * NTHR + tid; i < SEQ * 64; i += G * NTHR) { const int t = i >> 6, j = i & 63;
        const float inv = (float)pow(10000.0, -(double)(2 * j) / 128.0); const float ang = (float)pos[t] * inv; float sn, cs; sincosf(ang, &sn, &cs); COS[i] = cs; SIN[i] = sn; }
}

typedef short bf16x8 __attribute__((ext_vector_type(8)));
typedef short s16x4 __attribute__((ext_vector_type(4)));
typedef float f32x16 __attribute__((ext_vector_type(16)));
#define MFMA32(a, b, c) __builtin_amdgcn_mfma_f32_32x32x16_bf16((a), (b), (c), 0, 0, 0)
DI int crow(int reg, int h) { return (reg & 3) + 8 * (reg >> 2) + 4 * h; }
DI bf16x8 bf_ones() { return (bf16x8){16256, 16256, 16256, 16256, 16256, 16256, 16256, 16256}; }
DI int offb(int row, int ch) { return 256 * row + 16 * (ch ^ (((row & 3) << 2) | ((row >> 2) & 3))); }
DI bf16x8 rowfrag(ldsp tile, int row, int ks, int h) { return *(const LAS bf16x8*)(tile + offb(row, 2 * ks + h)); }
DI s16x4 tr_rd(ldsp p) { return __builtin_bit_cast(s16x4, __builtin_amdgcn_ds_read_tr16_b64_v4i16((LAS s16x4*)p)); }
DI bf16x8 trfrag(ldsp tile, int c, int ks, int lane) {
    const int h = lane >> 5, blk = (lane >> 4) & 1, q = (lane & 15) >> 2, p = lane & 3, ch = 4 * c + 2 * blk + (p >> 1);
    const s16x4 lo = tr_rd(tile + offb(16 * ks + 8 * h + q, ch) + 8 * (p & 1)), hi = tr_rd(tile + offb(16 * ks + 8 * h + 4 + q, ch) + 8 * (p & 1));
    return __builtin_shufflevector(lo, hi, 0, 1, 2, 3, 4, 5, 6, 7);
}
DI void gload8(const bf16* p, float (&f)[8]) { unpack8(*(const GAS u32x4*)p, f); }

DI void mixer_setup(const Args& a, ldsp lds, int g, int grp, int tid, int lane, int wave) {
    if (g < NHG) {
        LAS float* rowv = (LAS float*)(lds + GATE_OFF + wave * 1536); LAS float* colv = rowv + 128; LAS float* alog = rowv + 256;
        const float* PRE = (const float*)(a.ws + WS_PRE); const float bi = ((const float*)a.in[IN_BI])[g], bfg = ((const float*)a.in[IN_BF])[g];
        const int t0 = (8 * grp + wave) * CH + 2 * lane;
        const float i0 = PRE[(size_t)t0 * 16 + g] + bi, i1 = PRE[(size_t)(t0 + 1) * 16 + g] + bi;
        const float f0 = PRE[(size_t)t0 * 16 + 8 + g] + bfg, f1 = PRE[(size_t)(t0 + 1) * 16 + 8 + g] + bfg;
        const float l0 = fminf(f0, 0.f) - log1pf(__expf(-fabsf(f0))), l1 = fminf(f1, 0.f) - log1pf(__expf(-fabsf(f1)));
        float p = l0 + l1;
#pragma unroll
        for (int o = 1; o < 64; o <<= 1) { const float y = __shfl_up(p, o); if (lane >= o) p += y; }
        const float b1 = p, b0 = p - l1;
        rowv[2 * lane] = b0; rowv[2 * lane + 1] = b1; alog[2 * lane] = b0; alog[2 * lane + 1] = b1; colv[2 * lane] = i0 - b0; colv[2 * lane + 1] = i1 - b1;
        if (tid < 128) { LAS float* cwl = (LAS float*)(lds + CONVW_OFF); const float* cw = (const float*)a.in[IN_CW]; const float* cb = (const float*)a.in[IN_CB];
#pragma unroll
            for (int j = 0; j < 4; ++j) { cwl[j * 128 + tid] = cw[j * 2048 + g * HD + tid]; cwl[640 + j * 128 + tid] = cw[j * 2048 + 1024 + g * HD + tid]; }
            cwl[512 + tid] = cb[g * HD + tid]; cwl[640 + 512 + tid] = cb[1024 + g * HD + tid]; }
    } else if (tid < 128) {
        LAS float* rowv = (LAS float*)(lds + GATE_OFF); LAS float* colv = rowv + 128; LAS float* alog = rowv + 256;
        const float lg = log1pf(-exp2f(-5.0f - (float)(g - NHG)));
        rowv[tid] = (float)tid * lg; colv[tid] = -(float)tid * lg; alog[tid] = (float)(tid + 1) * lg;
    }
    LDS_WAIT(); __syncthreads();
}
template <bool WITHQ> DI void mixer_tiles(const Args& a, ldsp lds, int g, int c, const LAS float* gt, int tid) {
    const bf16* proj = (const bf16*)(a.ws + WS_B);
    const LAS float* colv = gt + 128; const float rv127 = gt[127];
    ldsp Q = lds, K = lds + 32768, V = lds + 65536;
    const float kscale = 0.08838834764831845f;
    const int sq = tid >> 4, dg = tid & 15, tb = c * CH + 4 * sq;
    u32x4 vv[4];
    if (g < NHG) {
        const bf16* pk = proj + PC_MK + g * HD + 8 * dg; const bf16* pq = proj + PC_MQ + g * HD + 8 * dg; const bf16* pv = proj + PC_MV + g * HD + 8 * dg;
        u32x4 rk[7], rq[7];
#pragma unroll
        for (int j = 0; j < 7; ++j) { const int tt = tb - 3 + j, tc = tt < 0 ? 0 : tt; rk[j] = *(const GAS u32x4*)(pk + (size_t)tc * NPJ); if (WITHQ) rq[j] = *(const GAS u32x4*)(pq + (size_t)tc * NPJ);
            if (tt < 0) { rk[j] = (u32x4){0u, 0u, 0u, 0u}; if (WITHQ) rq[j] = (u32x4){0u, 0u, 0u, 0u}; } }
#pragma unroll
        for (int i = 0; i < 4; ++i) vv[i] = *(const GAS u32x4*)(pv + (size_t)(tb + i) * NPJ);
        const LAS float* cwl = (const LAS float*)(lds + CONVW_OFF);
#pragma unroll
        for (int qk = 0; qk < (WITHQ ? 2 : 1); ++qk) {
            const LAS float* wl = cwl + (qk == 0 ? 640 : 0) + 8 * dg;
            float w[5][8];
#pragma unroll
            for (int j = 0; j < 5; ++j) { const f32x4 w0 = *(const LAS f32x4*)(wl + j * 128), w1 = *(const LAS f32x4*)(wl + j * 128 + 4); w[j][0] = w0.x; w[j][1] = w0.y; w[j][2] = w0.z; w[j][3] = w0.w; w[j][4] = w1.x; w[j][5] = w1.y; w[j][6] = w1.z; w[j][7] = w1.w; }
#pragma unroll
            for (int i = 0; i < 4; ++i) { float acc[8];
#pragma unroll
                for (int e = 0; e < 8; ++e) acc[e] = w[4][e];
#pragma unroll
                for (int j = 0; j < 4; ++j) { float uu[8]; unpack8(qk == 0 ? rk[i + j] : rq[i + j], uu);
#pragma unroll
                    for (int e = 0; e < 8; ++e) acc[e] += w[j][e] * uu[e]; }
                const int srow = 4 * sq + i; const float sc = qk == 0 ? kscale * __expf(rv127 + colv[srow]) : 1.0f;
#pragma unroll
                for (int e = 0; e < 8; ++e) acc[e] = silu_f(acc[e]) * sc;
                *(LAS u32x4*)((qk == 0 ? K : Q) + offb(srow, dg)) = pack8(acc); }
        }
    } else {
        const int gr = g - NHG; const float* COS = (const float*)(a.ws + WS_COS); const float* SIN = (const float*)(a.ws + WS_SIN);
        const int s2 = tid >> 3, dgp = tid & 7;
        const bf16* pv = proj + PC_RV + gr * HD + 8 * dg;
        u32x4 klo[2], khi[2], qlo[2], qhi[2]; f32x4 cs[2][2], sn[2][2];
#pragma unroll
        for (int i = 0; i < 2; ++i) { const size_t t = (size_t)(c * CH + 2 * s2 + i); const bf16* pr = proj + t * NPJ + gr * HD + 8 * dgp;
            klo[i] = *(const GAS u32x4*)(pr + PC_RK); khi[i] = *(const GAS u32x4*)(pr + PC_RK + 64);
            if (WITHQ) { qlo[i] = *(const GAS u32x4*)(pr + PC_RQ); qhi[i] = *(const GAS u32x4*)(pr + PC_RQ + 64); }
            cs[i][0] = *(const GAS f32x4*)(COS + t * 64 + 8 * dgp); cs[i][1] = *(const GAS f32x4*)(COS + t * 64 + 8 * dgp + 4);
            sn[i][0] = *(const GAS f32x4*)(SIN + t * 64 + 8 * dgp); sn[i][1] = *(const GAS f32x4*)(SIN + t * 64 + 8 * dgp + 4); }
#pragma unroll
        for (int i = 0; i < 4; ++i) vv[i] = *(const GAS u32x4*)(pv + (size_t)(tb + i) * NPJ);
#pragma unroll
        for (int i = 0; i < 2; ++i) { const int srow = 2 * s2 + i;
            const float c8[8] = {cs[i][0].x, cs[i][0].y, cs[i][0].z, cs[i][0].w, cs[i][1].x, cs[i][1].y, cs[i][1].z, cs[i][1].w};
            const float s8[8] = {sn[i][0].x, sn[i][0].y, sn[i][0].z, sn[i][0].w, sn[i][1].x, sn[i][1].y, sn[i][1].z, sn[i][1].w};
            float lo[8], hi[8], olo[8], ohi[8]; unpack8(klo[i], lo); unpack8(khi[i], hi);
            const float sc = kscale * __expf(rv127 + colv[srow]);
#pragma unroll
            for (int e = 0; e < 8; ++e) { olo[e] = (lo[e] * c8[e] - hi[e] * s8[e]) * sc; ohi[e] = (hi[e] * c8[e] + lo[e] * s8[e]) * sc; }
            *(LAS u32x4*)(K + offb(srow, dgp)) = pack8(olo); *(LAS u32x4*)(K + offb(srow, 8 + dgp)) = pack8(ohi);
            if (WITHQ) { unpack8(qlo[i], lo); unpack8(qhi[i], hi);
#pragma unroll
                for (int e = 0; e < 8; ++e) { olo[e] = lo[e] * c8[e] - hi[e] * s8[e]; ohi[e] = hi[e] * c8[e] + lo[e] * s8[e]; }
                *(LAS u32x4*)(Q + offb(srow, dgp)) = pack8(olo); *(LAS u32x4*)(Q + offb(srow, 8 + dgp)) = pack8(ohi); }
        }
    }
#pragma unroll
    for (int i = 0; i < 4; ++i) *(LAS u32x4*)(V + offb(4 * sq + i, dg)) = vv[i];
    LDS_WAIT(); __syncthreads();
}

DI void phase_m1(const Args& a, ldsp lds, int tid_in, int wave, int vcu, int G) {
    float* U = a.out; float* NLOC = (float*)(a.ws + WS_NLOC); float* DEC = (float*)(a.ws + WS_DEC);
    ldsp K = lds + 32768, V = lds + 65536; const int wi = wave >> 1, wj = wave & 1;
    for (int cg = vcu; cg < NHEADS * 16; cg += G) { const int g = cg >> 4, grp = cg & 15; const bool ml = g < NHG;
        mixer_setup(a, lds, g, grp, tid_in, tid_in & 63, wave);
        for (int ci = 0; ci < 8; ++ci) { const int c = 8 * grp + ci;
            int tid_o = tid_in; asm volatile("" : "+v"(tid_o));
            const int tid = tid_o, lane = tid & 63, r = lane & 31, h = lane >> 5;
            const LAS float* gt = (const LAS float*)(lds + GATE_OFF + (ml ? ci : 0) * 1536);
            mixer_tiles<false>(a, lds, g, c, gt, tid);
            if (tid == 0) DEC[g * NCH + c] = __expf(gt[256 + 127]);
            f32x16 accU[2], accN;
#pragma unroll
            for (int i = 0; i < 16; ++i) { accU[0][i] = 0.f; accU[1][i] = 0.f; accN[i] = 0.f; }
#pragma unroll
            for (int ks = 0; ks < 8; ++ks) {
                const bf16x8 af = trfrag(K, wi, ks, lane), b0 = trfrag(V, 2 * wj, ks, lane), b1 = trfrag(V, 2 * wj + 1, ks, lane);
                accU[0] = MFMA32(af, b0, accU[0]); accU[1] = MFMA32(af, b1, accU[1]);
                if (ml && wj == 0) accN = MFMA32(af, bf_ones(), accN);
            }
            float* o = U + ((size_t)(g * NCH + c) << 14);
#pragma unroll
            for (int n = 0; n < 2; ++n)
#pragma unroll
                for (int i = 0; i < 16; ++i) o[(32 * wi + crow(i, h)) * HD + 64 * wj + 32 * n + r] = accU[n][i];
            if (ml && wj == 0 && r == 0) {
#pragma unroll
                for (int i = 0; i < 16; ++i) NLOC[((size_t)g * NCH + c) * HD + 32 * wi + crow(i, h)] = accN[i]; }
            __syncthreads();
        }
    }
}
DI void phase_m2(const Args& a, int tid, int vcu, int G) {
    const float* UT = a.out; bf16* C0T = (bf16*)(a.ws + WS_A); const float* DEC = (const float*)(a.ws + WS_DEC);
    const float* NLOC = (const float*)(a.ws + WS_NLOC); float* N0 = (float*)(a.ws + WS_N0);
    const int gt = vcu * NTHR + tid, NT = G * NTHR;
    for (int p = gt; p < NHEADS * 8192; p += NT) { const int e0 = p * 2, g = e0 >> 14, r = e0 & 16383;
        const float* dec = DEC + g * NCH; float c0 = 0.f, c1 = 0.f;
        for (int c = 0; c < NCH; c += 8) { f32x2 uu[8];
#pragma unroll
            for (int j = 0; j < 8; ++j) uu[j] = *(const GAS f32x2*)(UT + ((size_t)(g * NCH + c + j) << 14) + r);
#pragma unroll
            for (int j = 0; j < 8; ++j) { *(GAS unsigned*)(C0T + ((size_t)(g * NCH + c + j) << 14) + r) = pk2(c0, c1); const float d = dec[c + j]; c0 = d * c0 + uu[j].x; c1 = d * c1 + uu[j].y; } }
    }
    for (int p = gt; p < NHG * HD; p += NT) { const int g = p >> 7, d = p & 127; float n = 0.f;
        for (int c = 0; c < NCH; ++c) { N0[((size_t)g * NCH + c) * HD + d] = n; n = DEC[g * NCH + c] * n + NLOC[((size_t)g * NCH + c) * HD + d]; } }
}
DI void phase_m3(const Args& a, ldsp lds, int tid_in, int wave, int vcu, int G) {
    const bf16* proj = (const bf16*)(a.ws + WS_B); const bf16* C0G = (const bf16*)(a.ws + WS_A); const float* N0 = (const float*)(a.ws + WS_N0);
    bf16* mixb = (bf16*)a.out;
    LAS unsigned short* n0b = (LAS unsigned short*)(lds + N0B_OFF);
    ldsp Q = lds, K = lds + 32768, V = lds + 65536, C0 = lds + 98304, P = lds + 98304; LAS float* H = (LAS float*)lds;
    const int wi = wave >> 1, wj = wave & 1;
    for (int cg = vcu; cg < NHEADS * 16; cg += G) { const int g = cg >> 4, grp = cg & 15; const bool ml = g < NHG;
        mixer_setup(a, lds, g, grp, tid_in, tid_in & 63, wave);
        for (int ci = 0; ci < 8; ++ci) { const int c = 8 * grp + ci;
            int tid_o = tid_in; asm volatile("" : "+v"(tid_o));
            const int tid = tid_o, lane = tid & 63, r = lane & 31, h = lane >> 5;
            const LAS float* gt = (const LAS float*)(lds + GATE_OFF + (ml ? ci : 0) * 1536);
            { const bf16* c0g = C0G + ((size_t)(g * NCH + c) << 14);
#pragma unroll
              for (int i = 0; i < 4; ++i) { const int item = tid + NTHR * i, d = item >> 4, ch = item & 15; *(LAS u32x4*)(C0 + offb(d, ch)) = *(const GAS u32x4*)(c0g + d * HD + 8 * ch); }
              if (tid < 128) n0b[tid] = ml ? (unsigned short)f2bf(N0[((size_t)g * NCH + c) * HD + tid]) : (unsigned short)0; }
            u32x4 gpre[2][2];
            { const int tl = tid >> 3, eg = tid & 7; const int hc = ml ? g * HD + 16 * eg : (g - NHG) * HD + 16 * eg;
#pragma unroll
              for (int hh = 0; hh < 2; ++hh) { const bf16* gp = proj + (size_t)(c * CH + 64 * hh + tl) * NPJ + (ml ? PC_MO : PC_RG) + hc; gpre[hh][0] = *(const GAS u32x4*)gp; gpre[hh][1] = *(const GAS u32x4*)(gp + 8); } }
            mixer_tiles<true>(a, lds, g, c, gt, tid);
            f32x16 accO[2], accS[2], accD;
#pragma unroll
            for (int i = 0; i < 16; ++i) { accO[0][i] = 0.f; accO[1][i] = 0.f; accS[0][i] = 0.f; accS[1][i] = 0.f; accD[i] = 0.f; }
#pragma unroll
            for (int ks = 0; ks < 8; ++ks) {
                const bf16x8 af = rowfrag(Q, 32 * wi + r, ks, h), b0 = trfrag(C0, 2 * wj, ks, lane), b1 = trfrag(C0, 2 * wj + 1, ks, lane);
                accO[0] = MFMA32(af, b0, accO[0]); accO[1] = MFMA32(af, b1, accO[1]);
                if (ml) { const bf16x8 bn = *(const LAS bf16x8*)(n0b + 16 * ks + 8 * h); accD = MFMA32(af, bn, accD); }
            }
            float fac[16]; const float rv127 = gt[127];
#pragma unroll
            for (int i = 0; i < 16; ++i) { const int t = 32 * wi + crow(i, h); const float al = __expf(gt[256 + t]); fac[i] = __expf(gt[t] - rv127); accO[0][i] *= al; accO[1][i] *= al; accD[i] *= al; }
#pragma unroll
            for (int ks = 0; ks < 8; ++ks) {
                const bf16x8 af = rowfrag(Q, 32 * wi + r, ks, h), b0 = rowfrag(K, 64 * wj + r, ks, h), b1 = rowfrag(K, 64 * wj + 32 + r, ks, h);
                accS[0] = MFMA32(af, b0, accS[0]); accS[1] = MFMA32(af, b1, accS[1]);
            }
            __syncthreads();
#pragma unroll
            for (int n = 0; n < 2; ++n) { const int sidx = 64 * wj + 32 * n + r;
#pragma unroll
                for (int i = 0; i < 16; ++i) { const int t = 32 * wi + crow(i, h); const float val = (sidx <= t) ? accS[n][i] * fac[i] : 0.f;
                    *(LAS unsigned short*)(P + offb(t, sidx >> 3) + 2 * (sidx & 7)) = (unsigned short)pk2(val, val); } }
            LDS_WAIT(); __syncthreads();
#pragma unroll
            for (int ks = 0; ks < 8; ++ks) {
                const bf16x8 af = rowfrag(P, 32 * wi + r, ks, h), b0 = trfrag(V, 2 * wj, ks, lane), b1 = trfrag(V, 2 * wj + 1, ks, lane);
                accO[0] = MFMA32(af, b0, accO[0]); accO[1] = MFMA32(af, b1, accO[1]);
                if (ml) accD = MFMA32(af, bf_ones(), accD);
            }
#pragma unroll
            for (int i = 0; i < 16; ++i) { const int t = 32 * wi + crow(i, h); const float rden = ml ? 1.0f / fmaxf(fabsf(accD[i]), 1.0f) : 1.0f;
                H[t * HD + 64 * wj + r] = accO[0][i] * rden; H[t * HD + 64 * wj + 32 + r] = accO[1][i] * rden; }
            LDS_WAIT(); __syncthreads();
#pragma unroll
            for (int hh = 0; hh < 2; ++hh) {
                const int tl = tid >> 3, eg = tid & 7, t = 64 * hh + tl;
                float hv[16]; float ss = 0.f;
#pragma unroll
                for (int q = 0; q < 4; ++q) { const f32x4 x4 = *(const LAS f32x4*)(H + t * HD + 16 * eg + 4 * q); hv[4 * q] = x4.x; hv[4 * q + 1] = x4.y; hv[4 * q + 2] = x4.z; hv[4 * q + 3] = x4.w; }
#pragma unroll
                for (int i = 0; i < 16; ++i) ss += hv[i] * hv[i];
                ss += __shfl_xor(ss, 1); ss += __shfl_xor(ss, 2); ss += __shfl_xor(ss, 4);
                const float rn = 1.0f / sqrtf(ss * (1.0f / HD) + NORM_EPS);
                const int tg = c * CH + t; const int hc = ml ? g * HD + 16 * eg : (g - NHG) * HD + 16 * eg;
                const float* gh = (const float*)(a.ws + WS_GHEAD) + (ml ? 0 : 1024) + hc;
                float ga[16]; { float t8[8]; unpack8(gpre[hh][0], t8);
#pragma unroll
                    for (int j = 0; j < 8; ++j) ga[j] = t8[j]; unpack8(gpre[hh][1], t8);
#pragma unroll
                    for (int j = 0; j < 8; ++j) ga[8 + j] = t8[j]; }
                float o[16];
#pragma unroll
                for (int i = 0; i < 16; ++i) o[i] = hv[i] * rn * gh[i] * (ml ? sigmoid_f(ga[i]) : silu_f(ga[i]));
                bf16* op = mixb + (size_t)tg * DM + (ml ? 0 : 1024) + hc;
                u32x4 w0, w1; w0.x = pk2(o[0], o[1]); w0.y = pk2(o[2], o[3]); w0.z = pk2(o[4], o[5]); w0.w = pk2(o[6], o[7]); w1.x = pk2(o[8], o[9]); w1.y = pk2(o[10], o[11]); w1.z = pk2(o[12], o[13]); w1.w = pk2(o[14], o[15]);
                *(GAS u32x4*)op = w0; *(GAS u32x4*)(op + 8) = w1;
            }
            __syncthreads();
        }
    }
}
DI void phase_r1(const Args& a, int lane, int wave, int vcu, int G) {
    const int gw = vcu * NWAVES + wave, NGW = G * NWAVES;
    const float* x = (const float*)a.in[IN_X]; const bf16* mix = (const bf16*)(a.ws + WS_B); float* x1 = a.out; bf16* h2 = (bf16*)(a.ws + WS_A);
    const GAS f32x4* gp = (const GAS f32x4*)a.in[IN_GPOST] + lane; const GAS f32x4* gf = (const GAS f32x4*)a.in[IN_GFPRE] + lane;
    for (int m = gw; m < SEQ; m += NGW) {
        const GAS u32x2* mr = (const GAS u32x2*)(mix + (size_t)m * DM) + lane; const GAS f32x4* xr = (const GAS f32x4*)(x + (size_t)m * DM) + lane;
        f32x4 v[8]; float s = 0.f;
#pragma unroll
        for (int j = 0; j < 8; ++j) { const u32x2 w = mr[64 * j]; v[j] = (f32x4){bflo(w.x), bfhi(w.x), bflo(w.y), bfhi(w.y)}; s += (v[j].x * v[j].x + v[j].y * v[j].y) + (v[j].z * v[j].z + v[j].w * v[j].w); }
        const float r = 1.0f / sqrtf(wave_sum(s) * (1.0f / DM) + NORM_EPS); float s2 = 0.f;
        GAS f32x4* xo = (GAS f32x4*)(x1 + (size_t)m * DM) + lane;
#pragma unroll
        for (int j = 0; j < 8; ++j) { const f32x4 xx = xr[64 * j], gg = gp[64 * j]; v[j] = xx + v[j] * r * gg; xo[64 * j] = v[j]; s2 += (v[j].x * v[j].x + v[j].y * v[j].y) + (v[j].z * v[j].z + v[j].w * v[j].w); }
        const float r2 = 1.0f / sqrtf(wave_sum(s2) * (1.0f / DM) + NORM_EPS);
        GAS u32x2* o = (GAS u32x2*)(h2 + (size_t)m * DM) + lane;
#pragma unroll
        for (int j = 0; j < 8; ++j) { const f32x4 gg = gf[64 * j]; u32x2 w; w.x = pk2(v[j].x * r2 * gg.x, v[j].y * r2 * gg.y); w.y = pk2(v[j].z * r2 * gg.z, v[j].w * r2 * gg.w); o[64 * j] = w; }
    }
}
DI void phase_r2(const Args& a, int lane, int wave, int vcu, int G, bool poison) {
    const int gw = vcu * NWAVES + wave, NGW = G * NWAVES;
    const bf16* ff = (const bf16*)(a.ws + WS_FF); float* out = a.out; const GAS f32x4* gp = (const GAS f32x4*)a.in[IN_GFPOST] + lane;
    const float qn = __builtin_nanf("");
    for (int m = gw; m < SEQ; m += NGW) {
        const GAS u32x2* fr = (const GAS u32x2*)(ff + (size_t)m * DM) + lane; GAS f32x4* xo = (GAS f32x4*)(out + (size_t)m * DM) + lane;
        f32x4 v[8]; float s = 0.f;
#pragma unroll
        for (int j = 0; j < 8; ++j) { const u32x2 w = fr[64 * j]; v[j] = (f32x4){bflo(w.x), bfhi(w.x), bflo(w.y), bfhi(w.y)}; s += (v[j].x * v[j].x + v[j].y * v[j].y) + (v[j].z * v[j].z + v[j].w * v[j].w); }
        const float r = 1.0f / sqrtf(wave_sum(s) * (1.0f / DM) + NORM_EPS);
#pragma unroll
        for (int j = 0; j < 8; ++j) { const f32x4 gg = gp[64 * j]; f32x4 o = xo[64 * j] + v[j] * r * gg; if (poison) o = (f32x4){qn, qn, qn, qn}; xo[64 * j] = o; }
    }
}

__global__ void __launch_bounds__(NTHR, 2) fwd(Args a) {
    extern __shared__ __attribute__((aligned(16))) unsigned char lds_raw[];
    ldsp lds = (ldsp)lds_raw;
    const int tid = threadIdx.x, lane = tid & 63, wave = __builtin_amdgcn_readfirstlane(tid >> 6);
    const int G = gridDim.x; const int bx = blockIdx.x; const int vcu = (G % 8 == 0) ? (bx % 8) * (G / 8) + bx / 8 : bx;
    volatile LAS unsigned* MISC = (volatile LAS unsigned*)(lds + MISC_OFF);
    if (tid < 32) MISC[tid] = 0u;
    __syncthreads();
    unsigned* ctl = (unsigned*)(a.ws + WS_CTL);
    XcdBarrier bar; bar.bar = ctl + CW_BAR; bar.x = 0; bar.st = nullptr;
    if (N_LAUNCHES == 1) bar = xcd_barrier_post(ctl + CW_BAR, MISC + 8);
    const int lo = a.ph_lo, hi = a.ph_hi;
#define IN(k) (lo <= (k) && (k) < hi)
#define SEAM(k) do { if (IN(k) && IN((k) + 1)) xcd_barrier(bar); } while (0)

#define PH1_BODY { pg8::Gemm g{(const bf16*)(a.ws + WS_A), (const bf16*)(a.ws + WS_WIN), SEQ, NPJ, DM}; pg8::StaticOrder S; S.init(SEQ, NPJ, G, bx); \
        pg8::EpiBf16 E{(bf16*)(a.ws + WS_B), NPJ}; pg8::gemm_phase<pg8::EpiBf16, pg8::StaticOrder, true, true>(lds, g, S, E); }
#define PH5_BODY { pg8::Gemm g{(const bf16*)a.out, (const bf16*)(a.ws + WS_WO), SEQ, DM, DM}; pg8::StaticOrder S; S.init(SEQ, DM, G, bx); \
        pg8::EpiBf16 E{(bf16*)(a.ws + WS_B), DM}; pg8::gemm_phase<pg8::EpiBf16, pg8::StaticOrder, true, true>(lds, g, S, E); }
#define PH7_BODY { pg8::Gemm g{(const bf16*)(a.ws + WS_A), (const bf16*)(a.ws + WS_WGU), SEQ, 2 * DFF, DM}; pg8::StaticOrder S; S.init(SEQ, 2 * DFF, G, bx); \
        pg8::EpiSwiGLU E{(bf16*)(a.ws + WS_B), DFF}; pg8::gemm_phase<pg8::EpiSwiGLU, pg8::StaticOrder, true, true>(lds, g, S, E); }
#define PH8_BODY { pg8::Gemm g{(const bf16*)(a.ws + WS_B), (const bf16*)(a.ws + WS_WD), SEQ, DM, DFF}; pg8::StaticOrder S; S.init(SEQ, DM, G, bx); \
        pg8::EpiBf16 E{(bf16*)(a.ws + WS_FF), DM}; pg8::gemm_phase<pg8::EpiBf16, pg8::StaticOrder, true, true>(lds, g, S, E); }
#define DUP(k) (((PROBE_DUP) >> (k)) & 1)
    if (IN(0)) { phase_p0(a, lds, tid, lane, wave, vcu, G); if (DUP(0)) { __syncthreads(); phase_p0(a, lds, tid, lane, wave, vcu, G); } SEAM(0); }
    if (IN(1)) { PH1_BODY if (DUP(1)) PH1_BODY SEAM(1); }
    if (IN(2)) { phase_m1(a, lds, tid, wave, vcu, G); if (DUP(2)) phase_m1(a, lds, tid, wave, vcu, G); SEAM(2); }
    if (IN(3)) { phase_m2(a, tid, vcu, G); if (DUP(3)) phase_m2(a, tid, vcu, G); SEAM(3); }
    if (IN(4)) { phase_m3(a, lds, tid, wave, vcu, G); if (DUP(4)) phase_m3(a, lds, tid, wave, vcu, G); SEAM(4); }
    if (IN(5)) { PH5_BODY if (DUP(5)) PH5_BODY SEAM(5); }
    if (IN(6)) { phase_r1(a, lane, wave, vcu, G); if (DUP(6)) phase_r1(a, lane, wave, vcu, G); SEAM(6); }
    if (IN(7)) { PH7_BODY if (DUP(7)) PH7_BODY SEAM(7); }
    if (IN(8)) { PH8_BODY if (DUP(8)) PH8_BODY SEAM(8); }
    if (IN(9)) {
        bool poison = false;
        if (N_LAUNCHES == 1) poison = __hip_atomic_load(ctl + CW_BAR + XB_TMO, __ATOMIC_RELAXED, __HIP_MEMORY_SCOPE_AGENT) != 0u;
        phase_r2(a, lane, wave, vcu, G, poison);
    }
#undef PH1_BODY
#undef PH5_BODY
#undef PH7_BODY
#undef PH8_BODY
#undef DUP
#undef IN
#undef SEAM
}

extern "C" void kernel_launch(void* const* d_in, const int* in_sizes, int n_in, void* d_out, int out_size, void* d_ws, size_t ws_size, hipStream_t stream) {
    static int grid = 0;
    if (grid == 0) {
        if (n_in != 17 || in_sizes[0] != SEQ * DM || out_size != SEQ * DM || ws_size < WS_END) {
            fprintf(stderr, "kernel_launch: unexpected shapes (n_in %d, in0 %d, out %d, ws %zu); nothing launched\n", n_in, n_in > 0 ? in_sizes[0] : -1, out_size, ws_size); grid = -1; return; }
        int dev = 0, cus = 0, per_cu = 0;
        if (hipGetDevice(&dev) != hipSuccess || hipDeviceGetAttribute(&cus, hipDeviceAttributeMultiprocessorCount, dev) != hipSuccess) { grid = -1; return; }
        if (hipFuncSetAttribute((const void*)fwd, hipFuncAttributeMaxDynamicSharedMemorySize, LDS_BYTES) != hipSuccess) { fprintf(stderr, "kernel_launch: hipFuncSetAttribute failed\n"); grid = -1; return; }
        if (hipOccupancyMaxActiveBlocksPerMultiprocessor(&per_cu, (const void*)fwd, NTHR, LDS_BYTES) != hipSuccess || per_cu < 1)
            fprintf(stderr, "kernel_launch: note: occupancy query reports %d workgroups per CU\n", per_cu);
        (void)hipGetLastError();
        grid = cus;
    }
    if (grid < 0) return;
    if (hipMemsetAsync((char*)d_ws + WS_CTL, 0, CTL_ZERO_BYTES, stream) != hipSuccess) return;
    Args a{};
    for (int i = 0; i < 17; ++i) a.in[i] = d_in[i];
    a.out = (float*)d_out; a.ws = (unsigned char*)d_ws;
    if (N_LAUNCHES == 1) { a.ph_lo = 0; a.ph_hi = NPHASES; a.li = 0; hipLaunchKernelGGL(fwd, dim3(grid), dim3(NTHR), LDS_BYTES, stream, a); }
    else for (int li = 0; li < NPHASES; ++li) { a.ph_lo = li; a.ph_hi = li + 1; a.li = li; hipLaunchKernelGGL(fwd, dim3(grid), dim3(NTHR), LDS_BYTES, stream, a); }
}
```

```cpp
#include <hip/hip_runtime.h>
#include <cstdio>
#include <cstdint>

#ifndef PROBE_DUP
#define PROBE_DUP 0
#endif
#ifndef MK_N_LAUNCHES
#define MK_N_LAUNCHES 1
#endif

namespace pg8 {
#define PG8_LAS __attribute__((address_space(3)))
typedef unsigned short bf16_t;
typedef short bf16x8 __attribute__((ext_vector_type(8)));
typedef float f32x4 __attribute__((ext_vector_type(4)));
typedef unsigned u32x4 __attribute__((ext_vector_type(4)));
constexpr int BM = 256, BK = 64, HALF = 128, HTB = HALF * BK * 2  , STAGE_BYTES = 8 * HTB, NXCD = 8, WGM = 8;

__host__ __device__ __forceinline__ int lds_byte(int r, int c) { const int st = (r >> 4) * 2 + (c >> 5), rr = r & 15, cc = c & 31, ob = rr * 64 + cc * 2; return st * 1024 + (ob ^ (((ob >> 9) & 1) << 5)); }
__host__ __device__ __forceinline__ void stage_rc(int b, int& R, int& C) { const int st = b / 1024, sb = b % 1024, swz = sb ^ (((sb >> 9) & 1) << 5); R = (st >> 1) * 16 + swz / 64; C = (st & 1) * 32 + (swz % 64) / 2; }
__host__ __device__ __forceinline__ int perm32(int rho) { const int n = rho >> 4, i = rho & 15; return 8 * (i >> 2) + 4 * n + (i & 3); }

struct Unit { int pm, pn; };
struct Gemm { const bf16_t* A; const bf16_t* Bt; int M, N, K; };

struct StaticOrder {
    int nM, nN, nwg, G, c;
    __host__ __device__ void init(int M, int N, int G_, int c_) { nM = M / BM; nN = N / BM; nwg = nM * nN; G = G_; c = c_; }
    __host__ __device__ bool next(int i, Unit& u) const {
        const long L = (long)i * G + c; if (L >= nwg) return false;
        int wgid = (int)L; { const int q = nwg / NXCD, r = nwg % NXCD, xcd = wgid % NXCD, off = wgid / NXCD; wgid = (xcd < r ? xcd * (q + 1) : r * (q + 1) + (xcd - r) * q) + off; }
        const int nig = WGM * nN, gid = wgid / nig, fm = gid * WGM, gsz = (nM - fm) < WGM ? (nM - fm) : WGM;
        u.pm = fm + ((wgid % nig) % gsz); u.pn = (wgid % nig) / gsz; return true;
    }
    __device__ __forceinline__ void a_ready(const Unit&) const {}
    __device__ __forceinline__ void done(const Unit&) const {}
};

__device__ __forceinline__ unsigned cvt_pk_bf16(float lo, float hi) { unsigned r; asm volatile("v_cvt_pk_bf16_f32 %0, %1, %2" : "=v"(r) : "v"(lo), "v"(hi)); return r; }

struct EpiF32 {
    static constexpr bool PERM = false, AFTER_DRAIN = false;
    float* C; int ldc;
    __device__ __forceinline__ void operator()(const f32x4 (&acc)[2][2][4][2], const Unit& u, int wr, int wc, int fr, int fq) const {
        const int row0 = u.pm * BM + wr * 64 + fr, col0 = u.pn * BM + wc * 32 + 4 * fq;
#pragma unroll
        for (int ai = 0; ai < 2; ++ai)
#pragma unroll
            for (int m = 0; m < 4; ++m) { float* rowp = C + (size_t)(row0 + ai * HALF + m * 16) * ldc + col0;
#pragma unroll
                for (int bj = 0; bj < 2; ++bj)
#pragma unroll
                    for (int n = 0; n < 2; ++n) *(f32x4*)(rowp + bj * HALF + n * 16) = acc[ai][bj][m][n]; }
    }
};
struct EpiBf16 {
    static constexpr bool PERM = true, AFTER_DRAIN = false;
    bf16_t* O; int ldc;
    __device__ __forceinline__ void operator()(const f32x4 (&acc)[2][2][4][2], const Unit& u, int wr, int wc, int fr, int fq) const {
        const int row0 = u.pm * BM + wr * 64 + fr, col0 = u.pn * BM + wc * 32 + 8 * fq;
#pragma unroll
        for (int ai = 0; ai < 2; ++ai)
#pragma unroll
            for (int m = 0; m < 4; ++m) { bf16_t* rowp = O + (size_t)(row0 + ai * HALF + m * 16) * ldc + col0;
#pragma unroll
                for (int bj = 0; bj < 2; ++bj) { const f32x4 v0 = acc[ai][bj][m][0], v1 = acc[ai][bj][m][1];
                    u32x4 w; w.x = cvt_pk_bf16(v0[0], v0[1]); w.y = cvt_pk_bf16(v0[2], v0[3]); w.z = cvt_pk_bf16(v1[0], v1[1]); w.w = cvt_pk_bf16(v1[2], v1[3]);
                    *(u32x4*)(rowp + bj * HALF) = w; } }
    }
};
__device__ __forceinline__ float silu_f(float x) { return x * __builtin_amdgcn_rcpf(1.0f + __expf(-x)); }
struct EpiSwiGLU {
    static constexpr bool PERM = true, AFTER_DRAIN = false;
    bf16_t* O; int ldc;
    __device__ __forceinline__ void operator()(const f32x4 (&acc)[2][2][4][2], const Unit& u, int wr, int wc, int fr, int fq) const {
        const int row0 = u.pm * BM + wr * 64 + fr, col0 = u.pn * HALF + wc * 32 + 8 * fq;
#pragma unroll
        for (int ai = 0; ai < 2; ++ai)
#pragma unroll
            for (int m = 0; m < 4; ++m) { bf16_t* rowp = O + (size_t)(row0 + ai * HALF + m * 16) * ldc + col0;
                const f32x4 g0 = acc[ai][0][m][0], g1 = acc[ai][0][m][1], u0 = acc[ai][1][m][0], u1 = acc[ai][1][m][1];
                u32x4 w; w.x = cvt_pk_bf16(silu_f(g0[0]) * u0[0], silu_f(g0[1]) * u0[1]); w.y = cvt_pk_bf16(silu_f(g0[2]) * u0[2], silu_f(g0[3]) * u0[3]);
                w.z = cvt_pk_bf16(silu_f(g1[0]) * u1[0], silu_f(g1[1]) * u1[1]); w.w = cvt_pk_bf16(silu_f(g1[2]) * u1[2], silu_f(g1[3]) * u1[3]);
                *(u32x4*)rowp = w; }
    }
};

template <class Epi, class Sched, bool ALIGN_EPI = false, bool SP2 = false>
__device__ __forceinline__ void gemm_phase(PG8_LAS unsigned char* lds, const Gemm g, const Sched& S, const Epi& E) {
    const int tid = threadIdx.x, wid = __builtin_amdgcn_readfirstlane(tid >> 6), lane = tid & 63, wr = wid >> 2, wc = wid & 3, fr = lane & 15, fq = lane >> 4;
    const int K = g.K, nt = K / BK;
    unsigned voffA[2], voffB[2];
#pragma unroll
    for (int i = 0; i < 2; ++i) { int R, C; stage_rc(tid * 16 + i * 8192, R, C); const int Rb = Epi::PERM ? ((R & ~31) + perm32(R & 31)) : R;
        voffA[i] = (unsigned)(R * K + C) * 2u; voffB[i] = (unsigned)(Rb * K + C) * 2u; }
    const size_t kstep = (size_t)(BK * 2);
    const size_t hstep = (size_t)HALF * K * 2;
    const size_t tstep = 2 * hstep;
    const unsigned ldsw = (unsigned)wid * 1024u;
    const int aoff = lds_byte(wr * 64 + fr, fq * 8), boff = lds_byte(wc * 32 + fr, fq * 8);
#define PG8_SA(b, h) (((b) * 2 + (h)) * HTB)
#define PG8_SB(b, h) ((4 + (b) * 2 + (h)) * HTB)
#define PG8_STAGE(bufoff, gbase, voff) do { _Pragma("unroll") for (int _i = 0; _i < 2; ++_i) \
        __builtin_amdgcn_global_load_lds((const unsigned*)((const char*)(gbase) + (voff)[_i]), (PG8_LAS unsigned*)(lds + (bufoff) + ldsw + _i * 8192), 16, 0, 0); } while (0)
#define PG8_LDA(dst, b, h) do { _Pragma("unroll") for (int m = 0; m < 4; ++m) _Pragma("unroll") for (int k = 0; k < 2; ++k) dst[m][k] = *(const PG8_LAS bf16x8*)(lds + PG8_SA(b, h) + aoff + m * 2048 + k * 1024); } while (0)
#define PG8_LDB(dst, b, h) do { _Pragma("unroll") for (int n = 0; n < 2; ++n) _Pragma("unroll") for (int k = 0; k < 2; ++k) dst[n][k] = *(const PG8_LAS bf16x8*)(lds + PG8_SB(b, h) + boff + n * 2048 + k * 1024); } while (0)
#define PG8_MMA(ai, bj, At, Bt) do { __builtin_amdgcn_s_setprio(1); _Pragma("unroll") for (int m = 0; m < 4; ++m) _Pragma("unroll") for (int n = 0; n < 2; ++n) _Pragma("unroll") for (int k = 0; k < 2; ++k) \
        acc[ai][bj][m][n] = __builtin_amdgcn_mfma_f32_16x16x32_bf16(Bt[n][k], At[m][k], acc[ai][bj][m][n], 0, 0, 0); __builtin_amdgcn_s_setprio(0); } while (0)
#define PG8_WAIT_V(n) asm volatile("s_waitcnt vmcnt(" #n ")" ::: "memory")
#define PG8_WAIT_L(n) asm volatile("s_waitcnt lgkmcnt(" #n ")" ::: "memory")
#define PG8_BAR __builtin_amdgcn_s_barrier()
#define PG8_SCHED __builtin_amdgcn_sched_barrier(0)
    Unit cur, nxt; int ui = 0;
    if (!S.next(0, cur)) return;
    f32x4 acc[2][2][4][2];
#pragma unroll
    for (int a = 0; a < 2; ++a)
#pragma unroll
        for (int b = 0; b < 2; ++b)
#pragma unroll
            for (int m = 0; m < 4; ++m)
#pragma unroll
                for (int n = 0; n < 2; ++n) acc[a][b][m][n] = (f32x4){0.f, 0.f, 0.f, 0.f};
    bf16x8 At[4][2], B0[2][2], B1[2][2];
    const char* cA = (const char*)g.A + (size_t)cur.pm * tstep; const char* cB = (const char*)g.Bt + (size_t)cur.pn * tstep;
    S.a_ready(cur);
    if constexpr (SP2) {
        PG8_STAGE(PG8_SB(0, 0), cB, voffB); PG8_STAGE(PG8_SB(0, 1), cB + hstep, voffB); PG8_STAGE(PG8_SA(0, 0), cA, voffA); PG8_STAGE(PG8_SA(0, 1), cA + hstep, voffA);
        if (wr == 1) PG8_BAR;
        PG8_WAIT_V(2); PG8_BAR;
        PG8_STAGE(PG8_SB(1, 0), cB + kstep, voffB); PG8_STAGE(PG8_SA(1, 0), cA + kstep, voffA); PG8_STAGE(PG8_SB(1, 1), cB + hstep + kstep, voffB);
        PG8_WAIT_V(6); PG8_BAR;
    } else {
        PG8_STAGE(PG8_SB(0, 0), cB, voffB); PG8_STAGE(PG8_SA(0, 0), cA, voffA); PG8_STAGE(PG8_SB(0, 1), cB + hstep, voffB); PG8_STAGE(PG8_SA(0, 1), cA + hstep, voffA);
        if (wr == 1) PG8_BAR;
        PG8_WAIT_V(4); PG8_BAR;
        PG8_STAGE(PG8_SB(1, 0), cB + kstep, voffB); PG8_STAGE(PG8_SA(1, 0), cA + kstep, voffA); PG8_STAGE(PG8_SB(1, 1), cB + hstep + kstep, voffB);
        PG8_WAIT_V(6); PG8_BAR;
    }
    for (;;) {
        const bool has_next = S.next(ui + 1, nxt);
        const char* nA = has_next ? (const char*)g.A + (size_t)nxt.pm * tstep : cA; const char* nB = has_next ? (const char*)g.Bt + (size_t)nxt.pn * tstep : cB;
        for (int t = 0; t < nt; t += 2) {
            const bool last = (t == nt - 2);
            const char* a1 = cA + (size_t)(t + 1) * kstep;
            const char* a2 = last ? nA : cA + (size_t)(t + 2) * kstep; const char* b2 = last ? nB : cB + (size_t)(t + 2) * kstep;
            const char* a3 = a2 + kstep; const char* b3 = b2 + kstep;
            if (last && has_next) S.a_ready(nxt);
            if constexpr (SP2) {
            PG8_LDB(B0, 0, 0); PG8_LDB(B1, 0, 1); PG8_SCHED; PG8_LDA(At, 0, 0); PG8_STAGE(PG8_SA(1, 1), a1 + hstep, voffA);
            PG8_WAIT_V(8); PG8_WAIT_L(0); PG8_BAR; PG8_MMA(0, 0, At, B0); PG8_MMA(0, 1, At, B1); PG8_BAR; PG8_SCHED;
            PG8_LDA(At, 0, 1); PG8_STAGE(PG8_SB(0, 0), b2, voffB); PG8_STAGE(PG8_SB(0, 1), b2 + hstep, voffB); PG8_STAGE(PG8_SA(0, 0), a2, voffA);
            PG8_WAIT_V(8); PG8_WAIT_L(0); PG8_BAR; PG8_MMA(1, 0, At, B0); PG8_MMA(1, 1, At, B1); PG8_BAR; PG8_SCHED;
            PG8_LDB(B0, 1, 0); PG8_LDB(B1, 1, 1); PG8_SCHED; PG8_LDA(At, 1, 0); PG8_STAGE(PG8_SA(0, 1), a2 + hstep, voffA);
            PG8_WAIT_V(8); PG8_WAIT_L(0); PG8_BAR; PG8_MMA(0, 0, At, B0); PG8_MMA(0, 1, At, B1); PG8_BAR; PG8_SCHED;
            PG8_LDA(At, 1, 1); PG8_STAGE(PG8_SB(1, 0), b3, voffB); PG8_STAGE(PG8_SB(1, 1), b3 + hstep, voffB); PG8_STAGE(PG8_SA(1, 0), a3, voffA);
            PG8_WAIT_V(8); PG8_WAIT_L(0); PG8_BAR; PG8_MMA(1, 0, At, B0); PG8_MMA(1, 1, At, B1); PG8_BAR; PG8_SCHED;
            } else {
            PG8_LDB(B0, 0, 0); PG8_SCHED; PG8_LDA(At, 0, 0); PG8_STAGE(PG8_SA(1, 1), a1 + hstep, voffA);
            PG8_WAIT_L(8); PG8_BAR; PG8_WAIT_L(0); PG8_MMA(0, 0, At, B0); PG8_BAR; PG8_SCHED;
            PG8_LDB(B1, 0, 1); PG8_STAGE(PG8_SB(0, 0), b2, voffB);
            PG8_BAR; PG8_WAIT_L(0); PG8_MMA(0, 1, At, B1); PG8_BAR;
            PG8_LDA(At, 0, 1); PG8_STAGE(PG8_SA(0, 0), a2, voffA);
            PG8_BAR; PG8_WAIT_L(0); PG8_MMA(1, 0, At, B0); PG8_BAR; PG8_SCHED;
            PG8_STAGE(PG8_SB(0, 1), b2 + hstep, voffB);
            PG8_WAIT_V(6); PG8_BAR; PG8_MMA(1, 1, At, B1); PG8_BAR;
            PG8_LDB(B0, 1, 0); PG8_SCHED; PG8_LDA(At, 1, 0); PG8_STAGE(PG8_SA(0, 1), a2 + hstep, voffA);
            PG8_WAIT_L(8); PG8_BAR; PG8_WAIT_L(0); PG8_MMA(0, 0, At, B0); PG8_BAR; PG8_SCHED;
            PG8_LDB(B1, 1, 1); PG8_STAGE(PG8_SB(1, 0), b3, voffB);
            PG8_BAR; PG8_WAIT_L(0); PG8_MMA(0, 1, At, B1); PG8_BAR;
            PG8_LDA(At, 1, 1); PG8_STAGE(PG8_SA(1, 0), a3, voffA);
            PG8_BAR; PG8_WAIT_L(0); PG8_MMA(1, 0, At, B0); PG8_BAR; PG8_SCHED;
            PG8_STAGE(PG8_SB(1, 1), b3 + hstep, voffB);
            PG8_WAIT_V(6); PG8_BAR; PG8_MMA(1, 1, At, B1); PG8_BAR;
            }
        }
        if constexpr (ALIGN_EPI) { if (wr == 0) PG8_BAR; }
        if constexpr (!Epi::AFTER_DRAIN) { E(acc, cur, wr, wc, fr, fq); S.done(cur); }
        if (!has_next) break;
#pragma unroll
        for (int a = 0; a < 2; ++a)
#pragma unroll
            for (int b = 0; b < 2; ++b)
#pragma unroll
                for (int m = 0; m < 4; ++m)
#pragma unroll
                    for (int n = 0; n < 2; ++n) acc[a][b][m][n] = (f32x4){0.f, 0.f, 0.f, 0.f};
        cur = nxt; cA = nA; cB = nB; ++ui;
        if constexpr (ALIGN_EPI) { if (wr == 1) PG8_BAR; }
    }
    PG8_WAIT_V(0);
    if constexpr (!ALIGN_EPI) { if (wr == 0) PG8_BAR; }
    PG8_BAR;
#undef PG8_SA
#undef PG8_SB
#undef PG8_STAGE
#undef PG8_LDA
#undef PG8_LDB
#undef PG8_MMA
#undef PG8_WAIT_V
#undef PG8_WAIT_L
#undef PG8_BAR
#undef PG8_SCHED
}
}

constexpr int NWAVES = 8, NTHR = 512;
constexpr int SEQ = 16384, DM = 2048, HD = 128, NHG = 8, DPROJ = 8208, NPJ = 8192, DFF = 5632, CH = 128, NCH = SEQ / CH, NHEADS = 16;
constexpr float NORM_EPS = 1e-6f;
constexpr int N_LAUNCHES = MK_N_LAUNCHES, NPHASES = 10;
constexpr int PC_MQ = 0, PC_MK = 1024, PC_MV = 2048, PC_MO = 3072, PC_RQ = 4096, PC_RK = 5120, PC_RV = 6144, PC_RG = 7168;

constexpr size_t MiB = 1u << 20;
constexpr size_t WS_CTL = 0, CTL_ZERO_BYTES = 64 * 1024;
constexpr size_t WS_WIN = 2 * MiB, WS_WO = 34 * MiB, WS_WGU = 42 * MiB, WS_WD = 86 * MiB;
constexpr size_t WS_PRE = 108 * MiB;
constexpr size_t WS_RS = 109 * MiB;
constexpr size_t WS_NLOC = 110 * MiB;
constexpr size_t WS_N0 = 110 * MiB + 512 * 1024;
constexpr size_t WS_DEC = 111 * MiB;
constexpr size_t WS_GHEAD = 111 * MiB + 65536;
constexpr size_t WS_COS = 112 * MiB, WS_SIN = 116 * MiB;
constexpr size_t WS_B = 128 * MiB;
constexpr size_t WS_A = 384 * MiB;
constexpr size_t WS_FF = WS_B + 176 * MiB;
constexpr size_t WS_END = 448 * MiB;
constexpr int CW_BAR = 1024;

constexpr int RING_BYTES = 131072;
constexpr int GATE_OFF = RING_BYTES;
constexpr int N0B_OFF = GATE_OFF + 8 * 1536;
constexpr int CONVW_OFF = N0B_OFF + 256;
constexpr int MISC_OFF = CONVW_OFF + 5120;
constexpr int LDS_BYTES = 163840;
static_assert(MISC_OFF + 1024 + 5120 <= LDS_BYTES, "LDS map");

#define GAS __attribute__((address_space(1)))
#define LAS __attribute__((address_space(3)))
#define DI __device__ __forceinline__
typedef unsigned short bf16;
typedef unsigned u32x4 __attribute__((ext_vector_type(4)));
typedef unsigned u32x2 __attribute__((ext_vector_type(2)));
typedef float f32x4 __attribute__((ext_vector_type(4)));
typedef float f32x2 __attribute__((ext_vector_type(2)));
typedef LAS unsigned char* ldsp;
#define LDS_WAIT() asm volatile("s_waitcnt lgkmcnt(0)" ::: "memory")

DI unsigned f2bf(float f) { unsigned u = __builtin_bit_cast(unsigned, f); return (u + 0x7fffu + ((u >> 16) & 1u)) >> 16; }
DI unsigned pk2(float lo, float hi) { unsigned r; asm volatile("v_cvt_pk_bf16_f32 %0, %1, %2" : "=v"(r) : "v"(lo), "v"(hi)); return r; }
DI float bflo(unsigned w) { return __builtin_bit_cast(float, w << 16); }
DI float bfhi(unsigned w) { return __builtin_bit_cast(float, w & 0xffff0000u); }
DI void unpack8(const u32x4 w, float (&f)[8]) { f[0] = bflo(w.x); f[1] = bfhi(w.x); f[2] = bflo(w.y); f[3] = bfhi(w.y); f[4] = bflo(w.z); f[5] = bfhi(w.z); f[6] = bflo(w.w); f[7] = bfhi(w.w); }
DI u32x4 pack8(const float (&f)[8]) { u32x4 w; w.x = pk2(f[0], f[1]); w.y = pk2(f[2], f[3]); w.z = pk2(f[4], f[5]); w.w = pk2(f[6], f[7]); return w; }
DI float sigmoid_f(float x) { return __builtin_amdgcn_rcpf(1.0f + __expf(-x)); }
DI float silu_f(float x) { return x * __builtin_amdgcn_rcpf(1.0f + __expf(-x)); }
DI float wave_sum(float v) {
#pragma unroll
    for (int o = 1; o < 64; o <<= 1) v += __shfl_xor(v, o);
    return v;
}

#define XB_TMO      128
#define XB_XCNT(j)  (256  + 64 * (j))
#define XB_XSUB(j)  (1280 + 64 * (j))
#define XB_XGEN(j)  (2304 + 64 * (j))
#define XB_TOP      3328
#define XB_TOPGEN   3392
#define XCD_BAR_WORDS 3456
#define XB_SPIN_CAP (1u << 18)
__device__ __forceinline__ unsigned xb_ld(unsigned* p)              { return __hip_atomic_load(p, __ATOMIC_RELAXED, __HIP_MEMORY_SCOPE_AGENT); }
__device__ __forceinline__ unsigned xb_add(unsigned* p, unsigned v) { return __hip_atomic_fetch_add(p, v, __ATOMIC_RELAXED, __HIP_MEMORY_SCOPE_AGENT); }
__device__ __forceinline__ unsigned xb_xcc_id() { return (unsigned)__builtin_amdgcn_s_getreg((3 << 11) | 20) & 0xFu; }
#define XB_SPIN(cond, bar) do { unsigned _sp = 0; while (cond) { __builtin_amdgcn_s_sleep(1); \
    if ((++_sp & 255u) == 0u) { if (xb_ld(&(bar)[XB_TMO])) break; if (_sp > XB_SPIN_CAP) { atomicAdd(&(bar)[XB_TMO], 1u); break; } } } } while (0)
struct XcdBarrier { unsigned* bar; unsigned x; volatile LAS unsigned* st; };
__device__ __forceinline__ XcdBarrier xcd_barrier_post(unsigned* bar, volatile LAS unsigned* st) {
    XcdBarrier b; b.bar = bar; b.x = xb_xcc_id(); b.st = st;
    if (threadIdx.x == 0) (void)xb_add(&bar[XB_XCNT(b.x)], 1u);
    return b;
}
__device__ __forceinline__ void xcd_barrier_complete(unsigned* bar, unsigned x, unsigned& nloc, unsigned& nx) {
    const unsigned G = gridDim.x * gridDim.y * gridDim.z;
    unsigned sum, cnt, mine, sp = 0u;
    for (;;) {
        sum = 0u; cnt = 0u; mine = 0u;
#pragma unroll
        for (unsigned j = 0; j < 16; ++j) { const unsigned c = xb_ld(&bar[XB_XCNT(j)]); sum += c; cnt += (c > 0u) ? 1u : 0u; mine = (j == x) ? c : mine; }
        if (sum == G) break;
        __builtin_amdgcn_s_sleep(1);
        if ((++sp & 255u) == 0u) { if (xb_ld(&bar[XB_TMO])) break; if (sp > XB_SPIN_CAP) { atomicAdd(&bar[XB_TMO], 1u); break; } }
    }
    nloc = mine > 0u ? mine : 1u; nx = cnt > 0u ? cnt : 1u;
}
__device__ __forceinline__ void xcd_barrier(const XcdBarrier& b) {
    asm volatile("s_waitcnt vmcnt(0)" ::: "memory");
    __syncthreads();
    if (threadIdx.x == 0) {
        unsigned* bar = b.bar;
        __builtin_amdgcn_s_waitcnt(0);
        unsigned nloc = b.st[0], nx = b.st[1];
        if (nloc == 0u) { xcd_barrier_complete(bar, b.x, nloc, nx); b.st[0] = nloc; b.st[1] = nx; }
        const unsigned old = xb_add(&bar[XB_XSUB(b.x)], 1u);
        const unsigned gen = old / nloc;
        if (old + 1u == (gen + 1u) * nloc) {
            __builtin_amdgcn_fence(__ATOMIC_RELEASE, "agent");
            asm volatile("s_waitcnt vmcnt(0)" ::: "memory");
            const unsigned og = xb_add(&bar[XB_TOP], 1u);
            const unsigned tg = og / nx;
            if (og + 1u == (tg + 1u) * nx) xb_add(&bar[XB_TOPGEN], 1u);
            else XB_SPIN(xb_ld(&bar[XB_TOPGEN]) == tg, bar);
            __builtin_amdgcn_fence(__ATOMIC_ACQUIRE, "agent");
            xb_add(&bar[XB_XGEN(b.x)], 1u);
            asm volatile("s_waitcnt vmcnt(0)" ::: "memory");
        } else {
            XB_SPIN(xb_ld(&bar[XB_XGEN(b.x)]) == gen, bar);
            __builtin_amdgcn_fence(__ATOMIC_ACQUIRE, "agent");
            asm volatile("s_waitcnt vmcnt(0)" ::: "memory");
        }
    }
    __syncthreads();
}

struct Args { const void* in[17]; float* out; unsigned char* ws; int ph_lo, ph_hi, li, pad; };
enum { IN_X = 0, IN_POS, IN_GPRE, IN_WIN, IN_CW, IN_CB, IN_BI, IN_BF, IN_GMH, IN_GRH, IN_WOUT, IN_GPOST, IN_GFPRE, IN_WG, IN_WU, IN_WDN, IN_GFPOST };

DI void p0_transpose_item(const float* W, int K, int ldw, int src_col, bf16* WT, int dst_row, LAS float* scr, int kb, int lane) {
    const int k0 = 64 * kb;
#pragma unroll 8
    for (int i = 0; i < 32; ++i) { const int kk = 2 * i + (lane >> 5); scr[kk * 33 + (lane & 31)] = W[(size_t)(k0 + kk) * ldw + src_col + (lane & 31)]; }
    LDS_WAIT(); asm volatile("" ::: "memory");
    const int c = lane & 7;
#pragma unroll
    for (int j = 0; j < 4; ++j) { const int n = (lane >> 3) + 8 * j; const LAS float* s = scr + (8 * c) * 33 + n;
        u32x4 o; o.x = pk2(s[0 * 33], s[1 * 33]); o.y = pk2(s[2 * 33], s[3 * 33]); o.z = pk2(s[4 * 33], s[5 * 33]); o.w = pk2(s[6 * 33], s[7 * 33]);
        *(GAS u32x4*)(WT + (size_t)(dst_row + n) * K + k0 + 8 * c) = o; }
    LDS_WAIT(); asm volatile("" ::: "memory");
}
typedef float f32x4g __attribute__((ext_vector_type(4)));
DI void p0_gates(const Args& a, ldsp lds, int tid, int lane, int wave, int vcu, int G) {
    const float* x = (const float*)a.in[IN_X]; const float* gpre = (const float*)a.in[IN_GPRE]; const float* w_in = (const float*)a.in[IN_WIN]; float* PRE = (float*)(a.ws + WS_PRE);
    LAS float* Wl = (LAS float*)lds;
    LAS float* part = (LAS float*)(lds + MISC_OFF + 1024);
#pragma unroll 4
    for (int i = 0; i < 16; ++i) { const int idx = tid + NTHR * i, k = idx >> 2, c4 = idx & 3;
        f32x4 w = *(const GAS f32x4*)(w_in + (size_t)k * DPROJ + 4096 + 4 * c4); w = w * gpre[k];
        const int row = (k & ~15) + 4 * (k & 3) + ((k >> 2) & 3);
        *(LAS f32x4*)(Wl + row * 16 + 4 * c4) = w; }
    LDS_WAIT(); __syncthreads();
    for (int rb = vcu; rb < SEQ / 64; rb += G) {
        const int tile = wave & 3, kh = wave >> 2, row = lane & 15, q = lane >> 4, t0 = rb * 64 + tile * 16;
        const GAS f32x4* xr = (const GAS f32x4*)(x + (size_t)(t0 + row) * DM + kh * 1024 + 4 * q);
        const LAS float* wl = Wl + (kh * 1024 + q) * 16 + row;
        f32x4g acc = {0.f, 0.f, 0.f, 0.f}; float ss = 0.f;
        for (int sp = 0; sp < 64; sp += 4) { f32x4 xv[4];
#pragma unroll
            for (int j = 0; j < 4; ++j) xv[j] = xr[4 * (sp + j)];
#pragma unroll
            for (int j = 0; j < 4; ++j) { ss += (xv[j].x * xv[j].x + xv[j].y * xv[j].y) + (xv[j].z * xv[j].z + xv[j].w * xv[j].w);
                const LAS float* wp = wl + (sp + j) * 256;
                acc = __builtin_amdgcn_mfma_f32_16x16x4f32(xv[j].x, wp[0], acc, 0, 0, 0); acc = __builtin_amdgcn_mfma_f32_16x16x4f32(xv[j].y, wp[64], acc, 0, 0, 0);
                acc = __builtin_amdgcn_mfma_f32_16x16x4f32(xv[j].z, wp[128], acc, 0, 0, 0); acc = __builtin_amdgcn_mfma_f32_16x16x4f32(xv[j].w, wp[192], acc, 0, 0, 0); } }
        if (kh == 1) {
#pragma unroll
            for (int j = 0; j < 4; ++j) part[(tile * 4 + j) * 64 + lane] = acc[j];
            part[1024 + tile * 64 + lane] = ss; }
        LDS_WAIT(); __syncthreads();
        if (kh == 0) {
#pragma unroll
            for (int j = 0; j < 4; ++j) acc[j] += part[(tile * 4 + j) * 64 + lane];
            ss += part[1024 + tile * 64 + lane];
            ss += __shfl_xor(ss, 16); ss += __shfl_xor(ss, 32);
            const float rs = 1.0f / sqrtf(ss * (1.0f / DM) + NORM_EPS);
#pragma unroll
            for (int j = 0; j < 4; ++j) { const int ri = 4 * q + j; const float rsi = __shfl(rs, ri); PRE[(size_t)(t0 + ri) * 16 + row] = acc[j] * rsi; } }
        __syncthreads();
    }
}
DI void phase_p0(const Args& a, ldsp lds, int tid, int lane, int wave, int vcu, int G) {
    p0_gates(a, lds, tid, lane, wave, vcu, G);
    const int gw = vcu * NWAVES + wave, NGW = G * NWAVES;
    LAS float* scr = (LAS float*)(lds + wave * 16384);
    const float* w_in = (const float*)a.in[IN_WIN]; const float* w_out = (const float*)a.in[IN_WOUT];
    const float* w_g = (const float*)a.in[IN_WG]; const float* w_u = (const float*)a.in[IN_WU]; const float* w_d = (const float*)a.in[IN_WDN];
    bf16* WinT = (bf16*)(a.ws + WS_WIN); bf16* WoT = (bf16*)(a.ws + WS_WO); bf16* WguT = (bf16*)(a.ws + WS_WGU); bf16* WdT = (bf16*)(a.ws + WS_WD);
    constexpr int I_IN = 32 * 256, I_O = 32 * 64, I_G = 32 * 176, I_D = 88 * 64, NITEMS = I_IN + I_O + 2 * I_G + I_D;
    for (int it = gw; it < NITEMS; it += NGW) {
        int r = it;
        if (r < I_IN) { const int kb = r / 256, nb = r % 256; const int sc = nb < 128 ? 32 * nb : 4112 + 32 * (nb - 128);
            p0_transpose_item(w_in, DM, DPROJ, sc, WinT, 32 * nb, scr, kb, lane); continue; } r -= I_IN;
        if (r < I_O) { const int kb = r / 64, nb = r % 64; p0_transpose_item(w_out, DM, DM, 32 * nb, WoT, 32 * nb, scr, kb, lane); continue; } r -= I_O;
        if (r < I_G) { const int kb = r / 176, nb = r % 176; p0_transpose_item(w_g, DM, DFF, 32 * nb, WguT, 256 * (nb >> 2) + 32 * (nb & 3), scr, kb, lane); continue; } r -= I_G;
        if (r < I_G) { const int kb = r / 176, nb = r % 176; p0_transpose_item(w_u, DM, DFF, 32 * nb, WguT, 256 * (nb >> 2) + 128 + 32 * (nb & 3), scr, kb, lane); continue; } r -= I_G;
        { const int kb = r / 64, nb = r % 64; p0_transpose_item(w_d, DFF, DM, 32 * nb, WdT, 32 * nb, scr, kb, lane); }
    }
    const float* x = (const float*)a.in[IN_X]; const float* gpre = (const float*)a.in[IN_GPRE];
    bf16* hb = (bf16*)(a.ws + WS_A);
    {
        const GAS f32x4* gr = (const GAS f32x4*)gpre + lane;
#define P0_LOAD(buf, mm) do { const GAS f32x4* xr_ = (const GAS f32x4*)(x + (size_t)(mm) * DM) + lane; _Pragma("unroll") for (int j = 0; j < 8; ++j) buf[j] = xr_[64 * j]; } while (0)
#define P0_ROW(buf, mm) do { float s_ = 0.f; _Pragma("unroll") for (int j = 0; j < 8; ++j) s_ += (buf[j].x * buf[j].x + buf[j].y * buf[j].y) + (buf[j].z * buf[j].z + buf[j].w * buf[j].w); \
            const float r_ = 1.0f / sqrtf(wave_sum(s_) * (1.0f / DM) + NORM_EPS); GAS u32x2* o_ = (GAS u32x2*)(hb + (size_t)(mm) * DM) + lane; \
            _Pragma("unroll") for (int j = 0; j < 8; ++j) { const f32x4 gg = gr[64 * j]; u32x2 w; w.x = pk2(buf[j].x * r_ * gg.x, buf[j].y * r_ * gg.y); w.y = pk2(buf[j].z * r_ * gg.z, buf[j].w * r_ * gg.w); o_[64 * j] = w; } } while (0)
        f32x4 va[8], vb[8];
        int m = gw; if (m < SEQ) P0_LOAD(va, m);
        for (; m < SEQ; m += 2 * NGW) {
            if (m + NGW < SEQ) P0_LOAD(vb, m + NGW);
            P0_ROW(va, m);
            if (m + 2 * NGW < SEQ) P0_LOAD(va, m + 2 * NGW);
            if (m + NGW < SEQ) P0_ROW(vb, m + NGW);
        }
#undef P0_LOAD
#undef P0_ROW
    }
    { float* GH = (float*)(a.ws + WS_GHEAD); const float* gmh = (const float*)a.in[IN_GMH]; const float* grh = (const float*)a.in[IN_GRH];
      for (int i = vcu * NTHR + tid; i < 1024; i += G * NTHR) GH[i] = gmh[i];
      for (int i = vcu * NTHR + tid; i < 1024; i += G * NTHR) GH[1024 + i] = grh[i]; }
    const int* pos = (const int*)a.in[IN_POS]; float* COS = (float*)(a.ws + WS_COS); float* SIN = (float*)(a.ws + WS_SIN);
    for (int i = vcu * NTHR + tid; i < SEQ * 64; i += G * NTHR) { const int t = i >> 6, j = i & 63;
        const float inv = (float)pow(10000.0, -(double)(2 * j) / 128.0); const float ang = (float)pos[t] * inv; float sn, cs; sincosf(ang, &sn, &cs); COS[i] = cs; SIN[i] = sn; }
}

typedef short bf16x8 __attribute__((ext_vector_type(8)));
typedef short s16x4 __attribute__((ext_vector_type(4)));
typedef float f32x16 __attribute__((ext_vector_type(16)));
#define MFMA32(a, b, c) __builtin_amdgcn_mfma_f32_32x32x16_bf16((a), (b), (c), 0, 0, 0)
DI int crow(int reg, int h) { return (reg & 3) + 8 * (reg >> 2) + 4 * h; }
DI bf16x8 bf_ones() { return (bf16x8){16256, 16256, 16256, 16256, 16256, 16256, 16256, 16256}; }
DI int offb(int row, int ch) { return 256 * row + 16 * (ch ^ (((row & 3) << 2) | ((row >> 2) & 3))); }
DI int rowbase(int row, int h) { return offb(row, h); }
DI bf16x8 rowfrag(ldsp tile, int rb, int ks) { return *(const LAS bf16x8*)(tile + (rb ^ (ks << 5))); }
DI s16x4 tr_rd(ldsp p) { return __builtin_bit_cast(s16x4, __builtin_amdgcn_ds_read_tr16_b64_v4i16((LAS s16x4*)p)); }
struct TrB { int b0, b1; };
DI TrB trbase(int c, int lane) {
    const int h = lane >> 5, blk = (lane >> 4) & 1, q = (lane & 15) >> 2, p = lane & 3, ch = 4 * c + 2 * blk + (p >> 1);
    TrB b; b.b0 = offb(8 * h + q, ch) + 8 * (p & 1); b.b1 = offb(8 * h + 4 + q, ch) + 8 * (p & 1); return b;
}
DI bf16x8 trfrag(ldsp tile, const TrB b, int ks) {
    const s16x4 lo = tr_rd(tile + b.b0 + 4096 * ks), hi = tr_rd(tile + b.b1 + 4096 * ks);
    return __builtin_shufflevector(lo, hi, 0, 1, 2, 3, 4, 5, 6, 7);
}
DI void gload8(const bf16* p, float (&f)[8]) { unpack8(*(const GAS u32x4*)p, f); }

DI void mixer_setup(const Args& a, ldsp lds, int g, int grp, int tid, int lane, int wave) {
    if (g < NHG) {
        LAS float* rowv = (LAS float*)(lds + GATE_OFF + wave * 1536); LAS float* colv = rowv + 128; LAS float* alog = rowv + 256;
        const float* PRE = (const float*)(a.ws + WS_PRE); const float bi = ((const float*)a.in[IN_BI])[g], bfg = ((const float*)a.in[IN_BF])[g];
        const int t0 = (8 * grp + wave) * CH + 2 * lane;
        const float i0 = PRE[(size_t)t0 * 16 + g] + bi, i1 = PRE[(size_t)(t0 + 1) * 16 + g] + bi;
        const float f0 = PRE[(size_t)t0 * 16 + 8 + g] + bfg, f1 = PRE[(size_t)(t0 + 1) * 16 + 8 + g] + bfg;
        const float l0 = fminf(f0, 0.f) - log1pf(__expf(-fabsf(f0))), l1 = fminf(f1, 0.f) - log1pf(__expf(-fabsf(f1)));
        float p = l0 + l1;
#pragma unroll
        for (int o = 1; o < 64; o <<= 1) { const float y = __shfl_up(p, o); if (lane >= o) p += y; }
        const float b1 = p, b0 = p - l1;
        rowv[2 * lane] = b0; rowv[2 * lane + 1] = b1; alog[2 * lane] = b0; alog[2 * lane + 1] = b1; colv[2 * lane] = i0 - b0; colv[2 * lane + 1] = i1 - b1;
        if (tid < 128) { LAS float* cwl = (LAS float*)(lds + CONVW_OFF); const float* cw = (const float*)a.in[IN_CW]; const float* cb = (const float*)a.in[IN_CB];
#pragma unroll
            for (int j = 0; j < 4; ++j) { cwl[j * 128 + tid] = cw[j * 2048 + g * HD + tid]; cwl[640 + j * 128 + tid] = cw[j * 2048 + 1024 + g * HD + tid]; }
            cwl[512 + tid] = cb[g * HD + tid]; cwl[640 + 512 + tid] = cb[1024 + g * HD + tid]; }
    } else if (tid < 128) {
        LAS float* rowv = (LAS float*)(lds + GATE_OFF); LAS float* colv = rowv + 128; LAS float* alog = rowv + 256;
        const float lg = log1pf(-exp2f(-5.0f - (float)(g - NHG)));
        rowv[tid] = (float)tid * lg; colv[tid] = -(float)tid * lg; alog[tid] = (float)(tid + 1) * lg;
    }
    LDS_WAIT(); __syncthreads();
}
template <bool WITHQ> DI void mixer_tiles(const Args& a, ldsp lds, int g, int c, const LAS float* gt, int tid) {
    const bf16* proj = (const bf16*)(a.ws + WS_B);
    const LAS float* colv = gt + 128; const float rv127 = gt[127];
    ldsp Q = lds, K = lds + 32768, V = lds + 65536;
    const float kscale = 0.08838834764831845f;
    const int sq = tid >> 4, dg = tid & 15, tb = c * CH + 4 * sq;
    u32x4 vv[4];
    if (g < NHG) {
        const bf16* pk = proj + PC_MK + g * HD + 8 * dg; const bf16* pq = proj + PC_MQ + g * HD + 8 * dg; const bf16* pv = proj + PC_MV + g * HD + 8 * dg;
        u32x4 rk[7], rq[7];
#pragma unroll
        for (int j = 0; j < 7; ++j) { const int tt = tb - 3 + j, tc = tt < 0 ? 0 : tt; rk[j] = *(const GAS u32x4*)(pk + (size_t)tc * NPJ); if (WITHQ) rq[j] = *(const GAS u32x4*)(pq + (size_t)tc * NPJ);
            if (tt < 0) { rk[j] = (u32x4){0u, 0u, 0u, 0u}; if (WITHQ) rq[j] = (u32x4){0u, 0u, 0u, 0u}; } }
#pragma unroll
        for (int i = 0; i < 4; ++i) vv[i] = *(const GAS u32x4*)(pv + (size_t)(tb + i) * NPJ);
        const LAS float* cwl = (const LAS float*)(lds + CONVW_OFF);
#pragma unroll
        for (int qk = 0; qk < (WITHQ ? 2 : 1); ++qk) {
            const LAS float* wl = cwl + (qk == 0 ? 640 : 0) + 8 * dg;
            float w[5][8];
#pragma unroll
            for (int j = 0; j < 5; ++j) { const f32x4 w0 = *(const LAS f32x4*)(wl + j * 128), w1 = *(const LAS f32x4*)(wl + j * 128 + 4); w[j][0] = w0.x; w[j][1] = w0.y; w[j][2] = w0.z; w[j][3] = w0.w; w[j][4] = w1.x; w[j][5] = w1.y; w[j][6] = w1.z; w[j][7] = w1.w; }
#pragma unroll
            for (int i = 0; i < 4; ++i) { float acc[8];
#pragma unroll
                for (int e = 0; e < 8; ++e) acc[e] = w[4][e];
#pragma unroll
                for (int j = 0; j < 4; ++j) { float uu[8]; unpack8(qk == 0 ? rk[i + j] : rq[i + j], uu);
#pragma unroll
                    for (int e = 0; e < 8; ++e) acc[e] += w[j][e] * uu[e]; }
                const int srow = 4 * sq + i; const float sc = qk == 0 ? kscale * __expf(rv127 + colv[srow]) : 1.0f;
#pragma unroll
                for (int e = 0; e < 8; ++e) acc[e] = silu_f(acc[e]) * sc;
                *(LAS u32x4*)((qk == 0 ? K : Q) + offb(srow, dg)) = pack8(acc); }
        }
    } else {
        const int gr = g - NHG; const float* COS = (const float*)(a.ws + WS_COS); const float* SIN = (const float*)(a.ws + WS_SIN);
        const int s2 = tid >> 3, dgp = tid & 7;
        const bf16* pv = proj + PC_RV + gr * HD + 8 * dg;
        u32x4 klo[2], khi[2], qlo[2], qhi[2]; f32x4 cs[2][2], sn[2][2];
#pragma unroll
        for (int i = 0; i < 2; ++i) { const size_t t = (size_t)(c * CH + 2 * s2 + i); const bf16* pr = proj + t * NPJ + gr * HD + 8 * dgp;
            klo[i] = *(const GAS u32x4*)(pr + PC_RK); khi[i] = *(const GAS u32x4*)(pr + PC_RK + 64);
            if (WITHQ) { qlo[i] = *(const GAS u32x4*)(pr + PC_RQ); qhi[i] = *(const GAS u32x4*)(pr + PC_RQ + 64); }
            cs[i][0] = *(const GAS f32x4*)(COS + t * 64 + 8 * dgp); cs[i][1] = *(const GAS f32x4*)(COS + t * 64 + 8 * dgp + 4);
            sn[i][0] = *(const GAS f32x4*)(SIN + t * 64 + 8 * dgp); sn[i][1] = *(const GAS f32x4*)(SIN + t * 64 + 8 * dgp + 4); }
#pragma unroll
        for (int i = 0; i < 4; ++i) vv[i] = *(const GAS u32x4*)(pv + (size_t)(tb + i) * NPJ);
#pragma unroll
        for (int i = 0; i < 2; ++i) { const int srow = 2 * s2 + i;
            const float c8[8] = {cs[i][0].x, cs[i][0].y, cs[i][0].z, cs[i][0].w, cs[i][1].x, cs[i][1].y, cs[i][1].z, cs[i][1].w};
            const float s8[8] = {sn[i][0].x, sn[i][0].y, sn[i][0].z, sn[i][0].w, sn[i][1].x, sn[i][1].y, sn[i][1].z, sn[i][1].w};
            float lo[8], hi[8], olo[8], ohi[8]; unpack8(klo[i], lo); unpack8(khi[i], hi);
            const float sc = kscale * __expf(rv127 + colv[srow]);
#pragma unroll
            for (int e = 0; e < 8; ++e) { olo[e] = (lo[e] * c8[e] - hi[e] * s8[e]) * sc; ohi[e] = (hi[e] * c8[e] + lo[e] * s8[e]) * sc; }
            *(LAS u32x4*)(K + offb(srow, dgp)) = pack8(olo); *(LAS u32x4*)(K + offb(srow, 8 + dgp)) = pack8(ohi);
            if (WITHQ) { unpack8(qlo[i], lo); unpack8(qhi[i], hi);
#pragma unroll
                for (int e = 0; e < 8; ++e) { olo[e] = lo[e] * c8[e] - hi[e] * s8[e]; ohi[e] = hi[e] * c8[e] + lo[e] * s8[e]; }
                *(LAS u32x4*)(Q + offb(srow, dgp)) = pack8(olo); *(LAS u32x4*)(Q + offb(srow, 8 + dgp)) = pack8(ohi); }
        }
    }
#pragma unroll
    for (int i = 0; i < 4; ++i) *(LAS u32x4*)(V + offb(4 * sq + i, dg)) = vv[i];
    LDS_WAIT(); __syncthreads();
}

DI void phase_m1(const Args& a, ldsp lds, int tid_in, int wave, int vcu, int G) {
    float* UG = (float*)(a.ws + WS_A); float* NG = (float*)(a.ws + WS_NLOC); float* DG = (float*)(a.ws + WS_DEC);
    ldsp K = lds + 32768, V = lds + 65536; const int wi = wave >> 1, wj = wave & 1;
    for (int cg = vcu; cg < NHEADS * 16; cg += G) { const int g = cg >> 4, grp = cg & 15; const bool ml = g < NHG;
        { int tid_g = tid_in; asm volatile("" : "+v"(tid_g)); mixer_setup(a, lds, g, grp, tid_g, tid_g & 63, wave); }
        f32x16 accU[2], accN; float dsum = 0.f;
#pragma unroll
        for (int i = 0; i < 16; ++i) { accU[0][i] = 0.f; accU[1][i] = 0.f; accN[i] = 0.f; }
        for (int ci = 0; ci < 8; ++ci) { const int c = 8 * grp + ci;
            int tid_o = tid_in; asm volatile("" : "+v"(tid_o));
            const int tid = tid_o, lane = tid & 63;
            const LAS float* gt = (const LAS float*)(lds + GATE_OFF + (ml ? ci : 0) * 1536);
            mixer_tiles<false>(a, lds, g, c, gt, tid);
            const float la = gt[256 + 127], dec = __expf(la); dsum += la;
            accU[0] = accU[0] * dec; accU[1] = accU[1] * dec; accN = accN * dec;
            { const TrB tk = trbase(wi, lane), tv0 = trbase(2 * wj, lane), tv1 = trbase(2 * wj + 1, lane);
#pragma unroll
              for (int ks = 0; ks < 8; ++ks) {
                const bf16x8 af = trfrag(K, tk, ks), b0 = trfrag(V, tv0, ks), b1 = trfrag(V, tv1, ks);
                accU[0] = MFMA32(af, b0, accU[0]); accU[1] = MFMA32(af, b1, accU[1]);
                if (ml && wj == 0) accN = MFMA32(af, bf_ones(), accN);
              } }
            __syncthreads();
        }
        { int tid_o = tid_in; asm volatile("" : "+v"(tid_o)); const int lane = tid_o & 63, r = lane & 31, h = lane >> 5;
          float* o = UG + ((size_t)cg << 14) + wave * 2048 + lane;
#pragma unroll
          for (int n = 0; n < 2; ++n)
#pragma unroll
              for (int i = 0; i < 16; ++i) o[(n * 16 + i) * 64] = accU[n][i];
          if (ml && wj == 0 && r == 0) {
#pragma unroll
              for (int i = 0; i < 16; ++i) NG[(size_t)cg * HD + 32 * wi + crow(i, h)] = accN[i]; }
          if (tid_in == 0) DG[cg] = __expf(dsum); }
    }
}
DI void phase_m2(const Args& a, int tid, int vcu, int G) {
    const float* UG = (const float*)(a.ws + WS_A); float* G0 = (float*)(a.ws + WS_A + 16 * MiB); const float* DG = (const float*)(a.ws + WS_DEC);
    const float* NG = (const float*)(a.ws + WS_NLOC); float* N0G = (float*)(a.ws + WS_N0);
    const int gt = vcu * NTHR + tid, NT = G * NTHR;
    for (int p = gt; p < NHEADS * 8192; p += NT) { const int e0 = p * 2, g = e0 >> 14, r = e0 & 16383;
        f32x2 uu[16];
#pragma unroll
        for (int j = 0; j < 16; ++j) uu[j] = *(const GAS f32x2*)(UG + ((size_t)(g * 16 + j) << 14) + r);
        float c0 = 0.f, c1 = 0.f;
#pragma unroll
        for (int j = 0; j < 16; ++j) { *(GAS f32x2*)(G0 + ((size_t)(g * 16 + j) << 14) + r) = (f32x2){c0, c1}; const float d = DG[g * 16 + j]; c0 = d * c0 + uu[j].x; c1 = d * c1 + uu[j].y; }
    }
    for (int p = gt; p < NHG * HD; p += NT) { const int g = p >> 7, d = p & 127; float n = 0.f;
        for (int j = 0; j < 16; ++j) { N0G[(size_t)(g * 16 + j) * HD + d] = n; n = DG[g * 16 + j] * n + NG[(size_t)(g * 16 + j) * HD + d]; } }
}
DI void phase_m3(const Args& a, ldsp lds, int tid_in, int wave, int vcu, int G) {
    const bf16* proj = (const bf16*)(a.ws + WS_B); const float* G0 = (const float*)(a.ws + WS_A + 16 * MiB); const float* N0G = (const float*)(a.ws + WS_N0);
    bf16* mixb = (bf16*)a.out;
    LAS unsigned short* n0b = (LAS unsigned short*)(lds + N0B_OFF);
    ldsp Q = lds, K = lds + 32768, V = lds + 65536, C0 = lds + 98304, P = lds + 98304; LAS float* H = (LAS float*)lds;
    const int wi = wave >> 1, wj = wave & 1;
    for (int cg = vcu; cg < NHEADS * 16; cg += G) { const int g = cg >> 4, grp = cg & 15; const bool ml = g < NHG;
        { int tid_g = tid_in; asm volatile("" : "+v"(tid_g)); mixer_setup(a, lds, g, grp, tid_g, tid_g & 63, wave); }
        f32x16 accC[2], nst;
        { int tid_o = tid_in; asm volatile("" : "+v"(tid_o)); const int lane = tid_o & 63, h = lane >> 5; const float* gs = G0 + ((size_t)cg << 14) + wave * 2048 + lane;
#pragma unroll
          for (int i = 0; i < 16; ++i) { accC[0][i] = gs[i * 64]; accC[1][i] = gs[(16 + i) * 64]; nst[i] = ml ? N0G[(size_t)cg * HD + 32 * wi + crow(i, h)] : 0.f; } }
        for (int ci = 0; ci < 8; ++ci) { const int c = 8 * grp + ci;
            int tid_o = tid_in; asm volatile("" : "+v"(tid_o));
            const int tid = tid_o, lane = tid & 63, r = lane & 31, h = lane >> 5;
            const LAS float* gt = (const LAS float*)(lds + GATE_OFF + (ml ? ci : 0) * 1536);
#pragma unroll
            for (int n = 0; n < 2; ++n) { const int e = 64 * wj + 32 * n + r;
#pragma unroll
                for (int i = 0; i < 16; ++i) { const int d = 32 * wi + crow(i, h); *(LAS unsigned short*)(C0 + offb(d, e >> 3) + 2 * (e & 7)) = (unsigned short)pk2(accC[n][i], accC[n][i]); } }
            if (wj == 0 && r == 0) {
#pragma unroll
                for (int i = 0; i < 16; ++i) n0b[32 * wi + crow(i, h)] = (unsigned short)pk2(nst[i], nst[i]); }
            mixer_tiles<true>(a, lds, g, c, gt, tid);
            f32x16 accO[2], accS[2], accD;
#pragma unroll
            for (int i = 0; i < 16; ++i) { accO[0][i] = 0.f; accO[1][i] = 0.f; accS[0][i] = 0.f; accS[1][i] = 0.f; accD[i] = 0.f; }
            const TrB tk = trbase(wi, lane), tv0 = trbase(2 * wj, lane), tv1 = trbase(2 * wj + 1, lane);
            const int rbq = rowbase(32 * wi + r, h), rbk = rowbase(64 * wj + r, h);
#pragma unroll
            for (int ks = 0; ks < 8; ++ks) {
                const bf16x8 af = rowfrag(Q, rbq, ks), b0 = trfrag(C0, tv0, ks), b1 = trfrag(C0, tv1, ks);
                accO[0] = MFMA32(af, b0, accO[0]); accO[1] = MFMA32(af, b1, accO[1]);
                if (ml) { const bf16x8 bn = *(const LAS bf16x8*)(n0b + 16 * ks + 8 * h); accD = MFMA32(af, bn, accD); }
            }
#pragma unroll
            for (int i = 0; i < 16; ++i) { const int t = 32 * wi + crow(i, h); const float al = __expf(gt[256 + t]); accO[0][i] *= al; accO[1][i] *= al; accD[i] *= al; }
#pragma unroll
            for (int ks = 0; ks < 8; ++ks) {
                const bf16x8 af = rowfrag(Q, rbq, ks), b0 = rowfrag(K, rbk, ks), b1 = rowfrag(K + 8192, rbk, ks);
                accS[0] = MFMA32(af, b0, accS[0]); accS[1] = MFMA32(af, b1, accS[1]);
            }
            __syncthreads();
            float fac[16]; { const float rv127 = gt[127];
#pragma unroll
              for (int i = 0; i < 16; ++i) fac[i] = __expf(gt[32 * wi + crow(i, h)] - rv127); }
#pragma unroll
            for (int n = 0; n < 2; ++n) { const int sidx = 64 * wj + 32 * n + r;
#pragma unroll
                for (int i = 0; i < 16; ++i) { const int t = 32 * wi + crow(i, h); const float val = (sidx <= t) ? accS[n][i] * fac[i] : 0.f;
                    *(LAS unsigned short*)(P + offb(t, sidx >> 3) + 2 * (sidx & 7)) = (unsigned short)pk2(val, val); } }
            LDS_WAIT(); __syncthreads();
            u32x4 gpre[2][2];
            { const int tl = tid >> 3, eg = tid & 7; const int hc = ml ? g * HD + 16 * eg : (g - NHG) * HD + 16 * eg;
#pragma unroll
              for (int hh = 0; hh < 2; ++hh) { const bf16* gp = proj + (size_t)(c * CH + 64 * hh + tl) * NPJ + (ml ? PC_MO : PC_RG) + hc; gpre[hh][0] = *(const GAS u32x4*)gp; gpre[hh][1] = *(const GAS u32x4*)(gp + 8); } }
            { const float dec = __expf(gt[256 + 127]); accC[0] = accC[0] * dec; accC[1] = accC[1] * dec; nst = nst * dec; }
#pragma unroll
            for (int ks = 0; ks < 8; ++ks) {
                const bf16x8 af = rowfrag(P, rbq, ks), ak = trfrag(K, tk, ks), b0 = trfrag(V, tv0, ks), b1 = trfrag(V, tv1, ks);
                accO[0] = MFMA32(af, b0, accO[0]); accO[1] = MFMA32(af, b1, accO[1]);
                accC[0] = MFMA32(ak, b0, accC[0]); accC[1] = MFMA32(ak, b1, accC[1]);
                if (ml) { accD = MFMA32(af, bf_ones(), accD); nst = MFMA32(ak, bf_ones(), nst); }
            }
            __syncthreads();
#pragma unroll
            for (int i = 0; i < 16; ++i) { const int t = 32 * wi + crow(i, h); const float rden = ml ? 1.0f / fmaxf(fabsf(accD[i]), 1.0f) : 1.0f;
                H[t * HD + 64 * wj + r] = accO[0][i] * rden; H[t * HD + 64 * wj + 32 + r] = accO[1][i] * rden; }
            LDS_WAIT(); __syncthreads();
#pragma unroll
            for (int hh = 0; hh < 2; ++hh) {
                const int tl = tid >> 3, eg = tid & 7, t = 64 * hh + tl;
                float hv[16]; float ss = 0.f;
#pragma unroll
                for (int q = 0; q < 4; ++q) { const f32x4 x4 = *(const LAS f32x4*)(H + t * HD + 16 * eg + 4 * q); hv[4 * q] = x4.x; hv[4 * q + 1] = x4.y; hv[4 * q + 2] = x4.z; hv[4 * q + 3] = x4.w; }
#pragma unroll
                for (int i = 0; i < 16; ++i) ss += hv[i] * hv[i];
                ss += __shfl_xor(ss, 1); ss += __shfl_xor(ss, 2); ss += __shfl_xor(ss, 4);
                const float rn = 1.0f / sqrtf(ss * (1.0f / HD) + NORM_EPS);
                const int tg = c * CH + t; const int hc = ml ? g * HD + 16 * eg : (g - NHG) * HD + 16 * eg;
                const float* gh = (const float*)(a.ws + WS_GHEAD) + (ml ? 0 : 1024) + hc;
                float ga[16]; { float t8[8]; unpack8(gpre[hh][0], t8);
#pragma unroll
                    for (int j = 0; j < 8; ++j) ga[j] = t8[j]; unpack8(gpre[hh][1], t8);
#pragma unroll
                    for (int j = 0; j < 8; ++j) ga[8 + j] = t8[j]; }
                float o[16];
#pragma unroll
                for (int i = 0; i < 16; ++i) o[i] = hv[i] * rn * gh[i] * (ml ? sigmoid_f(ga[i]) : silu_f(ga[i]));
                bf16* op = mixb + (size_t)tg * DM + (ml ? 0 : 1024) + hc;
                u32x4 w0, w1; w0.x = pk2(o[0], o[1]); w0.y = pk2(o[2], o[3]); w0.z = pk2(o[4], o[5]); w0.w = pk2(o[6], o[7]); w1.x = pk2(o[8], o[9]); w1.y = pk2(o[10], o[11]); w1.z = pk2(o[12], o[13]); w1.w = pk2(o[14], o[15]);
                *(GAS u32x4*)op = w0; *(GAS u32x4*)(op + 8) = w1;
            }
            __syncthreads();
        }
    }
}
DI void phase_r1(const Args& a, int lane, int wave, int vcu, int G) {
    const int gw = vcu * NWAVES + wave, NGW = G * NWAVES;
    const float* x = (const float*)a.in[IN_X]; const bf16* mix = (const bf16*)(a.ws + WS_B); float* x1 = a.out; bf16* h2 = (bf16*)(a.ws + WS_A);
    const GAS f32x4* gp = (const GAS f32x4*)a.in[IN_GPOST] + lane; const GAS f32x4* gf = (const GAS f32x4*)a.in[IN_GFPRE] + lane;
#define R1_LOAD(bm, bx, mm) do { const GAS u32x2* mr_ = (const GAS u32x2*)(mix + (size_t)(mm) * DM) + lane; const GAS f32x4* xr_ = (const GAS f32x4*)(x + (size_t)(mm) * DM) + lane; \
        _Pragma("unroll") for (int j = 0; j < 8; ++j) { bm[j] = mr_[64 * j]; bx[j] = xr_[64 * j]; } } while (0)
#define R1_ROW(bm, bx, mm) do { f32x4 v[8]; float s_ = 0.f; \
        _Pragma("unroll") for (int j = 0; j < 8; ++j) { v[j] = (f32x4){bflo(bm[j].x), bfhi(bm[j].x), bflo(bm[j].y), bfhi(bm[j].y)}; s_ += (v[j].x * v[j].x + v[j].y * v[j].y) + (v[j].z * v[j].z + v[j].w * v[j].w); } \
        const float r_ = 1.0f / sqrtf(wave_sum(s_) * (1.0f / DM) + NORM_EPS); float s2_ = 0.f; GAS f32x4* xo_ = (GAS f32x4*)(x1 + (size_t)(mm) * DM) + lane; \
        _Pragma("unroll") for (int j = 0; j < 8; ++j) { const f32x4 gg = gp[64 * j]; v[j] = bx[j] + v[j] * r_ * gg; xo_[64 * j] = v[j]; s2_ += (v[j].x * v[j].x + v[j].y * v[j].y) + (v[j].z * v[j].z + v[j].w * v[j].w); } \
        const float r2_ = 1.0f / sqrtf(wave_sum(s2_) * (1.0f / DM) + NORM_EPS); GAS u32x2* o_ = (GAS u32x2*)(h2 + (size_t)(mm) * DM) + lane; \
        _Pragma("unroll") for (int j = 0; j < 8; ++j) { const f32x4 gg = gf[64 * j]; u32x2 w; w.x = pk2(v[j].x * r2_ * gg.x, v[j].y * r2_ * gg.y); w.y = pk2(v[j].z * r2_ * gg.z, v[j].w * r2_ * gg.w); o_[64 * j] = w; } } while (0)
    u32x2 ma[8], mb[8]; f32x4 xa[8], xb[8];
    int m = gw; if (m < SEQ) R1_LOAD(ma, xa, m);
    for (; m < SEQ; m += 2 * NGW) {
        if (m + NGW < SEQ) R1_LOAD(mb, xb, m + NGW);
        R1_ROW(ma, xa, m);
        if (m + 2 * NGW < SEQ) R1_LOAD(ma, xa, m + 2 * NGW);
        if (m + NGW < SEQ) R1_ROW(mb, xb, m + NGW);
    }
#undef R1_LOAD
#undef R1_ROW
}
DI void phase_r2(const Args& a, int lane, int wave, int vcu, int G, bool poison) {
    const int gw = vcu * NWAVES + wave, NGW = G * NWAVES;
    const bf16* ff = (const bf16*)(a.ws + WS_FF); float* out = a.out; const GAS f32x4* gp = (const GAS f32x4*)a.in[IN_GFPOST] + lane;
    const float qn = __builtin_nanf("");
#define R2_LOAD(bm, bx, mm) do { const GAS u32x2* fr_ = (const GAS u32x2*)(ff + (size_t)(mm) * DM) + lane; const GAS f32x4* xr_ = (const GAS f32x4*)(out + (size_t)(mm) * DM) + lane; \
        _Pragma("unroll") for (int j = 0; j < 8; ++j) { bm[j] = fr_[64 * j]; bx[j] = xr_[64 * j]; } } while (0)
#define R2_ROW(bm, bx, mm) do { f32x4 v[8]; float s_ = 0.f; \
        _Pragma("unroll") for (int j = 0; j < 8; ++j) { v[j] = (f32x4){bflo(bm[j].x), bfhi(bm[j].x), bflo(bm[j].y), bfhi(bm[j].y)}; s_ += (v[j].x * v[j].x + v[j].y * v[j].y) + (v[j].z * v[j].z + v[j].w * v[j].w); } \
        const float r_ = 1.0f / sqrtf(wave_sum(s_) * (1.0f / DM) + NORM_EPS); GAS f32x4* xo_ = (GAS f32x4*)(out + (size_t)(mm) * DM) + lane; \
        _Pragma("unroll") for (int j = 0; j < 8; ++j) { const f32x4 gg = gp[64 * j]; f32x4 o = bx[j] + v[j] * r_ * gg; if (poison) o = (f32x4){qn, qn, qn, qn}; xo_[64 * j] = o; } } while (0)
    u32x2 ma[8], mb[8]; f32x4 xa[8], xb[8];
    int m = gw; if (m < SEQ) R2_LOAD(ma, xa, m);
    for (; m < SEQ; m += 2 * NGW) {
        if (m + NGW < SEQ) R2_LOAD(mb, xb, m + NGW);
        R2_ROW(ma, xa, m);
        if (m + 2 * NGW < SEQ) R2_LOAD(ma, xa, m + 2 * NGW);
        if (m + NGW < SEQ) R2_ROW(mb, xb, m + NGW);
    }
#undef R2_LOAD
#undef R2_ROW
}

__global__ void __launch_bounds__(NTHR, 2) fwd(Args a) {
    extern __shared__ __attribute__((aligned(16))) unsigned char lds_raw[];
    ldsp lds = (ldsp)lds_raw;
    const int tid = threadIdx.x, lane = tid & 63, wave = __builtin_amdgcn_readfirstlane(tid >> 6);
    const int G = gridDim.x; const int bx = blockIdx.x; const int vcu = (G % 8 == 0) ? (bx % 8) * (G / 8) + bx / 8 : bx;
    volatile LAS unsigned* MISC = (volatile LAS unsigned*)(lds + MISC_OFF);
    if (tid < 32) MISC[tid] = 0u;
    __syncthreads();
    unsigned* ctl = (unsigned*)(a.ws + WS_CTL);
    XcdBarrier bar; bar.bar = ctl + CW_BAR; bar.x = 0; bar.st = nullptr;
    if (N_LAUNCHES == 1) bar = xcd_barrier_post(ctl + CW_BAR, MISC + 8);
    const int lo = a.ph_lo, hi = a.ph_hi;
#define IN(k) (lo <= (k) && (k) < hi)
#define SEAM(k) do { if (IN(k) && IN((k) + 1)) xcd_barrier(bar); } while (0)

#define PH1_BODY { pg8::Gemm g{(const bf16*)(a.ws + WS_A), (const bf16*)(a.ws + WS_WIN), SEQ, NPJ, DM}; pg8::StaticOrder S; S.init(SEQ, NPJ, G, bx); \
        pg8::EpiBf16 E{(bf16*)(a.ws + WS_B), NPJ}; pg8::gemm_phase<pg8::EpiBf16, pg8::StaticOrder, true, true>(lds, g, S, E); }
#define PH5_BODY { pg8::Gemm g{(const bf16*)a.out, (const bf16*)(a.ws + WS_WO), SEQ, DM, DM}; pg8::StaticOrder S; S.init(SEQ, DM, G, bx); \
        pg8::EpiBf16 E{(bf16*)(a.ws + WS_B), DM}; pg8::gemm_phase<pg8::EpiBf16, pg8::StaticOrder, true, true>(lds, g, S, E); }
#define PH7_BODY { pg8::Gemm g{(const bf16*)(a.ws + WS_A), (const bf16*)(a.ws + WS_WGU), SEQ, 2 * DFF, DM}; pg8::StaticOrder S; S.init(SEQ, 2 * DFF, G, bx); \
        pg8::EpiSwiGLU E{(bf16*)(a.ws + WS_B), DFF}; pg8::gemm_phase<pg8::EpiSwiGLU, pg8::StaticOrder, true, true>(lds, g, S, E); }
#define PH8_BODY { pg8::Gemm g{(const bf16*)(a.ws + WS_B), (const bf16*)(a.ws + WS_WD), SEQ, DM, DFF}; pg8::StaticOrder S; S.init(SEQ, DM, G, bx); \
        pg8::EpiBf16 E{(bf16*)(a.ws + WS_FF), DM}; pg8::gemm_phase<pg8::EpiBf16, pg8::StaticOrder, true, true>(lds, g, S, E); }
#define DUP(k) (((PROBE_DUP) >> (k)) & 1)
    if (IN(0)) { phase_p0(a, lds, tid, lane, wave, vcu, G); if (DUP(0)) { __syncthreads(); phase_p0(a, lds, tid, lane, wave, vcu, G); } SEAM(0); }
    if (IN(1)) { PH1_BODY if (DUP(1)) PH1_BODY SEAM(1); }
    if (IN(2)) { phase_m1(a, lds, tid, wave, vcu, G); if (DUP(2)) phase_m1(a, lds, tid, wave, vcu, G); SEAM(2); }
    if (IN(3)) { phase_m2(a, tid, vcu, G); if (DUP(3)) phase_m2(a, tid, vcu, G); SEAM(3); }
    if (IN(4)) { phase_m3(a, lds, tid, wave, vcu, G); if (DUP(4)) phase_m3(a, lds, tid, wave, vcu, G); SEAM(4); }
    if (IN(5)) { PH5_BODY if (DUP(5)) PH5_BODY SEAM(5); }
    if (IN(6)) { phase_r1(a, lane, wave, vcu, G); if (DUP(6)) phase_r1(a, lane, wave, vcu, G); SEAM(6); }
    if (IN(7)) { PH7_BODY if (DUP(7)) PH7_BODY SEAM(7); }
    if (IN(8)) { PH8_BODY if (DUP(8)) PH8_BODY SEAM(8); }
    if (IN(9)) {
        bool poison = false;
        if (N_LAUNCHES == 1) poison = __hip_atomic_load(ctl + CW_BAR + XB_TMO, __ATOMIC_RELAXED, __HIP_MEMORY_SCOPE_AGENT) != 0u;
        phase_r2(a, lane, wave, vcu, G, poison);
    }
#undef PH1_BODY
#undef PH5_BODY
#undef PH7_BODY
#undef PH8_BODY
#undef DUP
#undef IN
#undef SEAM
}

extern "C" void kernel_launch(void* const* d_in, const int* in_sizes, int n_in, void* d_out, int out_size, void* d_ws, size_t ws_size, hipStream_t stream) {
    static int grid = 0;
    if (grid == 0) {
        if (n_in != 17 || in_sizes[0] != SEQ * DM || out_size != SEQ * DM || ws_size < WS_END) {
            fprintf(stderr, "kernel_launch: unexpected shapes (n_in %d, in0 %d, out %d, ws %zu); nothing launched\n", n_in, n_in > 0 ? in_sizes[0] : -1, out_size, ws_size); grid = -1; return; }
        int dev = 0, cus = 0, per_cu = 0;
        if (hipGetDevice(&dev) != hipSuccess || hipDeviceGetAttribute(&cus, hipDeviceAttributeMultiprocessorCount, dev) != hipSuccess) { grid = -1; return; }
        if (hipFuncSetAttribute((const void*)fwd, hipFuncAttributeMaxDynamicSharedMemorySize, LDS_BYTES) != hipSuccess) { fprintf(stderr, "kernel_launch: hipFuncSetAttribute failed\n"); grid = -1; return; }
        if (hipOccupancyMaxActiveBlocksPerMultiprocessor(&per_cu, (const void*)fwd, NTHR, LDS_BYTES) != hipSuccess || per_cu < 1)
            fprintf(stderr, "kernel_launch: note: occupancy query reports %d workgroups per CU\n", per_cu);
        (void)hipGetLastError();
        grid = cus;
    }
    if (grid < 0) return;
    if (hipMemsetAsync((char*)d_ws + WS_CTL, 0, CTL_ZERO_BYTES, stream) != hipSuccess) return;
    Args a{};
    for (int i = 0; i < 17; ++i) a.in[i] = d_in[i];
    a.out = (float*)d_out; a.ws = (unsigned char*)d_ws;
    if (N_LAUNCHES == 1) { a.ph_lo = 0; a.ph_hi = NPHASES; a.li = 0; hipLaunchKernelGGL(fwd, dim3(grid), dim3(NTHR), LDS_BYTES, stream, a); }
    else for (int li = 0; li < NPHASES; ++li) { a.ph_lo = li; a.ph_hi = li + 1; a.li = li; hipLaunchKernelGGL(fwd, dim3(grid), dim3(NTHR), LDS_BYTES, stream, a); }
}
```

```cpp
#include <hip/hip_runtime.h>
#include <cstdio>
#include <cstdint>

#ifndef PROBE_DUP
#define PROBE_DUP 0
#endif
#ifndef MK_N_LAUNCHES
#define MK_N_LAUNCHES 1
#endif

namespace pg8 {
#define PG8_LAS __attribute__((address_space(3)))
typedef unsigned short bf16_t;
typedef short bf16x8 __attribute__((ext_vector_type(8)));
typedef float f32x4 __attribute__((ext_vector_type(4)));
typedef unsigned u32x4 __attribute__((ext_vector_type(4)));
constexpr int BM = 256, BK = 64, HALF = 128, HTB = HALF * BK * 2  , STAGE_BYTES = 8 * HTB, NXCD = 8, WGM = 8;

__host__ __device__ __forceinline__ int lds_byte(int r, int c) { const int st = (r >> 4) * 2 + (c >> 5), rr = r & 15, cc = c & 31, ob = rr * 64 + cc * 2; return st * 1024 + (ob ^ (((ob >> 9) & 1) << 5)); }
__host__ __device__ __forceinline__ void stage_rc(int b, int& R, int& C) { const int st = b / 1024, sb = b % 1024, swz = sb ^ (((sb >> 9) & 1) << 5); R = (st >> 1) * 16 + swz / 64; C = (st & 1) * 32 + (swz % 64) / 2; }
__host__ __device__ __forceinline__ int perm32(int rho) { const int n = rho >> 4, i = rho & 15; return 8 * (i >> 2) + 4 * n + (i & 3); }

struct Unit { int pm, pn; };
struct Gemm { const bf16_t* A; const bf16_t* Bt; int M, N, K; };

struct StaticOrder {
    int nM, nN, nwg, G, c;
    __host__ __device__ void init(int M, int N, int G_, int c_) { nM = M / BM; nN = N / BM; nwg = nM * nN; G = G_; c = c_; }
    __host__ __device__ bool next(int i, Unit& u) const {
        const long L = (long)i * G + c; if (L >= nwg) return false;
        int wgid = (int)L; { const int q = nwg / NXCD, r = nwg % NXCD, xcd = wgid % NXCD, off = wgid / NXCD; wgid = (xcd < r ? xcd * (q + 1) : r * (q + 1) + (xcd - r) * q) + off; }
        const int nig = WGM * nN, gid = wgid / nig, fm = gid * WGM, gsz = (nM - fm) < WGM ? (nM - fm) : WGM;
        u.pm = fm + ((wgid % nig) % gsz); u.pn = (wgid % nig) / gsz; return true;
    }
    __device__ __forceinline__ void a_ready(const Unit&) const {}
    __device__ __forceinline__ void done(const Unit&) const {}
};

__device__ __forceinline__ unsigned cvt_pk_bf16(float lo, float hi) { unsigned r; asm volatile("v_cvt_pk_bf16_f32 %0, %1, %2" : "=v"(r) : "v"(lo), "v"(hi)); return r; }

struct EpiF32 {
    static constexpr bool PERM = false, AFTER_DRAIN = false;
    float* C; int ldc;
    __device__ __forceinline__ void operator()(const f32x4 (&acc)[2][2][4][2], const Unit& u, int wr, int wc, int fr, int fq) const {
        const int row0 = u.pm * BM + wr * 64 + fr, col0 = u.pn * BM + wc * 32 + 4 * fq;
#pragma unroll
        for (int ai = 0; ai < 2; ++ai)
#pragma unroll
            for (int m = 0; m < 4; ++m) { float* rowp = C + (size_t)(row0 + ai * HALF + m * 16) * ldc + col0;
#pragma unroll
                for (int bj = 0; bj < 2; ++bj)
#pragma unroll
                    for (int n = 0; n < 2; ++n) *(f32x4*)(rowp + bj * HALF + n * 16) = acc[ai][bj][m][n]; }
    }
};
struct EpiBf16 {
    static constexpr bool PERM = true, AFTER_DRAIN = false;
    bf16_t* O; int ldc;
    __device__ __forceinline__ void operator()(const f32x4 (&acc)[2][2][4][2], const Unit& u, int wr, int wc, int fr, int fq) const {
        const int row0 = u.pm * BM + wr * 64 + fr, col0 = u.pn * BM + wc * 32 + 8 * fq;
#pragma unroll
        for (int ai = 0; ai < 2; ++ai)
#pragma unroll
            for (int m = 0; m < 4; ++m) { bf16_t* rowp = O + (size_t)(row0 + ai * HALF + m * 16) * ldc + col0;
#pragma unroll
                for (int bj = 0; bj < 2; ++bj) { const f32x4 v0 = acc[ai][bj][m][0], v1 = acc[ai][bj][m][1];
                    u32x4 w; w.x = cvt_pk_bf16(v0[0], v0[1]); w.y = cvt_pk_bf16(v0[2], v0[3]); w.z = cvt_pk_bf16(v1[0], v1[1]); w.w = cvt_pk_bf16(v1[2], v1[3]);
                    *(u32x4*)(rowp + bj * HALF) = w; } }
    }
};
__device__ __forceinline__ float silu_f(float x) { return x * __builtin_amdgcn_rcpf(1.0f + __expf(-x)); }
struct EpiSwiGLU {
    static constexpr bool PERM = true, AFTER_DRAIN = false;
    bf16_t* O; int ldc;
    __device__ __forceinline__ void operator()(const f32x4 (&acc)[2][2][4][2], const Unit& u, int wr, int wc, int fr, int fq) const {
        const int row0 = u.pm * BM + wr * 64 + fr, col0 = u.pn * HALF + wc * 32 + 8 * fq;
#pragma unroll
        for (int ai = 0; ai < 2; ++ai)
#pragma unroll
            for (int m = 0; m < 4; ++m) { bf16_t* rowp = O + (size_t)(row0 + ai * HALF + m * 16) * ldc + col0;
                const f32x4 g0 = acc[ai][0][m][0], g1 = acc[ai][0][m][1], u0 = acc[ai][1][m][0], u1 = acc[ai][1][m][1];
                u32x4 w; w.x = cvt_pk_bf16(silu_f(g0[0]) * u0[0], silu_f(g0[1]) * u0[1]); w.y = cvt_pk_bf16(silu_f(g0[2]) * u0[2], silu_f(g0[3]) * u0[3]);
                w.z = cvt_pk_bf16(silu_f(g1[0]) * u1[0], silu_f(g1[1]) * u1[1]); w.w = cvt_pk_bf16(silu_f(g1[2]) * u1[2], silu_f(g1[3]) * u1[3]);
                *(u32x4*)rowp = w; }
    }
};

template <class Epi, class Sched, bool ALIGN_EPI = false, bool SP2 = false>
__device__ __forceinline__ void gemm_phase(PG8_LAS unsigned char* lds, const Gemm g, const Sched& S, const Epi& E) {
    const int tid = threadIdx.x, wid = __builtin_amdgcn_readfirstlane(tid >> 6), lane = tid & 63, wr = wid >> 2, wc = wid & 3, fr = lane & 15, fq = lane >> 4;
    const int K = g.K, nt = K / BK;
    unsigned voffA[2], voffB[2];
#pragma unroll
    for (int i = 0; i < 2; ++i) { int R, C; stage_rc(tid * 16 + i * 8192, R, C); const int Rb = Epi::PERM ? ((R & ~31) + perm32(R & 31)) : R;
        voffA[i] = (unsigned)(R * K + C) * 2u; voffB[i] = (unsigned)(Rb * K + C) * 2u; }
    const size_t kstep = (size_t)(BK * 2);
    const size_t hstep = (size_t)HALF * K * 2;
    const size_t tstep = 2 * hstep;
    const unsigned ldsw = (unsigned)wid * 1024u;
    const int aoff = lds_byte(wr * 64 + fr, fq * 8), boff = lds_byte(wc * 32 + fr, fq * 8);
#define PG8_SA(b, h) (((b) * 2 + (h)) * HTB)
#define PG8_SB(b, h) ((4 + (b) * 2 + (h)) * HTB)
#define PG8_STAGE(bufoff, gbase, voff) do { _Pragma("unroll") for (int _i = 0; _i < 2; ++_i) \
        __builtin_amdgcn_global_load_lds((const unsigned*)((const char*)(gbase) + (voff)[_i]), (PG8_LAS unsigned*)(lds + (bufoff) + ldsw + _i * 8192), 16, 0, 0); } while (0)
#define PG8_LDA(dst, b, h) do { _Pragma("unroll") for (int m = 0; m < 4; ++m) _Pragma("unroll") for (int k = 0; k < 2; ++k) dst[m][k] = *(const PG8_LAS bf16x8*)(lds + PG8_SA(b, h) + aoff + m * 2048 + k * 1024); } while (0)
#define PG8_LDB(dst, b, h) do { _Pragma("unroll") for (int n = 0; n < 2; ++n) _Pragma("unroll") for (int k = 0; k < 2; ++k) dst[n][k] = *(const PG8_LAS bf16x8*)(lds + PG8_SB(b, h) + boff + n * 2048 + k * 1024); } while (0)
#define PG8_MMA(ai, bj, At, Bt) do { __builtin_amdgcn_s_setprio(1); _Pragma("unroll") for (int m = 0; m < 4; ++m) _Pragma("unroll") for (int n = 0; n < 2; ++n) _Pragma("unroll") for (int k = 0; k < 2; ++k) \
        acc[ai][bj][m][n] = __builtin_amdgcn_mfma_f32_16x16x32_bf16(Bt[n][k], At[m][k], acc[ai][bj][m][n], 0, 0, 0); __builtin_amdgcn_s_setprio(0); } while (0)
#define PG8_WAIT_V(n) asm volatile("s_waitcnt vmcnt(" #n ")" ::: "memory")
#define PG8_WAIT_L(n) asm volatile("s_waitcnt lgkmcnt(" #n ")" ::: "memory")
#define PG8_BAR __builtin_amdgcn_s_barrier()
#define PG8_SCHED __builtin_amdgcn_sched_barrier(0)
    Unit cur, nxt; int ui = 0;
    if (!S.next(0, cur)) return;
    f32x4 acc[2][2][4][2];
#pragma unroll
    for (int a = 0; a < 2; ++a)
#pragma unroll
        for (int b = 0; b < 2; ++b)
#pragma unroll
            for (int m = 0; m < 4; ++m)
#pragma unroll
                for (int n = 0; n < 2; ++n) acc[a][b][m][n] = (f32x4){0.f, 0.f, 0.f, 0.f};
    bf16x8 At[4][2], B0[2][2], B1[2][2];
    const char* cA = (const char*)g.A + (size_t)cur.pm * tstep; const char* cB = (const char*)g.Bt + (size_t)cur.pn * tstep;
    S.a_ready(cur);
    if constexpr (SP2) {
        PG8_STAGE(PG8_SB(0, 0), cB, voffB); PG8_STAGE(PG8_SB(0, 1), cB + hstep, voffB); PG8_STAGE(PG8_SA(0, 0), cA, voffA); PG8_STAGE(PG8_SA(0, 1), cA + hstep, voffA);
        if (wr == 1) PG8_BAR;
        PG8_WAIT_V(2); PG8_BAR;
        PG8_STAGE(PG8_SB(1, 0), cB + kstep, voffB); PG8_STAGE(PG8_SA(1, 0), cA + kstep, voffA); PG8_STAGE(PG8_SB(1, 1), cB + hstep + kstep, voffB);
        PG8_WAIT_V(6); PG8_BAR;
    } else {
        PG8_STAGE(PG8_SB(0, 0), cB, voffB); PG8_STAGE(PG8_SA(0, 0), cA, voffA); PG8_STAGE(PG8_SB(0, 1), cB + hstep, voffB); PG8_STAGE(PG8_SA(0, 1), cA + hstep, voffA);
        if (wr == 1) PG8_BAR;
        PG8_WAIT_V(4); PG8_BAR;
        PG8_STAGE(PG8_SB(1, 0), cB + kstep, voffB); PG8_STAGE(PG8_SA(1, 0), cA + kstep, voffA); PG8_STAGE(PG8_SB(1, 1), cB + hstep + kstep, voffB);
        PG8_WAIT_V(6); PG8_BAR;
    }
    for (;;) {
        const bool has_next = S.next(ui + 1, nxt);
        const char* nA = has_next ? (const char*)g.A + (size_t)nxt.pm * tstep : cA; const char* nB = has_next ? (const char*)g.Bt + (size_t)nxt.pn * tstep : cB;
        for (int t = 0; t < nt; t += 2) {
            const bool last = (t == nt - 2);
            const char* a1 = cA + (size_t)(t + 1) * kstep;
            const char* a2 = last ? nA : cA + (size_t)(t + 2) * kstep; const char* b2 = last ? nB : cB + (size_t)(t + 2) * kstep;
            const char* a3 = a2 + kstep; const char* b3 = b2 + kstep;
            if (last && has_next) S.a_ready(nxt);
            if constexpr (SP2) {
            PG8_LDB(B0, 0, 0); PG8_LDB(B1, 0, 1); PG8_SCHED; PG8_LDA(At, 0, 0); PG8_STAGE(PG8_SA(1, 1), a1 + hstep, voffA);
            PG8_WAIT_V(8); PG8_WAIT_L(0); PG8_BAR; PG8_MMA(0, 0, At, B0); PG8_MMA(0, 1, At, B1); PG8_BAR; PG8_SCHED;
            PG8_LDA(At, 0, 1); PG8_STAGE(PG8_SB(0, 0), b2, voffB); PG8_STAGE(PG8_SB(0, 1), b2 + hstep, voffB); PG8_STAGE(PG8_SA(0, 0), a2, voffA);
            PG8_WAIT_V(8); PG8_WAIT_L(0); PG8_BAR; PG8_MMA(1, 0, At, B0); PG8_MMA(1, 1, At, B1); PG8_BAR; PG8_SCHED;
            PG8_LDB(B0, 1, 0); PG8_LDB(B1, 1, 1); PG8_SCHED; PG8_LDA(At, 1, 0); PG8_STAGE(PG8_SA(0, 1), a2 + hstep, voffA);
            PG8_WAIT_V(8); PG8_WAIT_L(0); PG8_BAR; PG8_MMA(0, 0, At, B0); PG8_MMA(0, 1, At, B1); PG8_BAR; PG8_SCHED;
            PG8_LDA(At, 1, 1); PG8_STAGE(PG8_SB(1, 0), b3, voffB); PG8_STAGE(PG8_SB(1, 1), b3 + hstep, voffB); PG8_STAGE(PG8_SA(1, 0), a3, voffA);
            PG8_WAIT_V(8); PG8_WAIT_L(0); PG8_BAR; PG8_MMA(1, 0, At, B0); PG8_MMA(1, 1, At, B1); PG8_BAR; PG8_SCHED;
            } else {
            PG8_LDB(B0, 0, 0); PG8_SCHED; PG8_LDA(At, 0, 0); PG8_STAGE(PG8_SA(1, 1), a1 + hstep, voffA);
            PG8_WAIT_L(8); PG8_BAR; PG8_WAIT_L(0); PG8_MMA(0, 0, At, B0); PG8_BAR; PG8_SCHED;
            PG8_LDB(B1, 0, 1); PG8_STAGE(PG8_SB(0, 0), b2, voffB);
            PG8_BAR; PG8_WAIT_L(0); PG8_MMA(0, 1, At, B1); PG8_BAR;
            PG8_LDA(At, 0, 1); PG8_STAGE(PG8_SA(0, 0), a2, voffA);
            PG8_BAR; PG8_WAIT_L(0); PG8_MMA(1, 0, At, B0); PG8_BAR; PG8_SCHED;
            PG8_STAGE(PG8_SB(0, 1), b2 + hstep, voffB);
            PG8_WAIT_V(6); PG8_BAR; PG8_MMA(1, 1, At, B1); PG8_BAR;
            PG8_LDB(B0, 1, 0); PG8_SCHED; PG8_LDA(At, 1, 0); PG8_STAGE(PG8_SA(0, 1), a2 + hstep, voffA);
            PG8_WAIT_L(8); PG8_BAR; PG8_WAIT_L(0); PG8_MMA(0, 0, At, B0); PG8_BAR; PG8_SCHED;
            PG8_LDB(B1, 1, 1); PG8_STAGE(PG8_SB(1, 0), b3, voffB);
            PG8_BAR; PG8_WAIT_L(0); PG8_MMA(0, 1, At, B1); PG8_BAR;
            PG8_LDA(At, 1, 1); PG8_STAGE(PG8_SA(1, 0), a3, voffA);
            PG8_BAR; PG8_WAIT_L(0); PG8_MMA(1, 0, At, B0); PG8_BAR; PG8_SCHED;
            PG8_STAGE(PG8_SB(1, 1), b3 + hstep, voffB);
            PG8_WAIT_V(6); PG8_BAR; PG8_MMA(1, 1, At, B1); PG8_BAR;
            }
        }
        if constexpr (ALIGN_EPI) { if (wr == 0) PG8_BAR; }
        if constexpr (!Epi::AFTER_DRAIN) { E(acc, cur, wr, wc, fr, fq); S.done(cur); }
        if (!has_next) break;
#pragma unroll
        for (int a = 0; a < 2; ++a)
#pragma unroll
            for (int b = 0; b < 2; ++b)
#pragma unroll
                for (int m = 0; m < 4; ++m)
#pragma unroll
                    for (int n = 0; n < 2; ++n) acc[a][b][m][n] = (f32x4){0.f, 0.f, 0.f, 0.f};
        cur = nxt; cA = nA; cB = nB; ++ui;
        if constexpr (ALIGN_EPI) { if (wr == 1) PG8_BAR; }
    }
    PG8_WAIT_V(0);
    if constexpr (!ALIGN_EPI) { if (wr == 0) PG8_BAR; }
    PG8_BAR;
#undef PG8_SA
#undef PG8_SB
#undef PG8_STAGE
#undef PG8_LDA
#undef PG8_LDB
#undef PG8_MMA
#undef PG8_WAIT_V
#undef PG8_WAIT_L
#undef PG8_BAR
#undef PG8_SCHED
}
}

constexpr int NWAVES = 8, NTHR = 512;
constexpr int SEQ = 16384, DM = 2048, HD = 128, NHG = 8, DPROJ = 8208, NPJ = 8192, DFF = 5632, CH = 128, NCH = SEQ / CH, NHEADS = 16;
constexpr float NORM_EPS = 1e-6f;
constexpr int N_LAUNCHES = MK_N_LAUNCHES, NPHASES = 10;
constexpr int PC_MQ = 0, PC_MK = 1024, PC_MV = 2048, PC_MO = 3072, PC_RQ = 4096, PC_RK = 5120, PC_RV = 6144, PC_RG = 7168;

constexpr size_t MiB = 1u << 20;
constexpr size_t WS_CTL = 0, CTL_ZERO_BYTES = 64 * 1024;
constexpr size_t WS_WIN = 2 * MiB, WS_WO = 34 * MiB, WS_WGU = 42 * MiB, WS_WD = 86 * MiB;
constexpr size_t WS_PRE = 108 * MiB;
constexpr size_t WS_RS = 109 * MiB;
constexpr size_t WS_NLOC = 110 * MiB;
constexpr size_t WS_N0 = 110 * MiB + 512 * 1024;
constexpr size_t WS_DEC = 111 * MiB;
constexpr size_t WS_GHEAD = 111 * MiB + 65536;
constexpr size_t WS_COS = 112 * MiB, WS_SIN = 116 * MiB;
constexpr size_t WS_B = 128 * MiB;
constexpr size_t WS_A = 384 * MiB;
constexpr size_t WS_FF = WS_B + 176 * MiB;
constexpr size_t WS_END = 448 * MiB;
constexpr int CW_BAR = 1024;

constexpr int RING_BYTES = 131072;
constexpr int GATE_OFF = RING_BYTES;
constexpr int N0B_OFF = GATE_OFF + 8 * 1536;
constexpr int CONVW_OFF = N0B_OFF + 256;
constexpr int MISC_OFF = CONVW_OFF + 5120;
constexpr int LDS_BYTES = 163840;
static_assert(MISC_OFF + 1024 + 5120 <= LDS_BYTES, "LDS map");

#define GAS __attribute__((address_space(1)))
#define LAS __attribute__((address_space(3)))
#define DI __device__ __forceinline__
typedef unsigned short bf16;
typedef unsigned u32x4 __attribute__((ext_vector_type(4)));
typedef unsigned u32x2 __attribute__((ext_vector_type(2)));
typedef float f32x4 __attribute__((ext_vector_type(4)));
typedef float f32x2 __attribute__((ext_vector_type(2)));
typedef LAS unsigned char* ldsp;
#define LDS_WAIT() asm volatile("s_waitcnt lgkmcnt(0)" ::: "memory")

DI unsigned f2bf(float f) { unsigned u = __builtin_bit_cast(unsigned, f); return (u + 0x7fffu + ((u >> 16) & 1u)) >> 16; }
DI unsigned pk2(float lo, float hi) { unsigned r; asm volatile("v_cvt_pk_bf16_f32 %0, %1, %2" : "=v"(r) : "v"(lo), "v"(hi)); return r; }
DI float bflo(unsigned w) { return __builtin_bit_cast(float, w << 16); }
DI float bfhi(unsigned w) { return __builtin_bit_cast(float, w & 0xffff0000u); }
DI void unpack8(const u32x4 w, float (&f)[8]) { f[0] = bflo(w.x); f[1] = bfhi(w.x); f[2] = bflo(w.y); f[3] = bfhi(w.y); f[4] = bflo(w.z); f[5] = bfhi(w.z); f[6] = bflo(w.w); f[7] = bfhi(w.w); }
DI u32x4 pack8(const float (&f)[8]) { u32x4 w; w.x = pk2(f[0], f[1]); w.y = pk2(f[2], f[3]); w.z = pk2(f[4], f[5]); w.w = pk2(f[6], f[7]); return w; }
DI float sigmoid_f(float x) { return __builtin_amdgcn_rcpf(1.0f + __expf(-x)); }
DI float silu_f(float x) { return x * __builtin_amdgcn_rcpf(1.0f + __expf(-x)); }
DI float wave_sum(float v) {
#pragma unroll
    for (int o = 1; o < 64; o <<= 1) v += __shfl_xor(v, o);
    return v;
}

#define XB_TMO      128
#define XB_XCNT(j)  (256  + 64 * (j))
#define XB_XSUB(j)  (1280 + 64 * (j))
#define XB_XGEN(j)  (2304 + 64 * (j))
#define XB_TOP      3328
#define XB_TOPGEN   3392
#define XCD_BAR_WORDS 3456
#define XB_SPIN_CAP (1u << 18)
__device__ __forceinline__ unsigned xb_ld(unsigned* p)              { return __hip_atomic_load(p, __ATOMIC_RELAXED, __HIP_MEMORY_SCOPE_AGENT); }
__device__ __forceinline__ unsigned xb_add(unsigned* p, unsigned v) { return __hip_atomic_fetch_add(p, v, __ATOMIC_RELAXED, __HIP_MEMORY_SCOPE_AGENT); }
__device__ __forceinline__ unsigned xb_xcc_id() { return (unsigned)__builtin_amdgcn_s_getreg((3 << 11) | 20) & 0xFu; }
#define XB_SPIN(cond, bar) do { unsigned _sp = 0; while (cond) { __builtin_amdgcn_s_sleep(1); \
    if ((++_sp & 255u) == 0u) { if (xb_ld(&(bar)[XB_TMO])) break; if (_sp > XB_SPIN_CAP) { atomicAdd(&(bar)[XB_TMO], 1u); break; } } } } while (0)
struct XcdBarrier { unsigned* bar; unsigned x; volatile LAS unsigned* st; };
__device__ __forceinline__ XcdBarrier xcd_barrier_post(unsigned* bar, volatile LAS unsigned* st) {
    XcdBarrier b; b.bar = bar; b.x = xb_xcc_id(); b.st = st;
    if (threadIdx.x == 0) (void)xb_add(&bar[XB_XCNT(b.x)], 1u);
    return b;
}
__device__ __forceinline__ void xcd_barrier_complete(unsigned* bar, unsigned x, unsigned& nloc, unsigned& nx) {
    const unsigned G = gridDim.x * gridDim.y * gridDim.z;
    unsigned sum, cnt, mine, sp = 0u;
    for (;;) {
        sum = 0u; cnt = 0u; mine = 0u;
#pragma unroll
        for (unsigned j = 0; j < 16; ++j) { const unsigned c = xb_ld(&bar[XB_XCNT(j)]); sum += c; cnt += (c > 0u) ? 1u : 0u; mine = (j == x) ? c : mine; }
        if (sum == G) break;
        __builtin_amdgcn_s_sleep(1);
        if ((++sp & 255u) == 0u) { if (xb_ld(&bar[XB_TMO])) break; if (sp > XB_SPIN_CAP) { atomicAdd(&bar[XB_TMO], 1u); break; } }
    }
    nloc = mine > 0u ? mine : 1u; nx = cnt > 0u ? cnt : 1u;
}
__device__ __forceinline__ void xcd_barrier(const XcdBarrier& b) {
    asm volatile("s_waitcnt vmcnt(0)" ::: "memory");
    __syncthreads();
    if (threadIdx.x == 0) {
        unsigned* bar = b.bar;
        __builtin_amdgcn_s_waitcnt(0);
        unsigned nloc = b.st[0], nx = b.st[1];
        if (nloc == 0u) { xcd_barrier_complete(bar, b.x, nloc, nx); b.st[0] = nloc; b.st[1] = nx; }
        const unsigned old = xb_add(&bar[XB_XSUB(b.x)], 1u);
        const unsigned gen = old / nloc;
        if (old + 1u == (gen + 1u) * nloc) {
            __builtin_amdgcn_fence(__ATOMIC_RELEASE, "agent");
            asm volatile("s_waitcnt vmcnt(0)" ::: "memory");
            const unsigned og = xb_add(&bar[XB_TOP], 1u);
            const unsigned tg = og / nx;
            if (og + 1u == (tg + 1u) * nx) xb_add(&bar[XB_TOPGEN], 1u);
            else XB_SPIN(xb_ld(&bar[XB_TOPGEN]) == tg, bar);
            __builtin_amdgcn_fence(__ATOMIC_ACQUIRE, "agent");
            xb_add(&bar[XB_XGEN(b.x)], 1u);
            asm volatile("s_waitcnt vmcnt(0)" ::: "memory");
        } else {
            XB_SPIN(xb_ld(&bar[XB_XGEN(b.x)]) == gen, bar);
            __builtin_amdgcn_fence(__ATOMIC_ACQUIRE, "agent");
            asm volatile("s_waitcnt vmcnt(0)" ::: "memory");
        }
    }
    __syncthreads();
}

struct Args { const void* in[17]; float* out; unsigned char* ws; int ph_lo, ph_hi, li, pad; };
enum { IN_X = 0, IN_POS, IN_GPRE, IN_WIN, IN_CW, IN_CB, IN_BI, IN_BF, IN_GMH, IN_GRH, IN_WOUT, IN_GPOST, IN_GFPRE, IN_WG, IN_WU, IN_WDN, IN_GFPOST };

struct TrItem { const float* W; bf16* WT; int K, ldw, src_col, dst_row, kb; };
DI void p0_tr_load(const TrItem& it, int lane, f32x4 (&v)[8]) {
    const float* src = it.W + (size_t)(64 * it.kb + (lane >> 3)) * it.ldw + it.src_col + 4 * (lane & 7);
#pragma unroll
    for (int i = 0; i < 8; ++i) v[i] = *(const GAS f32x4*)(src + (size_t)(8 * i) * it.ldw);
}
DI void p0_tr_store(const TrItem& it, int lane, const f32x4 (&v)[8], LAS float* scr) {
#pragma unroll
    for (int i = 0; i < 8; ++i) *(LAS f32x4*)(scr + (8 * i + (lane >> 3)) * 36 + 4 * (lane & 7)) = v[i];
    LDS_WAIT(); asm volatile("" ::: "memory");
    const int c = lane & 7;
#pragma unroll
    for (int j = 0; j < 4; ++j) { const int n = (lane >> 3) + 8 * j; const LAS float* sp = scr + (8 * c) * 36 + n;
        u32x4 o; o.x = pk2(sp[0 * 36], sp[1 * 36]); o.y = pk2(sp[2 * 36], sp[3 * 36]); o.z = pk2(sp[4 * 36], sp[5 * 36]); o.w = pk2(sp[6 * 36], sp[7 * 36]);
        *(GAS u32x4*)(it.WT + (size_t)(it.dst_row + n) * it.K + 64 * it.kb + 8 * c) = o; }
    LDS_WAIT(); asm volatile("" ::: "memory");
}
constexpr int I_IN = 32 * 256, I_O = 32 * 64, I_G = 32 * 176, I_D = 88 * 64;
DI TrItem tr_item(const Args& a, int set, int r) {
    TrItem it;
    if (set == 0) { const int kb = r / 256, nb = r % 256; it.W = (const float*)a.in[IN_WIN]; it.WT = (bf16*)(a.ws + WS_WIN); it.K = DM; it.ldw = DPROJ; it.src_col = nb < 128 ? 32 * nb : 4112 + 32 * (nb - 128); it.dst_row = 32 * nb; it.kb = kb; return it; }
    if (r < I_O) { const int kb = r / 64, nb = r % 64; it.W = (const float*)a.in[IN_WOUT]; it.WT = (bf16*)(a.ws + WS_WO); it.K = DM; it.ldw = DM; it.src_col = 32 * nb; it.dst_row = 32 * nb; it.kb = kb; return it; } r -= I_O;
    if (r < I_G) { const int kb = r / 176, nb = r % 176; it.W = (const float*)a.in[IN_WG]; it.WT = (bf16*)(a.ws + WS_WGU); it.K = DM; it.ldw = DFF; it.src_col = 32 * nb; it.dst_row = 256 * (nb >> 2) + 32 * (nb & 3); it.kb = kb; return it; } r -= I_G;
    if (r < I_G) { const int kb = r / 176, nb = r % 176; it.W = (const float*)a.in[IN_WU]; it.WT = (bf16*)(a.ws + WS_WGU); it.K = DM; it.ldw = DFF; it.src_col = 32 * nb; it.dst_row = 256 * (nb >> 2) + 128 + 32 * (nb & 3); it.kb = kb; return it; } r -= I_G;
    { const int kb = r / 64, nb = r % 64; it.W = (const float*)a.in[IN_WDN]; it.WT = (bf16*)(a.ws + WS_WD); it.K = DFF; it.ldw = DM; it.src_col = 32 * nb; it.dst_row = 32 * nb; it.kb = kb; return it; }
}
DI void convert_weights(const Args& a, ldsp lds, int set, int lane, int wave, int vcu, int G) {
    const int gw = vcu * NWAVES + wave, NGW = G * NWAVES, nitems = set == 0 ? I_IN : I_O + 2 * I_G + I_D;
    LAS float* scr = (LAS float*)(lds + wave * 16384);
    f32x4 va[8], vb[8];
    int it = gw; if (it < nitems) p0_tr_load(tr_item(a, set, it), lane, va);
    for (; it < nitems; it += 2 * NGW) {
        if (it + NGW < nitems) p0_tr_load(tr_item(a, set, it + NGW), lane, vb);
        p0_tr_store(tr_item(a, set, it), lane, va, scr);
        if (it + 2 * NGW < nitems) p0_tr_load(tr_item(a, set, it + 2 * NGW), lane, va);
        if (it + NGW < nitems) p0_tr_store(tr_item(a, set, it + NGW), lane, vb, scr);
    }
}
typedef float f32x4g __attribute__((ext_vector_type(4)));
DI void p0_gates(const Args& a, ldsp lds, int tid, int lane, int wave, int vcu, int G) {
    const float* x = (const float*)a.in[IN_X]; const float* gpre = (const float*)a.in[IN_GPRE]; const float* w_in = (const float*)a.in[IN_WIN]; float* PRE = (float*)(a.ws + WS_PRE);
    LAS float* Wl = (LAS float*)lds;
    LAS float* part = (LAS float*)(lds + MISC_OFF + 1024);
#pragma unroll 4
    for (int i = 0; i < 16; ++i) { const int idx = tid + NTHR * i, k = idx >> 2, c4 = idx & 3;
        f32x4 w = *(const GAS f32x4*)(w_in + (size_t)k * DPROJ + 4096 + 4 * c4); w = w * gpre[k];
        const int row = (k & ~15) + 4 * (k & 3) + ((k >> 2) & 3);
        *(LAS f32x4*)(Wl + row * 16 + 4 * c4) = w; }
    LDS_WAIT(); __syncthreads();
    for (int rb = vcu; rb < SEQ / 64; rb += G) {
        const int tile = wave & 3, kh = wave >> 2, row = lane & 15, q = lane >> 4, t0 = rb * 64 + tile * 16;
        const GAS f32x4* xr = (const GAS f32x4*)(x + (size_t)(t0 + row) * DM + kh * 1024 + 4 * q);
        const LAS float* wl = Wl + (kh * 1024 + q) * 16 + row;
        f32x4g acc = {0.f, 0.f, 0.f, 0.f}; float ss = 0.f;
        for (int sp = 0; sp < 64; sp += 4) { f32x4 xv[4];
#pragma unroll
            for (int j = 0; j < 4; ++j) xv[j] = xr[4 * (sp + j)];
#pragma unroll
            for (int j = 0; j < 4; ++j) { ss += (xv[j].x * xv[j].x + xv[j].y * xv[j].y) + (xv[j].z * xv[j].z + xv[j].w * xv[j].w);
                const LAS float* wp = wl + (sp + j) * 256;
                acc = __builtin_amdgcn_mfma_f32_16x16x4f32(xv[j].x, wp[0], acc, 0, 0, 0); acc = __builtin_amdgcn_mfma_f32_16x16x4f32(xv[j].y, wp[64], acc, 0, 0, 0);
                acc = __builtin_amdgcn_mfma_f32_16x16x4f32(xv[j].z, wp[128], acc, 0, 0, 0); acc = __builtin_amdgcn_mfma_f32_16x16x4f32(xv[j].w, wp[192], acc, 0, 0, 0); } }
        if (kh == 1) {
#pragma unroll
            for (int j = 0; j < 4; ++j) part[(tile * 4 + j) * 64 + lane] = acc[j];
            part[1024 + tile * 64 + lane] = ss; }
        LDS_WAIT(); __syncthreads();
        if (kh == 0) {
#pragma unroll
            for (int j = 0; j < 4; ++j) acc[j] += part[(tile * 4 + j) * 64 + lane];
            ss += part[1024 + tile * 64 + lane];
            ss += __shfl_xor(ss, 16); ss += __shfl_xor(ss, 32);
            const float rs = 1.0f / sqrtf(ss * (1.0f / DM) + NORM_EPS);
#pragma unroll
            for (int j = 0; j < 4; ++j) { const int ri = 4 * q + j; const float rsi = __shfl(rs, ri); PRE[(size_t)(t0 + ri) * 16 + row] = acc[j] * rsi; } }
        __syncthreads();
    }
}
DI void phase_p0(const Args& a, ldsp lds, int tid, int lane, int wave, int vcu, int G) {
    p0_gates(a, lds, tid, lane, wave, vcu, G);
    const int gw = vcu * NWAVES + wave, NGW = G * NWAVES;
    convert_weights(a, lds, 0, lane, wave, vcu, G);
    convert_weights(a, lds, 1, lane, wave, vcu, G);
    const float* x = (const float*)a.in[IN_X]; const float* gpre = (const float*)a.in[IN_GPRE];
    bf16* hb = (bf16*)(a.ws + WS_A);
    {
        const GAS f32x4* gr = (const GAS f32x4*)gpre + lane;
#define P0_LOAD(buf, mm) do { const GAS f32x4* xr_ = (const GAS f32x4*)(x + (size_t)(mm) * DM) + lane; _Pragma("unroll") for (int j = 0; j < 8; ++j) buf[j] = xr_[64 * j]; } while (0)
#define P0_ROW(buf, mm) do { float s_ = 0.f; _Pragma("unroll") for (int j = 0; j < 8; ++j) s_ += (buf[j].x * buf[j].x + buf[j].y * buf[j].y) + (buf[j].z * buf[j].z + buf[j].w * buf[j].w); \
            const float r_ = 1.0f / sqrtf(wave_sum(s_) * (1.0f / DM) + NORM_EPS); GAS u32x2* o_ = (GAS u32x2*)(hb + (size_t)(mm) * DM) + lane; \
            _Pragma("unroll") for (int j = 0; j < 8; ++j) { const f32x4 gg = gr[64 * j]; u32x2 w; w.x = pk2(buf[j].x * r_ * gg.x, buf[j].y * r_ * gg.y); w.y = pk2(buf[j].z * r_ * gg.z, buf[j].w * r_ * gg.w); o_[64 * j] = w; } } while (0)
        f32x4 va[8], vb[8];
        int m = gw; if (m < SEQ) P0_LOAD(va, m);
        for (; m < SEQ; m += 2 * NGW) {
            if (m + NGW < SEQ) P0_LOAD(vb, m + NGW);
            P0_ROW(va, m);
            if (m + 2 * NGW < SEQ) P0_LOAD(va, m + 2 * NGW);
            if (m + NGW < SEQ) P0_ROW(vb, m + NGW);
        }
#undef P0_LOAD
#undef P0_ROW
    }
    { float* GH = (float*)(a.ws + WS_GHEAD); const float* gmh = (const float*)a.in[IN_GMH]; const float* grh = (const float*)a.in[IN_GRH];
      for (int i = vcu * NTHR + tid; i < 1024; i += G * NTHR) GH[i] = gmh[i];
      for (int i = vcu * NTHR + tid; i < 1024; i += G * NTHR) GH[1024 + i] = grh[i]; }
    const int* pos = (const int*)a.in[IN_POS]; float* COS = (float*)(a.ws + WS_COS); float* SIN = (float*)(a.ws + WS_SIN);
    { LAS float* invf = (LAS float*)(lds + GATE_OFF);
      if (tid < 64) invf[tid] = (float)pow(10000.0, -(double)(2 * tid) / 128.0);
      LDS_WAIT(); __syncthreads();
      for (int i = vcu * NTHR + tid; i < SEQ * 64; i += G * NTHR) { const int t = i >> 6, j = i & 63;
          const float ang = (float)pos[t] * invf[j]; float sn, cs; sincosf(ang, &sn, &cs); COS[i] = cs; SIN[i] = sn; } }
}

typedef short bf16x8 __attribute__((ext_vector_type(8)));
typedef short s16x4 __attribute__((ext_vector_type(4)));
typedef float f32x16 __attribute__((ext_vector_type(16)));
#define MFMA32(a, b, c) __builtin_amdgcn_mfma_f32_32x32x16_bf16((a), (b), (c), 0, 0, 0)
DI int crow(int reg, int h) { return (reg & 3) + 8 * (reg >> 2) + 4 * h; }
DI bf16x8 bf_ones() { return (bf16x8){16256, 16256, 16256, 16256, 16256, 16256, 16256, 16256}; }
DI int offb(int row, int ch) { return 256 * row + 16 * (ch ^ (((row & 3) << 2) | ((row >> 2) & 3))); }
DI int rowbase(int row, int h) { return offb(row, h); }
DI bf16x8 rowfrag(ldsp tile, int rb, int ks) { return *(const LAS bf16x8*)(tile + (rb ^ (ks << 5))); }
DI s16x4 tr_rd(ldsp p) { return __builtin_bit_cast(s16x4, __builtin_amdgcn_ds_read_tr16_b64_v4i16((LAS s16x4*)p)); }
struct TrB { int b0, b1; };
DI TrB trbase(int c, int lane) {
    const int h = lane >> 5, blk = (lane >> 4) & 1, q = (lane & 15) >> 2, p = lane & 3, ch = 4 * c + 2 * blk + (p >> 1);
    TrB b; b.b0 = offb(8 * h + q, ch) + 8 * (p & 1); b.b1 = offb(8 * h + 4 + q, ch) + 8 * (p & 1); return b;
}
DI bf16x8 trfrag(ldsp tile, const TrB b, int ks) {
    const s16x4 lo = tr_rd(tile + b.b0 + 4096 * ks), hi = tr_rd(tile + b.b1 + 4096 * ks);
    return __builtin_shufflevector(lo, hi, 0, 1, 2, 3, 4, 5, 6, 7);
}
DI void gload8(const bf16* p, float (&f)[8]) { unpack8(*(const GAS u32x4*)p, f); }

DI void mixer_setup(const Args& a, ldsp lds, int g, int grp, int tid, int lane, int wave) {
    if (g < NHG) {
        LAS float* rowv = (LAS float*)(lds + GATE_OFF + wave * 1536); LAS float* colv = rowv + 128; LAS float* alog = rowv + 256;
        const float* PRE = (const float*)(a.ws + WS_PRE); const float bi = ((const float*)a.in[IN_BI])[g], bfg = ((const float*)a.in[IN_BF])[g];
        const int t0 = (8 * grp + wave) * CH + 2 * lane;
        const float i0 = PRE[(size_t)t0 * 16 + g] + bi, i1 = PRE[(size_t)(t0 + 1) * 16 + g] + bi;
        const float f0 = PRE[(size_t)t0 * 16 + 8 + g] + bfg, f1 = PRE[(size_t)(t0 + 1) * 16 + 8 + g] + bfg;
        const float l0 = fminf(f0, 0.f) - log1pf(__expf(-fabsf(f0))), l1 = fminf(f1, 0.f) - log1pf(__expf(-fabsf(f1)));
        float p = l0 + l1;
#pragma unroll
        for (int o = 1; o < 64; o <<= 1) { const float y = __shfl_up(p, o); if (lane >= o) p += y; }
        const float b1 = p, b0 = p - l1;
        rowv[2 * lane] = b0; rowv[2 * lane + 1] = b1; alog[2 * lane] = b0; alog[2 * lane + 1] = b1; colv[2 * lane] = i0 - b0; colv[2 * lane + 1] = i1 - b1;
        if (tid < 128) { LAS float* cwl = (LAS float*)(lds + CONVW_OFF); const float* cw = (const float*)a.in[IN_CW]; const float* cb = (const float*)a.in[IN_CB];
#pragma unroll
            for (int j = 0; j < 4; ++j) { cwl[j * 128 + tid] = cw[j * 2048 + g * HD + tid]; cwl[640 + j * 128 + tid] = cw[j * 2048 + 1024 + g * HD + tid]; }
            cwl[512 + tid] = cb[g * HD + tid]; cwl[640 + 512 + tid] = cb[1024 + g * HD + tid]; }
    } else if (tid < 128) {
        LAS float* rowv = (LAS float*)(lds + GATE_OFF); LAS float* colv = rowv + 128; LAS float* alog = rowv + 256;
        const float lg = log1pf(-exp2f(-5.0f - (float)(g - NHG)));
        rowv[tid] = (float)tid * lg; colv[tid] = -(float)tid * lg; alog[tid] = (float)(tid + 1) * lg;
    }
    LDS_WAIT(); __syncthreads();
}
template <bool WITHQ> DI void mixer_tiles(const Args& a, ldsp lds, int g, int c, const LAS float* gt, int tid) {
    const bf16* proj = (const bf16*)(a.ws + WS_B);
    const LAS float* colv = gt + 128; const float rv127 = gt[127];
    ldsp Q = lds, K = lds + 32768, V = lds + 65536;
    const float kscale = 0.08838834764831845f;
    const int sq = tid >> 4, dg = tid & 15, tb = c * CH + 4 * sq;
    u32x4 vv[4];
    if (g < NHG) {
        const bf16* pk = proj + PC_MK + g * HD + 8 * dg; const bf16* pq = proj + PC_MQ + g * HD + 8 * dg; const bf16* pv = proj + PC_MV + g * HD + 8 * dg;
        u32x4 rk[7], rq[7];
#pragma unroll
        for (int j = 0; j < 7; ++j) { const int tt = tb - 3 + j, tc = tt < 0 ? 0 : tt; rk[j] = *(const GAS u32x4*)(pk + (size_t)tc * NPJ); if (WITHQ) rq[j] = *(const GAS u32x4*)(pq + (size_t)tc * NPJ);
            if (tt < 0) { rk[j] = (u32x4){0u, 0u, 0u, 0u}; if (WITHQ) rq[j] = (u32x4){0u, 0u, 0u, 0u}; } }
#pragma unroll
        for (int i = 0; i < 4; ++i) vv[i] = *(const GAS u32x4*)(pv + (size_t)(tb + i) * NPJ);
        const LAS float* cwl = (const LAS float*)(lds + CONVW_OFF);
#pragma unroll
        for (int qk = 0; qk < (WITHQ ? 2 : 1); ++qk) {
            const LAS float* wl = cwl + (qk == 0 ? 640 : 0) + 8 * dg;
            float w[5][8];
#pragma unroll
            for (int j = 0; j < 5; ++j) { const f32x4 w0 = *(const LAS f32x4*)(wl + j * 128), w1 = *(const LAS f32x4*)(wl + j * 128 + 4); w[j][0] = w0.x; w[j][1] = w0.y; w[j][2] = w0.z; w[j][3] = w0.w; w[j][4] = w1.x; w[j][5] = w1.y; w[j][6] = w1.z; w[j][7] = w1.w; }
#pragma unroll
            for (int i = 0; i < 4; ++i) { float acc[8];
#pragma unroll
                for (int e = 0; e < 8; ++e) acc[e] = w[4][e];
#pragma unroll
                for (int j = 0; j < 4; ++j) { float uu[8]; unpack8(qk == 0 ? rk[i + j] : rq[i + j], uu);
#pragma unroll
                    for (int e = 0; e < 8; ++e) acc[e] += w[j][e] * uu[e]; }
                const int srow = 4 * sq + i; const float sc = qk == 0 ? kscale * __expf(rv127 + colv[srow]) : 1.0f;
#pragma unroll
                for (int e = 0; e < 8; ++e) acc[e] = silu_f(acc[e]) * sc;
                *(LAS u32x4*)((qk == 0 ? K : Q) + offb(srow, dg)) = pack8(acc); }
        }
    } else {
        const int gr = g - NHG; const float* COS = (const float*)(a.ws + WS_COS); const float* SIN = (const float*)(a.ws + WS_SIN);
        const int s2 = tid >> 3, dgp = tid & 7;
        const bf16* pv = proj + PC_RV + gr * HD + 8 * dg;
        u32x4 klo[2], khi[2], qlo[2], qhi[2]; f32x4 cs[2][2], sn[2][2];
#pragma unroll
        for (int i = 0; i < 2; ++i) { const size_t t = (size_t)(c * CH + 2 * s2 + i); const bf16* pr = proj + t * NPJ + gr * HD + 8 * dgp;
            klo[i] = *(const GAS u32x4*)(pr + PC_RK); khi[i] = *(const GAS u32x4*)(pr + PC_RK + 64);
            if (WITHQ) { qlo[i] = *(const GAS u32x4*)(pr + PC_RQ); qhi[i] = *(const GAS u32x4*)(pr + PC_RQ + 64); }
            cs[i][0] = *(const GAS f32x4*)(COS + t * 64 + 8 * dgp); cs[i][1] = *(const GAS f32x4*)(COS + t * 64 + 8 * dgp + 4);
            sn[i][0] = *(const GAS f32x4*)(SIN + t * 64 + 8 * dgp); sn[i][1] = *(const GAS f32x4*)(SIN + t * 64 + 8 * dgp + 4); }
#pragma unroll
        for (int i = 0; i < 4; ++i) vv[i] = *(const GAS u32x4*)(pv + (size_t)(tb + i) * NPJ);
#pragma unroll
        for (int i = 0; i < 2; ++i) { const int srow = 2 * s2 + i;
            const float c8[8] = {cs[i][0].x, cs[i][0].y, cs[i][0].z, cs[i][0].w, cs[i][1].x, cs[i][1].y, cs[i][1].z, cs[i][1].w};
            const float s8[8] = {sn[i][0].x, sn[i][0].y, sn[i][0].z, sn[i][0].w, sn[i][1].x, sn[i][1].y, sn[i][1].z, sn[i][1].w};
            float lo[8], hi[8], olo[8], ohi[8]; unpack8(klo[i], lo); unpack8(khi[i], hi);
            const float sc = kscale * __expf(rv127 + colv[srow]);
#pragma unroll
            for (int e = 0; e < 8; ++e) { olo[e] = (lo[e] * c8[e] - hi[e] * s8[e]) * sc; ohi[e] = (hi[e] * c8[e] + lo[e] * s8[e]) * sc; }
            *(LAS u32x4*)(K + offb(srow, dgp)) = pack8(olo); *(LAS u32x4*)(K + offb(srow, 8 + dgp)) = pack8(ohi);
            if (WITHQ) { unpack8(qlo[i], lo); unpack8(qhi[i], hi);
#pragma unroll
                for (int e = 0; e < 8; ++e) { olo[e] = lo[e] * c8[e] - hi[e] * s8[e]; ohi[e] = hi[e] * c8[e] + lo[e] * s8[e]; }
                *(LAS u32x4*)(Q + offb(srow, dgp)) = pack8(olo); *(LAS u32x4*)(Q + offb(srow, 8 + dgp)) = pack8(ohi); }
        }
    }
#pragma unroll
    for (int i = 0; i < 4; ++i) *(LAS u32x4*)(V + offb(4 * sq + i, dg)) = vv[i];
    LDS_WAIT(); __syncthreads();
}

DI void phase_m1(const Args& a, ldsp lds, int tid_in, int wave, int vcu, int G) {
    float* UG = (float*)(a.ws + WS_A); float* NG = (float*)(a.ws + WS_NLOC); float* DG = (float*)(a.ws + WS_DEC);
    ldsp K = lds + 32768, V = lds + 65536; const int wi = wave >> 1, wj = wave & 1;
    for (int cg = vcu; cg < NHEADS * 16; cg += G) { const int g = cg >> 4, grp = cg & 15; const bool ml = g < NHG;
        { int tid_g = tid_in; asm volatile("" : "+v"(tid_g)); mixer_setup(a, lds, g, grp, tid_g, tid_g & 63, wave); }
        f32x16 accU[2], accN; float dsum = 0.f;
#pragma unroll
        for (int i = 0; i < 16; ++i) { accU[0][i] = 0.f; accU[1][i] = 0.f; accN[i] = 0.f; }
        for (int ci = 0; ci < 8; ++ci) { const int c = 8 * grp + ci;
            int tid_o = tid_in; asm volatile("" : "+v"(tid_o));
            const int tid = tid_o, lane = tid & 63;
            const LAS float* gt = (const LAS float*)(lds + GATE_OFF + (ml ? ci : 0) * 1536);
            mixer_tiles<false>(a, lds, g, c, gt, tid);
            const float la = gt[256 + 127], dec = __expf(la); dsum += la;
            accU[0] = accU[0] * dec; accU[1] = accU[1] * dec; accN = accN * dec;
            { const TrB tk = trbase(wi, lane), tv0 = trbase(2 * wj, lane), tv1 = trbase(2 * wj + 1, lane);
#pragma unroll
              for (int ks = 0; ks < 8; ++ks) {
                const bf16x8 af = trfrag(K, tk, ks), b0 = trfrag(V, tv0, ks), b1 = trfrag(V, tv1, ks);
                accU[0] = MFMA32(af, b0, accU[0]); accU[1] = MFMA32(af, b1, accU[1]);
                if (ml && wj == 0) accN = MFMA32(af, bf_ones(), accN);
              } }
            __syncthreads();
        }
        { int tid_o = tid_in; asm volatile("" : "+v"(tid_o)); const int lane = tid_o & 63, r = lane & 31, h = lane >> 5;
          float* o = UG + ((size_t)cg << 14) + wave * 2048 + lane;
#pragma unroll
          for (int n = 0; n < 2; ++n)
#pragma unroll
              for (int i = 0; i < 16; ++i) o[(n * 16 + i) * 64] = accU[n][i];
          if (ml && wj == 0 && r == 0) {
#pragma unroll
              for (int i = 0; i < 16; ++i) NG[(size_t)cg * HD + 32 * wi + crow(i, h)] = accN[i]; }
          if (tid_in == 0) DG[cg] = __expf(dsum); }
    }
}
DI void phase_m2(const Args& a, int tid, int vcu, int G) {
    const float* UG = (const float*)(a.ws + WS_A); float* G0 = (float*)(a.ws + WS_A + 16 * MiB); const float* DG = (const float*)(a.ws + WS_DEC);
    const float* NG = (const float*)(a.ws + WS_NLOC); float* N0G = (float*)(a.ws + WS_N0);
    const int gt = vcu * NTHR + tid, NT = G * NTHR;
    for (int p = gt; p < NHEADS * 8192; p += NT) { const int e0 = p * 2, g = e0 >> 14, r = e0 & 16383;
        f32x2 uu[16];
#pragma unroll
        for (int j = 0; j < 16; ++j) uu[j] = *(const GAS f32x2*)(UG + ((size_t)(g * 16 + j) << 14) + r);
        float c0 = 0.f, c1 = 0.f;
#pragma unroll
        for (int j = 0; j < 16; ++j) { *(GAS f32x2*)(G0 + ((size_t)(g * 16 + j) << 14) + r) = (f32x2){c0, c1}; const float d = DG[g * 16 + j]; c0 = d * c0 + uu[j].x; c1 = d * c1 + uu[j].y; }
    }
    for (int p = gt; p < NHG * HD; p += NT) { const int g = p >> 7, d = p & 127; float n = 0.f;
        for (int j = 0; j < 16; ++j) { N0G[(size_t)(g * 16 + j) * HD + d] = n; n = DG[g * 16 + j] * n + NG[(size_t)(g * 16 + j) * HD + d]; } }
}
DI void phase_m3(const Args& a, ldsp lds, int tid_in, int wave, int vcu, int G) {
    const bf16* proj = (const bf16*)(a.ws + WS_B); const float* G0 = (const float*)(a.ws + WS_A + 16 * MiB); const float* N0G = (const float*)(a.ws + WS_N0);
    bf16* mixb = (bf16*)a.out;
    LAS unsigned short* n0b = (LAS unsigned short*)(lds + N0B_OFF);
    ldsp Q = lds, K = lds + 32768, V = lds + 65536, C0 = lds + 98304, P = lds + 98304; LAS float* H = (LAS float*)lds;
    const int wi = wave >> 1, wj = wave & 1;
    for (int cg = vcu; cg < NHEADS * 16; cg += G) { const int g = cg >> 4, grp = cg & 15; const bool ml = g < NHG;
        { int tid_g = tid_in; asm volatile("" : "+v"(tid_g)); mixer_setup(a, lds, g, grp, tid_g, tid_g & 63, wave); }
        f32x16 accC[2], nst;
        { int tid_o = tid_in; asm volatile("" : "+v"(tid_o)); const int lane = tid_o & 63, h = lane >> 5; const float* gs = G0 + ((size_t)cg << 14) + wave * 2048 + lane;
#pragma unroll
          for (int i = 0; i < 16; ++i) { accC[0][i] = gs[i * 64]; accC[1][i] = gs[(16 + i) * 64]; nst[i] = ml ? N0G[(size_t)cg * HD + 32 * wi + crow(i, h)] : 0.f; } }
        for (int ci = 0; ci < 8; ++ci) { const int c = 8 * grp + ci;
            int tid_o = tid_in; asm volatile("" : "+v"(tid_o));
            const int tid = tid_o, lane = tid & 63, r = lane & 31, h = lane >> 5;
            const LAS float* gt = (const LAS float*)(lds + GATE_OFF + (ml ? ci : 0) * 1536);
#pragma unroll
            for (int n = 0; n < 2; ++n) { const int e = 64 * wj + 32 * n + r;
#pragma unroll
                for (int i = 0; i < 16; ++i) { const int d = 32 * wi + crow(i, h); *(LAS unsigned short*)(C0 + offb(d, e >> 3) + 2 * (e & 7)) = (unsigned short)pk2(accC[n][i], accC[n][i]); } }
            if (wj == 0 && r == 0) {
#pragma unroll
                for (int i = 0; i < 16; ++i) n0b[32 * wi + crow(i, h)] = (unsigned short)pk2(nst[i], nst[i]); }
            mixer_tiles<true>(a, lds, g, c, gt, tid);
            f32x16 accO[2], accS[2], accD;
#pragma unroll
            for (int i = 0; i < 16; ++i) { accO[0][i] = 0.f; accO[1][i] = 0.f; accS[0][i] = 0.f; accS[1][i] = 0.f; accD[i] = 0.f; }
            const TrB tk = trbase(wi, lane), tv0 = trbase(2 * wj, lane), tv1 = trbase(2 * wj + 1, lane);
            const int rbq = rowbase(32 * wi + r, h), rbk = rowbase(64 * wj + r, h);
#pragma unroll
            for (int ks = 0; ks < 8; ++ks) {
                const bf16x8 af = rowfrag(Q, rbq, ks), b0 = trfrag(C0, tv0, ks), b1 = trfrag(C0, tv1, ks);
                accO[0] = MFMA32(af, b0, accO[0]); accO[1] = MFMA32(af, b1, accO[1]);
                if (ml) { const bf16x8 bn = *(const LAS bf16x8*)(n0b + 16 * ks + 8 * h); accD = MFMA32(af, bn, accD); }
            }
#pragma unroll
            for (int i = 0; i < 16; ++i) { const int t = 32 * wi + crow(i, h); const float al = __expf(gt[256 + t]); accO[0][i] *= al; accO[1][i] *= al; accD[i] *= al; }
#pragma unroll
            for (int ks = 0; ks < 8; ++ks) {
                const bf16x8 af = rowfrag(Q, rbq, ks), b0 = rowfrag(K, rbk, ks), b1 = rowfrag(K + 8192, rbk, ks);
                accS[0] = MFMA32(af, b0, accS[0]); accS[1] = MFMA32(af, b1, accS[1]);
            }
            __syncthreads();
            float fac[16]; { const float rv127 = gt[127];
#pragma unroll
              for (int i = 0; i < 16; ++i) fac[i] = __expf(gt[32 * wi + crow(i, h)] - rv127); }
#pragma unroll
            for (int n = 0; n < 2; ++n) { const int sidx = 64 * wj + 32 * n + r;
#pragma unroll
                for (int i = 0; i < 16; ++i) { const int t = 32 * wi + crow(i, h); const float val = (sidx <= t) ? accS[n][i] * fac[i] : 0.f;
                    *(LAS unsigned short*)(P + offb(t, sidx >> 3) + 2 * (sidx & 7)) = (unsigned short)pk2(val, val); } }
            LDS_WAIT(); __syncthreads();
            u32x4 gpre[2][2];
            { const int tl = tid >> 3, eg = tid & 7; const int hc = ml ? g * HD + 16 * eg : (g - NHG) * HD + 16 * eg;
#pragma unroll
              for (int hh = 0; hh < 2; ++hh) { const bf16* gp = proj + (size_t)(c * CH + 64 * hh + tl) * NPJ + (ml ? PC_MO : PC_RG) + hc; gpre[hh][0] = *(const GAS u32x4*)gp; gpre[hh][1] = *(const GAS u32x4*)(gp + 8); } }
            { const float dec = __expf(gt[256 + 127]); accC[0] = accC[0] * dec; accC[1] = accC[1] * dec; nst = nst * dec; }
#pragma unroll
            for (int ks = 0; ks < 8; ++ks) {
                const bf16x8 af = rowfrag(P, rbq, ks), ak = trfrag(K, tk, ks), b0 = trfrag(V, tv0, ks), b1 = trfrag(V, tv1, ks);
                accO[0] = MFMA32(af, b0, accO[0]); accO[1] = MFMA32(af, b1, accO[1]);
                accC[0] = MFMA32(ak, b0, accC[0]); accC[1] = MFMA32(ak, b1, accC[1]);
                if (ml) { accD = MFMA32(af, bf_ones(), accD); nst = MFMA32(ak, bf_ones(), nst); }
            }
            __syncthreads();
#pragma unroll
            for (int i = 0; i < 16; ++i) { const int t = 32 * wi + crow(i, h); const float rden = ml ? 1.0f / fmaxf(fabsf(accD[i]), 1.0f) : 1.0f;
                H[t * HD + 64 * wj + r] = accO[0][i] * rden; H[t * HD + 64 * wj + 32 + r] = accO[1][i] * rden; }
            LDS_WAIT(); __syncthreads();
#pragma unroll
            for (int hh = 0; hh < 2; ++hh) {
                const int tl = tid >> 3, eg = tid & 7, t = 64 * hh + tl;
                float hv[16]; float ss = 0.f;
#pragma unroll
                for (int q = 0; q < 4; ++q) { const f32x4 x4 = *(const LAS f32x4*)(H + t * HD + 16 * eg + 4 * q); hv[4 * q] = x4.x; hv[4 * q + 1] = x4.y; hv[4 * q + 2] = x4.z; hv[4 * q + 3] = x4.w; }
#pragma unroll
                for (int i = 0; i < 16; ++i) ss += hv[i] * hv[i];
                ss += __shfl_xor(ss, 1); ss += __shfl_xor(ss, 2); ss += __shfl_xor(ss, 4);
                const float rn = 1.0f / sqrtf(ss * (1.0f / HD) + NORM_EPS);
                const int tg = c * CH + t; const int hc = ml ? g * HD + 16 * eg : (g - NHG) * HD + 16 * eg;
                const float* gh = (const float*)(a.ws + WS_GHEAD) + (ml ? 0 : 1024) + hc;
                float ga[16]; { float t8[8]; unpack8(gpre[hh][0], t8);
#pragma unroll
                    for (int j = 0; j < 8; ++j) ga[j] = t8[j]; unpack8(gpre[hh][1], t8);
#pragma unroll
                    for (int j = 0; j < 8; ++j) ga[8 + j] = t8[j]; }
                float o[16];
#pragma unroll
                for (int i = 0; i < 16; ++i) o[i] = hv[i] * rn * gh[i] * (ml ? sigmoid_f(ga[i]) : silu_f(ga[i]));
                bf16* op = mixb + (size_t)tg * DM + (ml ? 0 : 1024) + hc;
                u32x4 w0, w1; w0.x = pk2(o[0], o[1]); w0.y = pk2(o[2], o[3]); w0.z = pk2(o[4], o[5]); w0.w = pk2(o[6], o[7]); w1.x = pk2(o[8], o[9]); w1.y = pk2(o[10], o[11]); w1.z = pk2(o[12], o[13]); w1.w = pk2(o[14], o[15]);
                *(GAS u32x4*)op = w0; *(GAS u32x4*)(op + 8) = w1;
            }
            __syncthreads();
        }
    }
}
DI void phase_r1(const Args& a, int lane, int wave, int vcu, int G) {
    const int gw = vcu * NWAVES + wave, NGW = G * NWAVES;
    const float* x = (const float*)a.in[IN_X]; const bf16* mix = (const bf16*)(a.ws + WS_B); float* x1 = a.out; bf16* h2 = (bf16*)(a.ws + WS_A);
    const GAS f32x4* gp = (const GAS f32x4*)a.in[IN_GPOST] + lane; const GAS f32x4* gf = (const GAS f32x4*)a.in[IN_GFPRE] + lane;
#define R1_LOAD(bm, bx, mm) do { const GAS u32x2* mr_ = (const GAS u32x2*)(mix + (size_t)(mm) * DM) + lane; const GAS f32x4* xr_ = (const GAS f32x4*)(x + (size_t)(mm) * DM) + lane; \
        _Pragma("unroll") for (int j = 0; j < 8; ++j) { bm[j] = mr_[64 * j]; bx[j] = xr_[64 * j]; } } while (0)
#define R1_ROW(bm, bx, mm) do { f32x4 v[8]; float s_ = 0.f; \
        _Pragma("unroll") for (int j = 0; j < 8; ++j) { v[j] = (f32x4){bflo(bm[j].x), bfhi(bm[j].x), bflo(bm[j].y), bfhi(bm[j].y)}; s_ += (v[j].x * v[j].x + v[j].y * v[j].y) + (v[j].z * v[j].z + v[j].w * v[j].w); } \
        const float r_ = 1.0f / sqrtf(wave_sum(s_) * (1.0f / DM) + NORM_EPS); float s2_ = 0.f; GAS f32x4* xo_ = (GAS f32x4*)(x1 + (size_t)(mm) * DM) + lane; \
        _Pragma("unroll") for (int j = 0; j < 8; ++j) { const f32x4 gg = gp[64 * j]; v[j] = bx[j] + v[j] * r_ * gg; xo_[64 * j] = v[j]; s2_ += (v[j].x * v[j].x + v[j].y * v[j].y) + (v[j].z * v[j].z + v[j].w * v[j].w); } \
        const float r2_ = 1.0f / sqrtf(wave_sum(s2_) * (1.0f / DM) + NORM_EPS); GAS u32x2* o_ = (GAS u32x2*)(h2 + (size_t)(mm) * DM) + lane; \
        _Pragma("unroll") for (int j = 0; j < 8; ++j) { const f32x4 gg = gf[64 * j]; u32x2 w; w.x = pk2(v[j].x * r2_ * gg.x, v[j].y * r2_ * gg.y); w.y = pk2(v[j].z * r2_ * gg.z, v[j].w * r2_ * gg.w); o_[64 * j] = w; } } while (0)
    u32x2 ma[8], mb[8]; f32x4 xa[8], xb[8];
    int m = gw; if (m < SEQ) R1_LOAD(ma, xa, m);
    for (; m < SEQ; m += 2 * NGW) {
        if (m + NGW < SEQ) R1_LOAD(mb, xb, m + NGW);
        R1_ROW(ma, xa, m);
        if (m + 2 * NGW < SEQ) R1_LOAD(ma, xa, m + 2 * NGW);
        if (m + NGW < SEQ) R1_ROW(mb, xb, m + NGW);
    }
#undef R1_LOAD
#undef R1_ROW
}
DI void phase_r2(const Args& a, int lane, int wave, int vcu, int G, bool poison) {
    const int gw = vcu * NWAVES + wave, NGW = G * NWAVES;
    const bf16* ff = (const bf16*)(a.ws + WS_FF); float* out = a.out; const GAS f32x4* gp = (const GAS f32x4*)a.in[IN_GFPOST] + lane;
    const float qn = __builtin_nanf("");
#define R2_LOAD(bm, bx, mm) do { const GAS u32x2* fr_ = (const GAS u32x2*)(ff + (size_t)(mm) * DM) + lane; const GAS f32x4* xr_ = (const GAS f32x4*)(out + (size_t)(mm) * DM) + lane; \
        _Pragma("unroll") for (int j = 0; j < 8; ++j) { bm[j] = fr_[64 * j]; bx[j] = xr_[64 * j]; } } while (0)
#define R2_ROW(bm, bx, mm) do { f32x4 v[8]; float s_ = 0.f; \
        _Pragma("unroll") for (int j = 0; j < 8; ++j) { v[j] = (f32x4){bflo(bm[j].x), bfhi(bm[j].x), bflo(bm[j].y), bfhi(bm[j].y)}; s_ += (v[j].x * v[j].x + v[j].y * v[j].y) + (v[j].z * v[j].z + v[j].w * v[j].w); } \
        const float r_ = 1.0f / sqrtf(wave_sum(s_) * (1.0f / DM) + NORM_EPS); GAS f32x4* xo_ = (GAS f32x4*)(out + (size_t)(mm) * DM) + lane; \
        _Pragma("unroll") for (int j = 0; j < 8; ++j) { const f32x4 gg = gp[64 * j]; f32x4 o = bx[j] + v[j] * r_ * gg; if (poison) o = (f32x4){qn, qn, qn, qn}; xo_[64 * j] = o; } } while (0)
    u32x2 ma[8], mb[8]; f32x4 xa[8], xb[8];
    int m = gw; if (m < SEQ) R2_LOAD(ma, xa, m);
    for (; m < SEQ; m += 2 * NGW) {
        if (m + NGW < SEQ) R2_LOAD(mb, xb, m + NGW);
        R2_ROW(ma, xa, m);
        if (m + 2 * NGW < SEQ) R2_LOAD(ma, xa, m + 2 * NGW);
        if (m + NGW < SEQ) R2_ROW(mb, xb, m + NGW);
    }
#undef R2_LOAD
#undef R2_ROW
}

__global__ void __launch_bounds__(NTHR, 2) fwd(Args a) {
    extern __shared__ __attribute__((aligned(16))) unsigned char lds_raw[];
    ldsp lds = (ldsp)lds_raw;
    const int tid = threadIdx.x, lane = tid & 63, wave = __builtin_amdgcn_readfirstlane(tid >> 6);
    const int G = gridDim.x; const int bx = blockIdx.x; const int vcu = (G % 8 == 0) ? (bx % 8) * (G / 8) + bx / 8 : bx;
    volatile LAS unsigned* MISC = (volatile LAS unsigned*)(lds + MISC_OFF);
    if (tid < 32) MISC[tid] = 0u;
    __syncthreads();
    unsigned* ctl = (unsigned*)(a.ws + WS_CTL);
    XcdBarrier bar; bar.bar = ctl + CW_BAR; bar.x = 0; bar.st = nullptr;
    if (N_LAUNCHES == 1) bar = xcd_barrier_post(ctl + CW_BAR, MISC + 8);
    const int lo = a.ph_lo, hi = a.ph_hi;
#define IN(k) (lo <= (k) && (k) < hi)
#define SEAM(k) do { if (IN(k) && IN((k) + 1)) xcd_barrier(bar); } while (0)

#define PH1_BODY { pg8::Gemm g{(const bf16*)(a.ws + WS_A), (const bf16*)(a.ws + WS_WIN), SEQ, NPJ, DM}; pg8::StaticOrder S; S.init(SEQ, NPJ, G, bx); \
        pg8::EpiBf16 E{(bf16*)(a.ws + WS_B), NPJ}; pg8::gemm_phase<pg8::EpiBf16, pg8::StaticOrder, true, true>(lds, g, S, E); }
#define PH5_BODY { pg8::Gemm g{(const bf16*)a.out, (const bf16*)(a.ws + WS_WO), SEQ, DM, DM}; pg8::StaticOrder S; S.init(SEQ, DM, G, bx); \
        pg8::EpiBf16 E{(bf16*)(a.ws + WS_B), DM}; pg8::gemm_phase<pg8::EpiBf16, pg8::StaticOrder, true, true>(lds, g, S, E); }
#define PH7_BODY { pg8::Gemm g{(const bf16*)(a.ws + WS_A), (const bf16*)(a.ws + WS_WGU), SEQ, 2 * DFF, DM}; pg8::StaticOrder S; S.init(SEQ, 2 * DFF, G, bx); \
        pg8::EpiSwiGLU E{(bf16*)(a.ws + WS_B), DFF}; pg8::gemm_phase<pg8::EpiSwiGLU, pg8::StaticOrder, true, true>(lds, g, S, E); }
#define PH8_BODY { pg8::Gemm g{(const bf16*)(a.ws + WS_B), (const bf16*)(a.ws + WS_WD), SEQ, DM, DFF}; pg8::StaticOrder S; S.init(SEQ, DM, G, bx); \
        pg8::EpiBf16 E{(bf16*)(a.ws + WS_FF), DM}; pg8::gemm_phase<pg8::EpiBf16, pg8::StaticOrder, true, true>(lds, g, S, E); }
#define DUP(k) (((PROBE_DUP) >> (k)) & 1)
    if (IN(0)) { phase_p0(a, lds, tid, lane, wave, vcu, G); if (DUP(0)) { __syncthreads(); phase_p0(a, lds, tid, lane, wave, vcu, G); } SEAM(0); }
    if (IN(1)) { PH1_BODY if (DUP(1)) PH1_BODY SEAM(1); }
    if (IN(2)) { phase_m1(a, lds, tid, wave, vcu, G); if (DUP(2)) phase_m1(a, lds, tid, wave, vcu, G); SEAM(2); }
    if (IN(3)) { phase_m2(a, tid, vcu, G); if (DUP(3)) phase_m2(a, tid, vcu, G); SEAM(3); }
    if (IN(4)) { phase_m3(a, lds, tid, wave, vcu, G); if (DUP(4)) phase_m3(a, lds, tid, wave, vcu, G); SEAM(4); }
    if (IN(5)) { PH5_BODY if (DUP(5)) PH5_BODY SEAM(5); }
    if (IN(6)) { phase_r1(a, lane, wave, vcu, G); if (DUP(6)) phase_r1(a, lane, wave, vcu, G); SEAM(6); }
    if (IN(7)) { PH7_BODY if (DUP(7)) PH7_BODY SEAM(7); }
    if (IN(8)) { PH8_BODY if (DUP(8)) PH8_BODY SEAM(8); }
    if (IN(9)) {
        bool poison = false;
        if (N_LAUNCHES == 1) poison = __hip_atomic_load(ctl + CW_BAR + XB_TMO, __ATOMIC_RELAXED, __HIP_MEMORY_SCOPE_AGENT) != 0u;
        phase_r2(a, lane, wave, vcu, G, poison);
    }
#undef PH1_BODY
#undef PH5_BODY
#undef PH7_BODY
#undef PH8_BODY
#undef DUP
#undef IN
#undef SEAM
}

extern "C" void kernel_launch(void* const* d_in, const int* in_sizes, int n_in, void* d_out, int out_size, void* d_ws, size_t ws_size, hipStream_t stream) {
    static int grid = 0;
    if (grid == 0) {
        if (n_in != 17 || in_sizes[0] != SEQ * DM || out_size != SEQ * DM || ws_size < WS_END) {
            fprintf(stderr, "kernel_launch: unexpected shapes (n_in %d, in0 %d, out %d, ws %zu); nothing launched\n", n_in, n_in > 0 ? in_sizes[0] : -1, out_size, ws_size); grid = -1; return; }
        int dev = 0, cus = 0, per_cu = 0;
        if (hipGetDevice(&dev) != hipSuccess || hipDeviceGetAttribute(&cus, hipDeviceAttributeMultiprocessorCount, dev) != hipSuccess) { grid = -1; return; }
        if (hipFuncSetAttribute((const void*)fwd, hipFuncAttributeMaxDynamicSharedMemorySize, LDS_BYTES) != hipSuccess) { fprintf(stderr, "kernel_launch: hipFuncSetAttribute failed\n"); grid = -1; return; }
        if (hipOccupancyMaxActiveBlocksPerMultiprocessor(&per_cu, (const void*)fwd, NTHR, LDS_BYTES) != hipSuccess || per_cu < 1)
            fprintf(stderr, "kernel_launch: note: occupancy query reports %d workgroups per CU\n", per_cu);
        (void)hipGetLastError();
        grid = cus;
    }
    if (grid < 0) return;
    if (hipMemsetAsync((char*)d_ws + WS_CTL, 0, CTL_ZERO_BYTES, stream) != hipSuccess) return;
    Args a{};
    for (int i = 0; i < 17; ++i) a.in[i] = d_in[i];
    a.out = (float*)d_out; a.ws = (unsigned char*)d_ws;
    if (N_LAUNCHES == 1) { a.ph_lo = 0; a.ph_hi = NPHASES; a.li = 0; hipLaunchKernelGGL(fwd, dim3(grid), dim3(NTHR), LDS_BYTES, stream, a); }
    else for (int li = 0; li < NPHASES; ++li) { a.ph_lo = li; a.ph_hi = li + 1; a.li = li; hipLaunchKernelGGL(fwd, dim3(grid), dim3(NTHR), LDS_BYTES, stream, a); }
}
```

```cpp
#include <hip/hip_runtime.h>
#include <cstdio>
#include <cstdint>

#ifndef PROBE_DUP
#define PROBE_DUP 0
#endif
#ifndef MK_N_LAUNCHES
#define MK_N_LAUNCHES 1
#endif

namespace pg8 {
#define PG8_LAS __attribute__((address_space(3)))
typedef unsigned short bf16_t;
typedef short bf16x8 __attribute__((ext_vector_type(8)));
typedef float f32x4 __attribute__((ext_vector_type(4)));
typedef unsigned u32x4 __attribute__((ext_vector_type(4)));
constexpr int BM = 256, BK = 64, HALF = 128, HTB = HALF * BK * 2  , STAGE_BYTES = 8 * HTB, NXCD = 8, WGM = 4;

__host__ __device__ __forceinline__ int lds_byte(int r, int c) { const int st = (r >> 4) * 2 + (c >> 5), rr = r & 15, cc = c & 31, ob = rr * 64 + cc * 2; return st * 1024 + (ob ^ (((ob >> 9) & 1) << 5)); }
__host__ __device__ __forceinline__ void stage_rc(int b, int& R, int& C) { const int st = b / 1024, sb = b % 1024, swz = sb ^ (((sb >> 9) & 1) << 5); R = (st >> 1) * 16 + swz / 64; C = (st & 1) * 32 + (swz % 64) / 2; }
__host__ __device__ __forceinline__ int perm32(int rho) { const int n = rho >> 4, i = rho & 15; return 8 * (i >> 2) + 4 * n + (i & 3); }

struct Unit { int pm, pn; };
struct Gemm { const bf16_t* A; const bf16_t* Bt; int M, N, K; };

struct StaticOrder {
    int nM, nN, nwg, G, c;
    __host__ __device__ void init(int M, int N, int G_, int c_) { nM = M / BM; nN = N / BM; nwg = nM * nN; G = G_; c = c_; }
    __host__ __device__ bool next(int i, Unit& u) const {
        const long L = (long)i * G + c; if (L >= nwg) return false;
        int wgid = (int)L; { const int q = nwg / NXCD, r = nwg % NXCD, xcd = wgid % NXCD, off = wgid / NXCD; wgid = (xcd < r ? xcd * (q + 1) : r * (q + 1) + (xcd - r) * q) + off; }
        const int nig = WGM * nN, gid = wgid / nig, fm = gid * WGM, gsz = (nM - fm) < WGM ? (nM - fm) : WGM;
        u.pm = fm + ((wgid % nig) % gsz); u.pn = (wgid % nig) / gsz; return true;
    }
    __device__ __forceinline__ void a_ready(const Unit&) const {}
    __device__ __forceinline__ void done(const Unit&) const {}
};

__device__ __forceinline__ unsigned cvt_pk_bf16(float lo, float hi) { unsigned r; asm volatile("v_cvt_pk_bf16_f32 %0, %1, %2" : "=v"(r) : "v"(lo), "v"(hi)); return r; }

struct EpiF32 {
    static constexpr bool PERM = false, AFTER_DRAIN = false;
    float* C; int ldc;
    __device__ __forceinline__ void operator()(const f32x4 (&acc)[2][2][4][2], const Unit& u, int wr, int wc, int fr, int fq) const {
        const int row0 = u.pm * BM + wr * 64 + fr, col0 = u.pn * BM + wc * 32 + 4 * fq;
#pragma unroll
        for (int ai = 0; ai < 2; ++ai)
#pragma unroll
            for (int m = 0; m < 4; ++m) { float* rowp = C + (size_t)(row0 + ai * HALF + m * 16) * ldc + col0;
#pragma unroll
                for (int bj = 0; bj < 2; ++bj)
#pragma unroll
                    for (int n = 0; n < 2; ++n) *(f32x4*)(rowp + bj * HALF + n * 16) = acc[ai][bj][m][n]; }
    }
};
struct EpiBf16 {
    static constexpr bool PERM = true, AFTER_DRAIN = false;
    bf16_t* O; int ldc;
    __device__ __forceinline__ void operator()(const f32x4 (&acc)[2][2][4][2], const Unit& u, int wr, int wc, int fr, int fq) const {
        const int row0 = u.pm * BM + wr * 64 + fr, col0 = u.pn * BM + wc * 32 + 8 * fq;
#pragma unroll
        for (int ai = 0; ai < 2; ++ai)
#pragma unroll
            for (int m = 0; m < 4; ++m) { bf16_t* rowp = O + (size_t)(row0 + ai * HALF + m * 16) * ldc + col0;
#pragma unroll
                for (int bj = 0; bj < 2; ++bj) { const f32x4 v0 = acc[ai][bj][m][0], v1 = acc[ai][bj][m][1];
                    u32x4 w; w.x = cvt_pk_bf16(v0[0], v0[1]); w.y = cvt_pk_bf16(v0[2], v0[3]); w.z = cvt_pk_bf16(v1[0], v1[1]); w.w = cvt_pk_bf16(v1[2], v1[3]);
                    *(u32x4*)(rowp + bj * HALF) = w; } }
    }
};
__device__ __forceinline__ float silu_f(float x) { return x * __builtin_amdgcn_rcpf(1.0f + __expf(-x)); }
struct EpiSwiGLU {
    static constexpr bool PERM = true, AFTER_DRAIN = false;
    bf16_t* O; int ldc;
    __device__ __forceinline__ void operator()(const f32x4 (&acc)[2][2][4][2], const Unit& u, int wr, int wc, int fr, int fq) const {
        const int row0 = u.pm * BM + wr * 64 + fr, col0 = u.pn * HALF + wc * 32 + 8 * fq;
#pragma unroll
        for (int ai = 0; ai < 2; ++ai)
#pragma unroll
            for (int m = 0; m < 4; ++m) { bf16_t* rowp = O + (size_t)(row0 + ai * HALF + m * 16) * ldc + col0;
                const f32x4 g0 = acc[ai][0][m][0], g1 = acc[ai][0][m][1], u0 = acc[ai][1][m][0], u1 = acc[ai][1][m][1];
                u32x4 w; w.x = cvt_pk_bf16(silu_f(g0[0]) * u0[0], silu_f(g0[1]) * u0[1]); w.y = cvt_pk_bf16(silu_f(g0[2]) * u0[2], silu_f(g0[3]) * u0[3]);
                w.z = cvt_pk_bf16(silu_f(g1[0]) * u1[0], silu_f(g1[1]) * u1[1]); w.w = cvt_pk_bf16(silu_f(g1[2]) * u1[2], silu_f(g1[3]) * u1[3]);
                *(u32x4*)rowp = w; }
    }
};

template <class Epi, class Sched, bool ALIGN_EPI = false, bool SP2 = false>
__device__ __forceinline__ void gemm_phase(PG8_LAS unsigned char* lds, const Gemm g, const Sched& S, const Epi& E) {
    const int tid = threadIdx.x, wid = __builtin_amdgcn_readfirstlane(tid >> 6), lane = tid & 63, wr = wid >> 2, wc = wid & 3, fr = lane & 15, fq = lane >> 4;
    const int K = g.K, nt = K / BK;
    unsigned voffA[2], voffB[2];
#pragma unroll
    for (int i = 0; i < 2; ++i) { int R, C; stage_rc(tid * 16 + i * 8192, R, C); const int Rb = Epi::PERM ? ((R & ~31) + perm32(R & 31)) : R;
        voffA[i] = (unsigned)(R * K + C) * 2u; voffB[i] = (unsigned)(Rb * K + C) * 2u; }
    const size_t kstep = (size_t)(BK * 2);
    const size_t hstep = (size_t)HALF * K * 2;
    const size_t tstep = 2 * hstep;
    const unsigned ldsw = (unsigned)wid * 1024u;
    const int aoff = lds_byte(wr * 64 + fr, fq * 8), boff = lds_byte(wc * 32 + fr, fq * 8);
#define PG8_SA(b, h) (((b) * 2 + (h)) * HTB)
#define PG8_SB(b, h) ((4 + (b) * 2 + (h)) * HTB)
#define PG8_STAGE(bufoff, gbase, voff) do { _Pragma("unroll") for (int _i = 0; _i < 2; ++_i) \
        __builtin_amdgcn_global_load_lds((const unsigned*)((const char*)(gbase) + (voff)[_i]), (PG8_LAS unsigned*)(lds + (bufoff) + ldsw + _i * 8192), 16, 0, 0); } while (0)
#define PG8_LDA(dst, b, h) do { _Pragma("unroll") for (int m = 0; m < 4; ++m) _Pragma("unroll") for (int k = 0; k < 2; ++k) dst[m][k] = *(const PG8_LAS bf16x8*)(lds + PG8_SA(b, h) + aoff + m * 2048 + k * 1024); } while (0)
#define PG8_LDB(dst, b, h) do { _Pragma("unroll") for (int n = 0; n < 2; ++n) _Pragma("unroll") for (int k = 0; k < 2; ++k) dst[n][k] = *(const PG8_LAS bf16x8*)(lds + PG8_SB(b, h) + boff + n * 2048 + k * 1024); } while (0)
#define PG8_MMA(ai, bj, At, Bt) do { __builtin_amdgcn_s_setprio(1); _Pragma("unroll") for (int m = 0; m < 4; ++m) _Pragma("unroll") for (int n = 0; n < 2; ++n) _Pragma("unroll") for (int k = 0; k < 2; ++k) \
        acc[ai][bj][m][n] = __builtin_amdgcn_mfma_f32_16x16x32_bf16(Bt[n][k], At[m][k], acc[ai][bj][m][n], 0, 0, 0); __builtin_amdgcn_s_setprio(0); } while (0)
#define PG8_WAIT_V(n) asm volatile("s_waitcnt vmcnt(" #n ")" ::: "memory")
#define PG8_WAIT_L(n) asm volatile("s_waitcnt lgkmcnt(" #n ")" ::: "memory")
#define PG8_BAR __builtin_amdgcn_s_barrier()
#define PG8_SCHED __builtin_amdgcn_sched_barrier(0)
    Unit cur, nxt; int ui = 0;
    if (!S.next(0, cur)) return;
    f32x4 acc[2][2][4][2];
#pragma unroll
    for (int a = 0; a < 2; ++a)
#pragma unroll
        for (int b = 0; b < 2; ++b)
#pragma unroll
            for (int m = 0; m < 4; ++m)
#pragma unroll
                for (int n = 0; n < 2; ++n) acc[a][b][m][n] = (f32x4){0.f, 0.f, 0.f, 0.f};
    bf16x8 At[4][2], B0[2][2], B1[2][2];
    const char* cA = (const char*)g.A + (size_t)cur.pm * tstep; const char* cB = (const char*)g.Bt + (size_t)cur.pn * tstep;
    S.a_ready(cur);
    if constexpr (SP2) {
        PG8_STAGE(PG8_SB(0, 0), cB, voffB); PG8_STAGE(PG8_SB(0, 1), cB + hstep, voffB); PG8_STAGE(PG8_SA(0, 0), cA, voffA); PG8_STAGE(PG8_SA(0, 1), cA + hstep, voffA);
        if (wr == 1) PG8_BAR;
        PG8_WAIT_V(2); PG8_BAR;
        PG8_STAGE(PG8_SB(1, 0), cB + kstep, voffB); PG8_STAGE(PG8_SA(1, 0), cA + kstep, voffA); PG8_STAGE(PG8_SB(1, 1), cB + hstep + kstep, voffB);
        PG8_WAIT_V(6); PG8_BAR;
    } else {
        PG8_STAGE(PG8_SB(0, 0), cB, voffB); PG8_STAGE(PG8_SA(0, 0), cA, voffA); PG8_STAGE(PG8_SB(0, 1), cB + hstep, voffB); PG8_STAGE(PG8_SA(0, 1), cA + hstep, voffA);
        if (wr == 1) PG8_BAR;
        PG8_WAIT_V(4); PG8_BAR;
        PG8_STAGE(PG8_SB(1, 0), cB + kstep, voffB); PG8_STAGE(PG8_SA(1, 0), cA + kstep, voffA); PG8_STAGE(PG8_SB(1, 1), cB + hstep + kstep, voffB);
        PG8_WAIT_V(6); PG8_BAR;
    }
    for (;;) {
        const bool has_next = S.next(ui + 1, nxt);
        const char* nA = has_next ? (const char*)g.A + (size_t)nxt.pm * tstep : cA; const char* nB = has_next ? (const char*)g.Bt + (size_t)nxt.pn * tstep : cB;
        for (int t = 0; t < nt; t += 2) {
            const bool last = (t == nt - 2);
            const char* a1 = cA + (size_t)(t + 1) * kstep;
            const char* a2 = last ? nA : cA + (size_t)(t + 2) * kstep; const char* b2 = last ? nB : cB + (size_t)(t + 2) * kstep;
            const char* a3 = a2 + kstep; const char* b3 = b2 + kstep;
            if (last && has_next) S.a_ready(nxt);
            if constexpr (SP2) {
            PG8_LDB(B0, 0, 0); PG8_LDB(B1, 0, 1); PG8_SCHED; PG8_LDA(At, 0, 0); PG8_STAGE(PG8_SA(1, 1), a1 + hstep, voffA);
            PG8_WAIT_V(8); PG8_WAIT_L(0); PG8_BAR; PG8_MMA(0, 0, At, B0); PG8_MMA(0, 1, At, B1); PG8_BAR; PG8_SCHED;
            PG8_LDA(At, 0, 1); PG8_STAGE(PG8_SB(0, 0), b2, voffB); PG8_STAGE(PG8_SB(0, 1), b2 + hstep, voffB); PG8_STAGE(PG8_SA(0, 0), a2, voffA);
            PG8_WAIT_V(8); PG8_WAIT_L(0); PG8_BAR; PG8_MMA(1, 0, At, B0); PG8_MMA(1, 1, At, B1); PG8_BAR; PG8_SCHED;
            PG8_LDB(B0, 1, 0); PG8_LDB(B1, 1, 1); PG8_SCHED; PG8_LDA(At, 1, 0); PG8_STAGE(PG8_SA(0, 1), a2 + hstep, voffA);
            PG8_WAIT_V(8); PG8_WAIT_L(0); PG8_BAR; PG8_MMA(0, 0, At, B0); PG8_MMA(0, 1, At, B1); PG8_BAR; PG8_SCHED;
            PG8_LDA(At, 1, 1); PG8_STAGE(PG8_SB(1, 0), b3, voffB); PG8_STAGE(PG8_SB(1, 1), b3 + hstep, voffB); PG8_STAGE(PG8_SA(1, 0), a3, voffA);
            PG8_WAIT_V(8); PG8_WAIT_L(0); PG8_BAR; PG8_MMA(1, 0, At, B0); PG8_MMA(1, 1, At, B1); PG8_BAR; PG8_SCHED;
            } else {
            PG8_LDB(B0, 0, 0); PG8_SCHED; PG8_LDA(At, 0, 0); PG8_STAGE(PG8_SA(1, 1), a1 + hstep, voffA);
            PG8_WAIT_L(8); PG8_BAR; PG8_WAIT_L(0); PG8_MMA(0, 0, At, B0); PG8_BAR; PG8_SCHED;
            PG8_LDB(B1, 0, 1); PG8_STAGE(PG8_SB(0, 0), b2, voffB);
            PG8_BAR; PG8_WAIT_L(0); PG8_MMA(0, 1, At, B1); PG8_BAR;
            PG8_LDA(At, 0, 1); PG8_STAGE(PG8_SA(0, 0), a2, voffA);
            PG8_BAR; PG8_WAIT_L(0); PG8_MMA(1, 0, At, B0); PG8_BAR; PG8_SCHED;
            PG8_STAGE(PG8_SB(0, 1), b2 + hstep, voffB);
            PG8_WAIT_V(6); PG8_BAR; PG8_MMA(1, 1, At, B1); PG8_BAR;
            PG8_LDB(B0, 1, 0); PG8_SCHED; PG8_LDA(At, 1, 0); PG8_STAGE(PG8_SA(0, 1), a2 + hstep, voffA);
            PG8_WAIT_L(8); PG8_BAR; PG8_WAIT_L(0); PG8_MMA(0, 0, At, B0); PG8_BAR; PG8_SCHED;
            PG8_LDB(B1, 1, 1); PG8_STAGE(PG8_SB(1, 0), b3, voffB);
            PG8_BAR; PG8_WAIT_L(0); PG8_MMA(0, 1, At, B1); PG8_BAR;
            PG8_LDA(At, 1, 1); PG8_STAGE(PG8_SA(1, 0), a3, voffA);
            PG8_BAR; PG8_WAIT_L(0); PG8_MMA(1, 0, At, B0); PG8_BAR; PG8_SCHED;
            PG8_STAGE(PG8_SB(1, 1), b3 + hstep, voffB);
            PG8_WAIT_V(6); PG8_BAR; PG8_MMA(1, 1, At, B1); PG8_BAR;
            }
        }
        if constexpr (ALIGN_EPI) { if (wr == 0) PG8_BAR; }
        if constexpr (!Epi::AFTER_DRAIN) { E(acc, cur, wr, wc, fr, fq); S.done(cur); }
        if (!has_next) break;
#pragma unroll
        for (int a = 0; a < 2; ++a)
#pragma unroll
            for (int b = 0; b < 2; ++b)
#pragma unroll
                for (int m = 0; m < 4; ++m)
#pragma unroll
                    for (int n = 0; n < 2; ++n) acc[a][b][m][n] = (f32x4){0.f, 0.f, 0.f, 0.f};
        cur = nxt; cA = nA; cB = nB; ++ui;
        if constexpr (ALIGN_EPI) { if (wr == 1) PG8_BAR; }
    }
    PG8_WAIT_V(0);
    if constexpr (!ALIGN_EPI) { if (wr == 0) PG8_BAR; }
    PG8_BAR;
#undef PG8_SA
#undef PG8_SB
#undef PG8_STAGE
#undef PG8_LDA
#undef PG8_LDB
#undef PG8_MMA
#undef PG8_WAIT_V
#undef PG8_WAIT_L
#undef PG8_BAR
#undef PG8_SCHED
}
}

constexpr int NWAVES = 8, NTHR = 512;
constexpr int SEQ = 16384, DM = 2048, HD = 128, NHG = 8, DPROJ = 8208, NPJ = 8192, DFF = 5632, CH = 128, NCH = SEQ / CH, NHEADS = 16;
constexpr float NORM_EPS = 1e-6f;
constexpr int N_LAUNCHES = MK_N_LAUNCHES, NPHASES = 10;
constexpr int PC_MQ = 0, PC_MK = 1024, PC_MV = 2048, PC_MO = 3072, PC_RQ = 4096, PC_RK = 5120, PC_RV = 6144, PC_RG = 7168;

constexpr size_t MiB = 1u << 20;
constexpr size_t WS_CTL = 0, CTL_ZERO_BYTES = 64 * 1024;
constexpr size_t WS_WIN = 2 * MiB, WS_WO = 34 * MiB, WS_WGU = 42 * MiB, WS_WD = 86 * MiB;
constexpr size_t WS_PRE = 108 * MiB;
constexpr size_t WS_RS = 109 * MiB;
constexpr size_t WS_NLOC = 110 * MiB;
constexpr size_t WS_N0 = 110 * MiB + 512 * 1024;
constexpr size_t WS_DEC = 111 * MiB;
constexpr size_t WS_GHEAD = 111 * MiB + 65536;
constexpr size_t WS_COS = 112 * MiB, WS_SIN = 116 * MiB;
constexpr size_t WS_B = 128 * MiB;
constexpr size_t WS_A = 384 * MiB;
constexpr size_t WS_FF = WS_B + 176 * MiB;
constexpr size_t WS_END = 448 * MiB;
constexpr int CW_BAR = 1024;

constexpr int RING_BYTES = 131072;
constexpr int GATE_OFF = RING_BYTES;
constexpr int N0B_OFF = GATE_OFF + 8 * 1536;
constexpr int CONVW_OFF = N0B_OFF + 256;
constexpr int MISC_OFF = CONVW_OFF + 5120;
constexpr int LDS_BYTES = 163840;
static_assert(MISC_OFF + 1024 + 5120 <= LDS_BYTES, "LDS map");

#define GAS __attribute__((address_space(1)))
#define LAS __attribute__((address_space(3)))
#define DI __device__ __forceinline__
typedef unsigned short bf16;
typedef unsigned u32x4 __attribute__((ext_vector_type(4)));
typedef unsigned u32x2 __attribute__((ext_vector_type(2)));
typedef float f32x4 __attribute__((ext_vector_type(4)));
typedef float f32x2 __attribute__((ext_vector_type(2)));
typedef LAS unsigned char* ldsp;
#define LDS_WAIT() asm volatile("s_waitcnt lgkmcnt(0)" ::: "memory")

DI unsigned f2bf(float f) { unsigned u = __builtin_bit_cast(unsigned, f); return (u + 0x7fffu + ((u >> 16) & 1u)) >> 16; }
DI unsigned pk2(float lo, float hi) { unsigned r; asm volatile("v_cvt_pk_bf16_f32 %0, %1, %2" : "=v"(r) : "v"(lo), "v"(hi)); return r; }
DI float bflo(unsigned w) { return __builtin_bit_cast(float, w << 16); }
DI float bfhi(unsigned w) { return __builtin_bit_cast(float, w & 0xffff0000u); }
DI void unpack8(const u32x4 w, float (&f)[8]) { f[0] = bflo(w.x); f[1] = bfhi(w.x); f[2] = bflo(w.y); f[3] = bfhi(w.y); f[4] = bflo(w.z); f[5] = bfhi(w.z); f[6] = bflo(w.w); f[7] = bfhi(w.w); }
DI u32x4 pack8(const float (&f)[8]) { u32x4 w; w.x = pk2(f[0], f[1]); w.y = pk2(f[2], f[3]); w.z = pk2(f[4], f[5]); w.w = pk2(f[6], f[7]); return w; }
DI float sigmoid_f(float x) { return __builtin_amdgcn_rcpf(1.0f + __expf(-x)); }
DI float silu_f(float x) { return x * __builtin_amdgcn_rcpf(1.0f + __expf(-x)); }
DI float wave_sum(float v) {
#pragma unroll
    for (int o = 1; o < 64; o <<= 1) v += __shfl_xor(v, o);
    return v;
}

#define XB_TMO      128
#define XB_XCNT(j)  (256  + 64 * (j))
#define XB_XSUB(j)  (1280 + 64 * (j))
#define XB_XGEN(j)  (2304 + 64 * (j))
#define XB_TOP      3328
#define XB_TOPGEN   3392
#define XCD_BAR_WORDS 3456
#define XB_SPIN_CAP (1u << 18)
__device__ __forceinline__ unsigned xb_ld(unsigned* p)              { return __hip_atomic_load(p, __ATOMIC_RELAXED, __HIP_MEMORY_SCOPE_AGENT); }
__device__ __forceinline__ unsigned xb_add(unsigned* p, unsigned v) { return __hip_atomic_fetch_add(p, v, __ATOMIC_RELAXED, __HIP_MEMORY_SCOPE_AGENT); }
__device__ __forceinline__ unsigned xb_xcc_id() { return (unsigned)__builtin_amdgcn_s_getreg((3 << 11) | 20) & 0xFu; }
#define XB_SPIN(cond, bar) do { unsigned _sp = 0; while (cond) { __builtin_amdgcn_s_sleep(1); \
    if ((++_sp & 255u) == 0u) { if (xb_ld(&(bar)[XB_TMO])) break; if (_sp > XB_SPIN_CAP) { atomicAdd(&(bar)[XB_TMO], 1u); break; } } } } while (0)
struct XcdBarrier { unsigned* bar; unsigned x; volatile LAS unsigned* st; };
__device__ __forceinline__ XcdBarrier xcd_barrier_post(unsigned* bar, volatile LAS unsigned* st) {
    XcdBarrier b; b.bar = bar; b.x = xb_xcc_id(); b.st = st;
    if (threadIdx.x == 0) (void)xb_add(&bar[XB_XCNT(b.x)], 1u);
    return b;
}
__device__ __forceinline__ void xcd_barrier_complete(unsigned* bar, unsigned x, unsigned& nloc, unsigned& nx) {
    const unsigned G = gridDim.x * gridDim.y * gridDim.z;
    unsigned sum, cnt, mine, sp = 0u;
    for (;;) {
        sum = 0u; cnt = 0u; mine = 0u;
#pragma unroll
        for (unsigned j = 0; j < 16; ++j) { const unsigned c = xb_ld(&bar[XB_XCNT(j)]); sum += c; cnt += (c > 0u) ? 1u : 0u; mine = (j == x) ? c : mine; }
        if (sum == G) break;
        __builtin_amdgcn_s_sleep(1);
        if ((++sp & 255u) == 0u) { if (xb_ld(&bar[XB_TMO])) break; if (sp > XB_SPIN_CAP) { atomicAdd(&bar[XB_TMO], 1u); break; } }
    }
    nloc = mine > 0u ? mine : 1u; nx = cnt > 0u ? cnt : 1u;
}
__device__ __forceinline__ void xcd_barrier(const XcdBarrier& b) {
    asm volatile("s_waitcnt vmcnt(0)" ::: "memory");
    __syncthreads();
    if (threadIdx.x == 0) {
        unsigned* bar = b.bar;
        __builtin_amdgcn_s_waitcnt(0);
        unsigned nloc = b.st[0], nx = b.st[1];
        if (nloc == 0u) { xcd_barrier_complete(bar, b.x, nloc, nx); b.st[0] = nloc; b.st[1] = nx; }
        const unsigned old = xb_add(&bar[XB_XSUB(b.x)], 1u);
        const unsigned gen = old / nloc;
        if (old + 1u == (gen + 1u) * nloc) {
            __builtin_amdgcn_fence(__ATOMIC_RELEASE, "agent");
            asm volatile("s_waitcnt vmcnt(0)" ::: "memory");
            const unsigned og = xb_add(&bar[XB_TOP], 1u);
            const unsigned tg = og / nx;
            if (og + 1u == (tg + 1u) * nx) xb_add(&bar[XB_TOPGEN], 1u);
            else XB_SPIN(xb_ld(&bar[XB_TOPGEN]) == tg, bar);
            __builtin_amdgcn_fence(__ATOMIC_ACQUIRE, "agent");
            xb_add(&bar[XB_XGEN(b.x)], 1u);
            asm volatile("s_waitcnt vmcnt(0)" ::: "memory");
        } else {
            XB_SPIN(xb_ld(&bar[XB_XGEN(b.x)]) == gen, bar);
            __builtin_amdgcn_fence(__ATOMIC_ACQUIRE, "agent");
            asm volatile("s_waitcnt vmcnt(0)" ::: "memory");
        }
    }
    __syncthreads();
}

struct Args { const void* in[17]; float* out; unsigned char* ws; int ph_lo, ph_hi, li, pad; };
enum { IN_X = 0, IN_POS, IN_GPRE, IN_WIN, IN_CW, IN_CB, IN_BI, IN_BF, IN_GMH, IN_GRH, IN_WOUT, IN_GPOST, IN_GFPRE, IN_WG, IN_WU, IN_WDN, IN_GFPOST };

struct TrItem { const float* W; bf16* WT; int K, ldw, src_col, dst_row, kb; };
DI void p0_tr_load(const TrItem& it, int lane, f32x4 (&v)[8]) {
    const float* src = it.W + (size_t)(64 * it.kb + (lane >> 3)) * it.ldw + it.src_col + 4 * (lane & 7);
#pragma unroll
    for (int i = 0; i < 8; ++i) v[i] = *(const GAS f32x4*)(src + (size_t)(8 * i) * it.ldw);
}
DI void p0_tr_store(const TrItem& it, int lane, const f32x4 (&v)[8], LAS float* scr) {
#pragma unroll
    for (int i = 0; i < 8; ++i) *(LAS f32x4*)(scr + (8 * i + (lane >> 3)) * 36 + 4 * (lane & 7)) = v[i];
    LDS_WAIT(); asm volatile("" ::: "memory");
    const int c = lane & 7;
#pragma unroll
    for (int j = 0; j < 4; ++j) { const int n = (lane >> 3) + 8 * j; const LAS float* sp = scr + (8 * c) * 36 + n;
        u32x4 o; o.x = pk2(sp[0 * 36], sp[1 * 36]); o.y = pk2(sp[2 * 36], sp[3 * 36]); o.z = pk2(sp[4 * 36], sp[5 * 36]); o.w = pk2(sp[6 * 36], sp[7 * 36]);
        *(GAS u32x4*)(it.WT + (size_t)(it.dst_row + n) * it.K + 64 * it.kb + 8 * c) = o; }
    LDS_WAIT(); asm volatile("" ::: "memory");
}
constexpr int I_IN = 32 * 256, I_O = 32 * 64, I_G = 32 * 176, I_D = 88 * 64;
DI TrItem tr_item(const Args& a, int set, int r) {
    TrItem it;
    if (set == 0) { const int kb = r / 256, nb = r % 256; it.W = (const float*)a.in[IN_WIN]; it.WT = (bf16*)(a.ws + WS_WIN); it.K = DM; it.ldw = DPROJ; it.src_col = nb < 128 ? 32 * nb : 4112 + 32 * (nb - 128); it.dst_row = 32 * nb; it.kb = kb; return it; }
    if (r < I_O) { const int kb = r / 64, nb = r % 64; it.W = (const float*)a.in[IN_WOUT]; it.WT = (bf16*)(a.ws + WS_WO); it.K = DM; it.ldw = DM; it.src_col = 32 * nb; it.dst_row = 32 * nb; it.kb = kb; return it; } r -= I_O;
    if (r < I_G) { const int kb = r / 176, nb = r % 176; it.W = (const float*)a.in[IN_WG]; it.WT = (bf16*)(a.ws + WS_WGU); it.K = DM; it.ldw = DFF; it.src_col = 32 * nb; it.dst_row = 256 * (nb >> 2) + 32 * (nb & 3); it.kb = kb; return it; } r -= I_G;
    if (r < I_G) { const int kb = r / 176, nb = r % 176; it.W = (const float*)a.in[IN_WU]; it.WT = (bf16*)(a.ws + WS_WGU); it.K = DM; it.ldw = DFF; it.src_col = 32 * nb; it.dst_row = 256 * (nb >> 2) + 128 + 32 * (nb & 3); it.kb = kb; return it; } r -= I_G;
    { const int kb = r / 64, nb = r % 64; it.W = (const float*)a.in[IN_WDN]; it.WT = (bf16*)(a.ws + WS_WD); it.K = DFF; it.ldw = DM; it.src_col = 32 * nb; it.dst_row = 32 * nb; it.kb = kb; return it; }
}
DI void convert_weights(const Args& a, ldsp lds, int set, int lane, int wave, int vcu, int G) {
    const int gw = vcu * NWAVES + wave, NGW = G * NWAVES, nitems = set == 0 ? I_IN : I_O + 2 * I_G + I_D;
    LAS float* scr = (LAS float*)(lds + wave * 16384);
    f32x4 va[8], vb[8];
    int it = gw; if (it < nitems) p0_tr_load(tr_item(a, set, it), lane, va);
    for (; it < nitems; it += 2 * NGW) {
        if (it + NGW < nitems) p0_tr_load(tr_item(a, set, it + NGW), lane, vb);
        p0_tr_store(tr_item(a, set, it), lane, va, scr);
        if (it + 2 * NGW < nitems) p0_tr_load(tr_item(a, set, it + 2 * NGW), lane, va);
        if (it + NGW < nitems) p0_tr_store(tr_item(a, set, it + NGW), lane, vb, scr);
    }
}
typedef float f32x4g __attribute__((ext_vector_type(4)));
DI void p0_gates(const Args& a, ldsp lds, int tid, int lane, int wave, int vcu, int G) {
    const float* x = (const float*)a.in[IN_X]; const float* gpre = (const float*)a.in[IN_GPRE]; const float* w_in = (const float*)a.in[IN_WIN]; float* PRE = (float*)(a.ws + WS_PRE);
    LAS float* Wl = (LAS float*)lds;
    LAS float* part = (LAS float*)(lds + MISC_OFF + 1024);
#pragma unroll 4
    for (int i = 0; i < 16; ++i) { const int idx = tid + NTHR * i, k = idx >> 2, c4 = idx & 3;
        f32x4 w = *(const GAS f32x4*)(w_in + (size_t)k * DPROJ + 4096 + 4 * c4); w = w * gpre[k];
        const int row = (k & ~15) + 4 * (k & 3) + ((k >> 2) & 3);
        *(LAS f32x4*)(Wl + row * 16 + 4 * c4) = w; }
    LDS_WAIT(); __syncthreads();
    for (int rb = vcu; rb < SEQ / 64; rb += G) {
        const int tile = wave & 3, kh = wave >> 2, row = lane & 15, q = lane >> 4, t0 = rb * 64 + tile * 16;
        const GAS f32x4* xr = (const GAS f32x4*)(x + (size_t)(t0 + row) * DM + kh * 1024 + 4 * q);
        const LAS float* wl = Wl + (kh * 1024 + q) * 16 + row;
        f32x4g acc = {0.f, 0.f, 0.f, 0.f}; float ss = 0.f;
        for (int sp = 0; sp < 64; sp += 4) { f32x4 xv[4];
#pragma unroll
            for (int j = 0; j < 4; ++j) xv[j] = xr[4 * (sp + j)];
#pragma unroll
            for (int j = 0; j < 4; ++j) { ss += (xv[j].x * xv[j].x + xv[j].y * xv[j].y) + (xv[j].z * xv[j].z + xv[j].w * xv[j].w);
                const LAS float* wp = wl + (sp + j) * 256;
                acc = __builtin_amdgcn_mfma_f32_16x16x4f32(xv[j].x, wp[0], acc, 0, 0, 0); acc = __builtin_amdgcn_mfma_f32_16x16x4f32(xv[j].y, wp[64], acc, 0, 0, 0);
                acc = __builtin_amdgcn_mfma_f32_16x16x4f32(xv[j].z, wp[128], acc, 0, 0, 0); acc = __builtin_amdgcn_mfma_f32_16x16x4f32(xv[j].w, wp[192], acc, 0, 0, 0); } }
        if (kh == 1) {
#pragma unroll
            for (int j = 0; j < 4; ++j) part[(tile * 4 + j) * 64 + lane] = acc[j];
            part[1024 + tile * 64 + lane] = ss; }
        LDS_WAIT(); __syncthreads();
        if (kh == 0) {
#pragma unroll
            for (int j = 0; j < 4; ++j) acc[j] += part[(tile * 4 + j) * 64 + lane];
            ss += part[1024 + tile * 64 + lane];
            ss += __shfl_xor(ss, 16); ss += __shfl_xor(ss, 32);
            const float rs = 1.0f / sqrtf(ss * (1.0f / DM) + NORM_EPS);
#pragma unroll
            for (int j = 0; j < 4; ++j) { const int ri = 4 * q + j; const float rsi = __shfl(rs, ri); PRE[(size_t)(t0 + ri) * 16 + row] = acc[j] * rsi; } }
        __syncthreads();
    }
}
DI void phase_p0(const Args& a, ldsp lds, int tid, int lane, int wave, int vcu, int G) {
    p0_gates(a, lds, tid, lane, wave, vcu, G);
    const int gw = vcu * NWAVES + wave, NGW = G * NWAVES;
    convert_weights(a, lds, 0, lane, wave, vcu, G);
    convert_weights(a, lds, 1, lane, wave, vcu, G);
    const float* x = (const float*)a.in[IN_X]; const float* gpre = (const float*)a.in[IN_GPRE];
    bf16* hb = (bf16*)(a.ws + WS_A);
    {
        const GAS f32x4* gr = (const GAS f32x4*)gpre + lane;
#define P0_LOAD(buf, mm) do { const GAS f32x4* xr_ = (const GAS f32x4*)(x + (size_t)(mm) * DM) + lane; _Pragma("unroll") for (int j = 0; j < 8; ++j) buf[j] = xr_[64 * j]; } while (0)
#define P0_ROW(buf, mm) do { float s_ = 0.f; _Pragma("unroll") for (int j = 0; j < 8; ++j) s_ += (buf[j].x * buf[j].x + buf[j].y * buf[j].y) + (buf[j].z * buf[j].z + buf[j].w * buf[j].w); \
            const float r_ = 1.0f / sqrtf(wave_sum(s_) * (1.0f / DM) + NORM_EPS); GAS u32x2* o_ = (GAS u32x2*)(hb + (size_t)(mm) * DM) + lane; \
            _Pragma("unroll") for (int j = 0; j < 8; ++j) { const f32x4 gg = gr[64 * j]; u32x2 w; w.x = pk2(buf[j].x * r_ * gg.x, buf[j].y * r_ * gg.y); w.y = pk2(buf[j].z * r_ * gg.z, buf[j].w * r_ * gg.w); o_[64 * j] = w; } } while (0)
        f32x4 va[8], vb[8];
        int m = gw; if (m < SEQ) P0_LOAD(va, m);
        for (; m < SEQ; m += 2 * NGW) {
            if (m + NGW < SEQ) P0_LOAD(vb, m + NGW);
            P0_ROW(va, m);
            if (m + 2 * NGW < SEQ) P0_LOAD(va, m + 2 * NGW);
            if (m + NGW < SEQ) P0_ROW(vb, m + NGW);
        }
#undef P0_LOAD
#undef P0_ROW
    }
    { float* GH = (float*)(a.ws + WS_GHEAD); const float* gmh = (const float*)a.in[IN_GMH]; const float* grh = (const float*)a.in[IN_GRH];
      for (int i = vcu * NTHR + tid; i < 1024; i += G * NTHR) GH[i] = gmh[i];
      for (int i = vcu * NTHR + tid; i < 1024; i += G * NTHR) GH[1024 + i] = grh[i]; }
    const int* pos = (const int*)a.in[IN_POS]; float* COS = (float*)(a.ws + WS_COS); float* SIN = (float*)(a.ws + WS_SIN);
    { LAS float* invf = (LAS float*)(lds + GATE_OFF);
      if (tid < 64) invf[tid] = (float)pow(10000.0, -(double)(2 * tid) / 128.0);
      LDS_WAIT(); __syncthreads();
      for (int i = vcu * NTHR + tid; i < SEQ * 64; i += G * NTHR) { const int t = i >> 6, j = i & 63;
          const float ang = (float)pos[t] * invf[j]; float sn, cs; sincosf(ang, &sn, &cs); COS[i] = cs; SIN[i] = sn; } }
}

typedef short bf16x8 __attribute__((ext_vector_type(8)));
typedef short s16x4 __attribute__((ext_vector_type(4)));
typedef float f32x16 __attribute__((ext_vector_type(16)));
#define MFMA32(a, b, c) __builtin_amdgcn_mfma_f32_32x32x16_bf16((a), (b), (c), 0, 0, 0)
DI int crow(int reg, int h) { return (reg & 3) + 8 * (reg >> 2) + 4 * h; }
DI bf16x8 bf_ones() { return (bf16x8){16256, 16256, 16256, 16256, 16256, 16256, 16256, 16256}; }
DI int offb(int row, int ch) { return 256 * row + 16 * (ch ^ (((row & 3) << 2) | ((row >> 2) & 3))); }
DI int rowbase(int row, int h) { return offb(row, h); }
DI bf16x8 rowfrag(ldsp tile, int rb, int ks) { return *(const LAS bf16x8*)(tile + (rb ^ (ks << 5))); }
DI s16x4 tr_rd(ldsp p) { return __builtin_bit_cast(s16x4, __builtin_amdgcn_ds_read_tr16_b64_v4i16((LAS s16x4*)p)); }
struct TrB { int b0, b1; };
DI TrB trbase(int c, int lane) {
    const int h = lane >> 5, blk = (lane >> 4) & 1, q = (lane & 15) >> 2, p = lane & 3, ch = 4 * c + 2 * blk + (p >> 1);
    TrB b; b.b0 = offb(8 * h + q, ch) + 8 * (p & 1); b.b1 = offb(8 * h + 4 + q, ch) + 8 * (p & 1); return b;
}
DI bf16x8 trfrag(ldsp tile, const TrB b, int ks) {
    const s16x4 lo = tr_rd(tile + b.b0 + 4096 * ks), hi = tr_rd(tile + b.b1 + 4096 * ks);
    return __builtin_shufflevector(lo, hi, 0, 1, 2, 3, 4, 5, 6, 7);
}
DI void gload8(const bf16* p, float (&f)[8]) { unpack8(*(const GAS u32x4*)p, f); }

DI void mixer_setup(const Args& a, ldsp lds, int g, int grp, int tid, int lane, int wave) {
    if (g < NHG) {
        LAS float* rowv = (LAS float*)(lds + GATE_OFF + wave * 1536); LAS float* colv = rowv + 128; LAS float* alog = rowv + 256;
        const float* PRE = (const float*)(a.ws + WS_PRE); const float bi = ((const float*)a.in[IN_BI])[g], bfg = ((const float*)a.in[IN_BF])[g];
        const int t0 = (8 * grp + wave) * CH + 2 * lane;
        const float i0 = PRE[(size_t)t0 * 16 + g] + bi, i1 = PRE[(size_t)(t0 + 1) * 16 + g] + bi;
        const float f0 = PRE[(size_t)t0 * 16 + 8 + g] + bfg, f1 = PRE[(size_t)(t0 + 1) * 16 + 8 + g] + bfg;
        const float l0 = fminf(f0, 0.f) - log1pf(__expf(-fabsf(f0))), l1 = fminf(f1, 0.f) - log1pf(__expf(-fabsf(f1)));
        float p = l0 + l1;
#pragma unroll
        for (int o = 1; o < 64; o <<= 1) { const float y = __shfl_up(p, o); if (lane >= o) p += y; }
        const float b1 = p, b0 = p - l1;
        rowv[2 * lane] = b0; rowv[2 * lane + 1] = b1; alog[2 * lane] = b0; alog[2 * lane + 1] = b1; colv[2 * lane] = i0 - b0; colv[2 * lane + 1] = i1 - b1;
        if (tid < 128) { LAS float* cwl = (LAS float*)(lds + CONVW_OFF); const float* cw = (const float*)a.in[IN_CW]; const float* cb = (const float*)a.in[IN_CB];
#pragma unroll
            for (int j = 0; j < 4; ++j) { cwl[j * 128 + tid] = cw[j * 2048 + g * HD + tid]; cwl[640 + j * 128 + tid] = cw[j * 2048 + 1024 + g * HD + tid]; }
            cwl[512 + tid] = cb[g * HD + tid]; cwl[640 + 512 + tid] = cb[1024 + g * HD + tid]; }
    } else if (tid < 128) {
        LAS float* rowv = (LAS float*)(lds + GATE_OFF); LAS float* colv = rowv + 128; LAS float* alog = rowv + 256;
        const float lg = log1pf(-exp2f(-5.0f - (float)(g - NHG)));
        rowv[tid] = (float)tid * lg; colv[tid] = -(float)tid * lg; alog[tid] = (float)(tid + 1) * lg;
    }
    LDS_WAIT(); __syncthreads();
}
template <bool WITHQ> DI void mixer_tiles(const Args& a, ldsp lds, int g, int c, const LAS float* gt, int tid) {
    const bf16* proj = (const bf16*)(a.ws + WS_B);
    const LAS float* colv = gt + 128; const float rv127 = gt[127];
    ldsp Q = lds, K = lds + 32768, V = lds + 65536;
    const float kscale = 0.08838834764831845f;
    const int sq = tid >> 4, dg = tid & 15, tb = c * CH + 4 * sq;
    u32x4 vv[4];
    if (g < NHG) {
        const bf16* pk = proj + PC_MK + g * HD + 8 * dg; const bf16* pq = proj + PC_MQ + g * HD + 8 * dg; const bf16* pv = proj + PC_MV + g * HD + 8 * dg;
        u32x4 rk[7], rq[7];
#pragma unroll
        for (int j = 0; j < 7; ++j) { const int tt = tb - 3 + j, tc = tt < 0 ? 0 : tt; rk[j] = *(const GAS u32x4*)(pk + (size_t)tc * NPJ); if (WITHQ) rq[j] = *(const GAS u32x4*)(pq + (size_t)tc * NPJ);
            if (tt < 0) { rk[j] = (u32x4){0u, 0u, 0u, 0u}; if (WITHQ) rq[j] = (u32x4){0u, 0u, 0u, 0u}; } }
#pragma unroll
        for (int i = 0; i < 4; ++i) vv[i] = *(const GAS u32x4*)(pv + (size_t)(tb + i) * NPJ);
        const LAS float* cwl = (const LAS float*)(lds + CONVW_OFF);
#pragma unroll
        for (int qk = 0; qk < (WITHQ ? 2 : 1); ++qk) {
            const LAS float* wl = cwl + (qk == 0 ? 640 : 0) + 8 * dg;
            float w[5][8];
#pragma unroll
            for (int j = 0; j < 5; ++j) { const f32x4 w0 = *(const LAS f32x4*)(wl + j * 128), w1 = *(const LAS f32x4*)(wl + j * 128 + 4); w[j][0] = w0.x; w[j][1] = w0.y; w[j][2] = w0.z; w[j][3] = w0.w; w[j][4] = w1.x; w[j][5] = w1.y; w[j][6] = w1.z; w[j][7] = w1.w; }
#pragma unroll
            for (int i = 0; i < 4; ++i) { float acc[8];
#pragma unroll
                for (int e = 0; e < 8; ++e) acc[e] = w[4][e];
#pragma unroll
                for (int j = 0; j < 4; ++j) { float uu[8]; unpack8(qk == 0 ? rk[i + j] : rq[i + j], uu);
#pragma unroll
                    for (int e = 0; e < 8; ++e) acc[e] += w[j][e] * uu[e]; }
                const int srow = 4 * sq + i; const float sc = qk == 0 ? kscale * __expf(rv127 + colv[srow]) : 1.0f;
#pragma unroll
                for (int e = 0; e < 8; ++e) acc[e] = silu_f(acc[e]) * sc;
                *(LAS u32x4*)((qk == 0 ? K : Q) + offb(srow, dg)) = pack8(acc); }
        }
    } else {
        const int gr = g - NHG; const float* COS = (const float*)(a.ws + WS_COS); const float* SIN = (const float*)(a.ws + WS_SIN);
        const int s2 = tid >> 3, dgp = tid & 7;
        const bf16* pv = proj + PC_RV + gr * HD + 8 * dg;
        u32x4 klo[2], khi[2], qlo[2], qhi[2]; f32x4 cs[2][2], sn[2][2];
#pragma unroll
        for (int i = 0; i < 2; ++i) { const size_t t = (size_t)(c * CH + 2 * s2 + i); const bf16* pr = proj + t * NPJ + gr * HD + 8 * dgp;
            klo[i] = *(const GAS u32x4*)(pr + PC_RK); khi[i] = *(const GAS u32x4*)(pr + PC_RK + 64);
            if (WITHQ) { qlo[i] = *(const GAS u32x4*)(pr + PC_RQ); qhi[i] = *(const GAS u32x4*)(pr + PC_RQ + 64); }
            cs[i][0] = *(const GAS f32x4*)(COS + t * 64 + 8 * dgp); cs[i][1] = *(const GAS f32x4*)(COS + t * 64 + 8 * dgp + 4);
            sn[i][0] = *(const GAS f32x4*)(SIN + t * 64 + 8 * dgp); sn[i][1] = *(const GAS f32x4*)(SIN + t * 64 + 8 * dgp + 4); }
#pragma unroll
        for (int i = 0; i < 4; ++i) vv[i] = *(const GAS u32x4*)(pv + (size_t)(tb + i) * NPJ);
#pragma unroll
        for (int i = 0; i < 2; ++i) { const int srow = 2 * s2 + i;
            const float c8[8] = {cs[i][0].x, cs[i][0].y, cs[i][0].z, cs[i][0].w, cs[i][1].x, cs[i][1].y, cs[i][1].z, cs[i][1].w};
            const float s8[8] = {sn[i][0].x, sn[i][0].y, sn[i][0].z, sn[i][0].w, sn[i][1].x, sn[i][1].y, sn[i][1].z, sn[i][1].w};
            float lo[8], hi[8], olo[8], ohi[8]; unpack8(klo[i], lo); unpack8(khi[i], hi);
            const float sc = kscale * __expf(rv127 + colv[srow]);
#pragma unroll
            for (int e = 0; e < 8; ++e) { olo[e] = (lo[e] * c8[e] - hi[e] * s8[e]) * sc; ohi[e] = (hi[e] * c8[e] + lo[e] * s8[e]) * sc; }
            *(LAS u32x4*)(K + offb(srow, dgp)) = pack8(olo); *(LAS u32x4*)(K + offb(srow, 8 + dgp)) = pack8(ohi);
            if (WITHQ) { unpack8(qlo[i], lo); unpack8(qhi[i], hi);
#pragma unroll
                for (int e = 0; e < 8; ++e) { olo[e] = lo[e] * c8[e] - hi[e] * s8[e]; ohi[e] = hi[e] * c8[e] + lo[e] * s8[e]; }
                *(LAS u32x4*)(Q + offb(srow, dgp)) = pack8(olo); *(LAS u32x4*)(Q + offb(srow, 8 + dgp)) = pack8(ohi); }
        }
    }
#pragma unroll
    for (int i = 0; i < 4; ++i) *(LAS u32x4*)(V + offb(4 * sq + i, dg)) = vv[i];
    LDS_WAIT(); __syncthreads();
}

DI void phase_m1(const Args& a, ldsp lds, int tid_in, int wave, int vcu, int G) {
    float* UG = (float*)(a.ws + WS_A); float* NG = (float*)(a.ws + WS_NLOC); float* DG = (float*)(a.ws + WS_DEC);
    ldsp K = lds + 32768, V = lds + 65536; const int wi = wave >> 1, wj = wave & 1;
    for (int cg = vcu; cg < NHEADS * 16; cg += G) { const int g = cg >> 4, grp = cg & 15; const bool ml = g < NHG;
        { int tid_g = tid_in; asm volatile("" : "+v"(tid_g)); mixer_setup(a, lds, g, grp, tid_g, tid_g & 63, wave); }
        f32x16 accU[2], accN; float dsum = 0.f;
#pragma unroll
        for (int i = 0; i < 16; ++i) { accU[0][i] = 0.f; accU[1][i] = 0.f; accN[i] = 0.f; }
        for (int ci = 0; ci < 8; ++ci) { const int c = 8 * grp + ci;
            int tid_o = tid_in; asm volatile("" : "+v"(tid_o));
            const int tid = tid_o, lane = tid & 63;
            const LAS float* gt = (const LAS float*)(lds + GATE_OFF + (ml ? ci : 0) * 1536);
            mixer_tiles<false>(a, lds, g, c, gt, tid);
            const float la = gt[256 + 127], dec = __expf(la); dsum += la;
            accU[0] = accU[0] * dec; accU[1] = accU[1] * dec; accN = accN * dec;
            { const TrB tk = trbase(wi, lane), tv0 = trbase(2 * wj, lane), tv1 = trbase(2 * wj + 1, lane);
#pragma unroll
              for (int ks = 0; ks < 8; ++ks) {
                const bf16x8 af = trfrag(K, tk, ks), b0 = trfrag(V, tv0, ks), b1 = trfrag(V, tv1, ks);
                accU[0] = MFMA32(af, b0, accU[0]); accU[1] = MFMA32(af, b1, accU[1]);
                if (ml && wj == 0) accN = MFMA32(af, bf_ones(), accN);
              } }
            __syncthreads();
        }
        { int tid_o = tid_in; asm volatile("" : "+v"(tid_o)); const int lane = tid_o & 63, r = lane & 31, h = lane >> 5;
          float* o = UG + ((size_t)cg << 14) + wave * 2048 + lane;
#pragma unroll
          for (int n = 0; n < 2; ++n)
#pragma unroll
              for (int i = 0; i < 16; ++i) o[(n * 16 + i) * 64] = accU[n][i];
          if (ml && wj == 0 && r == 0) {
#pragma unroll
              for (int i = 0; i < 16; ++i) NG[(size_t)cg * HD + 32 * wi + crow(i, h)] = accN[i]; }
          if (tid_in == 0) DG[cg] = __expf(dsum); }
    }
}
DI void phase_m2(const Args& a, int tid, int vcu, int G) {
    const float* UG = (const float*)(a.ws + WS_A); float* G0 = (float*)(a.ws + WS_A + 16 * MiB); const float* DG = (const float*)(a.ws + WS_DEC);
    const float* NG = (const float*)(a.ws + WS_NLOC); float* N0G = (float*)(a.ws + WS_N0);
    const int gt = vcu * NTHR + tid, NT = G * NTHR;
    for (int p = gt; p < NHEADS * 8192; p += NT) { const int e0 = p * 2, g = e0 >> 14, r = e0 & 16383;
        f32x2 uu[16];
#pragma unroll
        for (int j = 0; j < 16; ++j) uu[j] = *(const GAS f32x2*)(UG + ((size_t)(g * 16 + j) << 14) + r);
        float c0 = 0.f, c1 = 0.f;
#pragma unroll
        for (int j = 0; j < 16; ++j) { *(GAS f32x2*)(G0 + ((size_t)(g * 16 + j) << 14) + r) = (f32x2){c0, c1}; const float d = DG[g * 16 + j]; c0 = d * c0 + uu[j].x; c1 = d * c1 + uu[j].y; }
    }
    for (int p = gt; p < NHG * HD; p += NT) { const int g = p >> 7, d = p & 127; float n = 0.f, ng[16], dg[16];
#pragma unroll
        for (int j = 0; j < 16; ++j) { ng[j] = NG[(size_t)(g * 16 + j) * HD + d]; dg[j] = DG[g * 16 + j]; }
#pragma unroll
        for (int j = 0; j < 16; ++j) { N0G[(size_t)(g * 16 + j) * HD + d] = n; n = dg[j] * n + ng[j]; } }
}
DI void phase_m3(const Args& a, ldsp lds, int tid_in, int wave, int vcu, int G) {
    const bf16* proj = (const bf16*)(a.ws + WS_B); const float* G0 = (const float*)(a.ws + WS_A + 16 * MiB); const float* N0G = (const float*)(a.ws + WS_N0);
    bf16* mixb = (bf16*)a.out;
    LAS unsigned short* n0b = (LAS unsigned short*)(lds + N0B_OFF);
    ldsp Q = lds, K = lds + 32768, V = lds + 65536, C0 = lds + 98304, P = lds + 98304; LAS float* H = (LAS float*)lds;
    const int wi = wave >> 1, wj = wave & 1;
    for (int cg = vcu; cg < NHEADS * 16; cg += G) { const int g = cg >> 4, grp = cg & 15; const bool ml = g < NHG;
        { int tid_g = tid_in; asm volatile("" : "+v"(tid_g)); mixer_setup(a, lds, g, grp, tid_g, tid_g & 63, wave); }
        f32x16 accC[2], nst;
        { int tid_o = tid_in; asm volatile("" : "+v"(tid_o)); const int lane = tid_o & 63, h = lane >> 5; const float* gs = G0 + ((size_t)cg << 14) + wave * 2048 + lane;
#pragma unroll
          for (int i = 0; i < 16; ++i) { accC[0][i] = gs[i * 64]; accC[1][i] = gs[(16 + i) * 64]; nst[i] = ml ? N0G[(size_t)cg * HD + 32 * wi + crow(i, h)] : 0.f; } }
        for (int ci = 0; ci < 8; ++ci) { const int c = 8 * grp + ci;
            int tid_o = tid_in; asm volatile("" : "+v"(tid_o));
            const int tid = tid_o, lane = tid & 63, r = lane & 31, h = lane >> 5;
            const LAS float* gt = (const LAS float*)(lds + GATE_OFF + (ml ? ci : 0) * 1536);
#pragma unroll
            for (int n = 0; n < 2; ++n) { const int e = 64 * wj + 32 * n + r;
#pragma unroll
                for (int i = 0; i < 16; ++i) { const int d = 32 * wi + crow(i, h); *(LAS unsigned short*)(C0 + offb(d, e >> 3) + 2 * (e & 7)) = (unsigned short)pk2(accC[n][i], accC[n][i]); } }
            if (wj == 0 && r == 0) {
#pragma unroll
                for (int i = 0; i < 16; ++i) n0b[32 * wi + crow(i, h)] = (unsigned short)pk2(nst[i], nst[i]); }
            mixer_tiles<true>(a, lds, g, c, gt, tid);
            f32x16 accO[2], accS[2], accD;
#pragma unroll
            for (int i = 0; i < 16; ++i) { accO[0][i] = 0.f; accO[1][i] = 0.f; accS[0][i] = 0.f; accS[1][i] = 0.f; accD[i] = 0.f; }
            const TrB tk = trbase(wi, lane), tv0 = trbase(2 * wj, lane), tv1 = trbase(2 * wj + 1, lane);
            const int rbq = rowbase(32 * wi + r, h), rbk = rowbase(64 * wj + r, h);
#pragma unroll
            for (int ks = 0; ks < 8; ++ks) {
                const bf16x8 af = rowfrag(Q, rbq, ks), b0 = trfrag(C0, tv0, ks), b1 = trfrag(C0, tv1, ks);
                accO[0] = MFMA32(af, b0, accO[0]); accO[1] = MFMA32(af, b1, accO[1]);
                if (ml) { const bf16x8 bn = *(const LAS bf16x8*)(n0b + 16 * ks + 8 * h); accD = MFMA32(af, bn, accD); }
            }
#pragma unroll
            for (int i = 0; i < 16; ++i) { const int t = 32 * wi + crow(i, h); const float al = __expf(gt[256 + t]); accO[0][i] *= al; accO[1][i] *= al; accD[i] *= al; }
#pragma unroll
            for (int ks = 0; ks < 8; ++ks) {
                const bf16x8 af = rowfrag(Q, rbq, ks), b0 = rowfrag(K, rbk, ks), b1 = rowfrag(K + 8192, rbk, ks);
                accS[0] = MFMA32(af, b0, accS[0]); accS[1] = MFMA32(af, b1, accS[1]);
            }
            __syncthreads();
            float fac[16]; { const float rv127 = gt[127];
#pragma unroll
              for (int i = 0; i < 16; ++i) fac[i] = __expf(gt[32 * wi + crow(i, h)] - rv127); }
#pragma unroll
            for (int n = 0; n < 2; ++n) { const int sidx = 64 * wj + 32 * n + r;
#pragma unroll
                for (int i = 0; i < 16; ++i) { const int t = 32 * wi + crow(i, h); const float val = (sidx <= t) ? accS[n][i] * fac[i] : 0.f;
                    *(LAS unsigned short*)(P + offb(t, sidx >> 3) + 2 * (sidx & 7)) = (unsigned short)pk2(val, val); } }
            LDS_WAIT(); __syncthreads();
            u32x4 gpre[2][2];
            { const int tl = tid >> 3, eg = tid & 7; const int hc = ml ? g * HD + 16 * eg : (g - NHG) * HD + 16 * eg;
#pragma unroll
              for (int hh = 0; hh < 2; ++hh) { const bf16* gp = proj + (size_t)(c * CH + 64 * hh + tl) * NPJ + (ml ? PC_MO : PC_RG) + hc; gpre[hh][0] = *(const GAS u32x4*)gp; gpre[hh][1] = *(const GAS u32x4*)(gp + 8); } }
            { const float dec = __expf(gt[256 + 127]); accC[0] = accC[0] * dec; accC[1] = accC[1] * dec; nst = nst * dec; }
#pragma unroll
            for (int ks = 0; ks < 8; ++ks) {
                const bf16x8 af = rowfrag(P, rbq, ks), ak = trfrag(K, tk, ks), b0 = trfrag(V, tv0, ks), b1 = trfrag(V, tv1, ks);
                accO[0] = MFMA32(af, b0, accO[0]); accO[1] = MFMA32(af, b1, accO[1]);
                accC[0] = MFMA32(ak, b0, accC[0]); accC[1] = MFMA32(ak, b1, accC[1]);
                if (ml) { accD = MFMA32(af, bf_ones(), accD); nst = MFMA32(ak, bf_ones(), nst); }
            }
            __syncthreads();
#pragma unroll
            for (int i = 0; i < 16; ++i) { const int t = 32 * wi + crow(i, h); const float rden = ml ? 1.0f / fmaxf(fabsf(accD[i]), 1.0f) : 1.0f;
                H[t * HD + 64 * wj + r] = accO[0][i] * rden; H[t * HD + 64 * wj + 32 + r] = accO[1][i] * rden; }
            LDS_WAIT(); __syncthreads();
#pragma unroll
            for (int hh = 0; hh < 2; ++hh) {
                const int tl = tid >> 3, eg = tid & 7, t = 64 * hh + tl;
                float hv[16]; float ss = 0.f;
#pragma unroll
                for (int q = 0; q < 4; ++q) { const f32x4 x4 = *(const LAS f32x4*)(H + t * HD + 16 * eg + 4 * q); hv[4 * q] = x4.x; hv[4 * q + 1] = x4.y; hv[4 * q + 2] = x4.z; hv[4 * q + 3] = x4.w; }
#pragma unroll
                for (int i = 0; i < 16; ++i) ss += hv[i] * hv[i];
                ss += __shfl_xor(ss, 1); ss += __shfl_xor(ss, 2); ss += __shfl_xor(ss, 4);
                const float rn = 1.0f / sqrtf(ss * (1.0f / HD) + NORM_EPS);
                const int tg = c * CH + t; const int hc = ml ? g * HD + 16 * eg : (g - NHG) * HD + 16 * eg;
                const float* gh = (const float*)(a.ws + WS_GHEAD) + (ml ? 0 : 1024) + hc;
                float ga[16]; { float t8[8]; unpack8(gpre[hh][0], t8);
#pragma unroll
                    for (int j = 0; j < 8; ++j) ga[j] = t8[j]; unpack8(gpre[hh][1], t8);
#pragma unroll
                    for (int j = 0; j < 8; ++j) ga[8 + j] = t8[j]; }
                float o[16];
#pragma unroll
                for (int i = 0; i < 16; ++i) o[i] = hv[i] * rn * gh[i] * (ml ? sigmoid_f(ga[i]) : silu_f(ga[i]));
                bf16* op = mixb + (size_t)tg * DM + (ml ? 0 : 1024) + hc;
                u32x4 w0, w1; w0.x = pk2(o[0], o[1]); w0.y = pk2(o[2], o[3]); w0.z = pk2(o[4], o[5]); w0.w = pk2(o[6], o[7]); w1.x = pk2(o[8], o[9]); w1.y = pk2(o[10], o[11]); w1.z = pk2(o[12], o[13]); w1.w = pk2(o[14], o[15]);
                *(GAS u32x4*)op = w0; *(GAS u32x4*)(op + 8) = w1;
            }
            __syncthreads();
        }
    }
}
DI void phase_r1(const Args& a, int lane, int wave, int vcu, int G) {
    const int gw = vcu * NWAVES + wave, NGW = G * NWAVES;
    const float* x = (const float*)a.in[IN_X]; const bf16* mix = (const bf16*)(a.ws + WS_B); float* x1 = a.out; bf16* h2 = (bf16*)(a.ws + WS_A);
    const GAS f32x4* gp = (const GAS f32x4*)a.in[IN_GPOST] + lane; const GAS f32x4* gf = (const GAS f32x4*)a.in[IN_GFPRE] + lane;
#define R1_LOAD(bm, bx, mm) do { const GAS u32x2* mr_ = (const GAS u32x2*)(mix + (size_t)(mm) * DM) + lane; const GAS f32x4* xr_ = (const GAS f32x4*)(x + (size_t)(mm) * DM) + lane; \
        _Pragma("unroll") for (int j = 0; j < 8; ++j) { bm[j] = mr_[64 * j]; bx[j] = xr_[64 * j]; } } while (0)
#define R1_ROW(bm, bx, mm) do { f32x4 v[8]; float s_ = 0.f; \
        _Pragma("unroll") for (int j = 0; j < 8; ++j) { v[j] = (f32x4){bflo(bm[j].x), bfhi(bm[j].x), bflo(bm[j].y), bfhi(bm[j].y)}; s_ += (v[j].x * v[j].x + v[j].y * v[j].y) + (v[j].z * v[j].z + v[j].w * v[j].w); } \
        const float r_ = 1.0f / sqrtf(wave_sum(s_) * (1.0f / DM) + NORM_EPS); float s2_ = 0.f; GAS f32x4* xo_ = (GAS f32x4*)(x1 + (size_t)(mm) * DM) + lane; \
        _Pragma("unroll") for (int j = 0; j < 8; ++j) { const f32x4 gg = gp[64 * j]; v[j] = bx[j] + v[j] * r_ * gg; xo_[64 * j] = v[j]; s2_ += (v[j].x * v[j].x + v[j].y * v[j].y) + (v[j].z * v[j].z + v[j].w * v[j].w); } \
        const float r2_ = 1.0f / sqrtf(wave_sum(s2_) * (1.0f / DM) + NORM_EPS); GAS u32x2* o_ = (GAS u32x2*)(h2 + (size_t)(mm) * DM) + lane; \
        _Pragma("unroll") for (int j = 0; j < 8; ++j) { const f32x4 gg = gf[64 * j]; u32x2 w; w.x = pk2(v[j].x * r2_ * gg.x, v[j].y * r2_ * gg.y); w.y = pk2(v[j].z * r2_ * gg.z, v[j].w * r2_ * gg.w); o_[64 * j] = w; } } while (0)
    u32x2 ma[8], mb[8]; f32x4 xa[8], xb[8];
    int m = gw; if (m < SEQ) R1_LOAD(ma, xa, m);
    for (; m < SEQ; m += 2 * NGW) {
        if (m + NGW < SEQ) R1_LOAD(mb, xb, m + NGW);
        R1_ROW(ma, xa, m);
        if (m + 2 * NGW < SEQ) R1_LOAD(ma, xa, m + 2 * NGW);
        if (m + NGW < SEQ) R1_ROW(mb, xb, m + NGW);
    }
#undef R1_LOAD
#undef R1_ROW
}
DI void phase_r2(const Args& a, int lane, int wave, int vcu, int G, bool poison) {
    const int gw = vcu * NWAVES + wave, NGW = G * NWAVES;
    const bf16* ff = (const bf16*)(a.ws + WS_FF); float* out = a.out; const GAS f32x4* gp = (const GAS f32x4*)a.in[IN_GFPOST] + lane;
    const float qn = __builtin_nanf("");
#define R2_LOAD(bm, bx, mm) do { const GAS u32x2* fr_ = (const GAS u32x2*)(ff + (size_t)(mm) * DM) + lane; const GAS f32x4* xr_ = (const GAS f32x4*)(out + (size_t)(mm) * DM) + lane; \
        _Pragma("unroll") for (int j = 0; j < 8; ++j) { bm[j] = fr_[64 * j]; bx[j] = xr_[64 * j]; } } while (0)
#define R2_ROW(bm, bx, mm) do { f32x4 v[8]; float s_ = 0.f; \
        _Pragma("unroll") for (int j = 0; j < 8; ++j) { v[j] = (f32x4){bflo(bm[j].x), bfhi(bm[j].x), bflo(bm[j].y), bfhi(bm[j].y)}; s_ += (v[j].x * v[j].x + v[j].y * v[j].y) + (v[j].z * v[j].z + v[j].w * v[j].w); } \
        const float r_ = 1.0f / sqrtf(wave_sum(s_) * (1.0f / DM) + NORM_EPS); GAS f32x4* xo_ = (GAS f32x4*)(out + (size_t)(mm) * DM) + lane; \
        _Pragma("unroll") for (int j = 0; j < 8; ++j) { const f32x4 gg = gp[64 * j]; f32x4 o = bx[j] + v[j] * r_ * gg; if (poison) o = (f32x4){qn, qn, qn, qn}; xo_[64 * j] = o; } } while (0)
    u32x2 ma[8], mb[8]; f32x4 xa[8], xb[8];
    int m = gw; if (m < SEQ) R2_LOAD(ma, xa, m);
    for (; m < SEQ; m += 2 * NGW) {
        if (m + NGW < SEQ) R2_LOAD(mb, xb, m + NGW);
        R2_ROW(ma, xa, m);
        if (m + 2 * NGW < SEQ) R2_LOAD(ma, xa, m + 2 * NGW);
        if (m + NGW < SEQ) R2_ROW(mb, xb, m + NGW);
    }
#undef R2_LOAD
#undef R2_ROW
}

__global__ void __launch_bounds__(NTHR, 2) fwd(Args a) {
    extern __shared__ __attribute__((aligned(16))) unsigned char lds_raw[];
    ldsp lds = (ldsp)lds_raw;
    const int tid = threadIdx.x, lane = tid & 63, wave = __builtin_amdgcn_readfirstlane(tid >> 6);
    const int G = gridDim.x; const int bx = blockIdx.x; const int vcu = (G % 8 == 0) ? (bx % 8) * (G / 8) + bx / 8 : bx;
    volatile LAS unsigned* MISC = (volatile LAS unsigned*)(lds + MISC_OFF);
    if (tid < 32) MISC[tid] = 0u;
    __syncthreads();
    unsigned* ctl = (unsigned*)(a.ws + WS_CTL);
    XcdBarrier bar; bar.bar = ctl + CW_BAR; bar.x = 0; bar.st = nullptr;
    if (N_LAUNCHES == 1) bar = xcd_barrier_post(ctl + CW_BAR, MISC + 8);
    const int lo = a.ph_lo, hi = a.ph_hi;
#define IN(k) (lo <= (k) && (k) < hi)
#define SEAM(k) do { if (IN(k) && IN((k) + 1)) xcd_barrier(bar); } while (0)

#define PH1_BODY { pg8::Gemm g{(const bf16*)(a.ws + WS_A), (const bf16*)(a.ws + WS_WIN), SEQ, NPJ, DM}; pg8::StaticOrder S; S.init(SEQ, NPJ, G, bx); \
        pg8::EpiBf16 E{(bf16*)(a.ws + WS_B), NPJ}; pg8::gemm_phase<pg8::EpiBf16, pg8::StaticOrder, true, true>(lds, g, S, E); }
#define PH5_BODY { pg8::Gemm g{(const bf16*)a.out, (const bf16*)(a.ws + WS_WO), SEQ, DM, DM}; pg8::StaticOrder S; S.init(SEQ, DM, G, bx); \
        pg8::EpiBf16 E{(bf16*)(a.ws + WS_B), DM}; pg8::gemm_phase<pg8::EpiBf16, pg8::StaticOrder, true, true>(lds, g, S, E); }
#define PH7_BODY { pg8::Gemm g{(const bf16*)(a.ws + WS_A), (const bf16*)(a.ws + WS_WGU), SEQ, 2 * DFF, DM}; pg8::StaticOrder S; S.init(SEQ, 2 * DFF, G, bx); \
        pg8::EpiSwiGLU E{(bf16*)(a.ws + WS_B), DFF}; pg8::gemm_phase<pg8::EpiSwiGLU, pg8::StaticOrder, true, true>(lds, g, S, E); }
#define PH8_BODY { pg8::Gemm g{(const bf16*)(a.ws + WS_B), (const bf16*)(a.ws + WS_WD), SEQ, DM, DFF}; pg8::StaticOrder S; S.init(SEQ, DM, G, bx); \
        pg8::EpiBf16 E{(bf16*)(a.ws + WS_FF), DM}; pg8::gemm_phase<pg8::EpiBf16, pg8::StaticOrder, true, true>(lds, g, S, E); }
#define DUP(k) (((PROBE_DUP) >> (k)) & 1)
    if (IN(0)) { phase_p0(a, lds, tid, lane, wave, vcu, G); if (DUP(0)) { __syncthreads(); phase_p0(a, lds, tid, lane, wave, vcu, G); } SEAM(0); }
    if (IN(1)) { PH1_BODY if (DUP(1)) PH1_BODY SEAM(1); }
    if (IN(2)) { phase_m1(a, lds, tid, wave, vcu, G); if (DUP(2)) phase_m1(a, lds, tid, wave, vcu, G); SEAM(2); }
    if (IN(3)) { phase_m2(a, tid, vcu, G); if (DUP(3)) phase_m2(a, tid, vcu, G); SEAM(3); }
    if (IN(4)) { phase_m3(a, lds, tid, wave, vcu, G); if (DUP(4)) phase_m3(a, lds, tid, wave, vcu, G); SEAM(4); }
    if (IN(5)) { PH5_BODY if (DUP(5)) PH5_BODY SEAM(5); }
    if (IN(6)) { phase_r1(a, lane, wave, vcu, G); if (DUP(6)) phase_r1(a, lane, wave, vcu, G); SEAM(6); }
    if (IN(7)) { PH7_BODY if (DUP(7)) PH7_BODY SEAM(7); }
    if (IN(8)) { PH8_BODY if (DUP(8)) PH8_BODY SEAM(8); }
    if (IN(9)) {
        bool poison = false;
        if (N_LAUNCHES == 1) poison = __hip_atomic_load(ctl + CW_BAR + XB_TMO, __ATOMIC_RELAXED, __HIP_MEMORY_SCOPE_AGENT) != 0u;
        phase_r2(a, lane, wave, vcu, G, poison);
    }
#undef PH1_BODY
#undef PH5_BODY
#undef PH7_BODY
#undef PH8_BODY
#undef DUP
#undef IN
#undef SEAM
}

extern "C" void kernel_launch(void* const* d_in, const int* in_sizes, int n_in, void* d_out, int out_size, void* d_ws, size_t ws_size, hipStream_t stream) {
    static int grid = 0;
    if (grid == 0) {
        if (n_in != 17 || in_sizes[0] != SEQ * DM || out_size != SEQ * DM || ws_size < WS_END) {
            fprintf(stderr, "kernel_launch: unexpected shapes (n_in %d, in0 %d, out %d, ws %zu); nothing launched\n", n_in, n_in > 0 ? in_sizes[0] : -1, out_size, ws_size); grid = -1; return; }
        int dev = 0, cus = 0, per_cu = 0;
        if (hipGetDevice(&dev) != hipSuccess || hipDeviceGetAttribute(&cus, hipDeviceAttributeMultiprocessorCount, dev) != hipSuccess) { grid = -1; return; }
        if (hipFuncSetAttribute((const void*)fwd, hipFuncAttributeMaxDynamicSharedMemorySize, LDS_BYTES) != hipSuccess) { fprintf(stderr, "kernel_launch: hipFuncSetAttribute failed\n"); grid = -1; return; }
        if (hipOccupancyMaxActiveBlocksPerMultiprocessor(&per_cu, (const void*)fwd, NTHR, LDS_BYTES) != hipSuccess || per_cu < 1)
            fprintf(stderr, "kernel_launch: note: occupancy query reports %d workgroups per CU\n", per_cu);
        (void)hipGetLastError();
        grid = cus;
    }
    if (grid < 0) return;
    if (hipMemsetAsync((char*)d_ws + WS_CTL, 0, CTL_ZERO_BYTES, stream) != hipSuccess) return;
    Args a{};
    for (int i = 0; i < 17; ++i) a.in[i] = d_in[i];
    a.out = (float*)d_out; a.ws = (unsigned char*)d_ws;
    if (N_LAUNCHES == 1) { a.ph_lo = 0; a.ph_hi = NPHASES; a.li = 0; hipLaunchKernelGGL(fwd, dim3(grid), dim3(NTHR), LDS_BYTES, stream, a); }
    else for (int li = 0; li < NPHASES; ++li) { a.ph_lo = li; a.ph_hi = li + 1; a.li = li; hipLaunchKernelGGL(fwd, dim3(grid), dim3(NTHR), LDS_BYTES, stream, a); }
}
```

```cpp
#include <hip/hip_runtime.h>
#include <cstdio>
#include <cstdint>

#ifndef PROBE_DUP
#define PROBE_DUP 0
#endif
#ifndef MK_N_LAUNCHES
#define MK_N_LAUNCHES 1
#endif

namespace pg8 {
#define PG8_LAS __attribute__((address_space(3)))
typedef unsigned short bf16_t;
typedef short bf16x8 __attribute__((ext_vector_type(8)));
typedef float f32x4 __attribute__((ext_vector_type(4)));
typedef unsigned u32x4 __attribute__((ext_vector_type(4)));
constexpr int BM = 256, BK = 64, HALF = 128, HTB = HALF * BK * 2  , STAGE_BYTES = 8 * HTB, NXCD = 8, WGM = 4;

__host__ __device__ __forceinline__ int lds_byte(int r, int c) { const int st = (r >> 4) * 2 + (c >> 5), rr = r & 15, cc = c & 31, ob = rr * 64 + cc * 2; return st * 1024 + (ob ^ (((ob >> 9) & 1) << 5)); }
__host__ __device__ __forceinline__ void stage_rc(int b, int& R, int& C) { const int st = b / 1024, sb = b % 1024, swz = sb ^ (((sb >> 9) & 1) << 5); R = (st >> 1) * 16 + swz / 64; C = (st & 1) * 32 + (swz % 64) / 2; }
__host__ __device__ __forceinline__ int perm32(int rho) { const int n = rho >> 4, i = rho & 15; return 8 * (i >> 2) + 4 * n + (i & 3); }

struct Unit { int pm, pn; };
struct Gemm { const bf16_t* A; const bf16_t* Bt; int M, N, K; };

struct StaticOrder {
    int nM, nN, nwg, G, c;
    __host__ __device__ void init(int M, int N, int G_, int c_) { nM = M / BM; nN = N / BM; nwg = nM * nN; G = G_; c = c_; }
    __host__ __device__ bool next(int i, Unit& u) const {
        const long L = (long)i * G + c; if (L >= nwg) return false;
        int wgid = (int)L; { const int q = nwg / NXCD, r = nwg % NXCD, xcd = wgid % NXCD, off = wgid / NXCD; wgid = (xcd < r ? xcd * (q + 1) : r * (q + 1) + (xcd - r) * q) + off; }
        const int nig = WGM * nN, gid = wgid / nig, fm = gid * WGM, gsz = (nM - fm) < WGM ? (nM - fm) : WGM;
        u.pm = fm + ((wgid % nig) % gsz); u.pn = (wgid % nig) / gsz; return true;
    }
    __device__ __forceinline__ void a_ready(const Unit&) const {}
    __device__ __forceinline__ void done(const Unit&) const {}
};

__device__ __forceinline__ unsigned cvt_pk_bf16(float lo, float hi) { unsigned r; asm volatile("v_cvt_pk_bf16_f32 %0, %1, %2" : "=v"(r) : "v"(lo), "v"(hi)); return r; }

struct EpiF32 {
    static constexpr bool PERM = false, AFTER_DRAIN = false;
    float* C; int ldc;
    __device__ __forceinline__ void operator()(const f32x4 (&acc)[2][2][4][2], const Unit& u, int wr, int wc, int fr, int fq) const {
        const int row0 = u.pm * BM + wr * 64 + fr, col0 = u.pn * BM + wc * 32 + 4 * fq;
#pragma unroll
        for (int ai = 0; ai < 2; ++ai)
#pragma unroll
            for (int m = 0; m < 4; ++m) { float* rowp = C + (size_t)(row0 + ai * HALF + m * 16) * ldc + col0;
#pragma unroll
                for (int bj = 0; bj < 2; ++bj)
#pragma unroll
                    for (int n = 0; n < 2; ++n) *(f32x4*)(rowp + bj * HALF + n * 16) = acc[ai][bj][m][n]; }
    }
};
struct EpiBf16 {
    static constexpr bool PERM = true, AFTER_DRAIN = false;
    bf16_t* O; int ldc;
    __device__ __forceinline__ void operator()(const f32x4 (&acc)[2][2][4][2], const Unit& u, int wr, int wc, int fr, int fq) const {
        const int row0 = u.pm * BM + wr * 64 + fr, col0 = u.pn * BM + wc * 32 + 8 * fq;
#pragma unroll
        for (int ai = 0; ai < 2; ++ai)
#pragma unroll
            for (int m = 0; m < 4; ++m) { bf16_t* rowp = O + (size_t)(row0 + ai * HALF + m * 16) * ldc + col0;
#pragma unroll
                for (int bj = 0; bj < 2; ++bj) { const f32x4 v0 = acc[ai][bj][m][0], v1 = acc[ai][bj][m][1];
                    u32x4 w; w.x = cvt_pk_bf16(v0[0], v0[1]); w.y = cvt_pk_bf16(v0[2], v0[3]); w.z = cvt_pk_bf16(v1[0], v1[1]); w.w = cvt_pk_bf16(v1[2], v1[3]);
                    *(u32x4*)(rowp + bj * HALF) = w; } }
    }
};
__device__ __forceinline__ float silu_f(float x) { return x * __builtin_amdgcn_rcpf(1.0f + __expf(-x)); }
struct EpiSwiGLU {
    static constexpr bool PERM = true, AFTER_DRAIN = false;
    bf16_t* O; int ldc;
    __device__ __forceinline__ void operator()(const f32x4 (&acc)[2][2][4][2], const Unit& u, int wr, int wc, int fr, int fq) const {
        const int row0 = u.pm * BM + wr * 64 + fr, col0 = u.pn * HALF + wc * 32 + 8 * fq;
#pragma unroll
        for (int ai = 0; ai < 2; ++ai)
#pragma unroll
            for (int m = 0; m < 4; ++m) { bf16_t* rowp = O + (size_t)(row0 + ai * HALF + m * 16) * ldc + col0;
                const f32x4 g0 = acc[ai][0][m][0], g1 = acc[ai][0][m][1], u0 = acc[ai][1][m][0], u1 = acc[ai][1][m][1];
                u32x4 w; w.x = cvt_pk_bf16(silu_f(g0[0]) * u0[0], silu_f(g0[1]) * u0[1]); w.y = cvt_pk_bf16(silu_f(g0[2]) * u0[2], silu_f(g0[3]) * u0[3]);
                w.z = cvt_pk_bf16(silu_f(g1[0]) * u1[0], silu_f(g1[1]) * u1[1]); w.w = cvt_pk_bf16(silu_f(g1[2]) * u1[2], silu_f(g1[3]) * u1[3]);
                *(u32x4*)rowp = w; }
    }
};

template <class Epi, class Sched, bool ALIGN_EPI = false, bool SP2 = false>
__device__ __forceinline__ void gemm_phase(PG8_LAS unsigned char* lds, const Gemm g, const Sched& S, const Epi& E) {
    const int tid = threadIdx.x, wid = __builtin_amdgcn_readfirstlane(tid >> 6), lane = tid & 63, wr = wid >> 2, wc = wid & 3, fr = lane & 15, fq = lane >> 4;
    const int K = g.K, nt = K / BK;
    unsigned voffA[2], voffB[2];
#pragma unroll
    for (int i = 0; i < 2; ++i) { int R, C; stage_rc(tid * 16 + i * 8192, R, C); const int Rb = Epi::PERM ? ((R & ~31) + perm32(R & 31)) : R;
        voffA[i] = (unsigned)(R * K + C) * 2u; voffB[i] = (unsigned)(Rb * K + C) * 2u; }
    const size_t kstep = (size_t)(BK * 2);
    const size_t hstep = (size_t)HALF * K * 2;
    const size_t tstep = 2 * hstep;
    const unsigned ldsw = (unsigned)wid * 1024u;
    const int aoff = lds_byte(wr * 64 + fr, fq * 8), boff = lds_byte(wc * 32 + fr, fq * 8);
#define PG8_SA(b, h) (((b) * 2 + (h)) * HTB)
#define PG8_SB(b, h) ((4 + (b) * 2 + (h)) * HTB)
#define PG8_STAGE(bufoff, gbase, voff) do { _Pragma("unroll") for (int _i = 0; _i < 2; ++_i) \
        __builtin_amdgcn_global_load_lds((const unsigned*)((const char*)(gbase) + (voff)[_i]), (PG8_LAS unsigned*)(lds + (bufoff) + ldsw + _i * 8192), 16, 0, 0); } while (0)
#define PG8_LDA(dst, b, h) do { _Pragma("unroll") for (int m = 0; m < 4; ++m) _Pragma("unroll") for (int k = 0; k < 2; ++k) dst[m][k] = *(const PG8_LAS bf16x8*)(lds + PG8_SA(b, h) + aoff + m * 2048 + k * 1024); } while (0)
#define PG8_LDB(dst, b, h) do { _Pragma("unroll") for (int n = 0; n < 2; ++n) _Pragma("unroll") for (int k = 0; k < 2; ++k) dst[n][k] = *(const PG8_LAS bf16x8*)(lds + PG8_SB(b, h) + boff + n * 2048 + k * 1024); } while (0)
#define PG8_MMA(ai, bj, At, Bt) do { __builtin_amdgcn_s_setprio(1); _Pragma("unroll") for (int m = 0; m < 4; ++m) _Pragma("unroll") for (int n = 0; n < 2; ++n) _Pragma("unroll") for (int k = 0; k < 2; ++k) \
        acc[ai][bj][m][n] = __builtin_amdgcn_mfma_f32_16x16x32_bf16(Bt[n][k], At[m][k], acc[ai][bj][m][n], 0, 0, 0); __builtin_amdgcn_s_setprio(0); } while (0)
#define PG8_WAIT_V(n) asm volatile("s_waitcnt vmcnt(" #n ")" ::: "memory")
#define PG8_WAIT_L(n) asm volatile("s_waitcnt lgkmcnt(" #n ")" ::: "memory")
#define PG8_BAR __builtin_amdgcn_s_barrier()
#define PG8_SCHED __builtin_amdgcn_sched_barrier(0)
    Unit cur, nxt; int ui = 0;
    if (!S.next(0, cur)) return;
    f32x4 acc[2][2][4][2];
#pragma unroll
    for (int a = 0; a < 2; ++a)
#pragma unroll
        for (int b = 0; b < 2; ++b)
#pragma unroll
            for (int m = 0; m < 4; ++m)
#pragma unroll
                for (int n = 0; n < 2; ++n) acc[a][b][m][n] = (f32x4){0.f, 0.f, 0.f, 0.f};
    bf16x8 At[4][2], B0[2][2], B1[2][2];
    const char* cA = (const char*)g.A + (size_t)cur.pm * tstep; const char* cB = (const char*)g.Bt + (size_t)cur.pn * tstep;
    S.a_ready(cur);
    if constexpr (SP2) {
        PG8_STAGE(PG8_SB(0, 0), cB, voffB); PG8_STAGE(PG8_SB(0, 1), cB + hstep, voffB); PG8_STAGE(PG8_SA(0, 0), cA, voffA); PG8_STAGE(PG8_SA(0, 1), cA + hstep, voffA);
        if (wr == 1) PG8_BAR;
        PG8_WAIT_V(2); PG8_BAR;
        PG8_STAGE(PG8_SB(1, 0), cB + kstep, voffB); PG8_STAGE(PG8_SA(1, 0), cA + kstep, voffA); PG8_STAGE(PG8_SB(1, 1), cB + hstep + kstep, voffB);
        PG8_WAIT_V(6); PG8_BAR;
    } else {
        PG8_STAGE(PG8_SB(0, 0), cB, voffB); PG8_STAGE(PG8_SA(0, 0), cA, voffA); PG8_STAGE(PG8_SB(0, 1), cB + hstep, voffB); PG8_STAGE(PG8_SA(0, 1), cA + hstep, voffA);
        if (wr == 1) PG8_BAR;
        PG8_WAIT_V(4); PG8_BAR;
        PG8_STAGE(PG8_SB(1, 0), cB + kstep, voffB); PG8_STAGE(PG8_SA(1, 0), cA + kstep, voffA); PG8_STAGE(PG8_SB(1, 1), cB + hstep + kstep, voffB);
        PG8_WAIT_V(6); PG8_BAR;
    }
    for (;;) {
        const bool has_next = S.next(ui + 1, nxt);
        const char* nA = has_next ? (const char*)g.A + (size_t)nxt.pm * tstep : cA; const char* nB = has_next ? (const char*)g.Bt + (size_t)nxt.pn * tstep : cB;
        for (int t = 0; t < nt; t += 2) {
            const bool last = (t == nt - 2);
            const char* a1 = cA + (size_t)(t + 1) * kstep;
            const char* a2 = last ? nA : cA + (size_t)(t + 2) * kstep; const char* b2 = last ? nB : cB + (size_t)(t + 2) * kstep;
            const char* a3 = a2 + kstep; const char* b3 = b2 + kstep;
            if (last && has_next) S.a_ready(nxt);
            if constexpr (SP2) {
            PG8_LDB(B0, 0, 0); PG8_LDB(B1, 0, 1); PG8_SCHED; PG8_LDA(At, 0, 0); PG8_STAGE(PG8_SA(1, 1), a1 + hstep, voffA);
            PG8_WAIT_V(8); PG8_WAIT_L(0); PG8_BAR; PG8_MMA(0, 0, At, B0); PG8_MMA(0, 1, At, B1); PG8_BAR; PG8_SCHED;
            PG8_LDA(At, 0, 1); PG8_STAGE(PG8_SB(0, 0), b2, voffB); PG8_STAGE(PG8_SB(0, 1), b2 + hstep, voffB); PG8_STAGE(PG8_SA(0, 0), a2, voffA);
            PG8_WAIT_V(8); PG8_WAIT_L(0); PG8_BAR; PG8_MMA(1, 0, At, B0); PG8_MMA(1, 1, At, B1); PG8_BAR; PG8_SCHED;
            PG8_LDB(B0, 1, 0); PG8_LDB(B1, 1, 1); PG8_SCHED; PG8_LDA(At, 1, 0); PG8_STAGE(PG8_SA(0, 1), a2 + hstep, voffA);
            PG8_WAIT_V(8); PG8_WAIT_L(0); PG8_BAR; PG8_MMA(0, 0, At, B0); PG8_MMA(0, 1, At, B1); PG8_BAR; PG8_SCHED;
            PG8_LDA(At, 1, 1); PG8_STAGE(PG8_SB(1, 0), b3, voffB); PG8_STAGE(PG8_SB(1, 1), b3 + hstep, voffB); PG8_STAGE(PG8_SA(1, 0), a3, voffA);
            PG8_WAIT_V(8); PG8_WAIT_L(0); PG8_BAR; PG8_MMA(1, 0, At, B0); PG8_MMA(1, 1, At, B1); PG8_BAR; PG8_SCHED;
            } else {
            PG8_LDB(B0, 0, 0); PG8_SCHED; PG8_LDA(At, 0, 0); PG8_STAGE(PG8_SA(1, 1), a1 + hstep, voffA);
            PG8_WAIT_L(8); PG8_BAR; PG8_WAIT_L(0); PG8_MMA(0, 0, At, B0); PG8_BAR; PG8_SCHED;
            PG8_LDB(B1, 0, 1); PG8_STAGE(PG8_SB(0, 0), b2, voffB);
            PG8_BAR; PG8_WAIT_L(0); PG8_MMA(0, 1, At, B1); PG8_BAR;
            PG8_LDA(At, 0, 1); PG8_STAGE(PG8_SA(0, 0), a2, voffA);
            PG8_BAR; PG8_WAIT_L(0); PG8_MMA(1, 0, At, B0); PG8_BAR; PG8_SCHED;
            PG8_STAGE(PG8_SB(0, 1), b2 + hstep, voffB);
            PG8_WAIT_V(6); PG8_BAR; PG8_MMA(1, 1, At, B1); PG8_BAR;
            PG8_LDB(B0, 1, 0); PG8_SCHED; PG8_LDA(At, 1, 0); PG8_STAGE(PG8_SA(0, 1), a2 + hstep, voffA);
            PG8_WAIT_L(8); PG8_BAR; PG8_WAIT_L(0); PG8_MMA(0, 0, At, B0); PG8_BAR; PG8_SCHED;
            PG8_LDB(B1, 1, 1); PG8_STAGE(PG8_SB(1, 0), b3, voffB);
            PG8_BAR; PG8_WAIT_L(0); PG8_MMA(0, 1, At, B1); PG8_BAR;
            PG8_LDA(At, 1, 1); PG8_STAGE(PG8_SA(1, 0), a3, voffA);
            PG8_BAR; PG8_WAIT_L(0); PG8_MMA(1, 0, At, B0); PG8_BAR; PG8_SCHED;
            PG8_STAGE(PG8_SB(1, 1), b3 + hstep, voffB);
            PG8_WAIT_V(6); PG8_BAR; PG8_MMA(1, 1, At, B1); PG8_BAR;
            }
        }
        if constexpr (ALIGN_EPI) { if (wr == 0) PG8_BAR; }
        if constexpr (!Epi::AFTER_DRAIN) { E(acc, cur, wr, wc, fr, fq); S.done(cur); }
        if (!has_next) break;
#pragma unroll
        for (int a = 0; a < 2; ++a)
#pragma unroll
            for (int b = 0; b < 2; ++b)
#pragma unroll
                for (int m = 0; m < 4; ++m)
#pragma unroll
                    for (int n = 0; n < 2; ++n) acc[a][b][m][n] = (f32x4){0.f, 0.f, 0.f, 0.f};
        cur = nxt; cA = nA; cB = nB; ++ui;
        if constexpr (ALIGN_EPI) { if (wr == 1) PG8_BAR; }
    }
    PG8_WAIT_V(0);
    if constexpr (!ALIGN_EPI) { if (wr == 0) PG8_BAR; }
    PG8_BAR;
#undef PG8_SA
#undef PG8_SB
#undef PG8_STAGE
#undef PG8_LDA
#undef PG8_LDB
#undef PG8_MMA
#undef PG8_WAIT_V
#undef PG8_WAIT_L
#undef PG8_BAR
#undef PG8_SCHED
}
}

constexpr int NWAVES = 8, NTHR = 512;
constexpr int SEQ = 16384, DM = 2048, HD = 128, NHG = 8, DPROJ = 8208, NPJ = 8192, DFF = 5632, CH = 128, NCH = SEQ / CH, NHEADS = 16;
constexpr float NORM_EPS = 1e-6f;
constexpr int N_LAUNCHES = MK_N_LAUNCHES, NPHASES = 10;
constexpr int PC_MQ = 0, PC_MK = 1024, PC_MV = 2048, PC_MO = 3072, PC_RQ = 4096, PC_RK = 5120, PC_RV = 6144, PC_RG = 7168;

constexpr size_t MiB = 1u << 20;
constexpr size_t WS_CTL = 0, CTL_ZERO_BYTES = 64 * 1024;
constexpr size_t WS_WIN = 2 * MiB, WS_WO = 34 * MiB, WS_WGU = 42 * MiB, WS_WD = 86 * MiB;
constexpr size_t WS_PRE = 108 * MiB;
constexpr size_t WS_RS = 109 * MiB;
constexpr size_t WS_NLOC = 110 * MiB;
constexpr size_t WS_N0 = 110 * MiB + 512 * 1024;
constexpr size_t WS_DEC = 111 * MiB;
constexpr size_t WS_GHEAD = 111 * MiB + 65536;
constexpr size_t WS_COS = 112 * MiB, WS_SIN = 116 * MiB;
constexpr size_t WS_B = 128 * MiB;
constexpr size_t WS_A = 384 * MiB;
constexpr size_t WS_FF = WS_B + 176 * MiB;
constexpr size_t WS_END = 448 * MiB;
constexpr int CW_BAR = 1024;

constexpr int RING_BYTES = 131072;
constexpr int GATE_OFF = RING_BYTES;
constexpr int N0B_OFF = GATE_OFF + 8 * 1536;
constexpr int CONVW_OFF = N0B_OFF + 256;
constexpr int MISC_OFF = CONVW_OFF + 5120;
constexpr int LDS_BYTES = 163840;
static_assert(MISC_OFF + 1024 + 5120 <= LDS_BYTES, "LDS map");

#define GAS __attribute__((address_space(1)))
#define LAS __attribute__((address_space(3)))
#define DI __device__ __forceinline__
typedef unsigned short bf16;
typedef unsigned u32x4 __attribute__((ext_vector_type(4)));
typedef unsigned u32x2 __attribute__((ext_vector_type(2)));
typedef float f32x4 __attribute__((ext_vector_type(4)));
typedef float f32x2 __attribute__((ext_vector_type(2)));
typedef LAS unsigned char* ldsp;
#define LDS_WAIT() asm volatile("s_waitcnt lgkmcnt(0)" ::: "memory")

DI unsigned f2bf(float f) { unsigned u = __builtin_bit_cast(unsigned, f); return (u + 0x7fffu + ((u >> 16) & 1u)) >> 16; }
DI unsigned pk2(float lo, float hi) { unsigned r; asm volatile("v_cvt_pk_bf16_f32 %0, %1, %2" : "=v"(r) : "v"(lo), "v"(hi)); return r; }
DI float bflo(unsigned w) { return __builtin_bit_cast(float, w << 16); }
DI float bfhi(unsigned w) { return __builtin_bit_cast(float, w & 0xffff0000u); }
DI void unpack8(const u32x4 w, float (&f)[8]) { f[0] = bflo(w.x); f[1] = bfhi(w.x); f[2] = bflo(w.y); f[3] = bfhi(w.y); f[4] = bflo(w.z); f[5] = bfhi(w.z); f[6] = bflo(w.w); f[7] = bfhi(w.w); }
DI u32x4 pack8(const float (&f)[8]) { u32x4 w; w.x = pk2(f[0], f[1]); w.y = pk2(f[2], f[3]); w.z = pk2(f[4], f[5]); w.w = pk2(f[6], f[7]); return w; }
DI float sigmoid_f(float x) { return __builtin_amdgcn_rcpf(1.0f + __expf(-x)); }
DI float silu_f(float x) { return x * __builtin_amdgcn_rcpf(1.0f + __expf(-x)); }
DI float wave_sum(float v) {
#pragma unroll
    for (int o = 1; o < 64; o <<= 1) v += __shfl_xor(v, o);
    return v;
}

#define XB_TMO      128
#define XB_XCNT(j)  (256  + 64 * (j))
#define XB_XSUB(j)  (1280 + 64 * (j))
#define XB_XGEN(j)  (2304 + 64 * (j))
#define XB_TOP      3328
#define XB_TOPGEN   3392
#define XCD_BAR_WORDS 3456
#define XB_SPIN_CAP (1u << 18)
__device__ __forceinline__ unsigned xb_ld(unsigned* p)              { return __hip_atomic_load(p, __ATOMIC_RELAXED, __HIP_MEMORY_SCOPE_AGENT); }
__device__ __forceinline__ unsigned xb_add(unsigned* p, unsigned v) { return __hip_atomic_fetch_add(p, v, __ATOMIC_RELAXED, __HIP_MEMORY_SCOPE_AGENT); }
__device__ __forceinline__ unsigned xb_xcc_id() { return (unsigned)__builtin_amdgcn_s_getreg((3 << 11) | 20) & 0xFu; }
#define XB_SPIN(cond, bar) do { unsigned _sp = 0; while (cond) { __builtin_amdgcn_s_sleep(1); \
    if ((++_sp & 255u) == 0u) { if (xb_ld(&(bar)[XB_TMO])) break; if (_sp > XB_SPIN_CAP) { atomicAdd(&(bar)[XB_TMO], 1u); break; } } } } while (0)
struct XcdBarrier { unsigned* bar; unsigned x; volatile LAS unsigned* st; };
__device__ __forceinline__ XcdBarrier xcd_barrier_post(unsigned* bar, volatile LAS unsigned* st) {
    XcdBarrier b; b.bar = bar; b.x = xb_xcc_id(); b.st = st;
    if (threadIdx.x == 0) (void)xb_add(&bar[XB_XCNT(b.x)], 1u);
    return b;
}
__device__ __forceinline__ void xcd_barrier_complete(unsigned* bar, unsigned x, unsigned& nloc, unsigned& nx) {
    const unsigned G = gridDim.x * gridDim.y * gridDim.z;
    unsigned sum, cnt, mine, sp = 0u;
    for (;;) {
        sum = 0u; cnt = 0u; mine = 0u;
#pragma unroll
        for (unsigned j = 0; j < 16; ++j) { const unsigned c = xb_ld(&bar[XB_XCNT(j)]); sum += c; cnt += (c > 0u) ? 1u : 0u; mine = (j == x) ? c : mine; }
        if (sum == G) break;
        __builtin_amdgcn_s_sleep(1);
        if ((++sp & 255u) == 0u) { if (xb_ld(&bar[XB_TMO])) break; if (sp > XB_SPIN_CAP) { atomicAdd(&bar[XB_TMO], 1u); break; } }
    }
    nloc = mine > 0u ? mine : 1u; nx = cnt > 0u ? cnt : 1u;
}
__device__ __forceinline__ void xcd_barrier(const XcdBarrier& b) {
    asm volatile("s_waitcnt vmcnt(0)" ::: "memory");
    __syncthreads();
    if (threadIdx.x == 0) {
        unsigned* bar = b.bar;
        __builtin_amdgcn_s_waitcnt(0);
        unsigned nloc = b.st[0], nx = b.st[1];
        if (nloc == 0u) { xcd_barrier_complete(bar, b.x, nloc, nx); b.st[0] = nloc; b.st[1] = nx; }
        const unsigned old = xb_add(&bar[XB_XSUB(b.x)], 1u);
        const unsigned gen = old / nloc;
        if (old + 1u == (gen + 1u) * nloc) {
            __builtin_amdgcn_fence(__ATOMIC_RELEASE, "agent");
            asm volatile("s_waitcnt vmcnt(0)" ::: "memory");
            const unsigned og = xb_add(&bar[XB_TOP], 1u);
            const unsigned tg = og / nx;
            if (og + 1u == (tg + 1u) * nx) xb_add(&bar[XB_TOPGEN], 1u);
            else XB_SPIN(xb_ld(&bar[XB_TOPGEN]) == tg, bar);
            __builtin_amdgcn_fence(__ATOMIC_ACQUIRE, "agent");
            xb_add(&bar[XB_XGEN(b.x)], 1u);
            asm volatile("s_waitcnt vmcnt(0)" ::: "memory");
        } else {
            XB_SPIN(xb_ld(&bar[XB_XGEN(b.x)]) == gen, bar);
            __builtin_amdgcn_fence(__ATOMIC_ACQUIRE, "agent");
            asm volatile("s_waitcnt vmcnt(0)" ::: "memory");
        }
    }
    __syncthreads();
}

struct Args { const void* in[17]; float* out; unsigned char* ws; int ph_lo, ph_hi, li, pad; };
enum { IN_X = 0, IN_POS, IN_GPRE, IN_WIN, IN_CW, IN_CB, IN_BI, IN_BF, IN_GMH, IN_GRH, IN_WOUT, IN_GPOST, IN_GFPRE, IN_WG, IN_WU, IN_WDN, IN_GFPOST };

struct TrItem { const float* W; bf16* WT; int K, ldw, src_col, dst_row, kb; };
DI void p0_tr_load(const TrItem& it, int lane, f32x4 (&v)[8]) {
    const float* src = it.W + (size_t)(64 * it.kb + (lane >> 3)) * it.ldw + it.src_col + 4 * (lane & 7);
#pragma unroll
    for (int i = 0; i < 8; ++i) v[i] = *(const GAS f32x4*)(src + (size_t)(8 * i) * it.ldw);
}
DI void p0_tr_store(const TrItem& it, int lane, const f32x4 (&v)[8], LAS float* scr) {
#pragma unroll
    for (int i = 0; i < 8; ++i) *(LAS f32x4*)(scr + (8 * i + (lane >> 3)) * 36 + 4 * (lane & 7)) = v[i];
    LDS_WAIT(); asm volatile("" ::: "memory");
    const int c = lane & 7;
#pragma unroll
    for (int j = 0; j < 4; ++j) { const int n = (lane >> 3) + 8 * j; const LAS float* sp = scr + (8 * c) * 36 + n;
        u32x4 o; o.x = pk2(sp[0 * 36], sp[1 * 36]); o.y = pk2(sp[2 * 36], sp[3 * 36]); o.z = pk2(sp[4 * 36], sp[5 * 36]); o.w = pk2(sp[6 * 36], sp[7 * 36]);
        *(GAS u32x4*)(it.WT + (size_t)(it.dst_row + n) * it.K + 64 * it.kb + 8 * c) = o; }
    LDS_WAIT(); asm volatile("" ::: "memory");
}
constexpr int I_IN = 32 * 256, I_O = 32 * 64, I_G = 32 * 176, I_D = 88 * 64;
DI TrItem tr_item(const Args& a, int set, int r) {
    TrItem it;
    if (set == 0) { const int kb = r / 256, nb = r % 256; it.W = (const float*)a.in[IN_WIN]; it.WT = (bf16*)(a.ws + WS_WIN); it.K = DM; it.ldw = DPROJ; it.src_col = nb < 128 ? 32 * nb : 4112 + 32 * (nb - 128); it.dst_row = 32 * nb; it.kb = kb; return it; }
    if (r < I_O) { const int kb = r / 64, nb = r % 64; it.W = (const float*)a.in[IN_WOUT]; it.WT = (bf16*)(a.ws + WS_WO); it.K = DM; it.ldw = DM; it.src_col = 32 * nb; it.dst_row = 32 * nb; it.kb = kb; return it; } r -= I_O;
    if (r < I_G) { const int kb = r / 176, nb = r % 176; it.W = (const float*)a.in[IN_WG]; it.WT = (bf16*)(a.ws + WS_WGU); it.K = DM; it.ldw = DFF; it.src_col = 32 * nb; it.dst_row = 256 * (nb >> 2) + 32 * (nb & 3); it.kb = kb; return it; } r -= I_G;
    if (r < I_G) { const int kb = r / 176, nb = r % 176; it.W = (const float*)a.in[IN_WU]; it.WT = (bf16*)(a.ws + WS_WGU); it.K = DM; it.ldw = DFF; it.src_col = 32 * nb; it.dst_row = 256 * (nb >> 2) + 128 + 32 * (nb & 3); it.kb = kb; return it; } r -= I_G;
    { const int kb = r / 64, nb = r % 64; it.W = (const float*)a.in[IN_WDN]; it.WT = (bf16*)(a.ws + WS_WD); it.K = DFF; it.ldw = DM; it.src_col = 32 * nb; it.dst_row = 32 * nb; it.kb = kb; return it; }
}
DI void convert_weights(const Args& a, ldsp lds, int set, int lane, int wave, int vcu, int G) {
    const int gw = vcu * NWAVES + wave, NGW = G * NWAVES, nitems = set == 0 ? I_IN : I_O + 2 * I_G + I_D;
    LAS float* scr = (LAS float*)(lds + wave * 16384);
    f32x4 va[8], vb[8];
    int it = gw; if (it < nitems) p0_tr_load(tr_item(a, set, it), lane, va);
    for (; it < nitems; it += 2 * NGW) {
        if (it + NGW < nitems) p0_tr_load(tr_item(a, set, it + NGW), lane, vb);
        p0_tr_store(tr_item(a, set, it), lane, va, scr);
        if (it + 2 * NGW < nitems) p0_tr_load(tr_item(a, set, it + 2 * NGW), lane, va);
        if (it + NGW < nitems) p0_tr_store(tr_item(a, set, it + NGW), lane, vb, scr);
    }
}
typedef float f32x4g __attribute__((ext_vector_type(4)));
DI void p0_gates(const Args& a, ldsp lds, int tid, int lane, int wave, int vcu, int G) {
    const float* x = (const float*)a.in[IN_X]; const float* gpre = (const float*)a.in[IN_GPRE]; const float* w_in = (const float*)a.in[IN_WIN]; float* PRE = (float*)(a.ws + WS_PRE);
    LAS float* Wl = (LAS float*)lds;
    LAS float* part = (LAS float*)(lds + MISC_OFF + 1024);
#pragma unroll 4
    for (int i = 0; i < 16; ++i) { const int idx = tid + NTHR * i, k = idx >> 2, c4 = idx & 3;
        f32x4 w = *(const GAS f32x4*)(w_in + (size_t)k * DPROJ + 4096 + 4 * c4); w = w * gpre[k];
        const int row = (k & ~15) + 4 * (k & 3) + ((k >> 2) & 3);
        *(LAS f32x4*)(Wl + row * 16 + 4 * c4) = w; }
    LDS_WAIT(); __syncthreads();
    for (int rb = vcu; rb < SEQ / 64; rb += G) {
        const int tile = wave & 3, kh = wave >> 2, row = lane & 15, q = lane >> 4, t0 = rb * 64 + tile * 16;
        const GAS f32x4* xr = (const GAS f32x4*)(x + (size_t)(t0 + row) * DM + kh * 1024 + 4 * q);
        const LAS float* wl = Wl + (kh * 1024 + q) * 16 + row;
        f32x4g acc = {0.f, 0.f, 0.f, 0.f}; float ss = 0.f;
        for (int sp = 0; sp < 64; sp += 4) { f32x4 xv[4];
#pragma unroll
            for (int j = 0; j < 4; ++j) xv[j] = xr[4 * (sp + j)];
#pragma unroll
            for (int j = 0; j < 4; ++j) { ss += (xv[j].x * xv[j].x + xv[j].y * xv[j].y) + (xv[j].z * xv[j].z + xv[j].w * xv[j].w);
                const LAS float* wp = wl + (sp + j) * 256;
                acc = __builtin_amdgcn_mfma_f32_16x16x4f32(xv[j].x, wp[0], acc, 0, 0, 0); acc = __builtin_amdgcn_mfma_f32_16x16x4f32(xv[j].y, wp[64], acc, 0, 0, 0);
                acc = __builtin_amdgcn_mfma_f32_16x16x4f32(xv[j].z, wp[128], acc, 0, 0, 0); acc = __builtin_amdgcn_mfma_f32_16x16x4f32(xv[j].w, wp[192], acc, 0, 0, 0); } }
        if (kh == 1) {
#pragma unroll
            for (int j = 0; j < 4; ++j) part[(tile * 4 + j) * 64 + lane] = acc[j];
            part[1024 + tile * 64 + lane] = ss; }
        LDS_WAIT(); __syncthreads();
        if (kh == 0) {
#pragma unroll
            for (int j = 0; j < 4; ++j) acc[j] += part[(tile * 4 + j) * 64 + lane];
            ss += part[1024 + tile * 64 + lane];
            ss += __shfl_xor(ss, 16); ss += __shfl_xor(ss, 32);
            const float rs = 1.0f / sqrtf(ss * (1.0f / DM) + NORM_EPS);
#pragma unroll
            for (int j = 0; j < 4; ++j) { const int ri = 4 * q + j; const float rsi = __shfl(rs, ri); PRE[(size_t)(t0 + ri) * 16 + row] = acc[j] * rsi; } }
        __syncthreads();
    }
}
DI void phase_p0(const Args& a, ldsp lds, int tid, int lane, int wave, int vcu, int G) {
    p0_gates(a, lds, tid, lane, wave, vcu, G);
    const int gw = vcu * NWAVES + wave, NGW = G * NWAVES;
    convert_weights(a, lds, 0, lane, wave, vcu, G);
    convert_weights(a, lds, 1, lane, wave, vcu, G);
    const float* x = (const float*)a.in[IN_X]; const float* gpre = (const float*)a.in[IN_GPRE];
    bf16* hb = (bf16*)(a.ws + WS_A);
    {
        const GAS f32x4* gr = (const GAS f32x4*)gpre + lane;
#define P0_LOAD(buf, mm) do { const GAS f32x4* xr_ = (const GAS f32x4*)(x + (size_t)(mm) * DM) + lane; _Pragma("unroll") for (int j = 0; j < 8; ++j) buf[j] = xr_[64 * j]; } while (0)
#define P0_ROW(buf, mm) do { float s_ = 0.f; _Pragma("unroll") for (int j = 0; j < 8; ++j) s_ += (buf[j].x * buf[j].x + buf[j].y * buf[j].y) + (buf[j].z * buf[j].z + buf[j].w * buf[j].w); \
            const float r_ = 1.0f / sqrtf(wave_sum(s_) * (1.0f / DM) + NORM_EPS); GAS u32x2* o_ = (GAS u32x2*)(hb + (size_t)(mm) * DM) + lane; \
            _Pragma("unroll") for (int j = 0; j < 8; ++j) { const f32x4 gg = gr[64 * j]; u32x2 w; w.x = pk2(buf[j].x * r_ * gg.x, buf[j].y * r_ * gg.y); w.y = pk2(buf[j].z * r_ * gg.z, buf[j].w * r_ * gg.w); o_[64 * j] = w; } } while (0)
        f32x4 va[8], vb[8];
        int m = gw; if (m < SEQ) P0_LOAD(va, m);
        for (; m < SEQ; m += 2 * NGW) {
            if (m + NGW < SEQ) P0_LOAD(vb, m + NGW);
            P0_ROW(va, m);
            if (m + 2 * NGW < SEQ) P0_LOAD(va, m + 2 * NGW);
            if (m + NGW < SEQ) P0_ROW(vb, m + NGW);
        }
#undef P0_LOAD
#undef P0_ROW
    }
    { float* GH = (float*)(a.ws + WS_GHEAD); const float* gmh = (const float*)a.in[IN_GMH]; const float* grh = (const float*)a.in[IN_GRH];
      for (int i = vcu * NTHR + tid; i < 1024; i += G * NTHR) GH[i] = gmh[i];
      for (int i = vcu * NTHR + tid; i < 1024; i += G * NTHR) GH[1024 + i] = grh[i]; }
    const int* pos = (const int*)a.in[IN_POS]; float* COS = (float*)(a.ws + WS_COS); float* SIN = (float*)(a.ws + WS_SIN);
    { LAS float* invf = (LAS float*)(lds + GATE_OFF);
      if (tid < 64) invf[tid] = (float)pow(10000.0, -(double)(2 * tid) / 128.0);
      LDS_WAIT(); __syncthreads();
      for (int i = vcu * NTHR + tid; i < SEQ * 64; i += G * NTHR) { const int t = i >> 6, j = i & 63;
          const float ang = (float)pos[t] * invf[j]; float sn, cs; sincosf(ang, &sn, &cs); COS[i] = cs; SIN[i] = sn; } }
}

typedef short bf16x8 __attribute__((ext_vector_type(8)));
typedef short s16x4 __attribute__((ext_vector_type(4)));
typedef float f32x16 __attribute__((ext_vector_type(16)));
#define MFMA32(a, b, c) __builtin_amdgcn_mfma_f32_32x32x16_bf16((a), (b), (c), 0, 0, 0)
DI int crow(int reg, int h) { return (reg & 3) + 8 * (reg >> 2) + 4 * h; }
DI bf16x8 bf_ones() { return (bf16x8){16256, 16256, 16256, 16256, 16256, 16256, 16256, 16256}; }
DI int offb(int row, int ch) { return 256 * row + 16 * (ch ^ (((row & 3) << 2) | ((row >> 2) & 3))); }
DI int rowbase(int row, int h) { return offb(row, h); }
DI bf16x8 rowfrag(ldsp tile, int rb, int ks) { return *(const LAS bf16x8*)(tile + (rb ^ (ks << 5))); }
DI s16x4 tr_rd(ldsp p) { return __builtin_bit_cast(s16x4, __builtin_amdgcn_ds_read_tr16_b64_v4i16((LAS s16x4*)p)); }
struct TrB { int b0, b1; };
DI TrB trbase(int c, int lane) {
    const int h = lane >> 5, blk = (lane >> 4) & 1, q = (lane & 15) >> 2, p = lane & 3, ch = 4 * c + 2 * blk + (p >> 1);
    TrB b; b.b0 = offb(8 * h + q, ch) + 8 * (p & 1); b.b1 = offb(8 * h + 4 + q, ch) + 8 * (p & 1); return b;
}
DI bf16x8 trfrag(ldsp tile, const TrB b, int ks) {
    const s16x4 lo = tr_rd(tile + b.b0 + 4096 * ks), hi = tr_rd(tile + b.b1 + 4096 * ks);
    return __builtin_shufflevector(lo, hi, 0, 1, 2, 3, 4, 5, 6, 7);
}
DI void gload8(const bf16* p, float (&f)[8]) { unpack8(*(const GAS u32x4*)p, f); }

DI void mixer_setup(const Args& a, ldsp lds, int g, int grp, int tid, int lane, int wave) {
    if (g < NHG) {
        LAS float* rowv = (LAS float*)(lds + GATE_OFF + wave * 1536); LAS float* colv = rowv + 128; LAS float* alog = rowv + 256;
        const float* PRE = (const float*)(a.ws + WS_PRE); const float bi = ((const float*)a.in[IN_BI])[g], bfg = ((const float*)a.in[IN_BF])[g];
        const int t0 = (8 * grp + wave) * CH + 2 * lane;
        const float i0 = PRE[(size_t)t0 * 16 + g] + bi, i1 = PRE[(size_t)(t0 + 1) * 16 + g] + bi;
        const float f0 = PRE[(size_t)t0 * 16 + 8 + g] + bfg, f1 = PRE[(size_t)(t0 + 1) * 16 + 8 + g] + bfg;
        const float l0 = fminf(f0, 0.f) - log1pf(__expf(-fabsf(f0))), l1 = fminf(f1, 0.f) - log1pf(__expf(-fabsf(f1)));
        float p = l0 + l1;
#pragma unroll
        for (int o = 1; o < 64; o <<= 1) { const float y = __shfl_up(p, o); if (lane >= o) p += y; }
        const float b1 = p, b0 = p - l1;
        rowv[2 * lane] = b0; rowv[2 * lane + 1] = b1; alog[2 * lane] = b0; alog[2 * lane + 1] = b1; colv[2 * lane] = i0 - b0; colv[2 * lane + 1] = i1 - b1;
        if (tid < 128) { LAS float* cwl = (LAS float*)(lds + CONVW_OFF); const float* cw = (const float*)a.in[IN_CW]; const float* cb = (const float*)a.in[IN_CB];
#pragma unroll
            for (int j = 0; j < 4; ++j) { cwl[j * 128 + tid] = cw[j * 2048 + g * HD + tid]; cwl[640 + j * 128 + tid] = cw[j * 2048 + 1024 + g * HD + tid]; }
            cwl[512 + tid] = cb[g * HD + tid]; cwl[640 + 512 + tid] = cb[1024 + g * HD + tid]; }
    } else if (tid < 128) {
        LAS float* rowv = (LAS float*)(lds + GATE_OFF); LAS float* colv = rowv + 128; LAS float* alog = rowv + 256;
        const float lg = log1pf(-exp2f(-5.0f - (float)(g - NHG)));
        rowv[tid] = (float)tid * lg; colv[tid] = -(float)tid * lg; alog[tid] = (float)(tid + 1) * lg;
    }
    LDS_WAIT(); __syncthreads();
}
template <bool WITHQ> DI void mixer_tiles(const Args& a, ldsp lds, int g, int c, const LAS float* gt, int tid) {
    const bf16* proj = (const bf16*)(a.ws + WS_B);
    const LAS float* colv = gt + 128; const float rv127 = gt[127];
    ldsp Q = lds, K = lds + 32768, V = lds + 65536;
    const float kscale = 0.08838834764831845f;
    const int sq = tid >> 4, dg = tid & 15, tb = c * CH + 4 * sq;
    u32x4 vv[4];
    if (g < NHG) {
        const bf16* pk = proj + PC_MK + g * HD + 8 * dg; const bf16* pq = proj + PC_MQ + g * HD + 8 * dg; const bf16* pv = proj + PC_MV + g * HD + 8 * dg;
        u32x4 rk[7], rq[7];
#pragma unroll
        for (int j = 0; j < 7; ++j) { const int tt = tb - 3 + j, tc = tt < 0 ? 0 : tt; rk[j] = *(const GAS u32x4*)(pk + (size_t)tc * NPJ); if (WITHQ) rq[j] = *(const GAS u32x4*)(pq + (size_t)tc * NPJ);
            if (tt < 0) { rk[j] = (u32x4){0u, 0u, 0u, 0u}; if (WITHQ) rq[j] = (u32x4){0u, 0u, 0u, 0u}; } }
#pragma unroll
        for (int i = 0; i < 4; ++i) vv[i] = *(const GAS u32x4*)(pv + (size_t)(tb + i) * NPJ);
        const LAS float* cwl = (const LAS float*)(lds + CONVW_OFF);
#pragma unroll
        for (int qk = 0; qk < (WITHQ ? 2 : 1); ++qk) {
            const LAS float* wl = cwl + (qk == 0 ? 640 : 0) + 8 * dg;
            float w[5][8];
#pragma unroll
            for (int j = 0; j < 5; ++j) { const f32x4 w0 = *(const LAS f32x4*)(wl + j * 128), w1 = *(const LAS f32x4*)(wl + j * 128 + 4); w[j][0] = w0.x; w[j][1] = w0.y; w[j][2] = w0.z; w[j][3] = w0.w; w[j][4] = w1.x; w[j][5] = w1.y; w[j][6] = w1.z; w[j][7] = w1.w; }
#pragma unroll
            for (int i = 0; i < 4; ++i) { float acc[8];
#pragma unroll
                for (int e = 0; e < 8; ++e) acc[e] = w[4][e];
#pragma unroll
                for (int j = 0; j < 4; ++j) { float uu[8]; unpack8(qk == 0 ? rk[i + j] : rq[i + j], uu);
#pragma unroll
                    for (int e = 0; e < 8; ++e) acc[e] += w[j][e] * uu[e]; }
                const int srow = 4 * sq + i; const float sc = qk == 0 ? kscale * __expf(rv127 + colv[srow]) : 1.0f;
#pragma unroll
                for (int e = 0; e < 8; ++e) acc[e] = silu_f(acc[e]) * sc;
                *(LAS u32x4*)((qk == 0 ? K : Q) + offb(srow, dg)) = pack8(acc); }
        }
    } else {
        const int gr = g - NHG; const float* COS = (const float*)(a.ws + WS_COS); const float* SIN = (const float*)(a.ws + WS_SIN);
        const int s2 = tid >> 3, dgp = tid & 7;
        const bf16* pv = proj + PC_RV + gr * HD + 8 * dg;
        u32x4 klo[2], khi[2], qlo[2], qhi[2]; f32x4 cs[2][2], sn[2][2];
#pragma unroll
        for (int i = 0; i < 2; ++i) { const size_t t = (size_t)(c * CH + 2 * s2 + i); const bf16* pr = proj + t * NPJ + gr * HD + 8 * dgp;
            klo[i] = *(const GAS u32x4*)(pr + PC_RK); khi[i] = *(const GAS u32x4*)(pr + PC_RK + 64);
            if (WITHQ) { qlo[i] = *(const GAS u32x4*)(pr + PC_RQ); qhi[i] = *(const GAS u32x4*)(pr + PC_RQ + 64); }
            cs[i][0] = *(const GAS f32x4*)(COS + t * 64 + 8 * dgp); cs[i][1] = *(const GAS f32x4*)(COS + t * 64 + 8 * dgp + 4);
            sn[i][0] = *(const GAS f32x4*)(SIN + t * 64 + 8 * dgp); sn[i][1] = *(const GAS f32x4*)(SIN + t * 64 + 8 * dgp + 4); }
#pragma unroll
        for (int i = 0; i < 4; ++i) vv[i] = *(const GAS u32x4*)(pv + (size_t)(tb + i) * NPJ);
#pragma unroll
        for (int i = 0; i < 2; ++i) { const int srow = 2 * s2 + i;
            const float c8[8] = {cs[i][0].x, cs[i][0].y, cs[i][0].z, cs[i][0].w, cs[i][1].x, cs[i][1].y, cs[i][1].z, cs[i][1].w};
            const float s8[8] = {sn[i][0].x, sn[i][0].y, sn[i][0].z, sn[i][0].w, sn[i][1].x, sn[i][1].y, sn[i][1].z, sn[i][1].w};
            float lo[8], hi[8], olo[8], ohi[8]; unpack8(klo[i], lo); unpack8(khi[i], hi);
            const float sc = kscale * __expf(rv127 + colv[srow]);
#pragma unroll
            for (int e = 0; e < 8; ++e) { olo[e] = (lo[e] * c8[e] - hi[e] * s8[e]) * sc; ohi[e] = (hi[e] * c8[e] + lo[e] * s8[e]) * sc; }
            *(LAS u32x4*)(K + offb(srow, dgp)) = pack8(olo); *(LAS u32x4*)(K + offb(srow, 8 + dgp)) = pack8(ohi);
            if (WITHQ) { unpack8(qlo[i], lo); unpack8(qhi[i], hi);
#pragma unroll
                for (int e = 0; e < 8; ++e) { olo[e] = lo[e] * c8[e] - hi[e] * s8[e]; ohi[e] = hi[e] * c8[e] + lo[e] * s8[e]; }
                *(LAS u32x4*)(Q + offb(srow, dgp)) = pack8(olo); *(LAS u32x4*)(Q + offb(srow, 8 + dgp)) = pack8(ohi); }
        }
    }
#pragma unroll
    for (int i = 0; i < 4; ++i) *(LAS u32x4*)(V + offb(4 * sq + i, dg)) = vv[i];
    LDS_WAIT(); __syncthreads();
}

DI void phase_m1(const Args& a, ldsp lds, int tid_in, int wave, int vcu, int G) {
    float* UG = (float*)(a.ws + WS_A); float* NG = (float*)(a.ws + WS_NLOC); float* DG = (float*)(a.ws + WS_DEC);
    ldsp K = lds + 32768, V = lds + 65536; const int wi = wave >> 1, wj = wave & 1;
    for (int cg = vcu; cg < NHEADS * 16; cg += G) { const int g = cg >> 4, grp = cg & 15; const bool ml = g < NHG;
        { int tid_g = tid_in; asm volatile("" : "+v"(tid_g)); mixer_setup(a, lds, g, grp, tid_g, tid_g & 63, wave); }
        f32x16 accU[2], accN; float dsum = 0.f;
#pragma unroll
        for (int i = 0; i < 16; ++i) { accU[0][i] = 0.f; accU[1][i] = 0.f; accN[i] = 0.f; }
        for (int ci = 0; ci < 8; ++ci) { const int c = 8 * grp + ci;
            int tid_o = tid_in; asm volatile("" : "+v"(tid_o));
            const int tid = tid_o, lane = tid & 63;
            const LAS float* gt = (const LAS float*)(lds + GATE_OFF + (ml ? ci : 0) * 1536);
            mixer_tiles<false>(a, lds, g, c, gt, tid);
            const float la = gt[256 + 127], dec = __expf(la); dsum += la;
            accU[0] = accU[0] * dec; accU[1] = accU[1] * dec; accN = accN * dec;
            { const TrB tk = trbase(wi, lane), tv0 = trbase(2 * wj, lane), tv1 = trbase(2 * wj + 1, lane);
#pragma unroll
              for (int ks = 0; ks < 8; ++ks) {
                const bf16x8 af = trfrag(K, tk, ks), b0 = trfrag(V, tv0, ks), b1 = trfrag(V, tv1, ks);
                accU[0] = MFMA32(af, b0, accU[0]); accU[1] = MFMA32(af, b1, accU[1]);
                if (ml && wj == 0) accN = MFMA32(af, bf_ones(), accN);
              } }
            __syncthreads();
        }
        { int tid_o = tid_in; asm volatile("" : "+v"(tid_o)); const int lane = tid_o & 63, r = lane & 31, h = lane >> 5;
          float* o = UG + ((size_t)cg << 14) + wave * 2048 + lane;
#pragma unroll
          for (int n = 0; n < 2; ++n)
#pragma unroll
              for (int i = 0; i < 16; ++i) o[(n * 16 + i) * 64] = accU[n][i];
          if (ml && wj == 0 && r == 0) {
#pragma unroll
              for (int i = 0; i < 16; ++i) NG[(size_t)cg * HD + 32 * wi + crow(i, h)] = accN[i]; }
          if (tid_in == 0) DG[cg] = __expf(dsum); }
    }
}
DI void phase_m3(const Args& a, ldsp lds, int tid_in, int wave, int vcu, int G) {
    const bf16* proj = (const bf16*)(a.ws + WS_B); const float* UG = (const float*)(a.ws + WS_A); const float* NG = (const float*)(a.ws + WS_NLOC); const float* DG = (const float*)(a.ws + WS_DEC);
    bf16* mixb = (bf16*)a.out;
    LAS unsigned short* n0b = (LAS unsigned short*)(lds + N0B_OFF);
    ldsp Q = lds, K = lds + 32768, V = lds + 65536, C0 = lds + 98304, P = lds + 98304; LAS float* H = (LAS float*)lds;
    const int wi = wave >> 1, wj = wave & 1;
    for (int cg = vcu; cg < NHEADS * 16; cg += G) { const int g = cg >> 4, grp = cg & 15; const bool ml = g < NHG;
        { int tid_g = tid_in; asm volatile("" : "+v"(tid_g)); mixer_setup(a, lds, g, grp, tid_g, tid_g & 63, wave); }
        f32x16 accC[2], nst;
#pragma unroll
        for (int i = 0; i < 16; ++i) { accC[0][i] = 0.f; accC[1][i] = 0.f; nst[i] = 0.f; }
        { int tid_o = tid_in; asm volatile("" : "+v"(tid_o)); const int lane = tid_o & 63, h = lane >> 5;
          for (int j = 0; j < grp; ++j) { const float* us = UG + ((size_t)(g * 16 + j) << 14) + wave * 2048 + lane; const float dj = DG[g * 16 + j];
#pragma unroll
              for (int i = 0; i < 16; ++i) { accC[0][i] = dj * accC[0][i] + us[i * 64]; accC[1][i] = dj * accC[1][i] + us[(16 + i) * 64]; }
              if (ml) {
#pragma unroll
                  for (int i = 0; i < 16; ++i) nst[i] = dj * nst[i] + NG[(size_t)(g * 16 + j) * HD + 32 * wi + crow(i, h)]; } } }
        for (int ci = 0; ci < 8; ++ci) { const int c = 8 * grp + ci;
            int tid_o = tid_in; asm volatile("" : "+v"(tid_o));
            const int tid = tid_o, lane = tid & 63, r = lane & 31, h = lane >> 5;
            const LAS float* gt = (const LAS float*)(lds + GATE_OFF + (ml ? ci : 0) * 1536);
#pragma unroll
            for (int n = 0; n < 2; ++n) { const int e = 64 * wj + 32 * n + r;
#pragma unroll
                for (int i = 0; i < 16; ++i) { const int d = 32 * wi + crow(i, h); *(LAS unsigned short*)(C0 + offb(d, e >> 3) + 2 * (e & 7)) = (unsigned short)pk2(accC[n][i], accC[n][i]); } }
            if (wj == 0 && r == 0) {
#pragma unroll
                for (int i = 0; i < 16; ++i) n0b[32 * wi + crow(i, h)] = (unsigned short)pk2(nst[i], nst[i]); }
            mixer_tiles<true>(a, lds, g, c, gt, tid);
            f32x16 accO[2], accS[2], accD;
#pragma unroll
            for (int i = 0; i < 16; ++i) { accO[0][i] = 0.f; accO[1][i] = 0.f; accS[0][i] = 0.f; accS[1][i] = 0.f; accD[i] = 0.f; }
            const TrB tk = trbase(wi, lane), tv0 = trbase(2 * wj, lane), tv1 = trbase(2 * wj + 1, lane);
            const int rbq = rowbase(32 * wi + r, h), rbk = rowbase(64 * wj + r, h);
#pragma unroll
            for (int ks = 0; ks < 8; ++ks) {
                const bf16x8 af = rowfrag(Q, rbq, ks), b0 = trfrag(C0, tv0, ks), b1 = trfrag(C0, tv1, ks);
                accO[0] = MFMA32(af, b0, accO[0]); accO[1] = MFMA32(af, b1, accO[1]);
                if (ml) { const bf16x8 bn = *(const LAS bf16x8*)(n0b + 16 * ks + 8 * h); accD = MFMA32(af, bn, accD); }
            }
#pragma unroll
            for (int i = 0; i < 16; ++i) { const int t = 32 * wi + crow(i, h); const float al = __expf(gt[256 + t]); accO[0][i] *= al; accO[1][i] *= al; accD[i] *= al; }
#pragma unroll
            for (int ks = 0; ks < 8; ++ks) {
                const bf16x8 af = rowfrag(Q, rbq, ks), b0 = rowfrag(K, rbk, ks), b1 = rowfrag(K + 8192, rbk, ks);
                accS[0] = MFMA32(af, b0, accS[0]); accS[1] = MFMA32(af, b1, accS[1]);
            }
            __syncthreads();
            float fac[16]; { const float rv127 = gt[127];
#pragma unroll
              for (int i = 0; i < 16; ++i) fac[i] = __expf(gt[32 * wi + crow(i, h)] - rv127); }
#pragma unroll
            for (int n = 0; n < 2; ++n) { const int sidx = 64 * wj + 32 * n + r;
#pragma unroll
                for (int i = 0; i < 16; ++i) { const int t = 32 * wi + crow(i, h); const float val = (sidx <= t) ? accS[n][i] * fac[i] : 0.f;
                    *(LAS unsigned short*)(P + offb(t, sidx >> 3) + 2 * (sidx & 7)) = (unsigned short)pk2(val, val); } }
            LDS_WAIT(); __syncthreads();
            u32x4 gpre[2][2];
            { const int tl = tid >> 3, eg = tid & 7; const int hc = ml ? g * HD + 16 * eg : (g - NHG) * HD + 16 * eg;
#pragma unroll
              for (int hh = 0; hh < 2; ++hh) { const bf16* gp = proj + (size_t)(c * CH + 64 * hh + tl) * NPJ + (ml ? PC_MO : PC_RG) + hc; gpre[hh][0] = *(const GAS u32x4*)gp; gpre[hh][1] = *(const GAS u32x4*)(gp + 8); } }
            { const float dec = __expf(gt[256 + 127]); accC[0] = accC[0] * dec; accC[1] = accC[1] * dec; nst = nst * dec; }
#pragma unroll
            for (int ks = 0; ks < 8; ++ks) {
                const bf16x8 af = rowfrag(P, rbq, ks), ak = trfrag(K, tk, ks), b0 = trfrag(V, tv0, ks), b1 = trfrag(V, tv1, ks);
                accO[0] = MFMA32(af, b0, accO[0]); accO[1] = MFMA32(af, b1, accO[1]);
                accC[0] = MFMA32(ak, b0, accC[0]); accC[1] = MFMA32(ak, b1, accC[1]);
                if (ml) { accD = MFMA32(af, bf_ones(), accD); nst = MFMA32(ak, bf_ones(), nst); }
            }
            __syncthreads();
#pragma unroll
            for (int i = 0; i < 16; ++i) { const int t = 32 * wi + crow(i, h); const float rden = ml ? 1.0f / fmaxf(fabsf(accD[i]), 1.0f) : 1.0f;
                H[t * HD + 64 * wj + r] = accO[0][i] * rden; H[t * HD + 64 * wj + 32 + r] = accO[1][i] * rden; }
            LDS_WAIT(); __syncthreads();
#pragma unroll
            for (int hh = 0; hh < 2; ++hh) {
                const int tl = tid >> 3, eg = tid & 7, t = 64 * hh + tl;
                float hv[16]; float ss = 0.f;
#pragma unroll
                for (int q = 0; q < 4; ++q) { const f32x4 x4 = *(const LAS f32x4*)(H + t * HD + 16 * eg + 4 * q); hv[4 * q] = x4.x; hv[4 * q + 1] = x4.y; hv[4 * q + 2] = x4.z; hv[4 * q + 3] = x4.w; }
#pragma unroll
                for (int i = 0; i < 16; ++i) ss += hv[i] * hv[i];
                ss += __shfl_xor(ss, 1); ss += __shfl_xor(ss, 2); ss += __shfl_xor(ss, 4);
                const float rn = 1.0f / sqrtf(ss * (1.0f / HD) + NORM_EPS);
                const int tg = c * CH + t; const int hc = ml ? g * HD + 16 * eg : (g - NHG) * HD + 16 * eg;
                const float* gh = (const float*)(a.ws + WS_GHEAD) + (ml ? 0 : 1024) + hc;
                float ga[16]; { float t8[8]; unpack8(gpre[hh][0], t8);
#pragma unroll
                    for (int j = 0; j < 8; ++j) ga[j] = t8[j]; unpack8(gpre[hh][1], t8);
#pragma unroll
                    for (int j = 0; j < 8; ++j) ga[8 + j] = t8[j]; }
                float o[16];
#pragma unroll
                for (int i = 0; i < 16; ++i) o[i] = hv[i] * rn * gh[i] * (ml ? sigmoid_f(ga[i]) : silu_f(ga[i]));
                bf16* op = mixb + (size_t)tg * DM + (ml ? 0 : 1024) + hc;
                u32x4 w0, w1; w0.x = pk2(o[0], o[1]); w0.y = pk2(o[2], o[3]); w0.z = pk2(o[4], o[5]); w0.w = pk2(o[6], o[7]); w1.x = pk2(o[8], o[9]); w1.y = pk2(o[10], o[11]); w1.z = pk2(o[12], o[13]); w1.w = pk2(o[14], o[15]);
                *(GAS u32x4*)op = w0; *(GAS u32x4*)(op + 8) = w1;
            }
            __syncthreads();
        }
    }
}
DI void phase_r1(const Args& a, int lane, int wave, int vcu, int G) {
    const int gw = vcu * NWAVES + wave, NGW = G * NWAVES;
    const float* x = (const float*)a.in[IN_X]; const bf16* mix = (const bf16*)(a.ws + WS_B); float* x1 = a.out; bf16* h2 = (bf16*)(a.ws + WS_A);
    const GAS f32x4* gp = (const GAS f32x4*)a.in[IN_GPOST] + lane; const GAS f32x4* gf = (const GAS f32x4*)a.in[IN_GFPRE] + lane;
#define R1_LOAD(bm, bx, mm) do { const GAS u32x2* mr_ = (const GAS u32x2*)(mix + (size_t)(mm) * DM) + lane; const GAS f32x4* xr_ = (const GAS f32x4*)(x + (size_t)(mm) * DM) + lane; \
        _Pragma("unroll") for (int j = 0; j < 8; ++j) { bm[j] = mr_[64 * j]; bx[j] = xr_[64 * j]; } } while (0)
#define R1_ROW(bm, bx, mm) do { f32x4 v[8]; float s_ = 0.f; \
        _Pragma("unroll") for (int j = 0; j < 8; ++j) { v[j] = (f32x4){bflo(bm[j].x), bfhi(bm[j].x), bflo(bm[j].y), bfhi(bm[j].y)}; s_ += (v[j].x * v[j].x + v[j].y * v[j].y) + (v[j].z * v[j].z + v[j].w * v[j].w); } \
        const float r_ = 1.0f / sqrtf(wave_sum(s_) * (1.0f / DM) + NORM_EPS); float s2_ = 0.f; GAS f32x4* xo_ = (GAS f32x4*)(x1 + (size_t)(mm) * DM) + lane; \
        _Pragma("unroll") for (int j = 0; j < 8; ++j) { const f32x4 gg = gp[64 * j]; v[j] = bx[j] + v[j] * r_ * gg; xo_[64 * j] = v[j]; s2_ += (v[j].x * v[j].x + v[j].y * v[j].y) + (v[j].z * v[j].z + v[j].w * v[j].w); } \
        const float r2_ = 1.0f / sqrtf(wave_sum(s2_) * (1.0f / DM) + NORM_EPS); GAS u32x2* o_ = (GAS u32x2*)(h2 + (size_t)(mm) * DM) + lane; \
        _Pragma("unroll") for (int j = 0; j < 8; ++j) { const f32x4 gg = gf[64 * j]; u32x2 w; w.x = pk2(v[j].x * r2_ * gg.x, v[j].y * r2_ * gg.y); w.y = pk2(v[j].z * r2_ * gg.z, v[j].w * r2_ * gg.w); o_[64 * j] = w; } } while (0)
    u32x2 ma[8], mb[8]; f32x4 xa[8], xb[8];
    int m = gw; if (m < SEQ) R1_LOAD(ma, xa, m);
    for (; m < SEQ; m += 2 * NGW) {
        if (m + NGW < SEQ) R1_LOAD(mb, xb, m + NGW);
        R1_ROW(ma, xa, m);
        if (m + 2 * NGW < SEQ) R1_LOAD(ma, xa, m + 2 * NGW);
        if (m + NGW < SEQ) R1_ROW(mb, xb, m + NGW);
    }
#undef R1_LOAD
#undef R1_ROW
}
DI void phase_r2(const Args& a, int lane, int wave, int vcu, int G, bool poison) {
    const int gw = vcu * NWAVES + wave, NGW = G * NWAVES;
    const bf16* ff = (const bf16*)(a.ws + WS_FF); float* out = a.out; const GAS f32x4* gp = (const GAS f32x4*)a.in[IN_GFPOST] + lane;
    const float qn = __builtin_nanf("");
#define R2_LOAD(bm, bx, mm) do { const GAS u32x2* fr_ = (const GAS u32x2*)(ff + (size_t)(mm) * DM) + lane; const GAS f32x4* xr_ = (const GAS f32x4*)(out + (size_t)(mm) * DM) + lane; \
        _Pragma("unroll") for (int j = 0; j < 8; ++j) { bm[j] = fr_[64 * j]; bx[j] = xr_[64 * j]; } } while (0)
#define R2_ROW(bm, bx, mm) do { f32x4 v[8]; float s_ = 0.f; \
        _Pragma("unroll") for (int j = 0; j < 8; ++j) { v[j] = (f32x4){bflo(bm[j].x), bfhi(bm[j].x), bflo(bm[j].y), bfhi(bm[j].y)}; s_ += (v[j].x * v[j].x + v[j].y * v[j].y) + (v[j].z * v[j].z + v[j].w * v[j].w); } \
        const float r_ = 1.0f / sqrtf(wave_sum(s_) * (1.0f / DM) + NORM_EPS); GAS f32x4* xo_ = (GAS f32x4*)(out + (size_t)(mm) * DM) + lane; \
        _Pragma("unroll") for (int j = 0; j < 8; ++j) { const f32x4 gg = gp[64 * j]; f32x4 o = bx[j] + v[j] * r_ * gg; if (poison) o = (f32x4){qn, qn, qn, qn}; xo_[64 * j] = o; } } while (0)
    u32x2 ma[8], mb[8]; f32x4 xa[8], xb[8];
    int m = gw; if (m < SEQ) R2_LOAD(ma, xa, m);
    for (; m < SEQ; m += 2 * NGW) {
        if (m + NGW < SEQ) R2_LOAD(mb, xb, m + NGW);
        R2_ROW(ma, xa, m);
        if (m + 2 * NGW < SEQ) R2_LOAD(ma, xa, m + 2 * NGW);
        if (m + NGW < SEQ) R2_ROW(mb, xb, m + NGW);
    }
#undef R2_LOAD
#undef R2_ROW
}

__global__ void __launch_bounds__(NTHR, 2) fwd(Args a) {
    extern __shared__ __attribute__((aligned(16))) unsigned char lds_raw[];
    ldsp lds = (ldsp)lds_raw;
    const int tid = threadIdx.x, lane = tid & 63, wave = __builtin_amdgcn_readfirstlane(tid >> 6);
    const int G = gridDim.x; const int bx = blockIdx.x; const int vcu = (G % 8 == 0) ? (bx % 8) * (G / 8) + bx / 8 : bx;
    volatile LAS unsigned* MISC = (volatile LAS unsigned*)(lds + MISC_OFF);
    if (tid < 32) MISC[tid] = 0u;
    __syncthreads();
    unsigned* ctl = (unsigned*)(a.ws + WS_CTL);
    XcdBarrier bar; bar.bar = ctl + CW_BAR; bar.x = 0; bar.st = nullptr;
    if (N_LAUNCHES == 1) bar = xcd_barrier_post(ctl + CW_BAR, MISC + 8);
    const int lo = a.ph_lo, hi = a.ph_hi;
#define IN(k) (lo <= (k) && (k) < hi)
#define SEAM(k) do { if (IN(k) && IN((k) + 1)) xcd_barrier(bar); } while (0)

#define PH1_BODY { pg8::Gemm g{(const bf16*)(a.ws + WS_A), (const bf16*)(a.ws + WS_WIN), SEQ, NPJ, DM}; pg8::StaticOrder S; S.init(SEQ, NPJ, G, bx); \
        pg8::EpiBf16 E{(bf16*)(a.ws + WS_B), NPJ}; pg8::gemm_phase<pg8::EpiBf16, pg8::StaticOrder, true, true>(lds, g, S, E); }
#define PH5_BODY { pg8::Gemm g{(const bf16*)a.out, (const bf16*)(a.ws + WS_WO), SEQ, DM, DM}; pg8::StaticOrder S; S.init(SEQ, DM, G, bx); \
        pg8::EpiBf16 E{(bf16*)(a.ws + WS_B), DM}; pg8::gemm_phase<pg8::EpiBf16, pg8::StaticOrder, true, true>(lds, g, S, E); }
#define PH7_BODY { pg8::Gemm g{(const bf16*)(a.ws + WS_A), (const bf16*)(a.ws + WS_WGU), SEQ, 2 * DFF, DM}; pg8::StaticOrder S; S.init(SEQ, 2 * DFF, G, bx); \
        pg8::EpiSwiGLU E{(bf16*)(a.ws + WS_B), DFF}; pg8::gemm_phase<pg8::EpiSwiGLU, pg8::StaticOrder, true, true>(lds, g, S, E); }
#define PH8_BODY { pg8::Gemm g{(const bf16*)(a.ws + WS_B), (const bf16*)(a.ws + WS_WD), SEQ, DM, DFF}; pg8::StaticOrder S; S.init(SEQ, DM, G, bx); \
        pg8::EpiBf16 E{(bf16*)(a.ws + WS_FF), DM}; pg8::gemm_phase<pg8::EpiBf16, pg8::StaticOrder, true, true>(lds, g, S, E); }
#define DUP(k) (((PROBE_DUP) >> (k)) & 1)
    if (IN(0)) { phase_p0(a, lds, tid, lane, wave, vcu, G); if (DUP(0)) { __syncthreads(); phase_p0(a, lds, tid, lane, wave, vcu, G); } SEAM(0); }
    if (IN(1)) { PH1_BODY if (DUP(1)) PH1_BODY SEAM(1); }
    if (IN(2)) { phase_m1(a, lds, tid, wave, vcu, G); if (DUP(2)) phase_m1(a, lds, tid, wave, vcu, G); SEAM(2); }
    if (IN(4)) { phase_m3(a, lds, tid, wave, vcu, G); if (DUP(4)) phase_m3(a, lds, tid, wave, vcu, G); SEAM(4); }
    if (IN(5)) { PH5_BODY if (DUP(5)) PH5_BODY SEAM(5); }
    if (IN(6)) { phase_r1(a, lane, wave, vcu, G); if (DUP(6)) phase_r1(a, lane, wave, vcu, G); SEAM(6); }
    if (IN(7)) { PH7_BODY if (DUP(7)) PH7_BODY SEAM(7); }
    if (IN(8)) { PH8_BODY if (DUP(8)) PH8_BODY SEAM(8); }
    if (IN(9)) {
        bool poison = false;
        if (N_LAUNCHES == 1) poison = __hip_atomic_load(ctl + CW_BAR + XB_TMO, __ATOMIC_RELAXED, __HIP_MEMORY_SCOPE_AGENT) != 0u;
        phase_r2(a, lane, wave, vcu, G, poison);
    }
#undef PH1_BODY
#undef PH5_BODY
#undef PH7_BODY
#undef PH8_BODY
#undef DUP
#undef IN
#undef SEAM
}

extern "C" void kernel_launch(void* const* d_in, const int* in_sizes, int n_in, void* d_out, int out_size, void* d_ws, size_t ws_size, hipStream_t stream) {
    static int grid = 0;
    if (grid == 0) {
        if (n_in != 17 || in_sizes[0] != SEQ * DM || out_size != SEQ * DM || ws_size < WS_END) {
            fprintf(stderr, "kernel_launch: unexpected shapes (n_in %d, in0 %d, out %d, ws %zu); nothing launched\n", n_in, n_in > 0 ? in_sizes[0] : -1, out_size, ws_size); grid = -1; return; }
        int dev = 0, cus = 0, per_cu = 0;
        if (hipGetDevice(&dev) != hipSuccess || hipDeviceGetAttribute(&cus, hipDeviceAttributeMultiprocessorCount, dev) != hipSuccess) { grid = -1; return; }
        if (hipFuncSetAttribute((const void*)fwd, hipFuncAttributeMaxDynamicSharedMemorySize, LDS_BYTES) != hipSuccess) { fprintf(stderr, "kernel_launch: hipFuncSetAttribute failed\n"); grid = -1; return; }
        if (hipOccupancyMaxActiveBlocksPerMultiprocessor(&per_cu, (const void*)fwd, NTHR, LDS_BYTES) != hipSuccess || per_cu < 1)
            fprintf(stderr, "kernel_launch: note: occupancy query reports %d workgroups per CU\n", per_cu);
        (void)hipGetLastError();
        grid = cus;
    }
    if (grid < 0) return;
    if (hipMemsetAsync((char*)d_ws + WS_CTL, 0, CTL_ZERO_BYTES, stream) != hipSuccess) return;
    Args a{};
    for (int i = 0; i < 17; ++i) a.in[i] = d_in[i];
    a.out = (float*)d_out; a.ws = (unsigned char*)d_ws;
    if (N_LAUNCHES == 1) { a.ph_lo = 0; a.ph_hi = NPHASES; a.li = 0; hipLaunchKernelGGL(fwd, dim3(grid), dim3(NTHR), LDS_BYTES, stream, a); }
    else for (int li = 0; li < NPHASES; ++li) { a.ph_lo = li; a.ph_hi = li + 1; a.li = li; hipLaunchKernelGGL(fwd, dim3(grid), dim3(NTHR), LDS_BYTES, stream, a); }
}
```

```cpp
#include <hip/hip_runtime.h>
#include <cstdio>
#include <cstdint>

#ifndef PROBE_DUP
#define PROBE_DUP 0
#endif
#ifndef MK_N_LAUNCHES
#define MK_N_LAUNCHES 1
#endif

namespace pg8 {
#define PG8_LAS __attribute__((address_space(3)))
typedef unsigned short bf16_t;
typedef short bf16x8 __attribute__((ext_vector_type(8)));
typedef float f32x4 __attribute__((ext_vector_type(4)));
typedef unsigned u32x4 __attribute__((ext_vector_type(4)));
constexpr int BM = 256, BK = 64, HALF = 128, HTB = HALF * BK * 2  , STAGE_BYTES = 8 * HTB, NXCD = 8, WGM = 4;

__host__ __device__ __forceinline__ int lds_byte(int r, int c) { const int st = (r >> 4) * 2 + (c >> 5), rr = r & 15, cc = c & 31, ob = rr * 64 + cc * 2; return st * 1024 + (ob ^ (((ob >> 9) & 1) << 5)); }
__host__ __device__ __forceinline__ void stage_rc(int b, int& R, int& C) { const int st = b / 1024, sb = b % 1024, swz = sb ^ (((sb >> 9) & 1) << 5); R = (st >> 1) * 16 + swz / 64; C = (st & 1) * 32 + (swz % 64) / 2; }
__host__ __device__ __forceinline__ int perm32(int rho) { const int n = rho >> 4, i = rho & 15; return 8 * (i >> 2) + 4 * n + (i & 3); }

struct Unit { int pm, pn; };
struct Gemm { const bf16_t* A; const bf16_t* Bt; int M, N, K; };

struct StaticOrder {
    int nM, nN, nwg, G, c;
    __host__ __device__ void init(int M, int N, int G_, int c_) { nM = M / BM; nN = N / BM; nwg = nM * nN; G = G_; c = c_; }
    __host__ __device__ bool next(int i, Unit& u) const {
        const long L = (long)i * G + c; if (L >= nwg) return false;
        int wgid = (int)L; { const int q = nwg / NXCD, r = nwg % NXCD, xcd = wgid % NXCD, off = wgid / NXCD; wgid = (xcd < r ? xcd * (q + 1) : r * (q + 1) + (xcd - r) * q) + off; }
        const int nig = WGM * nN, gid = wgid / nig, fm = gid * WGM, gsz = (nM - fm) < WGM ? (nM - fm) : WGM;
        u.pm = fm + ((wgid % nig) % gsz); u.pn = (wgid % nig) / gsz; return true;
    }
    __device__ __forceinline__ void a_ready(const Unit&) const {}
    __device__ __forceinline__ void done(const Unit&) const {}
};

__device__ __forceinline__ unsigned cvt_pk_bf16(float lo, float hi) { unsigned r; asm volatile("v_cvt_pk_bf16_f32 %0, %1, %2" : "=v"(r) : "v"(lo), "v"(hi)); return r; }

struct EpiF32 {
    static constexpr bool PERM = false, AFTER_DRAIN = false;
    float* C; int ldc;
    __device__ __forceinline__ void operator()(const f32x4 (&acc)[2][2][4][2], const Unit& u, int wr, int wc, int fr, int fq) const {
        const int row0 = u.pm * BM + wr * 64 + fr, col0 = u.pn * BM + wc * 32 + 4 * fq;
#pragma unroll
        for (int ai = 0; ai < 2; ++ai)
#pragma unroll
            for (int m = 0; m < 4; ++m) { float* rowp = C + (size_t)(row0 + ai * HALF + m * 16) * ldc + col0;
#pragma unroll
                for (int bj = 0; bj < 2; ++bj)
#pragma unroll
                    for (int n = 0; n < 2; ++n) *(f32x4*)(rowp + bj * HALF + n * 16) = acc[ai][bj][m][n]; }
    }
};
struct EpiBf16 {
    static constexpr bool PERM = true, AFTER_DRAIN = false;
    bf16_t* O; int ldc;
    __device__ __forceinline__ void operator()(const f32x4 (&acc)[2][2][4][2], const Unit& u, int wr, int wc, int fr, int fq) const {
        const int row0 = u.pm * BM + wr * 64 + fr, col0 = u.pn * BM + wc * 32 + 8 * fq;
#pragma unroll
        for (int ai = 0; ai < 2; ++ai)
#pragma unroll
            for (int m = 0; m < 4; ++m) { bf16_t* rowp = O + (size_t)(row0 + ai * HALF + m * 16) * ldc + col0;
#pragma unroll
                for (int bj = 0; bj < 2; ++bj) { const f32x4 v0 = acc[ai][bj][m][0], v1 = acc[ai][bj][m][1];
                    u32x4 w; w.x = cvt_pk_bf16(v0[0], v0[1]); w.y = cvt_pk_bf16(v0[2], v0[3]); w.z = cvt_pk_bf16(v1[0], v1[1]); w.w = cvt_pk_bf16(v1[2], v1[3]);
                    *(u32x4*)(rowp + bj * HALF) = w; } }
    }
};
__device__ __forceinline__ float silu_f(float x) { return x * __builtin_amdgcn_rcpf(1.0f + __expf(-x)); }
struct EpiSwiGLU {
    static constexpr bool PERM = true, AFTER_DRAIN = false;
    bf16_t* O; int ldc;
    __device__ __forceinline__ void operator()(const f32x4 (&acc)[2][2][4][2], const Unit& u, int wr, int wc, int fr, int fq) const {
        const int row0 = u.pm * BM + wr * 64 + fr, col0 = u.pn * HALF + wc * 32 + 8 * fq;
#pragma unroll
        for (int ai = 0; ai < 2; ++ai)
#pragma unroll
            for (int m = 0; m < 4; ++m) { bf16_t* rowp = O + (size_t)(row0 + ai * HALF + m * 16) * ldc + col0;
                const f32x4 g0 = acc[ai][0][m][0], g1 = acc[ai][0][m][1], u0 = acc[ai][1][m][0], u1 = acc[ai][1][m][1];
                u32x4 w; w.x = cvt_pk_bf16(silu_f(g0[0]) * u0[0], silu_f(g0[1]) * u0[1]); w.y = cvt_pk_bf16(silu_f(g0[2]) * u0[2], silu_f(g0[3]) * u0[3]);
                w.z = cvt_pk_bf16(silu_f(g1[0]) * u1[0], silu_f(g1[1]) * u1[1]); w.w = cvt_pk_bf16(silu_f(g1[2]) * u1[2], silu_f(g1[3]) * u1[3]);
                *(u32x4*)rowp = w; }
    }
};

template <class Epi, class Sched, bool ALIGN_EPI = false, bool SP2 = false>
__device__ __forceinline__ void gemm_phase(PG8_LAS unsigned char* lds, const Gemm g, const Sched& S, const Epi& E) {
    const int tid = threadIdx.x, wid = __builtin_amdgcn_readfirstlane(tid >> 6), lane = tid & 63, wr = wid >> 2, wc = wid & 3, fr = lane & 15, fq = lane >> 4;
    const int K = g.K, nt = K / BK;
    unsigned voffA[2], voffB[2];
#pragma unroll
    for (int i = 0; i < 2; ++i) { int R, C; stage_rc(tid * 16 + i * 8192, R, C); const int Rb = Epi::PERM ? ((R & ~31) + perm32(R & 31)) : R;
        voffA[i] = (unsigned)(R * K + C) * 2u; voffB[i] = (unsigned)(Rb * K + C) * 2u; }
    const size_t kstep = (size_t)(BK * 2);
    const size_t hstep = (size_t)HALF * K * 2;
    const size_t tstep = 2 * hstep;
    const unsigned ldsw = (unsigned)wid * 1024u;
    const int aoff = lds_byte(wr * 64 + fr, fq * 8), boff = lds_byte(wc * 32 + fr, fq * 8);
#define PG8_SA(b, h) (((b) * 2 + (h)) * HTB)
#define PG8_SB(b, h) ((4 + (b) * 2 + (h)) * HTB)
#define PG8_STAGE(bufoff, gbase, voff) do { _Pragma("unroll") for (int _i = 0; _i < 2; ++_i) \
        __builtin_amdgcn_global_load_lds((const unsigned*)((const char*)(gbase) + (voff)[_i]), (PG8_LAS unsigned*)(lds + (bufoff) + ldsw + _i * 8192), 16, 0, 0); } while (0)
#define PG8_LDA(dst, b, h) do { _Pragma("unroll") for (int m = 0; m < 4; ++m) _Pragma("unroll") for (int k = 0; k < 2; ++k) dst[m][k] = *(const PG8_LAS bf16x8*)(lds + PG8_SA(b, h) + aoff + m * 2048 + k * 1024); } while (0)
#define PG8_LDB(dst, b, h) do { _Pragma("unroll") for (int n = 0; n < 2; ++n) _Pragma("unroll") for (int k = 0; k < 2; ++k) dst[n][k] = *(const PG8_LAS bf16x8*)(lds + PG8_SB(b, h) + boff + n * 2048 + k * 1024); } while (0)
#define PG8_MMA(ai, bj, At, Bt) do { __builtin_amdgcn_s_setprio(1); _Pragma("unroll") for (int m = 0; m < 4; ++m) _Pragma("unroll") for (int n = 0; n < 2; ++n) _Pragma("unroll") for (int k = 0; k < 2; ++k) \
        acc[ai][bj][m][n] = __builtin_amdgcn_mfma_f32_16x16x32_bf16(Bt[n][k], At[m][k], acc[ai][bj][m][n], 0, 0, 0); __builtin_amdgcn_s_setprio(0); } while (0)
#define PG8_WAIT_V(n) asm volatile("s_waitcnt vmcnt(" #n ")" ::: "memory")
#define PG8_WAIT_L(n) asm volatile("s_waitcnt lgkmcnt(" #n ")" ::: "memory")
#define PG8_BAR __builtin_amdgcn_s_barrier()
#define PG8_SCHED __builtin_amdgcn_sched_barrier(0)
    Unit cur, nxt; int ui = 0;
    if (!S.next(0, cur)) return;
    f32x4 acc[2][2][4][2];
#pragma unroll
    for (int a = 0; a < 2; ++a)
#pragma unroll
        for (int b = 0; b < 2; ++b)
#pragma unroll
            for (int m = 0; m < 4; ++m)
#pragma unroll
                for (int n = 0; n < 2; ++n) acc[a][b][m][n] = (f32x4){0.f, 0.f, 0.f, 0.f};
    bf16x8 At[4][2], B0[2][2], B1[2][2];
    const char* cA = (const char*)g.A + (size_t)cur.pm * tstep; const char* cB = (const char*)g.Bt + (size_t)cur.pn * tstep;
    S.a_ready(cur);
    if constexpr (SP2) {
        PG8_STAGE(PG8_SB(0, 0), cB, voffB); PG8_STAGE(PG8_SB(0, 1), cB + hstep, voffB); PG8_STAGE(PG8_SA(0, 0), cA, voffA); PG8_STAGE(PG8_SA(0, 1), cA + hstep, voffA);
        if (wr == 1) PG8_BAR;
        PG8_WAIT_V(2); PG8_BAR;
        PG8_STAGE(PG8_SB(1, 0), cB + kstep, voffB); PG8_STAGE(PG8_SA(1, 0), cA + kstep, voffA); PG8_STAGE(PG8_SB(1, 1), cB + hstep + kstep, voffB);
        PG8_WAIT_V(6); PG8_BAR;
    } else {
        PG8_STAGE(PG8_SB(0, 0), cB, voffB); PG8_STAGE(PG8_SA(0, 0), cA, voffA); PG8_STAGE(PG8_SB(0, 1), cB + hstep, voffB); PG8_STAGE(PG8_SA(0, 1), cA + hstep, voffA);
        if (wr == 1) PG8_BAR;
        PG8_WAIT_V(4); PG8_BAR;
        PG8_STAGE(PG8_SB(1, 0), cB + kstep, voffB); PG8_STAGE(PG8_SA(1, 0), cA + kstep, voffA); PG8_STAGE(PG8_SB(1, 1), cB + hstep + kstep, voffB);
        PG8_WAIT_V(6); PG8_BAR;
    }
    for (;;) {
        const bool has_next = S.next(ui + 1, nxt);
        const char* nA = has_next ? (const char*)g.A + (size_t)nxt.pm * tstep : cA; const char* nB = has_next ? (const char*)g.Bt + (size_t)nxt.pn * tstep : cB;
        for (int t = 0; t < nt; t += 2) {
            const bool last = (t == nt - 2);
            const char* a1 = cA + (size_t)(t + 1) * kstep;
            const char* a2 = last ? nA : cA + (size_t)(t + 2) * kstep; const char* b2 = last ? nB : cB + (size_t)(t + 2) * kstep;
            const char* a3 = a2 + kstep; const char* b3 = b2 + kstep;
            if (last && has_next) S.a_ready(nxt);
            if constexpr (SP2) {
            PG8_LDB(B0, 0, 0); PG8_LDB(B1, 0, 1); PG8_SCHED; PG8_LDA(At, 0, 0); PG8_STAGE(PG8_SA(1, 1), a1 + hstep, voffA);
            PG8_WAIT_V(8); PG8_WAIT_L(0); PG8_BAR; PG8_MMA(0, 0, At, B0); PG8_MMA(0, 1, At, B1); PG8_BAR; PG8_SCHED;
            PG8_LDA(At, 0, 1); PG8_STAGE(PG8_SB(0, 0), b2, voffB); PG8_STAGE(PG8_SB(0, 1), b2 + hstep, voffB); PG8_STAGE(PG8_SA(0, 0), a2, voffA);
            PG8_WAIT_V(8); PG8_WAIT_L(0); PG8_BAR; PG8_MMA(1, 0, At, B0); PG8_MMA(1, 1, At, B1); PG8_BAR; PG8_SCHED;
            PG8_LDB(B0, 1, 0); PG8_LDB(B1, 1, 1); PG8_SCHED; PG8_LDA(At, 1, 0); PG8_STAGE(PG8_SA(0, 1), a2 + hstep, voffA);
            PG8_WAIT_V(8); PG8_WAIT_L(0); PG8_BAR; PG8_MMA(0, 0, At, B0); PG8_MMA(0, 1, At, B1); PG8_BAR; PG8_SCHED;
            PG8_LDA(At, 1, 1); PG8_STAGE(PG8_SB(1, 0), b3, voffB); PG8_STAGE(PG8_SB(1, 1), b3 + hstep, voffB); PG8_STAGE(PG8_SA(1, 0), a3, voffA);
            PG8_WAIT_V(8); PG8_WAIT_L(0); PG8_BAR; PG8_MMA(1, 0, At, B0); PG8_MMA(1, 1, At, B1); PG8_BAR; PG8_SCHED;
            } else {
            PG8_LDB(B0, 0, 0); PG8_SCHED; PG8_LDA(At, 0, 0); PG8_STAGE(PG8_SA(1, 1), a1 + hstep, voffA);
            PG8_WAIT_L(8); PG8_BAR; PG8_WAIT_L(0); PG8_MMA(0, 0, At, B0); PG8_BAR; PG8_SCHED;
            PG8_LDB(B1, 0, 1); PG8_STAGE(PG8_SB(0, 0), b2, voffB);
            PG8_BAR; PG8_WAIT_L(0); PG8_MMA(0, 1, At, B1); PG8_BAR;
            PG8_LDA(At, 0, 1); PG8_STAGE(PG8_SA(0, 0), a2, voffA);
            PG8_BAR; PG8_WAIT_L(0); PG8_MMA(1, 0, At, B0); PG8_BAR; PG8_SCHED;
            PG8_STAGE(PG8_SB(0, 1), b2 + hstep, voffB);
            PG8_WAIT_V(6); PG8_BAR; PG8_MMA(1, 1, At, B1); PG8_BAR;
            PG8_LDB(B0, 1, 0); PG8_SCHED; PG8_LDA(At, 1, 0); PG8_STAGE(PG8_SA(0, 1), a2 + hstep, voffA);
            PG8_WAIT_L(8); PG8_BAR; PG8_WAIT_L(0); PG8_MMA(0, 0, At, B0); PG8_BAR; PG8_SCHED;
            PG8_LDB(B1, 1, 1); PG8_STAGE(PG8_SB(1, 0), b3, voffB);
            PG8_BAR; PG8_WAIT_L(0); PG8_MMA(0, 1, At, B1); PG8_BAR;
            PG8_LDA(At, 1, 1); PG8_STAGE(PG8_SA(1, 0), a3, voffA);
            PG8_BAR; PG8_WAIT_L(0); PG8_MMA(1, 0, At, B0); PG8_BAR; PG8_SCHED;
            PG8_STAGE(PG8_SB(1, 1), b3 + hstep, voffB);
            PG8_WAIT_V(6); PG8_BAR; PG8_MMA(1, 1, At, B1); PG8_BAR;
            }
        }
        if constexpr (ALIGN_EPI) { if (wr == 0) PG8_BAR; }
        if constexpr (!Epi::AFTER_DRAIN) { E(acc, cur, wr, wc, fr, fq); S.done(cur); }
        if (!has_next) break;
#pragma unroll
        for (int a = 0; a < 2; ++a)
#pragma unroll
            for (int b = 0; b < 2; ++b)
#pragma unroll
                for (int m = 0; m < 4; ++m)
#pragma unroll
                    for (int n = 0; n < 2; ++n) acc[a][b][m][n] = (f32x4){0.f, 0.f, 0.f, 0.f};
        cur = nxt; cA = nA; cB = nB; ++ui;
        if constexpr (ALIGN_EPI) { if (wr == 1) PG8_BAR; }
    }
    PG8_WAIT_V(0);
    if constexpr (!ALIGN_EPI) { if (wr == 0) PG8_BAR; }
    PG8_BAR;
#undef PG8_SA
#undef PG8_SB
#undef PG8_STAGE
#undef PG8_LDA
#undef PG8_LDB
#undef PG8_MMA
#undef PG8_WAIT_V
#undef PG8_WAIT_L
#undef PG8_BAR
#undef PG8_SCHED
}
}

constexpr int NWAVES = 8, NTHR = 512;
constexpr int SEQ = 16384, DM = 2048, HD = 128, NHG = 8, DPROJ = 8208, NPJ = 8192, DFF = 5632, CH = 128, NCH = SEQ / CH, NHEADS = 16;
constexpr float NORM_EPS = 1e-6f;
constexpr int N_LAUNCHES = MK_N_LAUNCHES, NPHASES = 10;
constexpr int PC_MQ = 0, PC_MK = 1024, PC_MV = 2048, PC_MO = 3072, PC_RQ = 4096, PC_RK = 5120, PC_RV = 6144, PC_RG = 7168;

constexpr size_t MiB = 1u << 20;
constexpr size_t WS_CTL = 0, CTL_ZERO_BYTES = 64 * 1024;
constexpr size_t WS_WIN = 2 * MiB, WS_WO = 34 * MiB, WS_WGU = 42 * MiB, WS_WD = 86 * MiB;
constexpr size_t WS_PRE = 108 * MiB;
constexpr size_t WS_RS = 109 * MiB;
constexpr size_t WS_NLOC = 110 * MiB;
constexpr size_t WS_N0 = 110 * MiB + 512 * 1024;
constexpr size_t WS_DEC = 111 * MiB;
constexpr size_t WS_GHEAD = 111 * MiB + 65536;
constexpr size_t WS_COS = 112 * MiB, WS_SIN = 116 * MiB;
constexpr size_t WS_B = 128 * MiB;
constexpr size_t WS_A = 384 * MiB;
constexpr size_t WS_FF = WS_B + 176 * MiB;
constexpr size_t WS_END = 448 * MiB;
constexpr int CW_BAR = 1024;

constexpr int RING_BYTES = 131072;
constexpr int GATE_OFF = RING_BYTES;
constexpr int N0B_OFF = GATE_OFF + 8 * 1536;
constexpr int CONVW_OFF = N0B_OFF + 256;
constexpr int MISC_OFF = CONVW_OFF + 5120;
constexpr int LDS_BYTES = 163840;
static_assert(MISC_OFF + 1024 + 5120 <= LDS_BYTES, "LDS map");

#define GAS __attribute__((address_space(1)))
#define LAS __attribute__((address_space(3)))
#define DI __device__ __forceinline__
typedef unsigned short bf16;
typedef unsigned u32x4 __attribute__((ext_vector_type(4)));
typedef unsigned u32x2 __attribute__((ext_vector_type(2)));
typedef float f32x4 __attribute__((ext_vector_type(4)));
typedef float f32x2 __attribute__((ext_vector_type(2)));
typedef LAS unsigned char* ldsp;
#define LDS_WAIT() asm volatile("s_waitcnt lgkmcnt(0)" ::: "memory")

DI unsigned f2bf(float f) { unsigned u = __builtin_bit_cast(unsigned, f); return (u + 0x7fffu + ((u >> 16) & 1u)) >> 16; }
DI unsigned pk2(float lo, float hi) { unsigned r; asm volatile("v_cvt_pk_bf16_f32 %0, %1, %2" : "=v"(r) : "v"(lo), "v"(hi)); return r; }
DI float bflo(unsigned w) { return __builtin_bit_cast(float, w << 16); }
DI float bfhi(unsigned w) { return __builtin_bit_cast(float, w & 0xffff0000u); }
DI void unpack8(const u32x4 w, float (&f)[8]) { f[0] = bflo(w.x); f[1] = bfhi(w.x); f[2] = bflo(w.y); f[3] = bfhi(w.y); f[4] = bflo(w.z); f[5] = bfhi(w.z); f[6] = bflo(w.w); f[7] = bfhi(w.w); }
DI u32x4 pack8(const float (&f)[8]) { u32x4 w; w.x = pk2(f[0], f[1]); w.y = pk2(f[2], f[3]); w.z = pk2(f[4], f[5]); w.w = pk2(f[6], f[7]); return w; }
DI float sigmoid_f(float x) { return __builtin_amdgcn_rcpf(1.0f + __expf(-x)); }
DI float silu_f(float x) { return x * __builtin_amdgcn_rcpf(1.0f + __expf(-x)); }
DI float wave_sum(float v) {
#pragma unroll
    for (int o = 1; o < 64; o <<= 1) v += __shfl_xor(v, o);
    return v;
}

#define XB_TMO      128
#define XB_XCNT(j)  (256  + 64 * (j))
#define XB_XSUB(j)  (1280 + 64 * (j))
#define XB_XGEN(j)  (2304 + 64 * (j))
#define XB_TOP      3328
#define XB_TOPGEN   3392
#define XCD_BAR_WORDS 3456
#define XB_SPIN_CAP (1u << 18)
__device__ __forceinline__ unsigned xb_ld(unsigned* p)              { return __hip_atomic_load(p, __ATOMIC_RELAXED, __HIP_MEMORY_SCOPE_AGENT); }
__device__ __forceinline__ unsigned xb_add(unsigned* p, unsigned v) { return __hip_atomic_fetch_add(p, v, __ATOMIC_RELAXED, __HIP_MEMORY_SCOPE_AGENT); }
__device__ __forceinline__ unsigned xb_xcc_id() { return (unsigned)__builtin_amdgcn_s_getreg((3 << 11) | 20) & 0xFu; }
#define XB_SPIN(cond, bar) do { unsigned _sp = 0; while (cond) { __builtin_amdgcn_s_sleep(1); \
    if ((++_sp & 255u) == 0u) { if (xb_ld(&(bar)[XB_TMO])) break; if (_sp > XB_SPIN_CAP) { atomicAdd(&(bar)[XB_TMO], 1u); break; } } } } while (0)
struct XcdBarrier { unsigned* bar; unsigned x; volatile LAS unsigned* st; };
__device__ __forceinline__ XcdBarrier xcd_barrier_post(unsigned* bar, volatile LAS unsigned* st) {
    XcdBarrier b; b.bar = bar; b.x = xb_xcc_id(); b.st = st;
    if (threadIdx.x == 0) (void)xb_add(&bar[XB_XCNT(b.x)], 1u);
    return b;
}
__device__ __forceinline__ void xcd_barrier_complete(unsigned* bar, unsigned x, unsigned& nloc, unsigned& nx) {
    const unsigned G = gridDim.x * gridDim.y * gridDim.z;
    unsigned sum, cnt, mine, sp = 0u;
    for (;;) {
        sum = 0u; cnt = 0u; mine = 0u;
#pragma unroll
        for (unsigned j = 0; j < 16; ++j) { const unsigned c = xb_ld(&bar[XB_XCNT(j)]); sum += c; cnt += (c > 0u) ? 1u : 0u; mine = (j == x) ? c : mine; }
        if (sum == G) break;
        __builtin_amdgcn_s_sleep(1);
        if ((++sp & 255u) == 0u) { if (xb_ld(&bar[XB_TMO])) break; if (sp > XB_SPIN_CAP) { atomicAdd(&bar[XB_TMO], 1u); break; } }
    }
    nloc = mine > 0u ? mine : 1u; nx = cnt > 0u ? cnt : 1u;
}
__device__ __forceinline__ void xcd_barrier(const XcdBarrier& b) {
    asm volatile("s_waitcnt vmcnt(0)" ::: "memory");
    __syncthreads();
    if (threadIdx.x == 0) {
        unsigned* bar = b.bar;
        __builtin_amdgcn_s_waitcnt(0);
        unsigned nloc = b.st[0], nx = b.st[1];
        if (nloc == 0u) { xcd_barrier_complete(bar, b.x, nloc, nx); b.st[0] = nloc; b.st[1] = nx; }
        const unsigned old = xb_add(&bar[XB_XSUB(b.x)], 1u);
        const unsigned gen = old / nloc;
        if (old + 1u == (gen + 1u) * nloc) {
            __builtin_amdgcn_fence(__ATOMIC_RELEASE, "agent");
            asm volatile("s_waitcnt vmcnt(0)" ::: "memory");
            const unsigned og = xb_add(&bar[XB_TOP], 1u);
            const unsigned tg = og / nx;
            if (og + 1u == (tg + 1u) * nx) xb_add(&bar[XB_TOPGEN], 1u);
            else XB_SPIN(xb_ld(&bar[XB_TOPGEN]) == tg, bar);
            __builtin_amdgcn_fence(__ATOMIC_ACQUIRE, "agent");
            xb_add(&bar[XB_XGEN(b.x)], 1u);
            asm volatile("s_waitcnt vmcnt(0)" ::: "memory");
        } else {
            XB_SPIN(xb_ld(&bar[XB_XGEN(b.x)]) == gen, bar);
            __builtin_amdgcn_fence(__ATOMIC_ACQUIRE, "agent");
            asm volatile("s_waitcnt vmcnt(0)" ::: "memory");
        }
    }
    __syncthreads();
}

struct Args { const void* in[17]; float* out; unsigned char* ws; int ph_lo, ph_hi, li, pad; };
enum { IN_X = 0, IN_POS, IN_GPRE, IN_WIN, IN_CW, IN_CB, IN_BI, IN_BF, IN_GMH, IN_GRH, IN_WOUT, IN_GPOST, IN_GFPRE, IN_WG, IN_WU, IN_WDN, IN_GFPOST };

struct TrItem { const float* W; bf16* WT; int K, ldw, src_col, dst_row, kb; };
DI void p0_tr_load(const TrItem& it, int lane, f32x4 (&v)[8]) {
    const float* src = it.W + (size_t)(64 * it.kb + (lane >> 3)) * it.ldw + it.src_col + 4 * (lane & 7);
#pragma unroll
    for (int i = 0; i < 8; ++i) v[i] = *(const GAS f32x4*)(src + (size_t)(8 * i) * it.ldw);
}
DI void p0_tr_store(const TrItem& it, int lane, const f32x4 (&v)[8], LAS float* scr) {
#pragma unroll
    for (int i = 0; i < 8; ++i) *(LAS f32x4*)(scr + (8 * i + (lane >> 3)) * 36 + 4 * (lane & 7)) = v[i];
    LDS_WAIT(); asm volatile("" ::: "memory");
    const int c = lane & 7;
#pragma unroll
    for (int j = 0; j < 4; ++j) { const int n = (lane >> 3) + 8 * j; const LAS float* sp = scr + (8 * c) * 36 + n;
        u32x4 o; o.x = pk2(sp[0 * 36], sp[1 * 36]); o.y = pk2(sp[2 * 36], sp[3 * 36]); o.z = pk2(sp[4 * 36], sp[5 * 36]); o.w = pk2(sp[6 * 36], sp[7 * 36]);
        *(GAS u32x4*)(it.WT + (size_t)(it.dst_row + n) * it.K + 64 * it.kb + 8 * c) = o; }
    LDS_WAIT(); asm volatile("" ::: "memory");
}
constexpr int I_IN = 32 * 256, I_O = 32 * 64, I_G = 32 * 176, I_D = 88 * 64;
DI TrItem tr_item(const Args& a, int set, int r) {
    TrItem it;
    if (set == 0) { const int kb = r / 256, nb = r % 256; it.W = (const float*)a.in[IN_WIN]; it.WT = (bf16*)(a.ws + WS_WIN); it.K = DM; it.ldw = DPROJ; it.src_col = nb < 128 ? 32 * nb : 4112 + 32 * (nb - 128); it.dst_row = 32 * nb; it.kb = kb; return it; }
    if (r < I_O) { const int kb = r / 64, nb = r % 64; it.W = (const float*)a.in[IN_WOUT]; it.WT = (bf16*)(a.ws + WS_WO); it.K = DM; it.ldw = DM; it.src_col = 32 * nb; it.dst_row = 32 * nb; it.kb = kb; return it; } r -= I_O;
    if (r < I_G) { const int kb = r / 176, nb = r % 176; it.W = (const float*)a.in[IN_WG]; it.WT = (bf16*)(a.ws + WS_WGU); it.K = DM; it.ldw = DFF; it.src_col = 32 * nb; it.dst_row = 256 * (nb >> 2) + 32 * (nb & 3); it.kb = kb; return it; } r -= I_G;
    if (r < I_G) { const int kb = r / 176, nb = r % 176; it.W = (const float*)a.in[IN_WU]; it.WT = (bf16*)(a.ws + WS_WGU); it.K = DM; it.ldw = DFF; it.src_col = 32 * nb; it.dst_row = 256 * (nb >> 2) + 128 + 32 * (nb & 3); it.kb = kb; return it; } r -= I_G;
    { const int kb = r / 64, nb = r % 64; it.W = (const float*)a.in[IN_WDN]; it.WT = (bf16*)(a.ws + WS_WD); it.K = DFF; it.ldw = DM; it.src_col = 32 * nb; it.dst_row = 32 * nb; it.kb = kb; return it; }
}
DI void convert_weights(const Args& a, ldsp lds, int set, int lane, int wave, int vcu, int G) {
    const int gw = vcu * NWAVES + wave, NGW = G * NWAVES, nitems = set == 0 ? I_IN : I_O + 2 * I_G + I_D;
    LAS float* scr = (LAS float*)(lds + wave * 16384);
    f32x4 va[8], vb[8];
    int it = gw; if (it < nitems) p0_tr_load(tr_item(a, set, it), lane, va);
    for (; it < nitems; it += 2 * NGW) {
        if (it + NGW < nitems) p0_tr_load(tr_item(a, set, it + NGW), lane, vb);
        p0_tr_store(tr_item(a, set, it), lane, va, scr);
        if (it + 2 * NGW < nitems) p0_tr_load(tr_item(a, set, it + 2 * NGW), lane, va);
        if (it + NGW < nitems) p0_tr_store(tr_item(a, set, it + NGW), lane, vb, scr);
    }
}
DI void phase_p0(const Args& a, ldsp lds, int tid, int lane, int wave, int vcu, int G) {
    const int gw = vcu * NWAVES + wave, NGW = G * NWAVES;
    const float* x = (const float*)a.in[IN_X]; const float* gpre = (const float*)a.in[IN_GPRE]; const float* w_in = (const float*)a.in[IN_WIN];
    bf16* hb = (bf16*)(a.ws + WS_A); float* PRE = (float*)(a.ws + WS_PRE);
    LAS unsigned short* Wf = (LAS unsigned short*)lds;
#pragma unroll 4
    for (int i = 0; i < 16; ++i) { const int idx = tid + NTHR * i, k = idx >> 2, c4 = idx & 3;
        const f32x4 w = *(const GAS f32x4*)(w_in + (size_t)k * DPROJ + 4096 + 4 * c4);
        LAS unsigned short* d = Wf + ((k >> 5) * 64 + ((k >> 3) & 3) * 16 + 4 * c4) * 8 + (k & 7);
        d[0] = (unsigned short)f2bf(w.x); d[8] = (unsigned short)f2bf(w.y); d[16] = (unsigned short)f2bf(w.z); d[24] = (unsigned short)f2bf(w.w); }
    LDS_WAIT(); __syncthreads();
    LAS float* part = (LAS float*)(lds + 65536);
    for (int rb = vcu; rb < SEQ / 64; rb += G) {
        {
            const GAS f32x4* gr = (const GAS f32x4*)gpre + lane;
#define P0_LOAD(buf, mm) do { const GAS f32x4* xr_ = (const GAS f32x4*)(x + (size_t)(mm) * DM) + lane; _Pragma("unroll") for (int j = 0; j < 8; ++j) buf[j] = xr_[64 * j]; } while (0)
#define P0_ROW(buf, mm) do { float s_ = 0.f; _Pragma("unroll") for (int j = 0; j < 8; ++j) s_ += (buf[j].x * buf[j].x + buf[j].y * buf[j].y) + (buf[j].z * buf[j].z + buf[j].w * buf[j].w); \
            const float r_ = 1.0f / sqrtf(wave_sum(s_) * (1.0f / DM) + NORM_EPS); GAS u32x2* o_ = (GAS u32x2*)(hb + (size_t)(mm) * DM) + lane; \
            _Pragma("unroll") for (int j = 0; j < 8; ++j) { const f32x4 gg = gr[64 * j]; u32x2 w; w.x = pk2(buf[j].x * r_ * gg.x, buf[j].y * r_ * gg.y); w.y = pk2(buf[j].z * r_ * gg.z, buf[j].w * r_ * gg.w); o_[64 * j] = w; } } while (0)
            f32x4 va[8], vb[8];
            const int m0 = rb * 64 + wave * 8;
            P0_LOAD(va, m0);
#pragma unroll 1
            for (int i = 0; i < 8; i += 2) {
                P0_LOAD(vb, m0 + i + 1);
                P0_ROW(va, m0 + i);
                if (i + 2 < 8) P0_LOAD(va, m0 + i + 2);
                P0_ROW(vb, m0 + i + 1);
            }
#undef P0_LOAD
#undef P0_ROW
        }
        asm volatile("s_waitcnt vmcnt(0)" ::: "memory"); __syncthreads();
        {
            const int tile = wave & 3, kh = wave >> 2, row = lane & 15, kq = lane >> 4, t0 = rb * 64 + tile * 16;
            const GAS u32x4* hr = (const GAS u32x4*)(hb + (size_t)(t0 + row) * DM + kh * 1024 + 8 * kq);
            const LAS u32x4* wf = (const LAS u32x4*)lds + (kh * 32) * 64 + lane;
            pg8::f32x4 acc = {0.f, 0.f, 0.f, 0.f};
            for (int sp = 0; sp < 32; sp += 8) { u32x4 hv[8];
#pragma unroll
                for (int j = 0; j < 8; ++j) hv[j] = hr[4 * (sp + j)];
#pragma unroll
                for (int j = 0; j < 8; ++j) acc = __builtin_amdgcn_mfma_f32_16x16x32_bf16(__builtin_bit_cast(pg8::bf16x8, hv[j]), __builtin_bit_cast(pg8::bf16x8, wf[(sp + j) * 64]), acc, 0, 0, 0);
            }
            if (kh == 1) {
#pragma unroll
                for (int j = 0; j < 4; ++j) part[(tile * 4 + j) * 64 + lane] = acc[j]; }
            LDS_WAIT(); __syncthreads();
            if (kh == 0) {
#pragma unroll
                for (int j = 0; j < 4; ++j) PRE[(size_t)(t0 + 4 * kq + j) * 16 + row] = acc[j] + part[(tile * 4 + j) * 64 + lane]; }
            __syncthreads();
        }
    }
    __syncthreads();
    convert_weights(a, lds, 0, lane, wave, vcu, G);
    convert_weights(a, lds, 1, lane, wave, vcu, G);
    { float* GH = (float*)(a.ws + WS_GHEAD); const float* gmh = (const float*)a.in[IN_GMH]; const float* grh = (const float*)a.in[IN_GRH];
      for (int i = vcu * NTHR + tid; i < 1024; i += G * NTHR) GH[i] = gmh[i];
      for (int i = vcu * NTHR + tid; i < 1024; i += G * NTHR) GH[1024 + i] = grh[i]; }
    const int* pos = (const int*)a.in[IN_POS]; float* COS = (float*)(a.ws + WS_COS); float* SIN = (float*)(a.ws + WS_SIN);
    { LAS float* invf = (LAS float*)(lds + GATE_OFF);
      if (tid < 64) invf[tid] = (float)pow(10000.0, -(double)(2 * tid) / 128.0);
      LDS_WAIT(); __syncthreads();
      for (int i = vcu * NTHR + tid; i < SEQ * 64; i += G * NTHR) { const int t = i >> 6, j = i & 63;
          const float ang = (float)pos[t] * invf[j]; float sn, cs; sincosf(ang, &sn, &cs); COS[i] = cs; SIN[i] = sn; } }
}

typedef short bf16x8 __attribute__((ext_vector_type(8)));
typedef short s16x4 __attribute__((ext_vector_type(4)));
typedef float f32x16 __attribute__((ext_vector_type(16)));
#define MFMA32(a, b, c) __builtin_amdgcn_mfma_f32_32x32x16_bf16((a), (b), (c), 0, 0, 0)
DI int crow(int reg, int h) { return (reg & 3) + 8 * (reg >> 2) + 4 * h; }
DI bf16x8 bf_ones() { return (bf16x8){16256, 16256, 16256, 16256, 16256, 16256, 16256, 16256}; }
DI int offb(int row, int ch) { return 256 * row + 16 * (ch ^ (((row & 3) << 2) | ((row >> 2) & 3))); }
DI int rowbase(int row, int h) { return offb(row, h); }
DI bf16x8 rowfrag(ldsp tile, int rb, int ks) { return *(const LAS bf16x8*)(tile + (rb ^ (ks << 5))); }
DI s16x4 tr_rd(ldsp p) { return __builtin_bit_cast(s16x4, __builtin_amdgcn_ds_read_tr16_b64_v4i16((LAS s16x4*)p)); }
struct TrB { int b0, b1; };
DI TrB trbase(int c, int lane) {
    const int h = lane >> 5, blk = (lane >> 4) & 1, q = (lane & 15) >> 2, p = lane & 3, ch = 4 * c + 2 * blk + (p >> 1);
    TrB b; b.b0 = offb(8 * h + q, ch) + 8 * (p & 1); b.b1 = offb(8 * h + 4 + q, ch) + 8 * (p & 1); return b;
}
DI bf16x8 trfrag(ldsp tile, const TrB b, int ks) {
    const s16x4 lo = tr_rd(tile + b.b0 + 4096 * ks), hi = tr_rd(tile + b.b1 + 4096 * ks);
    return __builtin_shufflevector(lo, hi, 0, 1, 2, 3, 4, 5, 6, 7);
}
DI void gload8(const bf16* p, float (&f)[8]) { unpack8(*(const GAS u32x4*)p, f); }

DI void mixer_setup(const Args& a, ldsp lds, int g, int grp, int tid, int lane, int wave) {
    if (g < NHG) {
        LAS float* rowv = (LAS float*)(lds + GATE_OFF + wave * 1536); LAS float* colv = rowv + 128; LAS float* alog = rowv + 256;
        const float* PRE = (const float*)(a.ws + WS_PRE); const float bi = ((const float*)a.in[IN_BI])[g], bfg = ((const float*)a.in[IN_BF])[g];
        const int t0 = (8 * grp + wave) * CH + 2 * lane;
        const float i0 = PRE[(size_t)t0 * 16 + g] + bi, i1 = PRE[(size_t)(t0 + 1) * 16 + g] + bi;
        const float f0 = PRE[(size_t)t0 * 16 + 8 + g] + bfg, f1 = PRE[(size_t)(t0 + 1) * 16 + 8 + g] + bfg;
        const float l0 = fminf(f0, 0.f) - log1pf(__expf(-fabsf(f0))), l1 = fminf(f1, 0.f) - log1pf(__expf(-fabsf(f1)));
        float p = l0 + l1;
#pragma unroll
        for (int o = 1; o < 64; o <<= 1) { const float y = __shfl_up(p, o); if (lane >= o) p += y; }
        const float b1 = p, b0 = p - l1;
        rowv[2 * lane] = b0; rowv[2 * lane + 1] = b1; alog[2 * lane] = b0; alog[2 * lane + 1] = b1; colv[2 * lane] = i0 - b0; colv[2 * lane + 1] = i1 - b1;
        if (tid < 128) { LAS float* cwl = (LAS float*)(lds + CONVW_OFF); const float* cw = (const float*)a.in[IN_CW]; const float* cb = (const float*)a.in[IN_CB];
#pragma unroll
            for (int j = 0; j < 4; ++j) { cwl[j * 128 + tid] = cw[j * 2048 + g * HD + tid]; cwl[640 + j * 128 + tid] = cw[j * 2048 + 1024 + g * HD + tid]; }
            cwl[512 + tid] = cb[g * HD + tid]; cwl[640 + 512 + tid] = cb[1024 + g * HD + tid]; }
    } else if (tid < 128) {
        LAS float* rowv = (LAS float*)(lds + GATE_OFF); LAS float* colv = rowv + 128; LAS float* alog = rowv + 256;
        const float lg = log1pf(-exp2f(-5.0f - (float)(g - NHG)));
        rowv[tid] = (float)tid * lg; colv[tid] = -(float)tid * lg; alog[tid] = (float)(tid + 1) * lg;
    }
    LDS_WAIT(); __syncthreads();
}
template <bool WITHQ> DI void mixer_tiles(const Args& a, ldsp lds, int g, int c, const LAS float* gt, int tid) {
    const bf16* proj = (const bf16*)(a.ws + WS_B);
    const LAS float* colv = gt + 128; const float rv127 = gt[127];
    ldsp Q = lds, K = lds + 32768, V = lds + 65536;
    const float kscale = 0.08838834764831845f;
    const int sq = tid >> 4, dg = tid & 15, tb = c * CH + 4 * sq;
    u32x4 vv[4];
    if (g < NHG) {
        const bf16* pk = proj + PC_MK + g * HD + 8 * dg; const bf16* pq = proj + PC_MQ + g * HD + 8 * dg; const bf16* pv = proj + PC_MV + g * HD + 8 * dg;
        u32x4 rk[7], rq[7];
#pragma unroll
        for (int j = 0; j < 7; ++j) { const int tt = tb - 3 + j, tc = tt < 0 ? 0 : tt; rk[j] = *(const GAS u32x4*)(pk + (size_t)tc * NPJ); if (WITHQ) rq[j] = *(const GAS u32x4*)(pq + (size_t)tc * NPJ);
            if (tt < 0) { rk[j] = (u32x4){0u, 0u, 0u, 0u}; if (WITHQ) rq[j] = (u32x4){0u, 0u, 0u, 0u}; } }
#pragma unroll
        for (int i = 0; i < 4; ++i) vv[i] = *(const GAS u32x4*)(pv + (size_t)(tb + i) * NPJ);
        const LAS float* cwl = (const LAS float*)(lds + CONVW_OFF);
#pragma unroll
        for (int qk = 0; qk < (WITHQ ? 2 : 1); ++qk) {
            const LAS float* wl = cwl + (qk == 0 ? 640 : 0) + 8 * dg;
            float w[5][8];
#pragma unroll
            for (int j = 0; j < 5; ++j) { const f32x4 w0 = *(const LAS f32x4*)(wl + j * 128), w1 = *(const LAS f32x4*)(wl + j * 128 + 4); w[j][0] = w0.x; w[j][1] = w0.y; w[j][2] = w0.z; w[j][3] = w0.w; w[j][4] = w1.x; w[j][5] = w1.y; w[j][6] = w1.z; w[j][7] = w1.w; }
#pragma unroll
            for (int i = 0; i < 4; ++i) { float acc[8];
#pragma unroll
                for (int e = 0; e < 8; ++e) acc[e] = w[4][e];
#pragma unroll
                for (int j = 0; j < 4; ++j) { float uu[8]; unpack8(qk == 0 ? rk[i + j] : rq[i + j], uu);
#pragma unroll
                    for (int e = 0; e < 8; ++e) acc[e] += w[j][e] * uu[e]; }
                const int srow = 4 * sq + i; const float sc = qk == 0 ? kscale * __expf(rv127 + colv[srow]) : 1.0f;
#pragma unroll
                for (int e = 0; e < 8; ++e) acc[e] = silu_f(acc[e]) * sc;
                *(LAS u32x4*)((qk == 0 ? K : Q) + offb(srow, dg)) = pack8(acc); }
        }
    } else {
        const int gr = g - NHG; const float* COS = (const float*)(a.ws + WS_COS); const float* SIN = (const float*)(a.ws + WS_SIN);
        const int s2 = tid >> 3, dgp = tid & 7;
        const bf16* pv = proj + PC_RV + gr * HD + 8 * dg;
        u32x4 klo[2], khi[2], qlo[2], qhi[2]; f32x4 cs[2][2], sn[2][2];
#pragma unroll
        for (int i = 0; i < 2; ++i) { const size_t t = (size_t)(c * CH + 2 * s2 + i); const bf16* pr = proj + t * NPJ + gr * HD + 8 * dgp;
            klo[i] = *(const GAS u32x4*)(pr + PC_RK); khi[i] = *(const GAS u32x4*)(pr + PC_RK + 64);
            if (WITHQ) { qlo[i] = *(const GAS u32x4*)(pr + PC_RQ); qhi[i] = *(const GAS u32x4*)(pr + PC_RQ + 64); }
            cs[i][0] = *(const GAS f32x4*)(COS + t * 64 + 8 * dgp); cs[i][1] = *(const GAS f32x4*)(COS + t * 64 + 8 * dgp + 4);
            sn[i][0] = *(const GAS f32x4*)(SIN + t * 64 + 8 * dgp); sn[i][1] = *(const GAS f32x4*)(SIN + t * 64 + 8 * dgp + 4); }
#pragma unroll
        for (int i = 0; i < 4; ++i) vv[i] = *(const GAS u32x4*)(pv + (size_t)(tb + i) * NPJ);
#pragma unroll
        for (int i = 0; i < 2; ++i) { const int srow = 2 * s2 + i;
            const float c8[8] = {cs[i][0].x, cs[i][0].y, cs[i][0].z, cs[i][0].w, cs[i][1].x, cs[i][1].y, cs[i][1].z, cs[i][1].w};
            const float s8[8] = {sn[i][0].x, sn[i][0].y, sn[i][0].z, sn[i][0].w, sn[i][1].x, sn[i][1].y, sn[i][1].z, sn[i][1].w};
            float lo[8], hi[8], olo[8], ohi[8]; unpack8(klo[i], lo); unpack8(khi[i], hi);
            const float sc = kscale * __expf(rv127 + colv[srow]);
#pragma unroll
            for (int e = 0; e < 8; ++e) { olo[e] = (lo[e] * c8[e] - hi[e] * s8[e]) * sc; ohi[e] = (hi[e] * c8[e] + lo[e] * s8[e]) * sc; }
            *(LAS u32x4*)(K + offb(srow, dgp)) = pack8(olo); *(LAS u32x4*)(K + offb(srow, 8 + dgp)) = pack8(ohi);
            if (WITHQ) { unpack8(qlo[i], lo); unpack8(qhi[i], hi);
#pragma unroll
                for (int e = 0; e < 8; ++e) { olo[e] = lo[e] * c8[e] - hi[e] * s8[e]; ohi[e] = hi[e] * c8[e] + lo[e] * s8[e]; }
                *(LAS u32x4*)(Q + offb(srow, dgp)) = pack8(olo); *(LAS u32x4*)(Q + offb(srow, 8 + dgp)) = pack8(ohi); }
        }
    }
#pragma unroll
    for (int i = 0; i < 4; ++i) *(LAS u32x4*)(V + offb(4 * sq + i, dg)) = vv[i];
    LDS_WAIT(); __syncthreads();
}

DI void phase_m1(const Args& a, ldsp lds, int tid_in, int wave, int vcu, int G) {
    float* UG = (float*)(a.ws + WS_A); float* NG = (float*)(a.ws + WS_NLOC); float* DG = (float*)(a.ws + WS_DEC);
    ldsp K = lds + 32768, V = lds + 65536; const int wi = wave >> 1, wj = wave & 1;
    for (int cg = vcu; cg < NHEADS * 16; cg += G) { const int g = cg >> 4, grp = cg & 15; const bool ml = g < NHG;
        { int tid_g = tid_in; asm volatile("" : "+v"(tid_g)); mixer_setup(a, lds, g, grp, tid_g, tid_g & 63, wave); }
        f32x16 accU[2], accN; float dsum = 0.f;
#pragma unroll
        for (int i = 0; i < 16; ++i) { accU[0][i] = 0.f; accU[1][i] = 0.f; accN[i] = 0.f; }
        for (int ci = 0; ci < 8; ++ci) { const int c = 8 * grp + ci;
            int tid_o = tid_in; asm volatile("" : "+v"(tid_o));
            const int tid = tid_o, lane = tid & 63;
            const LAS float* gt = (const LAS float*)(lds + GATE_OFF + (ml ? ci : 0) * 1536);
            mixer_tiles<false>(a, lds, g, c, gt, tid);
            const float la = gt[256 + 127], dec = __expf(la); dsum += la;
            accU[0] = accU[0] * dec; accU[1] = accU[1] * dec; accN = accN * dec;
            { const TrB tk = trbase(wi, lane), tv0 = trbase(2 * wj, lane), tv1 = trbase(2 * wj + 1, lane);
#pragma unroll
              for (int ks = 0; ks < 8; ++ks) {
                const bf16x8 af = trfrag(K, tk, ks), b0 = trfrag(V, tv0, ks), b1 = trfrag(V, tv1, ks);
                accU[0] = MFMA32(af, b0, accU[0]); accU[1] = MFMA32(af, b1, accU[1]);
                if (ml && wj == 0) accN = MFMA32(af, bf_ones(), accN);
              } }
            __syncthreads();
        }
        { int tid_o = tid_in; asm volatile("" : "+v"(tid_o)); const int lane = tid_o & 63, r = lane & 31, h = lane >> 5;
          float* o = UG + ((size_t)cg << 14) + wave * 2048 + lane;
#pragma unroll
          for (int n = 0; n < 2; ++n)
#pragma unroll
              for (int i = 0; i < 16; ++i) o[(n * 16 + i) * 64] = accU[n][i];
          if (ml && wj == 0 && r == 0) {
#pragma unroll
              for (int i = 0; i < 16; ++i) NG[(size_t)cg * HD + 32 * wi + crow(i, h)] = accN[i]; }
          if (tid_in == 0) DG[cg] = __expf(dsum); }
    }
}
DI void phase_m3(const Args& a, ldsp lds, int tid_in, int wave, int vcu, int G) {
    const bf16* proj = (const bf16*)(a.ws + WS_B); const float* UG = (const float*)(a.ws + WS_A); const float* NG = (const float*)(a.ws + WS_NLOC); const float* DG = (const float*)(a.ws + WS_DEC);
    bf16* mixb = (bf16*)a.out;
    LAS unsigned short* n0b = (LAS unsigned short*)(lds + N0B_OFF);
    ldsp Q = lds, K = lds + 32768, V = lds + 65536, C0 = lds + 98304, P = lds + 98304; LAS float* H = (LAS float*)lds;
    const int wi = wave >> 1, wj = wave & 1;
    for (int cg = vcu; cg < NHEADS * 16; cg += G) { const int g = cg >> 4, grp = cg & 15; const bool ml = g < NHG;
        { int tid_g = tid_in; asm volatile("" : "+v"(tid_g)); mixer_setup(a, lds, g, grp, tid_g, tid_g & 63, wave); }
        f32x16 accC[2], nst;
#pragma unroll
        for (int i = 0; i < 16; ++i) { accC[0][i] = 0.f; accC[1][i] = 0.f; nst[i] = 0.f; }
        { int tid_o = tid_in; asm volatile("" : "+v"(tid_o)); const int lane = tid_o & 63, h = lane >> 5;
          for (int j = 0; j < grp; ++j) { const float* us = UG + ((size_t)(g * 16 + j) << 14) + wave * 2048 + lane; const float dj = DG[g * 16 + j];
#pragma unroll
              for (int i = 0; i < 16; ++i) { accC[0][i] = dj * accC[0][i] + us[i * 64]; accC[1][i] = dj * accC[1][i] + us[(16 + i) * 64]; }
              if (ml) {
#pragma unroll
                  for (int i = 0; i < 16; ++i) nst[i] = dj * nst[i] + NG[(size_t)(g * 16 + j) * HD + 32 * wi + crow(i, h)]; } } }
        for (int ci = 0; ci < 8; ++ci) { const int c = 8 * grp + ci;
            int tid_o = tid_in; asm volatile("" : "+v"(tid_o));
            const int tid = tid_o, lane = tid & 63, r = lane & 31, h = lane >> 5;
            const LAS float* gt = (const LAS float*)(lds + GATE_OFF + (ml ? ci : 0) * 1536);
#pragma unroll
            for (int n = 0; n < 2; ++n) { const int e = 64 * wj + 32 * n + r;
#pragma unroll
                for (int i = 0; i < 16; ++i) { const int d = 32 * wi + crow(i, h); *(LAS unsigned short*)(C0 + offb(d, e >> 3) + 2 * (e & 7)) = (unsigned short)pk2(accC[n][i], accC[n][i]); } }
            if (wj == 0 && r == 0) {
#pragma unroll
                for (int i = 0; i < 16; ++i) n0b[32 * wi + crow(i, h)] = (unsigned short)pk2(nst[i], nst[i]); }
            mixer_tiles<true>(a, lds, g, c, gt, tid);
            f32x16 accO[2], accS[2], accD;
#pragma unroll
            for (int i = 0; i < 16; ++i) { accO[0][i] = 0.f; accO[1][i] = 0.f; accS[0][i] = 0.f; accS[1][i] = 0.f; accD[i] = 0.f; }
            const TrB tk = trbase(wi, lane), tv0 = trbase(2 * wj, lane), tv1 = trbase(2 * wj + 1, lane);
            const int rbq = rowbase(32 * wi + r, h), rbk = rowbase(64 * wj + r, h);
#pragma unroll
            for (int ks = 0; ks < 8; ++ks) {
                const bf16x8 af = rowfrag(Q, rbq, ks), b0 = trfrag(C0, tv0, ks), b1 = trfrag(C0, tv1, ks);
                accO[0] = MFMA32(af, b0, accO[0]); accO[1] = MFMA32(af, b1, accO[1]);
                if (ml) { const bf16x8 bn = *(const LAS bf16x8*)(n0b + 16 * ks + 8 * h); accD = MFMA32(af, bn, accD); }
            }
#pragma unroll
            for (int i = 0; i < 16; ++i) { const int t = 32 * wi + crow(i, h); const float al = __expf(gt[256 + t]); accO[0][i] *= al; accO[1][i] *= al; accD[i] *= al; }
#pragma unroll
            for (int ks = 0; ks < 8; ++ks) {
                const bf16x8 af = rowfrag(Q, rbq, ks), b0 = rowfrag(K, rbk, ks), b1 = rowfrag(K + 8192, rbk, ks);
                accS[0] = MFMA32(af, b0, accS[0]); accS[1] = MFMA32(af, b1, accS[1]);
            }
            __syncthreads();
            float fac[16]; { const float rv127 = gt[127];
#pragma unroll
              for (int i = 0; i < 16; ++i) fac[i] = __expf(gt[32 * wi + crow(i, h)] - rv127); }
#pragma unroll
            for (int n = 0; n < 2; ++n) { const int sidx = 64 * wj + 32 * n + r;
#pragma unroll
                for (int i = 0; i < 16; ++i) { const int t = 32 * wi + crow(i, h); const float val = (sidx <= t) ? accS[n][i] * fac[i] : 0.f;
                    *(LAS unsigned short*)(P + offb(t, sidx >> 3) + 2 * (sidx & 7)) = (unsigned short)pk2(val, val); } }
            LDS_WAIT(); __syncthreads();
            u32x4 gpre[2][2];
            { const int tl = tid >> 3, eg = tid & 7; const int hc = ml ? g * HD + 16 * eg : (g - NHG) * HD + 16 * eg;
#pragma unroll
              for (int hh = 0; hh < 2; ++hh) { const bf16* gp = proj + (size_t)(c * CH + 64 * hh + tl) * NPJ + (ml ? PC_MO : PC_RG) + hc; gpre[hh][0] = *(const GAS u32x4*)gp; gpre[hh][1] = *(const GAS u32x4*)(gp + 8); } }
            { const float dec = __expf(gt[256 + 127]); accC[0] = accC[0] * dec; accC[1] = accC[1] * dec; nst = nst * dec; }
#pragma unroll
            for (int ks = 0; ks < 8; ++ks) {
                const bf16x8 af = rowfrag(P, rbq, ks), ak = trfrag(K, tk, ks), b0 = trfrag(V, tv0, ks), b1 = trfrag(V, tv1, ks);
                accO[0] = MFMA32(af, b0, accO[0]); accO[1] = MFMA32(af, b1, accO[1]);
                accC[0] = MFMA32(ak, b0, accC[0]); accC[1] = MFMA32(ak, b1, accC[1]);
                if (ml) { accD = MFMA32(af, bf_ones(), accD); nst = MFMA32(ak, bf_ones(), nst); }
            }
            __syncthreads();
#pragma unroll
            for (int i = 0; i < 16; ++i) { const int t = 32 * wi + crow(i, h); const float rden = ml ? 1.0f / fmaxf(fabsf(accD[i]), 1.0f) : 1.0f;
                H[t * HD + 64 * wj + r] = accO[0][i] * rden; H[t * HD + 64 * wj + 32 + r] = accO[1][i] * rden; }
            LDS_WAIT(); __syncthreads();
#pragma unroll
            for (int hh = 0; hh < 2; ++hh) {
                const int tl = tid >> 3, eg = tid & 7, t = 64 * hh + tl;
                float hv[16]; float ss = 0.f;
#pragma unroll
                for (int q = 0; q < 4; ++q) { const f32x4 x4 = *(const LAS f32x4*)(H + t * HD + 16 * eg + 4 * q); hv[4 * q] = x4.x; hv[4 * q + 1] = x4.y; hv[4 * q + 2] = x4.z; hv[4 * q + 3] = x4.w; }
#pragma unroll
                for (int i = 0; i < 16; ++i) ss += hv[i] * hv[i];
                ss += __shfl_xor(ss, 1); ss += __shfl_xor(ss, 2); ss += __shfl_xor(ss, 4);
                const float rn = 1.0f / sqrtf(ss * (1.0f / HD) + NORM_EPS);
                const int tg = c * CH + t; const int hc = ml ? g * HD + 16 * eg : (g - NHG) * HD + 16 * eg;
                const float* gh = (const float*)(a.ws + WS_GHEAD) + (ml ? 0 : 1024) + hc;
                float ga[16]; { float t8[8]; unpack8(gpre[hh][0], t8);
#pragma unroll
                    for (int j = 0; j < 8; ++j) ga[j] = t8[j]; unpack8(gpre[hh][1], t8);
#pragma unroll
                    for (int j = 0; j < 8; ++j) ga[8 + j] = t8[j]; }
                float o[16];
#pragma unroll
                for (int i = 0; i < 16; ++i) o[i] = hv[i] * rn * gh[i] * (ml ? sigmoid_f(ga[i]) : silu_f(ga[i]));
                bf16* op = mixb + (size_t)tg * DM + (ml ? 0 : 1024) + hc;
                u32x4 w0, w1; w0.x = pk2(o[0], o[1]); w0.y = pk2(o[2], o[3]); w0.z = pk2(o[4], o[5]); w0.w = pk2(o[6], o[7]); w1.x = pk2(o[8], o[9]); w1.y = pk2(o[10], o[11]); w1.z = pk2(o[12], o[13]); w1.w = pk2(o[14], o[15]);
                *(GAS u32x4*)op = w0; *(GAS u32x4*)(op + 8) = w1;
            }
            __syncthreads();
        }
    }
}
DI void phase_r1(const Args& a, int lane, int wave, int vcu, int G) {
    const int gw = vcu * NWAVES + wave, NGW = G * NWAVES;
    const float* x = (const float*)a.in[IN_X]; const bf16* mix = (const bf16*)(a.ws + WS_B); float* x1 = a.out; bf16* h2 = (bf16*)(a.ws + WS_A);
    const GAS f32x4* gp = (const GAS f32x4*)a.in[IN_GPOST] + lane; const GAS f32x4* gf = (const GAS f32x4*)a.in[IN_GFPRE] + lane;
#define R1_LOAD(bm, bx, mm) do { const GAS u32x2* mr_ = (const GAS u32x2*)(mix + (size_t)(mm) * DM) + lane; const GAS f32x4* xr_ = (const GAS f32x4*)(x + (size_t)(mm) * DM) + lane; \
        _Pragma("unroll") for (int j = 0; j < 8; ++j) { bm[j] = mr_[64 * j]; bx[j] = xr_[64 * j]; } } while (0)
#define R1_ROW(bm, bx, mm) do { f32x4 v[8]; float s_ = 0.f; \
        _Pragma("unroll") for (int j = 0; j < 8; ++j) { v[j] = (f32x4){bflo(bm[j].x), bfhi(bm[j].x), bflo(bm[j].y), bfhi(bm[j].y)}; s_ += (v[j].x * v[j].x + v[j].y * v[j].y) + (v[j].z * v[j].z + v[j].w * v[j].w); } \
        const float r_ = 1.0f / sqrtf(wave_sum(s_) * (1.0f / DM) + NORM_EPS); float s2_ = 0.f; GAS f32x4* xo_ = (GAS f32x4*)(x1 + (size_t)(mm) * DM) + lane; \
        _Pragma("unroll") for (int j = 0; j < 8; ++j) { const f32x4 gg = gp[64 * j]; v[j] = bx[j] + v[j] * r_ * gg; xo_[64 * j] = v[j]; s2_ += (v[j].x * v[j].x + v[j].y * v[j].y) + (v[j].z * v[j].z + v[j].w * v[j].w); } \
        const float r2_ = 1.0f / sqrtf(wave_sum(s2_) * (1.0f / DM) + NORM_EPS); GAS u32x2* o_ = (GAS u32x2*)(h2 + (size_t)(mm) * DM) + lane; \
        _Pragma("unroll") for (int j = 0; j < 8; ++j) { const f32x4 gg = gf[64 * j]; u32x2 w; w.x = pk2(v[j].x * r2_ * gg.x, v[j].y * r2_ * gg.y); w.y = pk2(v[j].z * r2_ * gg.z, v[j].w * r2_ * gg.w); o_[64 * j] = w; } } while (0)
    u32x2 ma[8], mb[8]; f32x4 xa[8], xb[8];
    int m = gw; if (m < SEQ) R1_LOAD(ma, xa, m);
    for (; m < SEQ; m += 2 * NGW) {
        if (m + NGW < SEQ) R1_LOAD(mb, xb, m + NGW);
        R1_ROW(ma, xa, m);
        if (m + 2 * NGW < SEQ) R1_LOAD(ma, xa, m + 2 * NGW);
        if (m + NGW < SEQ) R1_ROW(mb, xb, m + NGW);
    }
#undef R1_LOAD
#undef R1_ROW
}
DI void phase_r2(const Args& a, int lane, int wave, int vcu, int G, bool poison) {
    const int gw = vcu * NWAVES + wave, NGW = G * NWAVES;
    const bf16* ff = (const bf16*)(a.ws + WS_FF); float* out = a.out; const GAS f32x4* gp = (const GAS f32x4*)a.in[IN_GFPOST] + lane;
    const float qn = __builtin_nanf("");
#define R2_LOAD(bm, bx, mm) do { const GAS u32x2* fr_ = (const GAS u32x2*)(ff + (size_t)(mm) * DM) + lane; const GAS f32x4* xr_ = (const GAS f32x4*)(out + (size_t)(mm) * DM) + lane; \
        _Pragma("unroll") for (int j = 0; j < 8; ++j) { bm[j] = fr_[64 * j]; bx[j] = xr_[64 * j]; } } while (0)
#define R2_ROW(bm, bx, mm) do { f32x4 v[8]; float s_ = 0.f; \
        _Pragma("unroll") for (int j = 0; j < 8; ++j) { v[j] = (f32x4){bflo(bm[j].x), bfhi(bm[j].x), bflo(bm[j].y), bfhi(bm[j].y)}; s_ += (v[j].x * v[j].x + v[j].y * v[j].y) + (v[j].z * v[j].z + v[j].w * v[j].w); } \
        const float r_ = 1.0f / sqrtf(wave_sum(s_) * (1.0f / DM) + NORM_EPS); GAS f32x4* xo_ = (GAS f32x4*)(out + (size_t)(mm) * DM) + lane; \
        _Pragma("unroll") for (int j = 0; j < 8; ++j) { const f32x4 gg = gp[64 * j]; f32x4 o = bx[j] + v[j] * r_ * gg; if (poison) o = (f32x4){qn, qn, qn, qn}; xo_[64 * j] = o; } } while (0)
    u32x2 ma[8], mb[8]; f32x4 xa[8], xb[8];
    int m = gw; if (m < SEQ) R2_LOAD(ma, xa, m);
    for (; m < SEQ; m += 2 * NGW) {
        if (m + NGW < SEQ) R2_LOAD(mb, xb, m + NGW);
        R2_ROW(ma, xa, m);
        if (m + 2 * NGW < SEQ) R2_LOAD(ma, xa, m + 2 * NGW);
        if (m + NGW < SEQ) R2_ROW(mb, xb, m + NGW);
    }
#undef R2_LOAD
#undef R2_ROW
}

__global__ void __launch_bounds__(NTHR, 2) fwd(Args a) {
    extern __shared__ __attribute__((aligned(16))) unsigned char lds_raw[];
    ldsp lds = (ldsp)lds_raw;
    const int tid = threadIdx.x, lane = tid & 63, wave = __builtin_amdgcn_readfirstlane(tid >> 6);
    const int G = gridDim.x; const int bx = blockIdx.x; const int vcu = (G % 8 == 0) ? (bx % 8) * (G / 8) + bx / 8 : bx;
    volatile LAS unsigned* MISC = (volatile LAS unsigned*)(lds + MISC_OFF);
    if (tid < 32) MISC[tid] = 0u;
    __syncthreads();
    unsigned* ctl = (unsigned*)(a.ws + WS_CTL);
    XcdBarrier bar; bar.bar = ctl + CW_BAR; bar.x = 0; bar.st = nullptr;
    if (N_LAUNCHES == 1) bar = xcd_barrier_post(ctl + CW_BAR, MISC + 8);
    const int lo = a.ph_lo, hi = a.ph_hi;
#define IN(k) (lo <= (k) && (k) < hi)
#define SEAM(k) do { if (IN(k) && IN((k) + 1)) xcd_barrier(bar); } while (0)

#define PH1_BODY { pg8::Gemm g{(const bf16*)(a.ws + WS_A), (const bf16*)(a.ws + WS_WIN), SEQ, NPJ, DM}; pg8::StaticOrder S; S.init(SEQ, NPJ, G, bx); \
        pg8::EpiBf16 E{(bf16*)(a.ws + WS_B), NPJ}; pg8::gemm_phase<pg8::EpiBf16, pg8::StaticOrder, true, true>(lds, g, S, E); }
#define PH5_BODY { pg8::Gemm g{(const bf16*)a.out, (const bf16*)(a.ws + WS_WO), SEQ, DM, DM}; pg8::StaticOrder S; S.init(SEQ, DM, G, bx); \
        pg8::EpiBf16 E{(bf16*)(a.ws + WS_B), DM}; pg8::gemm_phase<pg8::EpiBf16, pg8::StaticOrder, true, true>(lds, g, S, E); }
#define PH7_BODY { pg8::Gemm g{(const bf16*)(a.ws + WS_A), (const bf16*)(a.ws + WS_WGU), SEQ, 2 * DFF, DM}; pg8::StaticOrder S; S.init(SEQ, 2 * DFF, G, bx); \
        pg8::EpiSwiGLU E{(bf16*)(a.ws + WS_B), DFF}; pg8::gemm_phase<pg8::EpiSwiGLU, pg8::StaticOrder, true, true>(lds, g, S, E); }
#define PH8_BODY { pg8::Gemm g{(const bf16*)(a.ws + WS_B), (const bf16*)(a.ws + WS_WD), SEQ, DM, DFF}; pg8::StaticOrder S; S.init(SEQ, DM, G, bx); \
        pg8::EpiBf16 E{(bf16*)(a.ws + WS_FF), DM}; pg8::gemm_phase<pg8::EpiBf16, pg8::StaticOrder, true, true>(lds, g, S, E); }
#define DUP(k) (((PROBE_DUP) >> (k)) & 1)
    if (IN(0)) { phase_p0(a, lds, tid, lane, wave, vcu, G); if (DUP(0)) { __syncthreads(); phase_p0(a, lds, tid, lane, wave, vcu, G); } SEAM(0); }
    if (IN(1)) { PH1_BODY if (DUP(1)) PH1_BODY SEAM(1); }
    if (IN(2)) { phase_m1(a, lds, tid, wave, vcu, G); if (DUP(2)) phase_m1(a, lds, tid, wave, vcu, G); SEAM(2); }
    if (IN(4)) { phase_m3(a, lds, tid, wave, vcu, G); if (DUP(4)) phase_m3(a, lds, tid, wave, vcu, G); SEAM(4); }
    if (IN(5)) { PH5_BODY if (DUP(5)) PH5_BODY SEAM(5); }
    if (IN(6)) { phase_r1(a, lane, wave, vcu, G); if (DUP(6)) phase_r1(a, lane, wave, vcu, G); SEAM(6); }
    if (IN(7)) { PH7_BODY if (DUP(7)) PH7_BODY SEAM(7); }
    if (IN(8)) { PH8_BODY if (DUP(8)) PH8_BODY SEAM(8); }
    if (IN(9)) {
        bool poison = false;
        if (N_LAUNCHES == 1) poison = __hip_atomic_load(ctl + CW_BAR + XB_TMO, __ATOMIC_RELAXED, __HIP_MEMORY_SCOPE_AGENT) != 0u;
        phase_r2(a, lane, wave, vcu, G, poison);
    }
#undef PH1_BODY
#undef PH5_BODY
#undef PH7_BODY
#undef PH8_BODY
#undef DUP
#undef IN
#undef SEAM
}

extern "C" void kernel_launch(void* const* d_in, const int* in_sizes, int n_in, void* d_out, int out_size, void* d_ws, size_t ws_size, hipStream_t stream) {
    static int grid = 0;
    if (grid == 0) {
        if (n_in != 17 || in_sizes[0] != SEQ * DM || out_size != SEQ * DM || ws_size < WS_END) {
            fprintf(stderr, "kernel_launch: unexpected shapes (n_in %d, in0 %d, out %d, ws %zu); nothing launched\n", n_in, n_in > 0 ? in_sizes[0] : -1, out_size, ws_size); grid = -1; return; }
        int dev = 0, cus = 0, per_cu = 0;
        if (hipGetDevice(&dev) != hipSuccess || hipDeviceGetAttribute(&cus, hipDeviceAttributeMultiprocessorCount, dev) != hipSuccess) { grid = -1; return; }
        if (hipFuncSetAttribute((const void*)fwd, hipFuncAttributeMaxDynamicSharedMemorySize, LDS_BYTES) != hipSuccess) { fprintf(stderr, "kernel_launch: hipFuncSetAttribute failed\n"); grid = -1; return; }
        if (hipOccupancyMaxActiveBlocksPerMultiprocessor(&per_cu, (const void*)fwd, NTHR, LDS_BYTES) != hipSuccess || per_cu < 1)
            fprintf(stderr, "kernel_launch: note: occupancy query reports %d workgroups per CU\n", per_cu);
        (void)hipGetLastError();
        grid = cus;
    }
    if (grid < 0) return;
    if (hipMemsetAsync((char*)d_ws + WS_CTL, 0, CTL_ZERO_BYTES, stream) != hipSuccess) return;
    Args a{};
    for (int i = 0; i < 17; ++i) a.in[i] = d_in[i];
    a.out = (float*)d_out; a.ws = (unsigned char*)d_ws;
    if (N_LAUNCHES == 1) { a.ph_lo = 0; a.ph_hi = NPHASES; a.li = 0; hipLaunchKernelGGL(fwd, dim3(grid), dim3(NTHR), LDS_BYTES, stream, a); }
    else for (int li = 0; li < NPHASES; ++li) { a.ph_lo = li; a.ph_hi = li + 1; a.li = li; hipLaunchKernelGGL(fwd, dim3(grid), dim3(NTHR), LDS_BYTES, stream, a); }
}
```

```cpp
#include <hip/hip_runtime.h>
#include <cstdio>
#include <cstdint>

#ifndef PROBE_DUP
#define PROBE_DUP 0
#endif
#ifndef MK_N_LAUNCHES
#define MK_N_LAUNCHES 1
#endif

namespace pg8 {
#define PG8_LAS __attribute__((address_space(3)))
typedef unsigned short bf16_t;
typedef short bf16x8 __attribute__((ext_vector_type(8)));
typedef float f32x4 __attribute__((ext_vector_type(4)));
typedef unsigned u32x4 __attribute__((ext_vector_type(4)));
constexpr int BM = 256, BK = 64, HALF = 128, HTB = HALF * BK * 2  , STAGE_BYTES = 8 * HTB, NXCD = 8, WGM = 4;

__host__ __device__ __forceinline__ int lds_byte(int r, int c) { const int st = (r >> 4) * 2 + (c >> 5), rr = r & 15, cc = c & 31, ob = rr * 64 + cc * 2; return st * 1024 + (ob ^ (((ob >> 9) & 1) << 5)); }
__host__ __device__ __forceinline__ void stage_rc(int b, int& R, int& C) { const int st = b / 1024, sb = b % 1024, swz = sb ^ (((sb >> 9) & 1) << 5); R = (st >> 1) * 16 + swz / 64; C = (st & 1) * 32 + (swz % 64) / 2; }
__host__ __device__ __forceinline__ int perm32(int rho) { const int n = rho >> 4, i = rho & 15; return 8 * (i >> 2) + 4 * n + (i & 3); }

struct Unit { int pm, pn; };
struct Gemm { const bf16_t* A; const bf16_t* Bt; int M, N, K; };

struct StaticOrder {
    int nM, nN, nwg, G, c;
    __host__ __device__ void init(int M, int N, int G_, int c_) { nM = M / BM; nN = N / BM; nwg = nM * nN; G = G_; c = c_; }
    __host__ __device__ bool next(int i, Unit& u) const {
        const long L = (long)i * G + c; if (L >= nwg) return false;
        int wgid = (int)L; { const int q = nwg / NXCD, r = nwg % NXCD, xcd = wgid % NXCD, off = wgid / NXCD; wgid = (xcd < r ? xcd * (q + 1) : r * (q + 1) + (xcd - r) * q) + off; }
        const int nig = WGM * nN, gid = wgid / nig, fm = gid * WGM, gsz = (nM - fm) < WGM ? (nM - fm) : WGM;
        u.pm = fm + ((wgid % nig) % gsz); u.pn = (wgid % nig) / gsz; return true;
    }
    __device__ __forceinline__ void a_ready(const Unit&) const {}
    __device__ __forceinline__ void done(const Unit&) const {}
};

__device__ __forceinline__ unsigned cvt_pk_bf16(float lo, float hi) { unsigned r; asm volatile("v_cvt_pk_bf16_f32 %0, %1, %2" : "=v"(r) : "v"(lo), "v"(hi)); return r; }

struct EpiF32 {
    static constexpr bool PERM = false, AFTER_DRAIN = false;
    float* C; int ldc;
    __device__ __forceinline__ void operator()(const f32x4 (&acc)[2][2][4][2], const Unit& u, int wr, int wc, int fr, int fq) const {
        const int row0 = u.pm * BM + wr * 64 + fr, col0 = u.pn * BM + wc * 32 + 4 * fq;
#pragma unroll
        for (int ai = 0; ai < 2; ++ai)
#pragma unroll
            for (int m = 0; m < 4; ++m) { float* rowp = C + (size_t)(row0 + ai * HALF + m * 16) * ldc + col0;
#pragma unroll
                for (int bj = 0; bj < 2; ++bj)
#pragma unroll
                    for (int n = 0; n < 2; ++n) *(f32x4*)(rowp + bj * HALF + n * 16) = acc[ai][bj][m][n]; }
    }
};
struct EpiBf16 {
    static constexpr bool PERM = true, AFTER_DRAIN = false;
    bf16_t* O; int ldc;
    __device__ __forceinline__ void operator()(const f32x4 (&acc)[2][2][4][2], const Unit& u, int wr, int wc, int fr, int fq) const {
        const int row0 = u.pm * BM + wr * 64 + fr, col0 = u.pn * BM + wc * 32 + 8 * fq;
#pragma unroll
        for (int ai = 0; ai < 2; ++ai)
#pragma unroll
            for (int m = 0; m < 4; ++m) { bf16_t* rowp = O + (size_t)(row0 + ai * HALF + m * 16) * ldc + col0;
#pragma unroll
                for (int bj = 0; bj < 2; ++bj) { const f32x4 v0 = acc[ai][bj][m][0], v1 = acc[ai][bj][m][1];
                    u32x4 w; w.x = cvt_pk_bf16(v0[0], v0[1]); w.y = cvt_pk_bf16(v0[2], v0[3]); w.z = cvt_pk_bf16(v1[0], v1[1]); w.w = cvt_pk_bf16(v1[2], v1[3]);
                    *(u32x4*)(rowp + bj * HALF) = w; } }
    }
};
__device__ __forceinline__ float silu_f(float x) { return x * __builtin_amdgcn_rcpf(1.0f + __expf(-x)); }
struct EpiSwiGLU {
    static constexpr bool PERM = true, AFTER_DRAIN = false;
    bf16_t* O; int ldc;
    __device__ __forceinline__ void operator()(const f32x4 (&acc)[2][2][4][2], const Unit& u, int wr, int wc, int fr, int fq) const {
        const int row0 = u.pm * BM + wr * 64 + fr, col0 = u.pn * HALF + wc * 32 + 8 * fq;
#pragma unroll
        for (int ai = 0; ai < 2; ++ai)
#pragma unroll
            for (int m = 0; m < 4; ++m) { bf16_t* rowp = O + (size_t)(row0 + ai * HALF + m * 16) * ldc + col0;
                const f32x4 g0 = acc[ai][0][m][0], g1 = acc[ai][0][m][1], u0 = acc[ai][1][m][0], u1 = acc[ai][1][m][1];
                u32x4 w; w.x = cvt_pk_bf16(silu_f(g0[0]) * u0[0], silu_f(g0[1]) * u0[1]); w.y = cvt_pk_bf16(silu_f(g0[2]) * u0[2], silu_f(g0[3]) * u0[3]);
                w.z = cvt_pk_bf16(silu_f(g1[0]) * u1[0], silu_f(g1[1]) * u1[1]); w.w = cvt_pk_bf16(silu_f(g1[2]) * u1[2], silu_f(g1[3]) * u1[3]);
                *(u32x4*)rowp = w; }
    }
};

template <class Epi, class Sched, bool ALIGN_EPI = false, bool SP2 = false>
__device__ __forceinline__ void gemm_phase(PG8_LAS unsigned char* lds, const Gemm g, const Sched& S, const Epi& E) {
    const int tid = threadIdx.x, wid = __builtin_amdgcn_readfirstlane(tid >> 6), lane = tid & 63, wr = wid >> 2, wc = wid & 3, fr = lane & 15, fq = lane >> 4;
    const int K = g.K, nt = K / BK;
    unsigned voffA[2], voffB[2];
#pragma unroll
    for (int i = 0; i < 2; ++i) { int R, C; stage_rc(tid * 16 + i * 8192, R, C); const int Rb = Epi::PERM ? ((R & ~31) + perm32(R & 31)) : R;
        voffA[i] = (unsigned)(R * K + C) * 2u; voffB[i] = (unsigned)(Rb * K + C) * 2u; }
    const size_t kstep = (size_t)(BK * 2);
    const size_t hstep = (size_t)HALF * K * 2;
    const size_t tstep = 2 * hstep;
    const unsigned ldsw = (unsigned)wid * 1024u;
    const int aoff = lds_byte(wr * 64 + fr, fq * 8), boff = lds_byte(wc * 32 + fr, fq * 8);
#define PG8_SA(b, h) (((b) * 2 + (h)) * HTB)
#define PG8_SB(b, h) ((4 + (b) * 2 + (h)) * HTB)
#define PG8_STAGE(bufoff, gbase, voff) do { _Pragma("unroll") for (int _i = 0; _i < 2; ++_i) \
        __builtin_amdgcn_global_load_lds((const unsigned*)((const char*)(gbase) + (voff)[_i]), (PG8_LAS unsigned*)(lds + (bufoff) + ldsw + _i * 8192), 16, 0, 0); } while (0)
#define PG8_LDA(dst, b, h) do { _Pragma("unroll") for (int m = 0; m < 4; ++m) _Pragma("unroll") for (int k = 0; k < 2; ++k) dst[m][k] = *(const PG8_LAS bf16x8*)(lds + PG8_SA(b, h) + aoff + m * 2048 + k * 1024); } while (0)
#define PG8_LDB(dst, b, h) do { _Pragma("unroll") for (int n = 0; n < 2; ++n) _Pragma("unroll") for (int k = 0; k < 2; ++k) dst[n][k] = *(const PG8_LAS bf16x8*)(lds + PG8_SB(b, h) + boff + n * 2048 + k * 1024); } while (0)
#define PG8_MMA(ai, bj, At, Bt) do { __builtin_amdgcn_s_setprio(1); _Pragma("unroll") for (int m = 0; m < 4; ++m) _Pragma("unroll") for (int n = 0; n < 2; ++n) _Pragma("unroll") for (int k = 0; k < 2; ++k) \
        acc[ai][bj][m][n] = __builtin_amdgcn_mfma_f32_16x16x32_bf16(Bt[n][k], At[m][k], acc[ai][bj][m][n], 0, 0, 0); __builtin_amdgcn_s_setprio(0); } while (0)
#define PG8_WAIT_V(n) asm volatile("s_waitcnt vmcnt(" #n ")" ::: "memory")
#define PG8_WAIT_L(n) asm volatile("s_waitcnt lgkmcnt(" #n ")" ::: "memory")
#define PG8_BAR __builtin_amdgcn_s_barrier()
#define PG8_SCHED __builtin_amdgcn_sched_barrier(0)
    Unit cur, nxt; int ui = 0;
    if (!S.next(0, cur)) return;
    f32x4 acc[2][2][4][2];
#pragma unroll
    for (int a = 0; a < 2; ++a)
#pragma unroll
        for (int b = 0; b < 2; ++b)
#pragma unroll
            for (int m = 0; m < 4; ++m)
#pragma unroll
                for (int n = 0; n < 2; ++n) acc[a][b][m][n] = (f32x4){0.f, 0.f, 0.f, 0.f};
    bf16x8 At[4][2], B0[2][2], B1[2][2];
    const char* cA = (const char*)g.A + (size_t)cur.pm * tstep; const char* cB = (const char*)g.Bt + (size_t)cur.pn * tstep;
    S.a_ready(cur);
    if constexpr (SP2) {
        PG8_STAGE(PG8_SB(0, 0), cB, voffB); PG8_STAGE(PG8_SB(0, 1), cB + hstep, voffB); PG8_STAGE(PG8_SA(0, 0), cA, voffA); PG8_STAGE(PG8_SA(0, 1), cA + hstep, voffA);
        if (wr == 1) PG8_BAR;
        PG8_WAIT_V(2); PG8_BAR;
        PG8_STAGE(PG8_SB(1, 0), cB + kstep, voffB); PG8_STAGE(PG8_SA(1, 0), cA + kstep, voffA); PG8_STAGE(PG8_SB(1, 1), cB + hstep + kstep, voffB);
        PG8_WAIT_V(6); PG8_BAR;
    } else {
        PG8_STAGE(PG8_SB(0, 0), cB, voffB); PG8_STAGE(PG8_SA(0, 0), cA, voffA); PG8_STAGE(PG8_SB(0, 1), cB + hstep, voffB); PG8_STAGE(PG8_SA(0, 1), cA + hstep, voffA);
        if (wr == 1) PG8_BAR;
        PG8_WAIT_V(4); PG8_BAR;
        PG8_STAGE(PG8_SB(1, 0), cB + kstep, voffB); PG8_STAGE(PG8_SA(1, 0), cA + kstep, voffA); PG8_STAGE(PG8_SB(1, 1), cB + hstep + kstep, voffB);
        PG8_WAIT_V(6); PG8_BAR;
    }
    for (;;) {
        const bool has_next = S.next(ui + 1, nxt);
        const char* nA = has_next ? (const char*)g.A + (size_t)nxt.pm * tstep : cA; const char* nB = has_next ? (const char*)g.Bt + (size_t)nxt.pn * tstep : cB;
        for (int t = 0; t < nt; t += 2) {
            const bool last = (t == nt - 2);
            const char* a1 = cA + (size_t)(t + 1) * kstep;
            const char* a2 = last ? nA : cA + (size_t)(t + 2) * kstep; const char* b2 = last ? nB : cB + (size_t)(t + 2) * kstep;
            const char* a3 = a2 + kstep; const char* b3 = b2 + kstep;
            if (last && has_next) S.a_ready(nxt);
            if constexpr (SP2) {
            PG8_LDB(B0, 0, 0); PG8_LDB(B1, 0, 1); PG8_SCHED; PG8_LDA(At, 0, 0); PG8_STAGE(PG8_SA(1, 1), a1 + hstep, voffA);
            PG8_WAIT_V(8); PG8_WAIT_L(0); PG8_BAR; PG8_MMA(0, 0, At, B0); PG8_MMA(0, 1, At, B1); PG8_BAR; PG8_SCHED;
            PG8_LDA(At, 0, 1); PG8_STAGE(PG8_SB(0, 0), b2, voffB); PG8_STAGE(PG8_SB(0, 1), b2 + hstep, voffB); PG8_STAGE(PG8_SA(0, 0), a2, voffA);
            PG8_WAIT_V(8); PG8_WAIT_L(0); PG8_BAR; PG8_MMA(1, 0, At, B0); PG8_MMA(1, 1, At, B1); PG8_BAR; PG8_SCHED;
            PG8_LDB(B0, 1, 0); PG8_LDB(B1, 1, 1); PG8_SCHED; PG8_LDA(At, 1, 0); PG8_STAGE(PG8_SA(0, 1), a2 + hstep, voffA);
            PG8_WAIT_V(8); PG8_WAIT_L(0); PG8_BAR; PG8_MMA(0, 0, At, B0); PG8_MMA(0, 1, At, B1); PG8_BAR; PG8_SCHED;
            PG8_LDA(At, 1, 1); PG8_STAGE(PG8_SB(1, 0), b3, voffB); PG8_STAGE(PG8_SB(1, 1), b3 + hstep, voffB); PG8_STAGE(PG8_SA(1, 0), a3, voffA);
            PG8_WAIT_V(8); PG8_WAIT_L(0); PG8_BAR; PG8_MMA(1, 0, At, B0); PG8_MMA(1, 1, At, B1); PG8_BAR; PG8_SCHED;
            } else {
            PG8_LDB(B0, 0, 0); PG8_SCHED; PG8_LDA(At, 0, 0); PG8_STAGE(PG8_SA(1, 1), a1 + hstep, voffA);
            PG8_WAIT_L(8); PG8_BAR; PG8_WAIT_L(0); PG8_MMA(0, 0, At, B0); PG8_BAR; PG8_SCHED;
            PG8_LDB(B1, 0, 1); PG8_STAGE(PG8_SB(0, 0), b2, voffB);
            PG8_BAR; PG8_WAIT_L(0); PG8_MMA(0, 1, At, B1); PG8_BAR;
            PG8_LDA(At, 0, 1); PG8_STAGE(PG8_SA(0, 0), a2, voffA);
            PG8_BAR; PG8_WAIT_L(0); PG8_MMA(1, 0, At, B0); PG8_BAR; PG8_SCHED;
            PG8_STAGE(PG8_SB(0, 1), b2 + hstep, voffB);
            PG8_WAIT_V(6); PG8_BAR; PG8_MMA(1, 1, At, B1); PG8_BAR;
            PG8_LDB(B0, 1, 0); PG8_SCHED; PG8_LDA(At, 1, 0); PG8_STAGE(PG8_SA(0, 1), a2 + hstep, voffA);
            PG8_WAIT_L(8); PG8_BAR; PG8_WAIT_L(0); PG8_MMA(0, 0, At, B0); PG8_BAR; PG8_SCHED;
            PG8_LDB(B1, 1, 1); PG8_STAGE(PG8_SB(1, 0), b3, voffB);
            PG8_BAR; PG8_WAIT_L(0); PG8_MMA(0, 1, At, B1); PG8_BAR;
            PG8_LDA(At, 1, 1); PG8_STAGE(PG8_SA(1, 0), a3, voffA);
            PG8_BAR; PG8_WAIT_L(0); PG8_MMA(1, 0, At, B0); PG8_BAR; PG8_SCHED;
            PG8_STAGE(PG8_SB(1, 1), b3 + hstep, voffB);
            PG8_WAIT_V(6); PG8_BAR; PG8_MMA(1, 1, At, B1); PG8_BAR;
            }
        }
        if constexpr (ALIGN_EPI) { if (wr == 0) PG8_BAR; }
        if constexpr (!Epi::AFTER_DRAIN) { E(acc, cur, wr, wc, fr, fq); S.done(cur); }
        if (!has_next) break;
#pragma unroll
        for (int a = 0; a < 2; ++a)
#pragma unroll
            for (int b = 0; b < 2; ++b)
#pragma unroll
                for (int m = 0; m < 4; ++m)
#pragma unroll
                    for (int n = 0; n < 2; ++n) acc[a][b][m][n] = (f32x4){0.f, 0.f, 0.f, 0.f};
        cur = nxt; cA = nA; cB = nB; ++ui;
        if constexpr (ALIGN_EPI) { if (wr == 1) PG8_BAR; }
    }
    PG8_WAIT_V(0);
    if constexpr (!ALIGN_EPI) { if (wr == 0) PG8_BAR; }
    PG8_BAR;
#undef PG8_SA
#undef PG8_SB
#undef PG8_STAGE
#undef PG8_LDA
#undef PG8_LDB
#undef PG8_MMA
#undef PG8_WAIT_V
#undef PG8_WAIT_L
#undef PG8_BAR
#undef PG8_SCHED
}
}

constexpr int NWAVES = 8, NTHR = 512;
constexpr int SEQ = 16384, DM = 2048, HD = 128, NHG = 8, DPROJ = 8208, NPJ = 8192, DFF = 5632, CH = 128, NCH = SEQ / CH, NHEADS = 16;
constexpr float NORM_EPS = 1e-6f;
constexpr int N_LAUNCHES = MK_N_LAUNCHES, NPHASES = 10;
constexpr int PC_MQ = 0, PC_MK = 1024, PC_MV = 2048, PC_MO = 3072, PC_RQ = 4096, PC_RK = 5120, PC_RV = 6144, PC_RG = 7168;

constexpr size_t MiB = 1u << 20;
constexpr size_t WS_CTL = 0, CTL_ZERO_BYTES = 64 * 1024;
constexpr size_t WS_WIN = 2 * MiB, WS_WO = 34 * MiB, WS_WGU = 42 * MiB, WS_WD = 86 * MiB;
constexpr size_t WS_PRE = 108 * MiB;
constexpr size_t WS_RS = 109 * MiB;
constexpr size_t WS_NLOC = 110 * MiB;
constexpr size_t WS_N0 = 110 * MiB + 512 * 1024;
constexpr size_t WS_DEC = 111 * MiB;
constexpr size_t WS_GHEAD = 111 * MiB + 65536;
constexpr size_t WS_COS = 112 * MiB, WS_SIN = 116 * MiB;
constexpr size_t WS_B = 128 * MiB;
constexpr size_t WS_A = 384 * MiB;
constexpr size_t WS_FF = WS_B + 176 * MiB;
constexpr size_t WS_X1 = 448 * MiB;
constexpr size_t WS_END = 512 * MiB;
constexpr int CW_BAR = 1024;

constexpr int RING_BYTES = 131072;
constexpr int GATE_OFF = RING_BYTES;
constexpr int N0B_OFF = GATE_OFF + 8 * 1536;
constexpr int CONVW_OFF = N0B_OFF + 256;
constexpr int MISC_OFF = CONVW_OFF + 5120;
constexpr int LDS_BYTES = 163840;
static_assert(MISC_OFF + 1024 + 5120 <= LDS_BYTES, "LDS map");

#define GAS __attribute__((address_space(1)))
#define LAS __attribute__((address_space(3)))
#define DI __device__ __forceinline__
typedef unsigned short bf16;
typedef unsigned u32x4 __attribute__((ext_vector_type(4)));
typedef unsigned u32x2 __attribute__((ext_vector_type(2)));
typedef float f32x4 __attribute__((ext_vector_type(4)));
typedef float f32x2 __attribute__((ext_vector_type(2)));
typedef LAS unsigned char* ldsp;
#define LDS_WAIT() asm volatile("s_waitcnt lgkmcnt(0)" ::: "memory")

DI unsigned f2bf(float f) { unsigned u = __builtin_bit_cast(unsigned, f); return (u + 0x7fffu + ((u >> 16) & 1u)) >> 16; }
DI unsigned pk2(float lo, float hi) { unsigned r; asm volatile("v_cvt_pk_bf16_f32 %0, %1, %2" : "=v"(r) : "v"(lo), "v"(hi)); return r; }
DI float bflo(unsigned w) { return __builtin_bit_cast(float, w << 16); }
DI float bfhi(unsigned w) { return __builtin_bit_cast(float, w & 0xffff0000u); }
DI void unpack8(const u32x4 w, float (&f)[8]) { f[0] = bflo(w.x); f[1] = bfhi(w.x); f[2] = bflo(w.y); f[3] = bfhi(w.y); f[4] = bflo(w.z); f[5] = bfhi(w.z); f[6] = bflo(w.w); f[7] = bfhi(w.w); }
DI u32x4 pack8(const float (&f)[8]) { u32x4 w; w.x = pk2(f[0], f[1]); w.y = pk2(f[2], f[3]); w.z = pk2(f[4], f[5]); w.w = pk2(f[6], f[7]); return w; }
DI float sigmoid_f(float x) { return __builtin_amdgcn_rcpf(1.0f + __expf(-x)); }
DI float silu_f(float x) { return x * __builtin_amdgcn_rcpf(1.0f + __expf(-x)); }
DI float wave_sum(float v) {
#pragma unroll
    for (int o = 1; o < 64; o <<= 1) v += __shfl_xor(v, o);
    return v;
}

#define XB_TMO      128
#define XB_XCNT(j)  (256  + 64 * (j))
#define XB_XSUB(j)  (1280 + 64 * (j))
#define XB_XGEN(j)  (2304 + 64 * (j))
#define XB_TOP      3328
#define XB_TOPGEN   3392
#define XCD_BAR_WORDS 3456
#define XB_SPIN_CAP (1u << 18)
__device__ __forceinline__ unsigned xb_ld(unsigned* p)              { return __hip_atomic_load(p, __ATOMIC_RELAXED, __HIP_MEMORY_SCOPE_AGENT); }
__device__ __forceinline__ unsigned xb_add(unsigned* p, unsigned v) { return __hip_atomic_fetch_add(p, v, __ATOMIC_RELAXED, __HIP_MEMORY_SCOPE_AGENT); }
__device__ __forceinline__ unsigned xb_xcc_id() { return (unsigned)__builtin_amdgcn_s_getreg((3 << 11) | 20) & 0xFu; }
#define XB_SPIN(cond, bar) do { unsigned _sp = 0; while (cond) { __builtin_amdgcn_s_sleep(1); \
    if ((++_sp & 255u) == 0u) { if (xb_ld(&(bar)[XB_TMO])) break; if (_sp > XB_SPIN_CAP) { atomicAdd(&(bar)[XB_TMO], 1u); break; } } } } while (0)
struct XcdBarrier { unsigned* bar; unsigned x; volatile LAS unsigned* st; };
__device__ __forceinline__ XcdBarrier xcd_barrier_post(unsigned* bar, volatile LAS unsigned* st) {
    XcdBarrier b; b.bar = bar; b.x = xb_xcc_id(); b.st = st;
    if (threadIdx.x == 0) (void)xb_add(&bar[XB_XCNT(b.x)], 1u);
    return b;
}
__device__ __forceinline__ void xcd_barrier_complete(unsigned* bar, unsigned x, unsigned& nloc, unsigned& nx) {
    const unsigned G = gridDim.x * gridDim.y * gridDim.z;
    unsigned sum, cnt, mine, sp = 0u;
    for (;;) {
        sum = 0u; cnt = 0u; mine = 0u;
#pragma unroll
        for (unsigned j = 0; j < 16; ++j) { const unsigned c = xb_ld(&bar[XB_XCNT(j)]); sum += c; cnt += (c > 0u) ? 1u : 0u; mine = (j == x) ? c : mine; }
        if (sum == G) break;
        __builtin_amdgcn_s_sleep(1);
        if ((++sp & 255u) == 0u) { if (xb_ld(&bar[XB_TMO])) break; if (sp > XB_SPIN_CAP) { atomicAdd(&bar[XB_TMO], 1u); break; } }
    }
    nloc = mine > 0u ? mine : 1u; nx = cnt > 0u ? cnt : 1u;
}
__device__ __forceinline__ void xcd_barrier(const XcdBarrier& b) {
    asm volatile("s_waitcnt vmcnt(0)" ::: "memory");
    __syncthreads();
    if (threadIdx.x == 0) {
        unsigned* bar = b.bar;
        __builtin_amdgcn_s_waitcnt(0);
        unsigned nloc = b.st[0], nx = b.st[1];
        if (nloc == 0u) { xcd_barrier_complete(bar, b.x, nloc, nx); b.st[0] = nloc; b.st[1] = nx; }
        const unsigned old = xb_add(&bar[XB_XSUB(b.x)], 1u);
        const unsigned gen = old / nloc;
        if (old + 1u == (gen + 1u) * nloc) {
            __builtin_amdgcn_fence(__ATOMIC_RELEASE, "agent");
            asm volatile("s_waitcnt vmcnt(0)" ::: "memory");
            const unsigned og = xb_add(&bar[XB_TOP], 1u);
            const unsigned tg = og / nx;
            if (og + 1u == (tg + 1u) * nx) xb_add(&bar[XB_TOPGEN], 1u);
            else XB_SPIN(xb_ld(&bar[XB_TOPGEN]) == tg, bar);
            __builtin_amdgcn_fence(__ATOMIC_ACQUIRE, "agent");
            xb_add(&bar[XB_XGEN(b.x)], 1u);
            asm volatile("s_waitcnt vmcnt(0)" ::: "memory");
        } else {
            XB_SPIN(xb_ld(&bar[XB_XGEN(b.x)]) == gen, bar);
            __builtin_amdgcn_fence(__ATOMIC_ACQUIRE, "agent");
            asm volatile("s_waitcnt vmcnt(0)" ::: "memory");
        }
    }
    __syncthreads();
}

struct Args { const void* in[17]; float* out; unsigned char* ws; int ph_lo, ph_hi, li, pad; };
enum { IN_X = 0, IN_POS, IN_GPRE, IN_WIN, IN_CW, IN_CB, IN_BI, IN_BF, IN_GMH, IN_GRH, IN_WOUT, IN_GPOST, IN_GFPRE, IN_WG, IN_WU, IN_WDN, IN_GFPOST };

struct TrItem { const float* W; bf16* WT; int K, ldw, src_col, dst_row, kb; };
DI void p0_tr_load(const TrItem& it, int lane, f32x4 (&v)[8]) {
    const float* src = it.W + (size_t)(64 * it.kb + (lane >> 3)) * it.ldw + it.src_col + 4 * (lane & 7);
#pragma unroll
    for (int i = 0; i < 8; ++i) v[i] = *(const GAS f32x4*)(src + (size_t)(8 * i) * it.ldw);
}
DI void p0_tr_store(const TrItem& it, int lane, const f32x4 (&v)[8], LAS float* scr) {
#pragma unroll
    for (int i = 0; i < 8; ++i) *(LAS f32x4*)(scr + (8 * i + (lane >> 3)) * 36 + 4 * (lane & 7)) = v[i];
    LDS_WAIT(); asm volatile("" ::: "memory");
    const int c = lane & 7;
#pragma unroll
    for (int j = 0; j < 4; ++j) { const int n = (lane >> 3) + 8 * j; const LAS float* sp = scr + (8 * c) * 36 + n;
        u32x4 o; o.x = pk2(sp[0 * 36], sp[1 * 36]); o.y = pk2(sp[2 * 36], sp[3 * 36]); o.z = pk2(sp[4 * 36], sp[5 * 36]); o.w = pk2(sp[6 * 36], sp[7 * 36]);
        *(GAS u32x4*)(it.WT + (size_t)(it.dst_row + n) * it.K + 64 * it.kb + 8 * c) = o; }
    LDS_WAIT(); asm volatile("" ::: "memory");
}
constexpr int I_IN = 32 * 256, I_O = 32 * 64, I_G = 32 * 176, I_D = 88 * 64;
DI TrItem tr_item(const Args& a, int set, int r) {
    TrItem it;
    if (set == 0) { const int kb = r / 256, nb = r % 256; it.W = (const float*)a.in[IN_WIN]; it.WT = (bf16*)(a.ws + WS_WIN); it.K = DM; it.ldw = DPROJ; it.src_col = nb < 128 ? 32 * nb : 4112 + 32 * (nb - 128); it.dst_row = 32 * nb; it.kb = kb; return it; }
    if (r < I_O) { const int kb = r / 64, nb = r % 64; it.W = (const float*)a.in[IN_WOUT]; it.WT = (bf16*)(a.ws + WS_WO); it.K = DM; it.ldw = DM; it.src_col = 32 * nb; it.dst_row = 32 * nb; it.kb = kb; return it; } r -= I_O;
    if (r < I_G) { const int kb = r / 176, nb = r % 176; it.W = (const float*)a.in[IN_WG]; it.WT = (bf16*)(a.ws + WS_WGU); it.K = DM; it.ldw = DFF; it.src_col = 32 * nb; it.dst_row = 256 * (nb >> 2) + 32 * (nb & 3); it.kb = kb; return it; } r -= I_G;
    if (r < I_G) { const int kb = r / 176, nb = r % 176; it.W = (const float*)a.in[IN_WU]; it.WT = (bf16*)(a.ws + WS_WGU); it.K = DM; it.ldw = DFF; it.src_col = 32 * nb; it.dst_row = 256 * (nb >> 2) + 128 + 32 * (nb & 3); it.kb = kb; return it; } r -= I_G;
    { const int kb = r / 64, nb = r % 64; it.W = (const float*)a.in[IN_WDN]; it.WT = (bf16*)(a.ws + WS_WD); it.K = DFF; it.ldw = DM; it.src_col = 32 * nb; it.dst_row = 32 * nb; it.kb = kb; return it; }
}
DI void convert_weights(const Args& a, ldsp lds, int set, int lane, int wave, int vcu, int G) {
    const int gw = vcu * NWAVES + wave, NGW = G * NWAVES, nitems = set == 0 ? I_IN : I_O + 2 * I_G + I_D;
    LAS float* scr = (LAS float*)(lds + wave * 16384);
    f32x4 va[8], vb[8];
    int it = gw; if (it < nitems) p0_tr_load(tr_item(a, set, it), lane, va);
    for (; it < nitems; it += 2 * NGW) {
        if (it + NGW < nitems) p0_tr_load(tr_item(a, set, it + NGW), lane, vb);
        p0_tr_store(tr_item(a, set, it), lane, va, scr);
        if (it + 2 * NGW < nitems) p0_tr_load(tr_item(a, set, it + 2 * NGW), lane, va);
        if (it + NGW < nitems) p0_tr_store(tr_item(a, set, it + NGW), lane, vb, scr);
    }
}
DI void phase_p0(const Args& a, ldsp lds, int tid, int lane, int wave, int vcu, int G) {
    const int gw = vcu * NWAVES + wave, NGW = G * NWAVES;
    const float* x = (const float*)a.in[IN_X]; const float* gpre = (const float*)a.in[IN_GPRE]; const float* w_in = (const float*)a.in[IN_WIN];
    bf16* hb = (bf16*)(a.ws + WS_A); float* PRE = (float*)(a.ws + WS_PRE);
    LAS unsigned short* Wf = (LAS unsigned short*)lds;
#pragma unroll 4
    for (int i = 0; i < 16; ++i) { const int idx = tid + NTHR * i, k = idx >> 2, c4 = idx & 3;
        const f32x4 w = *(const GAS f32x4*)(w_in + (size_t)k * DPROJ + 4096 + 4 * c4);
        LAS unsigned short* d = Wf + ((k >> 5) * 64 + ((k >> 3) & 3) * 16 + 4 * c4) * 8 + (k & 7);
        d[0] = (unsigned short)f2bf(w.x); d[8] = (unsigned short)f2bf(w.y); d[16] = (unsigned short)f2bf(w.z); d[24] = (unsigned short)f2bf(w.w); }
    LDS_WAIT(); __syncthreads();
    LAS float* part = (LAS float*)(lds + 65536);
    for (int rb = vcu; rb < SEQ / 64; rb += G) {
        {
            const GAS f32x4* gr = (const GAS f32x4*)gpre + lane;
#define P0_LOAD(buf, mm) do { const GAS f32x4* xr_ = (const GAS f32x4*)(x + (size_t)(mm) * DM) + lane; _Pragma("unroll") for (int j = 0; j < 8; ++j) buf[j] = xr_[64 * j]; } while (0)
#define P0_ROW(buf, mm) do { float s_ = 0.f; _Pragma("unroll") for (int j = 0; j < 8; ++j) s_ += (buf[j].x * buf[j].x + buf[j].y * buf[j].y) + (buf[j].z * buf[j].z + buf[j].w * buf[j].w); \
            const float r_ = 1.0f / sqrtf(wave_sum(s_) * (1.0f / DM) + NORM_EPS); GAS u32x2* o_ = (GAS u32x2*)(hb + (size_t)(mm) * DM) + lane; \
            _Pragma("unroll") for (int j = 0; j < 8; ++j) { const f32x4 gg = gr[64 * j]; u32x2 w; w.x = pk2(buf[j].x * r_ * gg.x, buf[j].y * r_ * gg.y); w.y = pk2(buf[j].z * r_ * gg.z, buf[j].w * r_ * gg.w); o_[64 * j] = w; } } while (0)
            f32x4 va[8], vb[8];
            const int m0 = rb * 64 + wave * 8;
            P0_LOAD(va, m0);
#pragma unroll 1
            for (int i = 0; i < 8; i += 2) {
                P0_LOAD(vb, m0 + i + 1);
                P0_ROW(va, m0 + i);
                if (i + 2 < 8) P0_LOAD(va, m0 + i + 2);
                P0_ROW(vb, m0 + i + 1);
            }
#undef P0_LOAD
#undef P0_ROW
        }
        asm volatile("s_waitcnt vmcnt(0)" ::: "memory"); __syncthreads();
        {
            const int tile = wave & 3, kh = wave >> 2, row = lane & 15, kq = lane >> 4, t0 = rb * 64 + tile * 16;
            const GAS u32x4* hr = (const GAS u32x4*)(hb + (size_t)(t0 + row) * DM + kh * 1024 + 8 * kq);
            const LAS u32x4* wf = (const LAS u32x4*)lds + (kh * 32) * 64 + lane;
            pg8::f32x4 acc = {0.f, 0.f, 0.f, 0.f};
            for (int sp = 0; sp < 32; sp += 8) { u32x4 hv[8];
#pragma unroll
                for (int j = 0; j < 8; ++j) hv[j] = hr[4 * (sp + j)];
#pragma unroll
                for (int j = 0; j < 8; ++j) acc = __builtin_amdgcn_mfma_f32_16x16x32_bf16(__builtin_bit_cast(pg8::bf16x8, hv[j]), __builtin_bit_cast(pg8::bf16x8, wf[(sp + j) * 64]), acc, 0, 0, 0);
            }
            if (kh == 1) {
#pragma unroll
                for (int j = 0; j < 4; ++j) part[(tile * 4 + j) * 64 + lane] = acc[j]; }
            LDS_WAIT(); __syncthreads();
            if (kh == 0) {
#pragma unroll
                for (int j = 0; j < 4; ++j) PRE[(size_t)(t0 + 4 * kq + j) * 16 + row] = acc[j] + part[(tile * 4 + j) * 64 + lane]; }
            __syncthreads();
        }
    }
    __syncthreads();
    convert_weights(a, lds, 0, lane, wave, vcu, G);
    convert_weights(a, lds, 1, lane, wave, vcu, G);
    { float* GH = (float*)(a.ws + WS_GHEAD); const float* gmh = (const float*)a.in[IN_GMH]; const float* grh = (const float*)a.in[IN_GRH];
      for (int i = vcu * NTHR + tid; i < 1024; i += G * NTHR) GH[i] = gmh[i];
      for (int i = vcu * NTHR + tid; i < 1024; i += G * NTHR) GH[1024 + i] = grh[i]; }
    const int* pos = (const int*)a.in[IN_POS]; float* COS = (float*)(a.ws + WS_COS); float* SIN = (float*)(a.ws + WS_SIN);
    { LAS float* invf = (LAS float*)(lds + GATE_OFF);
      if (tid < 64) invf[tid] = (float)pow(10000.0, -(double)(2 * tid) / 128.0);
      LDS_WAIT(); __syncthreads();
      for (int i = vcu * NTHR + tid; i < SEQ * 64; i += G * NTHR) { const int t = i >> 6, j = i & 63;
          const float ang = (float)pos[t] * invf[j]; float sn, cs; sincosf(ang, &sn, &cs); COS[i] = cs; SIN[i] = sn; } }
}

typedef short bf16x8 __attribute__((ext_vector_type(8)));
typedef short s16x4 __attribute__((ext_vector_type(4)));
typedef float f32x16 __attribute__((ext_vector_type(16)));
#define MFMA32(a, b, c) __builtin_amdgcn_mfma_f32_32x32x16_bf16((a), (b), (c), 0, 0, 0)
DI int crow(int reg, int h) { return (reg & 3) + 8 * (reg >> 2) + 4 * h; }
DI bf16x8 bf_ones() { return (bf16x8){16256, 16256, 16256, 16256, 16256, 16256, 16256, 16256}; }
DI int offb(int row, int ch) { return 256 * row + 16 * (ch ^ (((row & 3) << 2) | ((row >> 2) & 3))); }
DI int rowbase(int row, int h) { return offb(row, h); }
DI bf16x8 rowfrag(ldsp tile, int rb, int ks) { return *(const LAS bf16x8*)(tile + (rb ^ (ks << 5))); }
DI s16x4 tr_rd(ldsp p) { return __builtin_bit_cast(s16x4, __builtin_amdgcn_ds_read_tr16_b64_v4i16((LAS s16x4*)p)); }
struct TrB { int b0, b1; };
DI TrB trbase(int c, int lane) {
    const int h = lane >> 5, blk = (lane >> 4) & 1, q = (lane & 15) >> 2, p = lane & 3, ch = 4 * c + 2 * blk + (p >> 1);
    TrB b; b.b0 = offb(8 * h + q, ch) + 8 * (p & 1); b.b1 = offb(8 * h + 4 + q, ch) + 8 * (p & 1); return b;
}
DI bf16x8 trfrag(ldsp tile, const TrB b, int ks) {
    const s16x4 lo = tr_rd(tile + b.b0 + 4096 * ks), hi = tr_rd(tile + b.b1 + 4096 * ks);
    return __builtin_shufflevector(lo, hi, 0, 1, 2, 3, 4, 5, 6, 7);
}
DI void gload8(const bf16* p, float (&f)[8]) { unpack8(*(const GAS u32x4*)p, f); }

DI void mixer_setup(const Args& a, ldsp lds, int g, int grp, int tid, int lane, int wave) {
    if (g < NHG) {
        LAS float* rowv = (LAS float*)(lds + GATE_OFF + wave * 1536); LAS float* colv = rowv + 128; LAS float* alog = rowv + 256;
        const float* PRE = (const float*)(a.ws + WS_PRE); const float bi = ((const float*)a.in[IN_BI])[g], bfg = ((const float*)a.in[IN_BF])[g];
        const int t0 = (8 * grp + wave) * CH + 2 * lane;
        const float i0 = PRE[(size_t)t0 * 16 + g] + bi, i1 = PRE[(size_t)(t0 + 1) * 16 + g] + bi;
        const float f0 = PRE[(size_t)t0 * 16 + 8 + g] + bfg, f1 = PRE[(size_t)(t0 + 1) * 16 + 8 + g] + bfg;
        const float l0 = fminf(f0, 0.f) - log1pf(__expf(-fabsf(f0))), l1 = fminf(f1, 0.f) - log1pf(__expf(-fabsf(f1)));
        float p = l0 + l1;
#pragma unroll
        for (int o = 1; o < 64; o <<= 1) { const float y = __shfl_up(p, o); if (lane >= o) p += y; }
        const float b1 = p, b0 = p - l1;
        rowv[2 * lane] = b0; rowv[2 * lane + 1] = b1; alog[2 * lane] = b0; alog[2 * lane + 1] = b1; colv[2 * lane] = i0 - b0; colv[2 * lane + 1] = i1 - b1;
        if (tid < 128) { LAS float* cwl = (LAS float*)(lds + CONVW_OFF); const float* cw = (const float*)a.in[IN_CW]; const float* cb = (const float*)a.in[IN_CB];
#pragma unroll
            for (int j = 0; j < 4; ++j) { cwl[j * 128 + tid] = cw[j * 2048 + g * HD + tid]; cwl[640 + j * 128 + tid] = cw[j * 2048 + 1024 + g * HD + tid]; }
            cwl[512 + tid] = cb[g * HD + tid]; cwl[640 + 512 + tid] = cb[1024 + g * HD + tid]; }
    } else if (tid < 128) {
        LAS float* rowv = (LAS float*)(lds + GATE_OFF); LAS float* colv = rowv + 128; LAS float* alog = rowv + 256;
        const float lg = log1pf(-exp2f(-5.0f - (float)(g - NHG)));
        rowv[tid] = (float)tid * lg; colv[tid] = -(float)tid * lg; alog[tid] = (float)(tid + 1) * lg;
    }
    LDS_WAIT(); __syncthreads();
}
template <bool WITHQ> DI void mixer_tiles(const Args& a, ldsp lds, int g, int c, const LAS float* gt, int tid) {
    const bf16* proj = (const bf16*)(a.ws + WS_B);
    const LAS float* colv = gt + 128; const float rv127 = gt[127];
    ldsp Q = lds, K = lds + 32768, V = lds + 65536;
    const float kscale = 0.08838834764831845f;
    const int sq = tid >> 4, dg = tid & 15, tb = c * CH + 4 * sq;
    u32x4 vv[4];
    if (g < NHG) {
        const bf16* pk = proj + PC_MK + g * HD + 8 * dg; const bf16* pq = proj + PC_MQ + g * HD + 8 * dg; const bf16* pv = proj + PC_MV + g * HD + 8 * dg;
        u32x4 rk[7], rq[7];
#pragma unroll
        for (int j = 0; j < 7; ++j) { const int tt = tb - 3 + j, tc = tt < 0 ? 0 : tt; rk[j] = *(const GAS u32x4*)(pk + (size_t)tc * NPJ); if (WITHQ) rq[j] = *(const GAS u32x4*)(pq + (size_t)tc * NPJ);
            if (tt < 0) { rk[j] = (u32x4){0u, 0u, 0u, 0u}; if (WITHQ) rq[j] = (u32x4){0u, 0u, 0u, 0u}; } }
#pragma unroll
        for (int i = 0; i < 4; ++i) vv[i] = *(const GAS u32x4*)(pv + (size_t)(tb + i) * NPJ);
        const LAS float* cwl = (const LAS float*)(lds + CONVW_OFF);
#pragma unroll
        for (int qk = 0; qk < (WITHQ ? 2 : 1); ++qk) {
            const LAS float* wl = cwl + (qk == 0 ? 640 : 0) + 8 * dg;
            float w[5][8];
#pragma unroll
            for (int j = 0; j < 5; ++j) { const f32x4 w0 = *(const LAS f32x4*)(wl + j * 128), w1 = *(const LAS f32x4*)(wl + j * 128 + 4); w[j][0] = w0.x; w[j][1] = w0.y; w[j][2] = w0.z; w[j][3] = w0.w; w[j][4] = w1.x; w[j][5] = w1.y; w[j][6] = w1.z; w[j][7] = w1.w; }
#pragma unroll
            for (int i = 0; i < 4; ++i) { float acc[8];
#pragma unroll
                for (int e = 0; e < 8; ++e) acc[e] = w[4][e];
#pragma unroll
                for (int j = 0; j < 4; ++j) { float uu[8]; unpack8(qk == 0 ? rk[i + j] : rq[i + j], uu);
#pragma unroll
                    for (int e = 0; e < 8; ++e) acc[e] += w[j][e] * uu[e]; }
                const int srow = 4 * sq + i; const float sc = qk == 0 ? kscale * __expf(rv127 + colv[srow]) : 1.0f;
#pragma unroll
                for (int e = 0; e < 8; ++e) acc[e] = silu_f(acc[e]) * sc;
                *(LAS u32x4*)((qk == 0 ? K : Q) + offb(srow, dg)) = pack8(acc); }
        }
    } else {
        const int gr = g - NHG; const float* COS = (const float*)(a.ws + WS_COS); const float* SIN = (const float*)(a.ws + WS_SIN);
        const int s2 = tid >> 3, dgp = tid & 7;
        const bf16* pv = proj + PC_RV + gr * HD + 8 * dg;
        u32x4 klo[2], khi[2], qlo[2], qhi[2]; f32x4 cs[2][2], sn[2][2];
#pragma unroll
        for (int i = 0; i < 2; ++i) { const size_t t = (size_t)(c * CH + 2 * s2 + i); const bf16* pr = proj + t * NPJ + gr * HD + 8 * dgp;
            klo[i] = *(const GAS u32x4*)(pr + PC_RK); khi[i] = *(const GAS u32x4*)(pr + PC_RK + 64);
            if (WITHQ) { qlo[i] = *(const GAS u32x4*)(pr + PC_RQ); qhi[i] = *(const GAS u32x4*)(pr + PC_RQ + 64); }
            cs[i][0] = *(const GAS f32x4*)(COS + t * 64 + 8 * dgp); cs[i][1] = *(const GAS f32x4*)(COS + t * 64 + 8 * dgp + 4);
            sn[i][0] = *(const GAS f32x4*)(SIN + t * 64 + 8 * dgp); sn[i][1] = *(const GAS f32x4*)(SIN + t * 64 + 8 * dgp + 4); }
#pragma unroll
        for (int i = 0; i < 4; ++i) vv[i] = *(const GAS u32x4*)(pv + (size_t)(tb + i) * NPJ);
#pragma unroll
        for (int i = 0; i < 2; ++i) { const int srow = 2 * s2 + i;
            const float c8[8] = {cs[i][0].x, cs[i][0].y, cs[i][0].z, cs[i][0].w, cs[i][1].x, cs[i][1].y, cs[i][1].z, cs[i][1].w};
            const float s8[8] = {sn[i][0].x, sn[i][0].y, sn[i][0].z, sn[i][0].w, sn[i][1].x, sn[i][1].y, sn[i][1].z, sn[i][1].w};
            float lo[8], hi[8], olo[8], ohi[8]; unpack8(klo[i], lo); unpack8(khi[i], hi);
            const float sc = kscale * __expf(rv127 + colv[srow]);
#pragma unroll
            for (int e = 0; e < 8; ++e) { olo[e] = (lo[e] * c8[e] - hi[e] * s8[e]) * sc; ohi[e] = (hi[e] * c8[e] + lo[e] * s8[e]) * sc; }
            *(LAS u32x4*)(K + offb(srow, dgp)) = pack8(olo); *(LAS u32x4*)(K + offb(srow, 8 + dgp)) = pack8(ohi);
            if (WITHQ) { unpack8(qlo[i], lo); unpack8(qhi[i], hi);
#pragma unroll
                for (int e = 0; e < 8; ++e) { olo[e] = lo[e] * c8[e] - hi[e] * s8[e]; ohi[e] = hi[e] * c8[e] + lo[e] * s8[e]; }
                *(LAS u32x4*)(Q + offb(srow, dgp)) = pack8(olo); *(LAS u32x4*)(Q + offb(srow, 8 + dgp)) = pack8(ohi); }
        }
    }
#pragma unroll
    for (int i = 0; i < 4; ++i) *(LAS u32x4*)(V + offb(4 * sq + i, dg)) = vv[i];
    LDS_WAIT(); __syncthreads();
}

DI void phase_m1(const Args& a, ldsp lds, int tid_in, int wave, int vcu, int G) {
    float* UG = (float*)(a.ws + WS_A); float* NG = (float*)(a.ws + WS_NLOC); float* DG = (float*)(a.ws + WS_DEC);
    ldsp K = lds + 32768, V = lds + 65536; const int wi = wave >> 1, wj = wave & 1;
    for (int cg = vcu; cg < NHEADS * 16; cg += G) { const int g = cg >> 4, grp = cg & 15; const bool ml = g < NHG;
        { int tid_g = tid_in; asm volatile("" : "+v"(tid_g)); mixer_setup(a, lds, g, grp, tid_g, tid_g & 63, wave); }
        f32x16 accU[2], accN; float dsum = 0.f;
#pragma unroll
        for (int i = 0; i < 16; ++i) { accU[0][i] = 0.f; accU[1][i] = 0.f; accN[i] = 0.f; }
        for (int ci = 0; ci < 8; ++ci) { const int c = 8 * grp + ci;
            int tid_o = tid_in; asm volatile("" : "+v"(tid_o));
            const int tid = tid_o, lane = tid & 63;
            const LAS float* gt = (const LAS float*)(lds + GATE_OFF + (ml ? ci : 0) * 1536);
            mixer_tiles<false>(a, lds, g, c, gt, tid);
            const float la = gt[256 + 127], dec = __expf(la); dsum += la;
            accU[0] = accU[0] * dec; accU[1] = accU[1] * dec; accN = accN * dec;
            { const TrB tk = trbase(wi, lane), tv0 = trbase(2 * wj, lane), tv1 = trbase(2 * wj + 1, lane);
#pragma unroll
              for (int ks = 0; ks < 8; ++ks) {
                const bf16x8 af = trfrag(K, tk, ks), b0 = trfrag(V, tv0, ks), b1 = trfrag(V, tv1, ks);
                accU[0] = MFMA32(af, b0, accU[0]); accU[1] = MFMA32(af, b1, accU[1]);
                if (ml && wj == 0) accN = MFMA32(af, bf_ones(), accN);
              } }
            __syncthreads();
        }
        { int tid_o = tid_in; asm volatile("" : "+v"(tid_o)); const int lane = tid_o & 63, r = lane & 31, h = lane >> 5;
          float* o = UG + ((size_t)cg << 14) + wave * 2048 + lane;
#pragma unroll
          for (int n = 0; n < 2; ++n)
#pragma unroll
              for (int i = 0; i < 16; ++i) o[(n * 16 + i) * 64] = accU[n][i];
          if (ml && wj == 0 && r == 0) {
#pragma unroll
              for (int i = 0; i < 16; ++i) NG[(size_t)cg * HD + 32 * wi + crow(i, h)] = accN[i]; }
          if (tid_in == 0) DG[cg] = __expf(dsum); }
    }
}
DI void phase_m3(const Args& a, ldsp lds, int tid_in, int wave, int vcu, int G) {
    const bf16* proj = (const bf16*)(a.ws + WS_B); const float* UG = (const float*)(a.ws + WS_A); const float* NG = (const float*)(a.ws + WS_NLOC); const float* DG = (const float*)(a.ws + WS_DEC);
    bf16* mixb = (bf16*)a.out;
    LAS unsigned short* n0b = (LAS unsigned short*)(lds + N0B_OFF);
    ldsp Q = lds, K = lds + 32768, V = lds + 65536, C0 = lds + 98304, P = lds + 98304; LAS float* H = (LAS float*)lds;
    const int wi = wave >> 1, wj = wave & 1;
    for (int cg = vcu; cg < NHEADS * 16; cg += G) { const int g = cg >> 4, grp = cg & 15; const bool ml = g < NHG;
        { int tid_g = tid_in; asm volatile("" : "+v"(tid_g)); mixer_setup(a, lds, g, grp, tid_g, tid_g & 63, wave); }
        f32x16 accC[2], nst;
#pragma unroll
        for (int i = 0; i < 16; ++i) { accC[0][i] = 0.f; accC[1][i] = 0.f; nst[i] = 0.f; }
        { int tid_o = tid_in; asm volatile("" : "+v"(tid_o)); const int lane = tid_o & 63, h = lane >> 5;
          for (int j = 0; j < grp; ++j) { const float* us = UG + ((size_t)(g * 16 + j) << 14) + wave * 2048 + lane; const float dj = DG[g * 16 + j];
#pragma unroll
              for (int i = 0; i < 16; ++i) { accC[0][i] = dj * accC[0][i] + us[i * 64]; accC[1][i] = dj * accC[1][i] + us[(16 + i) * 64]; }
              if (ml) {
#pragma unroll
                  for (int i = 0; i < 16; ++i) nst[i] = dj * nst[i] + NG[(size_t)(g * 16 + j) * HD + 32 * wi + crow(i, h)]; } } }
        for (int ci = 0; ci < 8; ++ci) { const int c = 8 * grp + ci;
            int tid_o = tid_in; asm volatile("" : "+v"(tid_o));
            const int tid = tid_o, lane = tid & 63, r = lane & 31, h = lane >> 5;
            const LAS float* gt = (const LAS float*)(lds + GATE_OFF + (ml ? ci : 0) * 1536);
#pragma unroll
            for (int n = 0; n < 2; ++n) { const int e = 64 * wj + 32 * n + r;
#pragma unroll
                for (int i = 0; i < 16; ++i) { const int d = 32 * wi + crow(i, h); *(LAS unsigned short*)(C0 + offb(d, e >> 3) + 2 * (e & 7)) = (unsigned short)pk2(accC[n][i], accC[n][i]); } }
            if (wj == 0 && r == 0) {
#pragma unroll
                for (int i = 0; i < 16; ++i) n0b[32 * wi + crow(i, h)] = (unsigned short)pk2(nst[i], nst[i]); }
            mixer_tiles<true>(a, lds, g, c, gt, tid);
            f32x16 accO[2], accS[2], accD;
#pragma unroll
            for (int i = 0; i < 16; ++i) { accO[0][i] = 0.f; accO[1][i] = 0.f; accS[0][i] = 0.f; accS[1][i] = 0.f; accD[i] = 0.f; }
            const TrB tk = trbase(wi, lane), tv0 = trbase(2 * wj, lane), tv1 = trbase(2 * wj + 1, lane);
            const int rbq = rowbase(32 * wi + r, h), rbk = rowbase(64 * wj + r, h);
#pragma unroll
            for (int ks = 0; ks < 8; ++ks) {
                const bf16x8 af = rowfrag(Q, rbq, ks), b0 = trfrag(C0, tv0, ks), b1 = trfrag(C0, tv1, ks);
                accO[0] = MFMA32(af, b0, accO[0]); accO[1] = MFMA32(af, b1, accO[1]);
                if (ml) { const bf16x8 bn = *(const LAS bf16x8*)(n0b + 16 * ks + 8 * h); accD = MFMA32(af, bn, accD); }
            }
#pragma unroll
            for (int i = 0; i < 16; ++i) { const int t = 32 * wi + crow(i, h); const float al = __expf(gt[256 + t]); accO[0][i] *= al; accO[1][i] *= al; accD[i] *= al; }
#pragma unroll
            for (int ks = 0; ks < 8; ++ks) {
                const bf16x8 af = rowfrag(Q, rbq, ks), b0 = rowfrag(K, rbk, ks), b1 = rowfrag(K + 8192, rbk, ks);
                accS[0] = MFMA32(af, b0, accS[0]); accS[1] = MFMA32(af, b1, accS[1]);
            }
            __syncthreads();
            float fac[16]; { const float rv127 = gt[127];
#pragma unroll
              for (int i = 0; i < 16; ++i) fac[i] = __expf(gt[32 * wi + crow(i, h)] - rv127); }
#pragma unroll
            for (int n = 0; n < 2; ++n) { const int sidx = 64 * wj + 32 * n + r;
#pragma unroll
                for (int i = 0; i < 16; ++i) { const int t = 32 * wi + crow(i, h); const float val = (sidx <= t) ? accS[n][i] * fac[i] : 0.f;
                    *(LAS unsigned short*)(P + offb(t, sidx >> 3) + 2 * (sidx & 7)) = (unsigned short)pk2(val, val); } }
            LDS_WAIT(); __syncthreads();
            u32x4 gpre[2][2];
            { const int tl = tid >> 3, eg = tid & 7; const int hc = ml ? g * HD + 16 * eg : (g - NHG) * HD + 16 * eg;
#pragma unroll
              for (int hh = 0; hh < 2; ++hh) { const bf16* gp = proj + (size_t)(c * CH + 64 * hh + tl) * NPJ + (ml ? PC_MO : PC_RG) + hc; gpre[hh][0] = *(const GAS u32x4*)gp; gpre[hh][1] = *(const GAS u32x4*)(gp + 8); } }
            { const float dec = __expf(gt[256 + 127]); accC[0] = accC[0] * dec; accC[1] = accC[1] * dec; nst = nst * dec; }
#pragma unroll
            for (int ks = 0; ks < 8; ++ks) {
                const bf16x8 af = rowfrag(P, rbq, ks), ak = trfrag(K, tk, ks), b0 = trfrag(V, tv0, ks), b1 = trfrag(V, tv1, ks);
                accO[0] = MFMA32(af, b0, accO[0]); accO[1] = MFMA32(af, b1, accO[1]);
                accC[0] = MFMA32(ak, b0, accC[0]); accC[1] = MFMA32(ak, b1, accC[1]);
                if (ml) { accD = MFMA32(af, bf_ones(), accD); nst = MFMA32(ak, bf_ones(), nst); }
            }
            __syncthreads();
#pragma unroll
            for (int i = 0; i < 16; ++i) { const int t = 32 * wi + crow(i, h); const float rden = ml ? 1.0f / fmaxf(fabsf(accD[i]), 1.0f) : 1.0f;
                H[t * HD + 64 * wj + r] = accO[0][i] * rden; H[t * HD + 64 * wj + 32 + r] = accO[1][i] * rden; }
            LDS_WAIT(); __syncthreads();
#pragma unroll
            for (int hh = 0; hh < 2; ++hh) {
                const int tl = tid >> 3, eg = tid & 7, t = 64 * hh + tl;
                float hv[16]; float ss = 0.f;
#pragma unroll
                for (int q = 0; q < 4; ++q) { const f32x4 x4 = *(const LAS f32x4*)(H + t * HD + 16 * eg + 4 * q); hv[4 * q] = x4.x; hv[4 * q + 1] = x4.y; hv[4 * q + 2] = x4.z; hv[4 * q + 3] = x4.w; }
#pragma unroll
                for (int i = 0; i < 16; ++i) ss += hv[i] * hv[i];
                ss += __shfl_xor(ss, 1); ss += __shfl_xor(ss, 2); ss += __shfl_xor(ss, 4);
                const float rn = 1.0f / sqrtf(ss * (1.0f / HD) + NORM_EPS);
                const int tg = c * CH + t; const int hc = ml ? g * HD + 16 * eg : (g - NHG) * HD + 16 * eg;
                const float* gh = (const float*)(a.ws + WS_GHEAD) + (ml ? 0 : 1024) + hc;
                float ga[16]; { float t8[8]; unpack8(gpre[hh][0], t8);
#pragma unroll
                    for (int j = 0; j < 8; ++j) ga[j] = t8[j]; unpack8(gpre[hh][1], t8);
#pragma unroll
                    for (int j = 0; j < 8; ++j) ga[8 + j] = t8[j]; }
                float o[16];
#pragma unroll
                for (int i = 0; i < 16; ++i) o[i] = hv[i] * rn * gh[i] * (ml ? sigmoid_f(ga[i]) : silu_f(ga[i]));
                bf16* op = mixb + (size_t)tg * DM + (ml ? 0 : 1024) + hc;
                u32x4 w0, w1; w0.x = pk2(o[0], o[1]); w0.y = pk2(o[2], o[3]); w0.z = pk2(o[4], o[5]); w0.w = pk2(o[6], o[7]); w1.x = pk2(o[8], o[9]); w1.y = pk2(o[10], o[11]); w1.z = pk2(o[12], o[13]); w1.w = pk2(o[14], o[15]);
                *(GAS u32x4*)op = w0; *(GAS u32x4*)(op + 8) = w1;
            }
            __syncthreads();
        }
    }
}
DI void phase_r1(const Args& a, int lane, int wave, int vcu, int G) {
    const int gw = vcu * NWAVES + wave, NGW = G * NWAVES;
    const float* x = (const float*)a.in[IN_X]; const bf16* mix = (const bf16*)(a.ws + WS_B); bf16* x1 = (bf16*)(a.ws + WS_X1); bf16* h2 = (bf16*)(a.ws + WS_A);
    const GAS f32x4* gp = (const GAS f32x4*)a.in[IN_GPOST] + lane; const GAS f32x4* gf = (const GAS f32x4*)a.in[IN_GFPRE] + lane;
#define R1_LOAD(bm, bx, mm) do { const GAS u32x2* mr_ = (const GAS u32x2*)(mix + (size_t)(mm) * DM) + lane; const GAS f32x4* xr_ = (const GAS f32x4*)(x + (size_t)(mm) * DM) + lane; \
        _Pragma("unroll") for (int j = 0; j < 8; ++j) { bm[j] = mr_[64 * j]; bx[j] = xr_[64 * j]; } } while (0)
#define R1_ROW(bm, bx, mm) do { f32x4 v[8]; float s_ = 0.f; \
        _Pragma("unroll") for (int j = 0; j < 8; ++j) { v[j] = (f32x4){bflo(bm[j].x), bfhi(bm[j].x), bflo(bm[j].y), bfhi(bm[j].y)}; s_ += (v[j].x * v[j].x + v[j].y * v[j].y) + (v[j].z * v[j].z + v[j].w * v[j].w); } \
        const float r_ = 1.0f / sqrtf(wave_sum(s_) * (1.0f / DM) + NORM_EPS); float s2_ = 0.f; GAS u32x2* xo_ = (GAS u32x2*)(x1 + (size_t)(mm) * DM) + lane; \
        _Pragma("unroll") for (int j = 0; j < 8; ++j) { const f32x4 gg = gp[64 * j]; v[j] = bx[j] + v[j] * r_ * gg; u32x2 xw; xw.x = pk2(v[j].x, v[j].y); xw.y = pk2(v[j].z, v[j].w); xo_[64 * j] = xw; s2_ += (v[j].x * v[j].x + v[j].y * v[j].y) + (v[j].z * v[j].z + v[j].w * v[j].w); } \
        const float r2_ = 1.0f / sqrtf(wave_sum(s2_) * (1.0f / DM) + NORM_EPS); GAS u32x2* o_ = (GAS u32x2*)(h2 + (size_t)(mm) * DM) + lane; \
        _Pragma("unroll") for (int j = 0; j < 8; ++j) { const f32x4 gg = gf[64 * j]; u32x2 w; w.x = pk2(v[j].x * r2_ * gg.x, v[j].y * r2_ * gg.y); w.y = pk2(v[j].z * r2_ * gg.z, v[j].w * r2_ * gg.w); o_[64 * j] = w; } } while (0)
    u32x2 ma[8], mb[8]; f32x4 xa[8], xb[8];
    int m = gw; if (m < SEQ) R1_LOAD(ma, xa, m);
    for (; m < SEQ; m += 2 * NGW) {
        if (m + NGW < SEQ) R1_LOAD(mb, xb, m + NGW);
        R1_ROW(ma, xa, m);
        if (m + 2 * NGW < SEQ) R1_LOAD(ma, xa, m + 2 * NGW);
        if (m + NGW < SEQ) R1_ROW(mb, xb, m + NGW);
    }
#undef R1_LOAD
#undef R1_ROW
}
DI void phase_r2(const Args& a, int lane, int wave, int vcu, int G, bool poison) {
    const int gw = vcu * NWAVES + wave, NGW = G * NWAVES;
    const bf16* ff = (const bf16*)(a.ws + WS_FF); const bf16* x1 = (const bf16*)(a.ws + WS_X1); float* out = a.out; const GAS f32x4* gp = (const GAS f32x4*)a.in[IN_GFPOST] + lane;
    const float qn = __builtin_nanf("");
#define R2_LOAD(bm, bx, mm) do { const GAS u32x2* fr_ = (const GAS u32x2*)(ff + (size_t)(mm) * DM) + lane; const GAS u32x2* xr_ = (const GAS u32x2*)(x1 + (size_t)(mm) * DM) + lane; \
        _Pragma("unroll") for (int j = 0; j < 8; ++j) { bm[j] = fr_[64 * j]; bx[j] = xr_[64 * j]; } } while (0)
#define R2_ROW(bm, bx, mm) do { f32x4 v[8]; float s_ = 0.f; \
        _Pragma("unroll") for (int j = 0; j < 8; ++j) { v[j] = (f32x4){bflo(bm[j].x), bfhi(bm[j].x), bflo(bm[j].y), bfhi(bm[j].y)}; s_ += (v[j].x * v[j].x + v[j].y * v[j].y) + (v[j].z * v[j].z + v[j].w * v[j].w); } \
        const float r_ = 1.0f / sqrtf(wave_sum(s_) * (1.0f / DM) + NORM_EPS); GAS f32x4* xo_ = (GAS f32x4*)(out + (size_t)(mm) * DM) + lane; \
        _Pragma("unroll") for (int j = 0; j < 8; ++j) { const f32x4 gg = gp[64 * j]; f32x4 o = (f32x4){bflo(bx[j].x), bfhi(bx[j].x), bflo(bx[j].y), bfhi(bx[j].y)} + v[j] * r_ * gg; if (poison) o = (f32x4){qn, qn, qn, qn}; xo_[64 * j] = o; } } while (0)
    u32x2 ma[8], mb[8], xa[8], xb[8];
    int m = gw; if (m < SEQ) R2_LOAD(ma, xa, m);
    for (; m < SEQ; m += 2 * NGW) {
        if (m + NGW < SEQ) R2_LOAD(mb, xb, m + NGW);
        R2_ROW(ma, xa, m);
        if (m + 2 * NGW < SEQ) R2_LOAD(ma, xa, m + 2 * NGW);
        if (m + NGW < SEQ) R2_ROW(mb, xb, m + NGW);
    }
#undef R2_LOAD
#undef R2_ROW
}

__global__ void __launch_bounds__(NTHR, 2) fwd(Args a) {
    extern __shared__ __attribute__((aligned(16))) unsigned char lds_raw[];
    ldsp lds = (ldsp)lds_raw;
    const int tid = threadIdx.x, lane = tid & 63, wave = __builtin_amdgcn_readfirstlane(tid >> 6);
    const int G = gridDim.x; const int bx = blockIdx.x; const int vcu = (G % 8 == 0) ? (bx % 8) * (G / 8) + bx / 8 : bx;
    volatile LAS unsigned* MISC = (volatile LAS unsigned*)(lds + MISC_OFF);
    if (tid < 32) MISC[tid] = 0u;
    __syncthreads();
    unsigned* ctl = (unsigned*)(a.ws + WS_CTL);
    XcdBarrier bar; bar.bar = ctl + CW_BAR; bar.x = 0; bar.st = nullptr;
    if (N_LAUNCHES == 1) bar = xcd_barrier_post(ctl + CW_BAR, MISC + 8);
    const int lo = a.ph_lo, hi = a.ph_hi;
#define IN(k) (lo <= (k) && (k) < hi)
#define SEAM(k) do { if (IN(k) && IN((k) + 1)) xcd_barrier(bar); } while (0)

#define PH1_BODY { pg8::Gemm g{(const bf16*)(a.ws + WS_A), (const bf16*)(a.ws + WS_WIN), SEQ, NPJ, DM}; pg8::StaticOrder S; S.init(SEQ, NPJ, G, bx); \
        pg8::EpiBf16 E{(bf16*)(a.ws + WS_B), NPJ}; pg8::gemm_phase<pg8::EpiBf16, pg8::StaticOrder, true, true>(lds, g, S, E); }
#define PH5_BODY { pg8::Gemm g{(const bf16*)a.out, (const bf16*)(a.ws + WS_WO), SEQ, DM, DM}; pg8::StaticOrder S; S.init(SEQ, DM, G, bx); \
        pg8::EpiBf16 E{(bf16*)(a.ws + WS_B), DM}; pg8::gemm_phase<pg8::EpiBf16, pg8::StaticOrder, true, true>(lds, g, S, E); }
#define PH7_BODY { pg8::Gemm g{(const bf16*)(a.ws + WS_A), (const bf16*)(a.ws + WS_WGU), SEQ, 2 * DFF, DM}; pg8::StaticOrder S; S.init(SEQ, 2 * DFF, G, bx); \
        pg8::EpiSwiGLU E{(bf16*)(a.ws + WS_B), DFF}; pg8::gemm_phase<pg8::EpiSwiGLU, pg8::StaticOrder, true, true>(lds, g, S, E); }
#define PH8_BODY { pg8::Gemm g{(const bf16*)(a.ws + WS_B), (const bf16*)(a.ws + WS_WD), SEQ, DM, DFF}; pg8::StaticOrder S; S.init(SEQ, DM, G, bx); \
        pg8::EpiBf16 E{(bf16*)(a.ws + WS_FF), DM}; pg8::gemm_phase<pg8::EpiBf16, pg8::StaticOrder, true, true>(lds, g, S, E); }
#define DUP(k) (((PROBE_DUP) >> (k)) & 1)
    if (IN(0)) { phase_p0(a, lds, tid, lane, wave, vcu, G); if (DUP(0)) { __syncthreads(); phase_p0(a, lds, tid, lane, wave, vcu, G); } SEAM(0); }
    if (IN(1)) { PH1_BODY if (DUP(1)) PH1_BODY SEAM(1); }
    if (IN(2)) { phase_m1(a, lds, tid, wave, vcu, G); if (DUP(2)) phase_m1(a, lds, tid, wave, vcu, G); SEAM(2); }
    if (IN(4)) { phase_m3(a, lds, tid, wave, vcu, G); if (DUP(4)) phase_m3(a, lds, tid, wave, vcu, G); SEAM(4); }
    if (IN(5)) { PH5_BODY if (DUP(5)) PH5_BODY SEAM(5); }
    if (IN(6)) { phase_r1(a, lane, wave, vcu, G); if (DUP(6)) phase_r1(a, lane, wave, vcu, G); SEAM(6); }
    if (IN(7)) { PH7_BODY if (DUP(7)) PH7_BODY SEAM(7); }
    if (IN(8)) { PH8_BODY if (DUP(8)) PH8_BODY SEAM(8); }
    if (IN(9)) {
        bool poison = false;
        if (N_LAUNCHES == 1) poison = __hip_atomic_load(ctl + CW_BAR + XB_TMO, __ATOMIC_RELAXED, __HIP_MEMORY_SCOPE_AGENT) != 0u;
        phase_r2(a, lane, wave, vcu, G, poison);
    }
#undef PH1_BODY
#undef PH5_BODY
#undef PH7_BODY
#undef PH8_BODY
#undef DUP
#undef IN
#undef SEAM
}

extern "C" void kernel_launch(void* const* d_in, const int* in_sizes, int n_in, void* d_out, int out_size, void* d_ws, size_t ws_size, hipStream_t stream) {
    static int grid = 0;
    if (grid == 0) {
        if (n_in != 17 || in_sizes[0] != SEQ * DM || out_size != SEQ * DM || ws_size < WS_END) {
            fprintf(stderr, "kernel_launch: unexpected shapes (n_in %d, in0 %d, out %d, ws %zu); nothing launched\n", n_in, n_in > 0 ? in_sizes[0] : -1, out_size, ws_size); grid = -1; return; }
        int dev = 0, cus = 0, per_cu = 0;
        if (hipGetDevice(&dev) != hipSuccess || hipDeviceGetAttribute(&cus, hipDeviceAttributeMultiprocessorCount, dev) != hipSuccess) { grid = -1; return; }
        if (hipFuncSetAttribute((const void*)fwd, hipFuncAttributeMaxDynamicSharedMemorySize, LDS_BYTES) != hipSuccess) { fprintf(stderr, "kernel_launch: hipFuncSetAttribute failed\n"); grid = -1; return; }
        if (hipOccupancyMaxActiveBlocksPerMultiprocessor(&per_cu, (const void*)fwd, NTHR, LDS_BYTES) != hipSuccess || per_cu < 1)
            fprintf(stderr, "kernel_launch: note: occupancy query reports %d workgroups per CU\n", per_cu);
        (void)hipGetLastError();
        grid = cus;
    }
    if (grid < 0) return;
    if (hipMemsetAsync((char*)d_ws + WS_CTL, 0, CTL_ZERO_BYTES, stream) != hipSuccess) return;
    Args a{};
    for (int i = 0; i < 17; ++i) a.in[i] = d_in[i];
    a.out = (float*)d_out; a.ws = (unsigned char*)d_ws;
    if (N_LAUNCHES == 1) { a.ph_lo = 0; a.ph_hi = NPHASES; a.li = 0; hipLaunchKernelGGL(fwd, dim3(grid), dim3(NTHR), LDS_BYTES, stream, a); }
    else for (int li = 0; li < NPHASES; ++li) { a.ph_lo = li; a.ph_hi = li + 1; a.li = li; hipLaunchKernelGGL(fwd, dim3(grid), dim3(NTHR), LDS_BYTES, stream, a); }
}
```

```cpp
#include <hip/hip_runtime.h>
#include <cstdio>
#include <cstdint>

#ifndef PROBE_DUP
#define PROBE_DUP 0
#endif
#ifndef MK_N_LAUNCHES
#define MK_N_LAUNCHES 1
#endif

namespace pg8 {
#define PG8_LAS __attribute__((address_space(3)))
typedef unsigned short bf16_t;
typedef short bf16x8 __attribute__((ext_vector_type(8)));
typedef float f32x4 __attribute__((ext_vector_type(4)));
typedef unsigned u32x4 __attribute__((ext_vector_type(4)));
constexpr int BM = 256, BK = 64, HALF = 128, HTB = HALF * BK * 2  , STAGE_BYTES = 8 * HTB, NXCD = 8, WGM = 4;

__host__ __device__ __forceinline__ int lds_byte(int r, int c) { const int st = (r >> 4) * 2 + (c >> 5), rr = r & 15, cc = c & 31, ob = rr * 64 + cc * 2; return st * 1024 + (ob ^ (((ob >> 9) & 1) << 5)); }
__host__ __device__ __forceinline__ void stage_rc(int b, int& R, int& C) { const int st = b / 1024, sb = b % 1024, swz = sb ^ (((sb >> 9) & 1) << 5); R = (st >> 1) * 16 + swz / 64; C = (st & 1) * 32 + (swz % 64) / 2; }
__host__ __device__ __forceinline__ int perm32(int rho) { const int n = rho >> 4, i = rho & 15; return 8 * (i >> 2) + 4 * n + (i & 3); }

struct Unit { int pm, pn; };
struct Gemm { const bf16_t* A; const bf16_t* Bt; int M, N, K; };

struct StaticOrder {
    int nM, nN, nwg, G, c;
    __host__ __device__ void init(int M, int N, int G_, int c_) { nM = M / BM; nN = N / BM; nwg = nM * nN; G = G_; c = c_; }
    __host__ __device__ bool next(int i, Unit& u) const {
        const long L = (long)i * G + c; if (L >= nwg) return false;
        int wgid = (int)L; { const int q = nwg / NXCD, r = nwg % NXCD, xcd = wgid % NXCD, off = wgid / NXCD; wgid = (xcd < r ? xcd * (q + 1) : r * (q + 1) + (xcd - r) * q) + off; }
        const int nig = WGM * nN, gid = wgid / nig, fm = gid * WGM, gsz = (nM - fm) < WGM ? (nM - fm) : WGM;
        u.pm = fm + ((wgid % nig) % gsz); u.pn = (wgid % nig) / gsz; return true;
    }
    __device__ __forceinline__ void a_ready(const Unit&) const {}
    __device__ __forceinline__ void done(const Unit&) const {}
};

typedef __bf16 bf16x2_t __attribute__((ext_vector_type(2))); typedef float f32x2_t __attribute__((ext_vector_type(2)));
__device__ __forceinline__ unsigned cvt_pk_bf16(float lo, float hi) { const f32x2_t v = {lo, hi}; return __builtin_bit_cast(unsigned, __builtin_convertvector(v, bf16x2_t)); }

struct EpiF32 {
    static constexpr bool PERM = false, AFTER_DRAIN = false;
    float* C; int ldc;
    __device__ __forceinline__ void operator()(const f32x4 (&acc)[2][2][4][2], const Unit& u, int wr, int wc, int fr, int fq) const {
        const int row0 = u.pm * BM + wr * 64 + fr, col0 = u.pn * BM + wc * 32 + 4 * fq;
#pragma unroll
        for (int ai = 0; ai < 2; ++ai)
#pragma unroll
            for (int m = 0; m < 4; ++m) { float* rowp = C + (size_t)(row0 + ai * HALF + m * 16) * ldc + col0;
#pragma unroll
                for (int bj = 0; bj < 2; ++bj)
#pragma unroll
                    for (int n = 0; n < 2; ++n) *(f32x4*)(rowp + bj * HALF + n * 16) = acc[ai][bj][m][n]; }
    }
};
struct EpiBf16 {
    static constexpr bool PERM = true, AFTER_DRAIN = false;
    bf16_t* O; int ldc;
    __device__ __forceinline__ void operator()(const f32x4 (&acc)[2][2][4][2], const Unit& u, int wr, int wc, int fr, int fq) const {
        const int row0 = u.pm * BM + wr * 64 + fr, col0 = u.pn * BM + wc * 32 + 8 * fq;
#pragma unroll
        for (int ai = 0; ai < 2; ++ai)
#pragma unroll
            for (int m = 0; m < 4; ++m) { bf16_t* rowp = O + (size_t)(row0 + ai * HALF + m * 16) * ldc + col0;
#pragma unroll
                for (int bj = 0; bj < 2; ++bj) { const f32x4 v0 = acc[ai][bj][m][0], v1 = acc[ai][bj][m][1];
                    u32x4 w; w.x = cvt_pk_bf16(v0[0], v0[1]); w.y = cvt_pk_bf16(v0[2], v0[3]); w.z = cvt_pk_bf16(v1[0], v1[1]); w.w = cvt_pk_bf16(v1[2], v1[3]);
                    *(u32x4*)(rowp + bj * HALF) = w; } }
    }
};
__device__ __forceinline__ float silu_f(float x) { return x * __builtin_amdgcn_rcpf(1.0f + __expf(-x)); }
struct EpiSwiGLU {
    static constexpr bool PERM = true, AFTER_DRAIN = false;
    bf16_t* O; int ldc;
    __device__ __forceinline__ void operator()(const f32x4 (&acc)[2][2][4][2], const Unit& u, int wr, int wc, int fr, int fq) const {
        const int row0 = u.pm * BM + wr * 64 + fr, col0 = u.pn * HALF + wc * 32 + 8 * fq;
#pragma unroll
        for (int ai = 0; ai < 2; ++ai)
#pragma unroll
            for (int m = 0; m < 4; ++m) { bf16_t* rowp = O + (size_t)(row0 + ai * HALF + m * 16) * ldc + col0;
                const f32x4 g0 = acc[ai][0][m][0], g1 = acc[ai][0][m][1], u0 = acc[ai][1][m][0], u1 = acc[ai][1][m][1];
                u32x4 w; w.x = cvt_pk_bf16(silu_f(g0[0]) * u0[0], silu_f(g0[1]) * u0[1]); w.y = cvt_pk_bf16(silu_f(g0[2]) * u0[2], silu_f(g0[3]) * u0[3]);
                w.z = cvt_pk_bf16(silu_f(g1[0]) * u1[0], silu_f(g1[1]) * u1[1]); w.w = cvt_pk_bf16(silu_f(g1[2]) * u1[2], silu_f(g1[3]) * u1[3]);
                *(u32x4*)rowp = w; }
    }
};

template <class Epi, class Sched, bool ALIGN_EPI = false, bool SP2 = false>
__device__ __forceinline__ void gemm_phase(PG8_LAS unsigned char* lds, const Gemm g, const Sched& S, const Epi& E, const int tid) {
    const int wid = __builtin_amdgcn_readfirstlane(tid >> 6), lane = tid & 63, wr = wid >> 2, wc = wid & 3, fr = lane & 15, fq = lane >> 4;
    const int K = g.K, nt = K / BK;
    unsigned voffA[2], voffB[2];
#pragma unroll
    for (int i = 0; i < 2; ++i) { int R, C; stage_rc(tid * 16 + i * 8192, R, C); const int Rb = Epi::PERM ? ((R & ~31) + perm32(R & 31)) : R;
        voffA[i] = (unsigned)(R * K + C) * 2u; voffB[i] = (unsigned)(Rb * K + C) * 2u; }
    const size_t kstep = (size_t)(BK * 2);
    const size_t hstep = (size_t)HALF * K * 2;
    const size_t tstep = 2 * hstep;
    const unsigned ldsw = (unsigned)wid * 1024u;
    const int aoff = lds_byte(wr * 64 + fr, fq * 8), boff = lds_byte(wc * 32 + fr, fq * 8);
#define PG8_SA(b, h) (((b) * 2 + (h)) * HTB)
#define PG8_SB(b, h) ((4 + (b) * 2 + (h)) * HTB)
#define PG8_STAGE(bufoff, gbase, voff) do { _Pragma("unroll") for (int _i = 0; _i < 2; ++_i) \
        __builtin_amdgcn_global_load_lds((const unsigned*)((const char*)(gbase) + (voff)[_i]), (PG8_LAS unsigned*)(lds + (bufoff) + ldsw + _i * 8192), 16, 0, 0); } while (0)
#define PG8_LDA(dst, b, h) do { _Pragma("unroll") for (int m = 0; m < 4; ++m) _Pragma("unroll") for (int k = 0; k < 2; ++k) dst[m][k] = *(const PG8_LAS bf16x8*)(lds + PG8_SA(b, h) + aoff + m * 2048 + k * 1024); } while (0)
#define PG8_LDB(dst, b, h) do { _Pragma("unroll") for (int n = 0; n < 2; ++n) _Pragma("unroll") for (int k = 0; k < 2; ++k) dst[n][k] = *(const PG8_LAS bf16x8*)(lds + PG8_SB(b, h) + boff + n * 2048 + k * 1024); } while (0)
#define PG8_MMA(ai, bj, At, Bt) do { __builtin_amdgcn_s_setprio(1); _Pragma("unroll") for (int m = 0; m < 4; ++m) _Pragma("unroll") for (int n = 0; n < 2; ++n) _Pragma("unroll") for (int k = 0; k < 2; ++k) \
        acc[ai][bj][m][n] = __builtin_amdgcn_mfma_f32_16x16x32_bf16(Bt[n][k], At[m][k], acc[ai][bj][m][n], 0, 0, 0); __builtin_amdgcn_s_setprio(0); } while (0)
#define PG8_WAIT_V(n) asm volatile("s_waitcnt vmcnt(" #n ")" ::: "memory")
#define PG8_WAIT_L(n) asm volatile("s_waitcnt lgkmcnt(" #n ")" ::: "memory")
#define PG8_BAR __builtin_amdgcn_s_barrier()
#define PG8_SCHED __builtin_amdgcn_sched_barrier(0)
    Unit cur, nxt; int ui = 0;
    if (!S.next(0, cur)) return;
    f32x4 acc[2][2][4][2];
#pragma unroll
    for (int a = 0; a < 2; ++a)
#pragma unroll
        for (int b = 0; b < 2; ++b)
#pragma unroll
            for (int m = 0; m < 4; ++m)
#pragma unroll
                for (int n = 0; n < 2; ++n) acc[a][b][m][n] = (f32x4){0.f, 0.f, 0.f, 0.f};
    bf16x8 At[4][2], B0[2][2], B1[2][2];
    const char* cA = (const char*)g.A + (size_t)cur.pm * tstep; const char* cB = (const char*)g.Bt + (size_t)cur.pn * tstep;
    S.a_ready(cur);
    if constexpr (SP2) {
        PG8_STAGE(PG8_SB(0, 0), cB, voffB); PG8_STAGE(PG8_SB(0, 1), cB + hstep, voffB); PG8_STAGE(PG8_SA(0, 0), cA, voffA); PG8_STAGE(PG8_SA(0, 1), cA + hstep, voffA);
        if (wr == 1) PG8_BAR;
        PG8_WAIT_V(2); PG8_BAR;
        PG8_STAGE(PG8_SB(1, 0), cB + kstep, voffB); PG8_STAGE(PG8_SA(1, 0), cA + kstep, voffA); PG8_STAGE(PG8_SB(1, 1), cB + hstep + kstep, voffB);
        PG8_WAIT_V(6); PG8_BAR;
    } else {
        PG8_STAGE(PG8_SB(0, 0), cB, voffB); PG8_STAGE(PG8_SA(0, 0), cA, voffA); PG8_STAGE(PG8_SB(0, 1), cB + hstep, voffB); PG8_STAGE(PG8_SA(0, 1), cA + hstep, voffA);
        if (wr == 1) PG8_BAR;
        PG8_WAIT_V(4); PG8_BAR;
        PG8_STAGE(PG8_SB(1, 0), cB + kstep, voffB); PG8_STAGE(PG8_SA(1, 0), cA + kstep, voffA); PG8_STAGE(PG8_SB(1, 1), cB + hstep + kstep, voffB);
        PG8_WAIT_V(6); PG8_BAR;
    }
    for (;;) {
        const bool has_next = S.next(ui + 1, nxt);
        const char* nA = has_next ? (const char*)g.A + (size_t)nxt.pm * tstep : cA; const char* nB = has_next ? (const char*)g.Bt + (size_t)nxt.pn * tstep : cB;
        for (int t = 0; t < nt; t += 2) {
            const bool last = (t == nt - 2);
            const char* a1 = cA + (size_t)(t + 1) * kstep;
            const char* a2 = last ? nA : cA + (size_t)(t + 2) * kstep; const char* b2 = last ? nB : cB + (size_t)(t + 2) * kstep;
            const char* a3 = a2 + kstep; const char* b3 = b2 + kstep;
            if (last && has_next) S.a_ready(nxt);
            if constexpr (SP2) {
            PG8_LDB(B0, 0, 0); PG8_LDB(B1, 0, 1); PG8_SCHED; PG8_LDA(At, 0, 0); PG8_STAGE(PG8_SA(1, 1), a1 + hstep, voffA);
            PG8_WAIT_V(8); PG8_WAIT_L(0); PG8_BAR; PG8_MMA(0, 0, At, B0); PG8_MMA(0, 1, At, B1); PG8_BAR; PG8_SCHED;
            PG8_LDA(At, 0, 1); PG8_STAGE(PG8_SB(0, 0), b2, voffB); PG8_STAGE(PG8_SB(0, 1), b2 + hstep, voffB); PG8_STAGE(PG8_SA(0, 0), a2, voffA);
            PG8_WAIT_V(8); PG8_WAIT_L(0); PG8_BAR; PG8_MMA(1, 0, At, B0); PG8_MMA(1, 1, At, B1); PG8_BAR; PG8_SCHED;
            PG8_LDB(B0, 1, 0); PG8_LDB(B1, 1, 1); PG8_SCHED; PG8_LDA(At, 1, 0); PG8_STAGE(PG8_SA(0, 1), a2 + hstep, voffA);
            PG8_WAIT_V(8); PG8_WAIT_L(0); PG8_BAR; PG8_MMA(0, 0, At, B0); PG8_MMA(0, 1, At, B1); PG8_BAR; PG8_SCHED;
            PG8_LDA(At, 1, 1); PG8_STAGE(PG8_SB(1, 0), b3, voffB); PG8_STAGE(PG8_SB(1, 1), b3 + hstep, voffB); PG8_STAGE(PG8_SA(1, 0), a3, voffA);
            PG8_WAIT_V(8); PG8_WAIT_L(0); PG8_BAR; PG8_MMA(1, 0, At, B0); PG8_MMA(1, 1, At, B1); PG8_BAR; PG8_SCHED;
            } else {
            PG8_LDB(B0, 0, 0); PG8_SCHED; PG8_LDA(At, 0, 0); PG8_STAGE(PG8_SA(1, 1), a1 + hstep, voffA);
            PG8_WAIT_L(8); PG8_BAR; PG8_WAIT_L(0); PG8_MMA(0, 0, At, B0); PG8_BAR; PG8_SCHED;
            PG8_LDB(B1, 0, 1); PG8_STAGE(PG8_SB(0, 0), b2, voffB);
            PG8_BAR; PG8_WAIT_L(0); PG8_MMA(0, 1, At, B1); PG8_BAR;
            PG8_LDA(At, 0, 1); PG8_STAGE(PG8_SA(0, 0), a2, voffA);
            PG8_BAR; PG8_WAIT_L(0); PG8_MMA(1, 0, At, B0); PG8_BAR; PG8_SCHED;
            PG8_STAGE(PG8_SB(0, 1), b2 + hstep, voffB);
            PG8_WAIT_V(6); PG8_BAR; PG8_MMA(1, 1, At, B1); PG8_BAR;
            PG8_LDB(B0, 1, 0); PG8_SCHED; PG8_LDA(At, 1, 0); PG8_STAGE(PG8_SA(0, 1), a2 + hstep, voffA);
            PG8_WAIT_L(8); PG8_BAR; PG8_WAIT_L(0); PG8_MMA(0, 0, At, B0); PG8_BAR; PG8_SCHED;
            PG8_LDB(B1, 1, 1); PG8_STAGE(PG8_SB(1, 0), b3, voffB);
            PG8_BAR; PG8_WAIT_L(0); PG8_MMA(0, 1, At, B1); PG8_BAR;
            PG8_LDA(At, 1, 1); PG8_STAGE(PG8_SA(1, 0), a3, voffA);
            PG8_BAR; PG8_WAIT_L(0); PG8_MMA(1, 0, At, B0); PG8_BAR; PG8_SCHED;
            PG8_STAGE(PG8_SB(1, 1), b3 + hstep, voffB);
            PG8_WAIT_V(6); PG8_BAR; PG8_MMA(1, 1, At, B1); PG8_BAR;
            }
        }
        if constexpr (ALIGN_EPI) { if (wr == 0) PG8_BAR; }
        if constexpr (!Epi::AFTER_DRAIN) { E(acc, cur, wr, wc, fr, fq); S.done(cur); }
        if (!has_next) break;
#pragma unroll
        for (int a = 0; a < 2; ++a)
#pragma unroll
            for (int b = 0; b < 2; ++b)
#pragma unroll
                for (int m = 0; m < 4; ++m)
#pragma unroll
                    for (int n = 0; n < 2; ++n) acc[a][b][m][n] = (f32x4){0.f, 0.f, 0.f, 0.f};
        cur = nxt; cA = nA; cB = nB; ++ui;
        if constexpr (ALIGN_EPI) { if (wr == 1) PG8_BAR; }
    }
    PG8_WAIT_V(0);
    if constexpr (!ALIGN_EPI) { if (wr == 0) PG8_BAR; }
    PG8_BAR;
#undef PG8_SA
#undef PG8_SB
#undef PG8_STAGE
#undef PG8_LDA
#undef PG8_LDB
#undef PG8_MMA
#undef PG8_WAIT_V
#undef PG8_WAIT_L
#undef PG8_BAR
#undef PG8_SCHED
}
}

constexpr int NWAVES = 8, NTHR = 512;
constexpr int SEQ = 16384, DM = 2048, HD = 128, NHG = 8, DPROJ = 8208, NPJ = 8192, DFF = 5632, CH = 128, NCH = SEQ / CH, NHEADS = 16;
constexpr float NORM_EPS = 1e-6f;
constexpr int N_LAUNCHES = MK_N_LAUNCHES, NPHASES = 10;
constexpr int PC_MQ = 0, PC_MK = 1024, PC_MV = 2048, PC_MO = 3072, PC_RQ = 4096, PC_RK = 5120, PC_RV = 6144, PC_RG = 7168;

constexpr size_t MiB = 1u << 20;
constexpr size_t WS_CTL = 0, CTL_ZERO_BYTES = 64 * 1024;
constexpr size_t WS_WIN = 2 * MiB, WS_WO = 34 * MiB, WS_WGU = 42 * MiB, WS_WD = 86 * MiB;
constexpr size_t WS_PRE = 108 * MiB;
constexpr size_t WS_RS = 109 * MiB;
constexpr size_t WS_NLOC = 110 * MiB;
constexpr size_t WS_N0 = 110 * MiB + 512 * 1024;
constexpr size_t WS_DEC = 111 * MiB;
constexpr size_t WS_GHEAD = 111 * MiB + 65536;
constexpr size_t WS_COS = 112 * MiB, WS_SIN = 116 * MiB;
constexpr size_t WS_B = 128 * MiB;
constexpr size_t WS_A = 384 * MiB;
constexpr size_t WS_FF = WS_B + 176 * MiB;
constexpr size_t WS_X1 = 448 * MiB;
constexpr size_t WS_END = 512 * MiB;
constexpr int CW_BAR = 1024;

constexpr int RING_BYTES = 131072;
constexpr int GATE_OFF = RING_BYTES;
constexpr int N0B_OFF = GATE_OFF + 8 * 1536;
constexpr int CONVW_OFF = N0B_OFF + 256;
constexpr int NST_OFF = CONVW_OFF + 5120;
constexpr int GHL_OFF = NST_OFF + 512;
constexpr int MISC_OFF = GHL_OFF + 512;
constexpr int LDS_BYTES = 163840;
static_assert(MISC_OFF + 1024 + 5120 <= LDS_BYTES, "LDS map");

#define GAS __attribute__((address_space(1)))
#define LAS __attribute__((address_space(3)))
#define DI __device__ __forceinline__
typedef unsigned short bf16;
typedef unsigned u32x4 __attribute__((ext_vector_type(4)));
typedef unsigned u32x2 __attribute__((ext_vector_type(2)));
typedef float f32x4 __attribute__((ext_vector_type(4)));
typedef float f32x2 __attribute__((ext_vector_type(2)));
typedef LAS unsigned char* ldsp;
#define LDS_WAIT() asm volatile("s_waitcnt lgkmcnt(0)" ::: "memory")

DI unsigned f2bf(float f) { unsigned u = __builtin_bit_cast(unsigned, f); return (u + 0x7fffu + ((u >> 16) & 1u)) >> 16; }
typedef __bf16 bf16x2_t __attribute__((ext_vector_type(2)));
DI unsigned pk2(float lo, float hi) { const f32x2 v = {lo, hi}; return __builtin_bit_cast(unsigned, __builtin_convertvector(v, bf16x2_t)); }
DI float bflo(unsigned w) { return __builtin_bit_cast(float, w << 16); }
DI float bfhi(unsigned w) { return __builtin_bit_cast(float, w & 0xffff0000u); }
DI void unpack8(const u32x4 w, float (&f)[8]) { f[0] = bflo(w.x); f[1] = bfhi(w.x); f[2] = bflo(w.y); f[3] = bfhi(w.y); f[4] = bflo(w.z); f[5] = bfhi(w.z); f[6] = bflo(w.w); f[7] = bfhi(w.w); }
DI u32x4 pack8(const float (&f)[8]) { u32x4 w; w.x = pk2(f[0], f[1]); w.y = pk2(f[2], f[3]); w.z = pk2(f[4], f[5]); w.w = pk2(f[6], f[7]); return w; }
DI float sigmoid_f(float x) { return __builtin_amdgcn_rcpf(1.0f + __expf(-x)); }
DI float silu_f(float x) { return x * __builtin_amdgcn_rcpf(1.0f + __expf(-x)); }
DI float wave_sum(float v) {
#pragma unroll
    for (int o = 1; o < 64; o <<= 1) v += __shfl_xor(v, o);
    return v;
}

#define XB_TMO      128
#define XB_XCNT(j)  (256  + 64 * (j))
#define XB_XSUB(j)  (1280 + 64 * (j))
#define XB_XGEN(j)  (2304 + 64 * (j))
#define XB_TOP      3328
#define XB_TOPGEN   3392
#define XCD_BAR_WORDS 3456
#define XB_SPIN_CAP (1u << 18)
__device__ __forceinline__ unsigned xb_ld(unsigned* p)              { return __hip_atomic_load(p, __ATOMIC_RELAXED, __HIP_MEMORY_SCOPE_AGENT); }
__device__ __forceinline__ unsigned xb_add(unsigned* p, unsigned v) { return __hip_atomic_fetch_add(p, v, __ATOMIC_RELAXED, __HIP_MEMORY_SCOPE_AGENT); }
__device__ __forceinline__ unsigned xb_xcc_id() { return (unsigned)__builtin_amdgcn_s_getreg((3 << 11) | 20) & 0xFu; }
#define XB_SPIN(cond, bar) do { unsigned _sp = 0; while (cond) { __builtin_amdgcn_s_sleep(1); \
    if ((++_sp & 255u) == 0u) { if (xb_ld(&(bar)[XB_TMO])) break; if (_sp > XB_SPIN_CAP) { atomicAdd(&(bar)[XB_TMO], 1u); break; } } } } while (0)
struct XcdBarrier { unsigned* bar; unsigned x; volatile LAS unsigned* st; };
__device__ __forceinline__ XcdBarrier xcd_barrier_post(unsigned* bar, volatile LAS unsigned* st, int tid) {
    XcdBarrier b; b.bar = bar; b.x = xb_xcc_id(); b.st = st;
    if (tid == 0) (void)xb_add(&bar[XB_XCNT(b.x)], 1u);
    return b;
}
__device__ __forceinline__ void xcd_barrier_complete(unsigned* bar, unsigned x, unsigned& nloc, unsigned& nx) {
    const unsigned G = gridDim.x * gridDim.y * gridDim.z;
    unsigned sum, cnt, mine, sp = 0u;
    for (;;) {
        sum = 0u; cnt = 0u; mine = 0u;
#pragma unroll
        for (unsigned j = 0; j < 16; ++j) { const unsigned c = xb_ld(&bar[XB_XCNT(j)]); sum += c; cnt += (c > 0u) ? 1u : 0u; mine = (j == x) ? c : mine; }
        if (sum == G) break;
        __builtin_amdgcn_s_sleep(1);
        if ((++sp & 255u) == 0u) { if (xb_ld(&bar[XB_TMO])) break; if (sp > XB_SPIN_CAP) { atomicAdd(&bar[XB_TMO], 1u); break; } }
    }
    nloc = mine > 0u ? mine : 1u; nx = cnt > 0u ? cnt : 1u;
}
__device__ __forceinline__ void xcd_barrier(const XcdBarrier& b, int tid) {
    asm volatile("s_waitcnt vmcnt(0)" ::: "memory");
    __syncthreads();
    if (tid == 0) {
        unsigned* bar = b.bar;
        __builtin_amdgcn_s_waitcnt(0);
        unsigned nloc = b.st[0], nx = b.st[1];
        if (nloc == 0u) { xcd_barrier_complete(bar, b.x, nloc, nx); b.st[0] = nloc; b.st[1] = nx; }
        const unsigned old = xb_add(&bar[XB_XSUB(b.x)], 1u);
        const unsigned gen = old / nloc;
        if (old + 1u == (gen + 1u) * nloc) {
            __builtin_amdgcn_fence(__ATOMIC_RELEASE, "agent");
            asm volatile("s_waitcnt vmcnt(0)" ::: "memory");
            const unsigned og = xb_add(&bar[XB_TOP], 1u);
            const unsigned tg = og / nx;
            if (og + 1u == (tg + 1u) * nx) xb_add(&bar[XB_TOPGEN], 1u);
            else XB_SPIN(xb_ld(&bar[XB_TOPGEN]) == tg, bar);
            __builtin_amdgcn_fence(__ATOMIC_ACQUIRE, "agent");
            xb_add(&bar[XB_XGEN(b.x)], 1u);
            asm volatile("s_waitcnt vmcnt(0)" ::: "memory");
        } else {
            XB_SPIN(xb_ld(&bar[XB_XGEN(b.x)]) == gen, bar);
            __builtin_amdgcn_fence(__ATOMIC_ACQUIRE, "agent");
            asm volatile("s_waitcnt vmcnt(0)" ::: "memory");
        }
    }
    __syncthreads();
}

struct Args { const void* in[17]; float* out; unsigned char* ws; int ph_lo, ph_hi, li, pad; };
enum { IN_X = 0, IN_POS, IN_GPRE, IN_WIN, IN_CW, IN_CB, IN_BI, IN_BF, IN_GMH, IN_GRH, IN_WOUT, IN_GPOST, IN_GFPRE, IN_WG, IN_WU, IN_WDN, IN_GFPOST };

struct TrItem { const float* W; bf16* WT; const float* gk; int K, ldw, src_col, dst_row, kb; };
DI void p0_tr_load(const TrItem& it, int lane, f32x4 (&v)[8]) {
    const float* src = it.W + (size_t)(64 * it.kb + (lane >> 3)) * it.ldw + it.src_col + 4 * (lane & 7);
#pragma unroll
    for (int i = 0; i < 8; ++i) v[i] = *(const GAS f32x4*)(src + (size_t)(8 * i) * it.ldw);
    if (it.gk) {
#pragma unroll
        for (int i = 0; i < 8; ++i) v[i] = v[i] * it.gk[64 * it.kb + (lane >> 3) + 8 * i]; }
}
DI void p0_tr_store(const TrItem& it, int lane, const f32x4 (&v)[8], LAS float* scr) {
#pragma unroll
    for (int i = 0; i < 8; ++i) *(LAS f32x4*)(scr + (8 * i + (lane >> 3)) * 36 + 4 * (lane & 7)) = v[i];
    LDS_WAIT(); asm volatile("" ::: "memory");
    const int c = lane & 7;
#pragma unroll
    for (int j = 0; j < 4; ++j) { const int n = (lane >> 3) + 8 * j; const LAS float* sp = scr + (8 * c) * 36 + n;
        u32x4 o; o.x = pk2(sp[0 * 36], sp[1 * 36]); o.y = pk2(sp[2 * 36], sp[3 * 36]); o.z = pk2(sp[4 * 36], sp[5 * 36]); o.w = pk2(sp[6 * 36], sp[7 * 36]);
        *(GAS u32x4*)(it.WT + (size_t)(it.dst_row + n) * it.K + 64 * it.kb + 8 * c) = o; }
    LDS_WAIT(); asm volatile("" ::: "memory");
}
constexpr int I_IN = 32 * 256, I_O = 32 * 64, I_G = 32 * 176, I_D = 88 * 64;
DI TrItem tr_item(const Args& a, int set, int r) {
    TrItem it; it.gk = nullptr;
    if (set == 0) { const int kb = r / 256, nb = r % 256; it.W = (const float*)a.in[IN_WIN]; it.WT = (bf16*)(a.ws + WS_WIN); it.K = DM; it.ldw = DPROJ; it.src_col = nb < 128 ? 32 * nb : 4112 + 32 * (nb - 128); it.dst_row = 32 * nb; it.kb = kb; return it; }
    if (r < I_O) { const int kb = r / 64, nb = r % 64; it.W = (const float*)a.in[IN_WOUT]; it.WT = (bf16*)(a.ws + WS_WO); it.K = DM; it.ldw = DM; it.src_col = 32 * nb; it.dst_row = 32 * nb; it.kb = kb; return it; } r -= I_O;
    if (r < I_G) { const int kb = r / 176, nb = r % 176; it.W = (const float*)a.in[IN_WG]; it.gk = (const float*)a.in[IN_GFPRE]; it.WT = (bf16*)(a.ws + WS_WGU); it.K = DM; it.ldw = DFF; it.src_col = 32 * nb; it.dst_row = 256 * (nb >> 2) + 32 * (nb & 3); it.kb = kb; return it; } r -= I_G;
    if (r < I_G) { const int kb = r / 176, nb = r % 176; it.W = (const float*)a.in[IN_WU]; it.gk = (const float*)a.in[IN_GFPRE]; it.WT = (bf16*)(a.ws + WS_WGU); it.K = DM; it.ldw = DFF; it.src_col = 32 * nb; it.dst_row = 256 * (nb >> 2) + 128 + 32 * (nb & 3); it.kb = kb; return it; } r -= I_G;
    { const int kb = r / 64, nb = r % 64; it.W = (const float*)a.in[IN_WDN]; it.WT = (bf16*)(a.ws + WS_WD); it.K = DFF; it.ldw = DM; it.src_col = 32 * nb; it.dst_row = 32 * nb; it.kb = kb; return it; }
}
DI void convert_weights(const Args& a, ldsp lds, int set, int lane, int wave, int vcu, int G) {
    const int gw = vcu * NWAVES + wave, NGW = G * NWAVES, nitems = set == 0 ? I_IN : I_O + 2 * I_G + I_D;
    LAS float* scr = (LAS float*)(lds + wave * 16384);
    f32x4 va[8], vb[8];
    int it = gw; if (it < nitems) p0_tr_load(tr_item(a, set, it), lane, va);
    for (; it < nitems; it += 2 * NGW) {
        if (it + NGW < nitems) p0_tr_load(tr_item(a, set, it + NGW), lane, vb);
        p0_tr_store(tr_item(a, set, it), lane, va, scr);
        if (it + 2 * NGW < nitems) p0_tr_load(tr_item(a, set, it + 2 * NGW), lane, va);
        if (it + NGW < nitems) p0_tr_store(tr_item(a, set, it + NGW), lane, vb, scr);
    }
}
DI void phase_p0(const Args& a, ldsp lds, int tid, int lane, int wave, int vcu, int G) {
    const int gw = vcu * NWAVES + wave, NGW = G * NWAVES;
    const float* x = (const float*)a.in[IN_X]; const float* gpre = (const float*)a.in[IN_GPRE]; const float* w_in = (const float*)a.in[IN_WIN];
    bf16* hb = (bf16*)(a.ws + WS_A); float* PRE = (float*)(a.ws + WS_PRE);
    LAS unsigned short* Wf = (LAS unsigned short*)lds;
#pragma unroll 4
    for (int i = 0; i < 16; ++i) { const int idx = tid + NTHR * i, k = idx >> 2, c4 = idx & 3;
        const f32x4 w = *(const GAS f32x4*)(w_in + (size_t)k * DPROJ + 4096 + 4 * c4);
        LAS unsigned short* d = Wf + ((k >> 5) * 64 + ((k >> 3) & 3) * 16 + 4 * c4) * 8 + (k & 7);
        d[0] = (unsigned short)f2bf(w.x); d[8] = (unsigned short)f2bf(w.y); d[16] = (unsigned short)f2bf(w.z); d[24] = (unsigned short)f2bf(w.w); }
    LDS_WAIT(); __syncthreads();
    LAS float* part = (LAS float*)(lds + 65536);
    for (int rb = vcu; rb < SEQ / 64; rb += G) {
        {
            f32x4 ggv[8]; { const GAS f32x4* gr = (const GAS f32x4*)gpre + lane;
#pragma unroll
              for (int j = 0; j < 8; ++j) ggv[j] = gr[64 * j]; }
#define P0_LOAD(buf, mm) do { const GAS f32x4* xr_ = (const GAS f32x4*)(x + (size_t)(mm) * DM) + lane; _Pragma("unroll") for (int j = 0; j < 8; ++j) buf[j] = xr_[64 * j]; } while (0)
#define P0_ROW(buf, mm) do { float s_ = 0.f; _Pragma("unroll") for (int j = 0; j < 8; ++j) s_ += (buf[j].x * buf[j].x + buf[j].y * buf[j].y) + (buf[j].z * buf[j].z + buf[j].w * buf[j].w); \
            const float r_ = 1.0f / sqrtf(wave_sum(s_) * (1.0f / DM) + NORM_EPS); GAS u32x2* o_ = (GAS u32x2*)(hb + (size_t)(mm) * DM) + lane; \
            _Pragma("unroll") for (int j = 0; j < 8; ++j) { const f32x4 gg = ggv[j]; u32x2 w; w.x = pk2(buf[j].x * r_ * gg.x, buf[j].y * r_ * gg.y); w.y = pk2(buf[j].z * r_ * gg.z, buf[j].w * r_ * gg.w); o_[64 * j] = w; } } while (0)
            f32x4 va[8], vb[8];
            const int m0 = rb * 64 + wave * 8;
            P0_LOAD(va, m0);
#pragma unroll 1
            for (int i = 0; i < 8; i += 2) {
                P0_LOAD(vb, m0 + i + 1);
                P0_ROW(va, m0 + i);
                if (i + 2 < 8) P0_LOAD(va, m0 + i + 2);
                P0_ROW(vb, m0 + i + 1);
            }
#undef P0_LOAD
#undef P0_ROW
        }
        asm volatile("s_waitcnt vmcnt(0)" ::: "memory"); __syncthreads();
        {
            const int tile = wave & 3, kh = wave >> 2, row = lane & 15, kq = lane >> 4, t0 = rb * 64 + tile * 16;
            const GAS u32x4* hr = (const GAS u32x4*)(hb + (size_t)(t0 + row) * DM + kh * 1024 + 8 * kq);
            const LAS u32x4* wf = (const LAS u32x4*)lds + (kh * 32) * 64 + lane;
            pg8::f32x4 acc = {0.f, 0.f, 0.f, 0.f};
            for (int sp = 0; sp < 32; sp += 8) { u32x4 hv[8];
#pragma unroll
                for (int j = 0; j < 8; ++j) hv[j] = hr[4 * (sp + j)];
#pragma unroll
                for (int j = 0; j < 8; ++j) acc = __builtin_amdgcn_mfma_f32_16x16x32_bf16(__builtin_bit_cast(pg8::bf16x8, hv[j]), __builtin_bit_cast(pg8::bf16x8, wf[(sp + j) * 64]), acc, 0, 0, 0);
            }
            if (kh == 1) {
#pragma unroll
                for (int j = 0; j < 4; ++j) part[(tile * 4 + j) * 64 + lane] = acc[j]; }
            LDS_WAIT(); __syncthreads();
            if (kh == 0) {
#pragma unroll
                for (int j = 0; j < 4; ++j) PRE[(size_t)(t0 + 4 * kq + j) * 16 + row] = acc[j] + part[(tile * 4 + j) * 64 + lane]; }
            __syncthreads();
        }
    }
    __syncthreads();
    convert_weights(a, lds, 0, lane, wave, vcu, G);
    convert_weights(a, lds, 1, lane, wave, vcu, G);
    { float* GH = (float*)(a.ws + WS_GHEAD); const float* gmh = (const float*)a.in[IN_GMH]; const float* grh = (const float*)a.in[IN_GRH];
      for (int i = vcu * NTHR + tid; i < 1024; i += G * NTHR) GH[i] = gmh[i];
      for (int i = vcu * NTHR + tid; i < 1024; i += G * NTHR) GH[1024 + i] = grh[i]; }
    const int* pos = (const int*)a.in[IN_POS]; float* COS = (float*)(a.ws + WS_COS); float* SIN = (float*)(a.ws + WS_SIN);
    { LAS float* invf = (LAS float*)(lds + GATE_OFF);
      if (tid < 64) invf[tid] = (float)pow(10000.0, -(double)(2 * tid) / 128.0);
      LDS_WAIT(); __syncthreads();
      for (int i = vcu * NTHR + tid; i < SEQ * 64; i += G * NTHR) { const int t = i >> 6, j = i & 63;
          const float ang = (float)pos[t] * invf[j];
          double rev = (double)ang * 0.15915494309189533577; rev -= __builtin_rint(rev); const float fr = (float)rev;
          COS[i] = __builtin_amdgcn_cosf(fr); SIN[i] = __builtin_amdgcn_sinf(fr); } }
}

typedef short bf16x8 __attribute__((ext_vector_type(8)));
typedef short s16x4 __attribute__((ext_vector_type(4)));
typedef float f32x16 __attribute__((ext_vector_type(16)));
#define MFMA32(a, b, c) __builtin_amdgcn_mfma_f32_32x32x16_bf16((a), (b), (c), 0, 0, 0)
DI int crow(int reg, int h) { return (reg & 3) + 8 * (reg >> 2) + 4 * h; }
DI bf16x8 bf_ones() { return (bf16x8){16256, 16256, 16256, 16256, 16256, 16256, 16256, 16256}; }
DI int offb(int row, int ch) { return 256 * row + 16 * (ch ^ (((row & 3) << 2) | ((row >> 2) & 3))); }
DI int rowbase(int row, int h) { return offb(row, h); }
DI bf16x8 rowfrag(ldsp tile, int rb, int ks) { return *(const LAS bf16x8*)(tile + (rb ^ (ks << 5))); }
DI s16x4 tr_rd(ldsp p) { return __builtin_bit_cast(s16x4, __builtin_amdgcn_ds_read_tr16_b64_v4i16((LAS s16x4*)p)); }
struct TrB { int b0, b1; };
DI TrB trbase(int c, int lane) {
    const int h = lane >> 5, blk = (lane >> 4) & 1, q = (lane & 15) >> 2, p = lane & 3, ch = 4 * c + 2 * blk + (p >> 1);
    TrB b; b.b0 = offb(8 * h + q, ch) + 8 * (p & 1); b.b1 = offb(8 * h + 4 + q, ch) + 8 * (p & 1); return b;
}
DI bf16x8 trfrag(ldsp tile, const TrB b, int ks) {
    const s16x4 lo = tr_rd(tile + b.b0 + 4096 * ks), hi = tr_rd(tile + b.b1 + 4096 * ks);
    return __builtin_shufflevector(lo, hi, 0, 1, 2, 3, 4, 5, 6, 7);
}
DI void gload8(const bf16* p, float (&f)[8]) { unpack8(*(const GAS u32x4*)p, f); }

constexpr int NGROUPS = 256, GM = 18, GR = 14;
struct Grp { int g, grp, c0, nch, base; };
DI Grp grp_of(int cg) { Grp r;
    if (cg < NHG * GM) { r.g = cg / GM; r.grp = cg % GM; r.base = r.g * GM; r.c0 = r.grp < 2 ? 8 * r.grp : 16 + 7 * (r.grp - 2); r.nch = r.grp < 2 ? 8 : 7; }
    else { const int q = cg - NHG * GM; r.g = NHG + q / GR; r.grp = q % GR; r.base = NHG * GM + (r.g - NHG) * GR; r.c0 = r.grp < 2 ? 10 * r.grp : 20 + 9 * (r.grp - 2); r.nch = r.grp < 2 ? 10 : 9; }
    return r; }
constexpr float KSCALE = 0.08838834764831845f;
DI void mixer_setup(const Args& a, ldsp lds, int g, int c0, int nch, int tid, int lane, int wave) {
    if (g < NHG) {
      if (wave < nch) {
        LAS float* rowv = (LAS float*)(lds + GATE_OFF + wave * 1536); LAS float* colv = rowv + 128; LAS float* alog = rowv + 256;
        const float* PRE = (const float*)(a.ws + WS_PRE); const float bi = ((const float*)a.in[IN_BI])[g], bfg = ((const float*)a.in[IN_BF])[g];
        const int t0 = (c0 + wave) * CH + 2 * lane;
        const float i0 = PRE[(size_t)t0 * 16 + g] + bi, i1 = PRE[(size_t)(t0 + 1) * 16 + g] + bi;
        const float f0 = PRE[(size_t)t0 * 16 + 8 + g] + bfg, f1 = PRE[(size_t)(t0 + 1) * 16 + 8 + g] + bfg;
        const float l0 = fminf(f0, 0.f) - log1pf(__expf(-fabsf(f0))), l1 = fminf(f1, 0.f) - log1pf(__expf(-fabsf(f1)));
        float p = l0 + l1;
#pragma unroll
        for (int o = 1; o < 64; o <<= 1) { const float y = __shfl_up(p, o); if (lane >= o) p += y; }
        const float b1 = p, b0 = p - l1, rv127 = __shfl(b1, 63);
        rowv[2 * lane] = __expf(b0 - rv127); rowv[2 * lane + 1] = __expf(b1 - rv127); alog[2 * lane] = __expf(b0); alog[2 * lane + 1] = __expf(b1);
        colv[2 * lane] = KSCALE * __expf(rv127 + (i0 - b0)); colv[2 * lane + 1] = KSCALE * __expf(rv127 + (i1 - b1));
      }
        if (tid < 128) { LAS float* cwl = (LAS float*)(lds + CONVW_OFF); const float* cw = (const float*)a.in[IN_CW]; const float* cb = (const float*)a.in[IN_CB];
#pragma unroll
            for (int j = 0; j < 4; ++j) { cwl[j * 128 + tid] = cw[j * 2048 + g * HD + tid]; cwl[640 + j * 128 + tid] = cw[j * 2048 + 1024 + g * HD + tid]; }
            cwl[512 + tid] = cb[g * HD + tid]; cwl[640 + 512 + tid] = cb[1024 + g * HD + tid]; }
    } else if (tid < 128) {
        LAS float* rowv = (LAS float*)(lds + GATE_OFF); LAS float* colv = rowv + 128; LAS float* alog = rowv + 256;
        const float lg = log1pf(-exp2f(-5.0f - (float)(g - NHG)));
        rowv[tid] = __expf((float)tid * lg - 127.0f * lg); colv[tid] = KSCALE * __expf(127.0f * lg + (-(float)tid * lg)); alog[tid] = __expf((float)(tid + 1) * lg);
    }
    if (tid >= 128 && tid < 256) { const int e = tid - 128; ((LAS float*)(lds + GHL_OFF))[e] = ((const float*)(a.ws + WS_GHEAD))[g * HD + e]; }
    LDS_WAIT(); __syncthreads();
}
struct KvRegs { u32x4 x[16]; };
DI void kv_load(const Args& a, int g, int c, int tid, KvRegs& R) {
    const bf16* proj = (const bf16*)(a.ws + WS_B);
    const int sq = tid >> 4, dg = tid & 15, tb = c * CH + 4 * sq;
    if (g < NHG) {
        const bf16* pk = proj + PC_MK + g * HD + 8 * dg; const bf16* pv = proj + PC_MV + g * HD + 8 * dg;
#pragma unroll
        for (int j = 0; j < 7; ++j) { const int tt = tb - 3 + j, tc = tt < 0 ? 0 : tt; R.x[j] = *(const GAS u32x4*)(pk + (size_t)tc * NPJ); if (tt < 0) R.x[j] = (u32x4){0u, 0u, 0u, 0u}; }
#pragma unroll
        for (int i = 0; i < 4; ++i) R.x[12 + i] = *(const GAS u32x4*)(pv + (size_t)(tb + i) * NPJ);
    } else {
        const int gr = g - NHG; const float* COS = (const float*)(a.ws + WS_COS); const float* SIN = (const float*)(a.ws + WS_SIN);
        const int s2 = tid >> 3, dgp = tid & 7; const bf16* pv = proj + PC_RV + gr * HD + 8 * dg;
#pragma unroll
        for (int i = 0; i < 2; ++i) { const size_t t = (size_t)(c * CH + 2 * s2 + i); const bf16* pr = proj + t * NPJ + gr * HD + 8 * dgp;
            R.x[i] = *(const GAS u32x4*)(pr + PC_RK); R.x[2 + i] = *(const GAS u32x4*)(pr + PC_RK + 64);
            R.x[4 + 4 * i] = *(const GAS u32x4*)(COS + t * 64 + 8 * dgp); R.x[5 + 4 * i] = *(const GAS u32x4*)(COS + t * 64 + 8 * dgp + 4);
            R.x[6 + 4 * i] = *(const GAS u32x4*)(SIN + t * 64 + 8 * dgp); R.x[7 + 4 * i] = *(const GAS u32x4*)(SIN + t * 64 + 8 * dgp + 4); }
#pragma unroll
        for (int i = 0; i < 4; ++i) R.x[12 + i] = *(const GAS u32x4*)(pv + (size_t)(tb + i) * NPJ);
    }
}
DI void kv_build(ldsp lds, int g, const LAS float* gt, int tid, const KvRegs& R) {
    const LAS float* sck = gt + 128;
    ldsp K = lds + 32768, V = lds + 65536;
    const int sq = tid >> 4, dg = tid & 15;
    if (g < NHG) {
        const LAS float* wl = (const LAS float*)(lds + CONVW_OFF) + 640 + 8 * dg;
#pragma unroll
        for (int i = 0; i < 4; ++i) { float acc[8];
            { const f32x4 w0 = *(const LAS f32x4*)(wl + 512), w1 = *(const LAS f32x4*)(wl + 516); acc[0] = w0.x; acc[1] = w0.y; acc[2] = w0.z; acc[3] = w0.w; acc[4] = w1.x; acc[5] = w1.y; acc[6] = w1.z; acc[7] = w1.w; }
#pragma unroll
            for (int j = 0; j < 4; ++j) { float uu[8]; unpack8(R.x[i + j], uu);
                const f32x4 w0 = *(const LAS f32x4*)(wl + j * 128), w1 = *(const LAS f32x4*)(wl + j * 128 + 4);
                acc[0] = __builtin_fmaf(w0.x, uu[0], acc[0]); acc[1] = __builtin_fmaf(w0.y, uu[1], acc[1]); acc[2] = __builtin_fmaf(w0.z, uu[2], acc[2]); acc[3] = __builtin_fmaf(w0.w, uu[3], acc[3]); acc[4] = __builtin_fmaf(w1.x, uu[4], acc[4]); acc[5] = __builtin_fmaf(w1.y, uu[5], acc[5]); acc[6] = __builtin_fmaf(w1.z, uu[6], acc[6]); acc[7] = __builtin_fmaf(w1.w, uu[7], acc[7]); }
            const int srow = 4 * sq + i; const float sc = sck[srow];
#pragma unroll
            for (int e = 0; e < 8; ++e) acc[e] = silu_f(acc[e]) * sc;
            *(LAS u32x4*)(K + offb(srow, dg)) = pack8(acc); }
    } else {
        const int s2 = tid >> 3, dgp = tid & 7;
#pragma unroll
        for (int i = 0; i < 2; ++i) { const int srow = 2 * s2 + i;
            const f32x4 cA = __builtin_bit_cast(f32x4, R.x[4 + 4 * i]), cB = __builtin_bit_cast(f32x4, R.x[5 + 4 * i]), sA = __builtin_bit_cast(f32x4, R.x[6 + 4 * i]), sB = __builtin_bit_cast(f32x4, R.x[7 + 4 * i]);
            const float c8[8] = {cA.x, cA.y, cA.z, cA.w, cB.x, cB.y, cB.z, cB.w};
            const float s8[8] = {sA.x, sA.y, sA.z, sA.w, sB.x, sB.y, sB.z, sB.w};
            float lo[8], hi[8], olo[8], ohi[8]; unpack8(R.x[i], lo); unpack8(R.x[2 + i], hi);
            const float sc = sck[srow];
#pragma unroll
            for (int e = 0; e < 8; ++e) { olo[e] = __builtin_fmaf(lo[e], c8[e], -hi[e] * s8[e]) * sc; ohi[e] = __builtin_fmaf(hi[e], c8[e], lo[e] * s8[e]) * sc; }
            *(LAS u32x4*)(K + offb(srow, dgp)) = pack8(olo); *(LAS u32x4*)(K + offb(srow, 8 + dgp)) = pack8(ohi); }
    }
#pragma unroll
    for (int i = 0; i < 4; ++i) *(LAS u32x4*)(V + offb(4 * sq + i, dg)) = R.x[12 + i];
    LDS_WAIT(); __syncthreads();
}
DI void phase_m1(const Args& a, ldsp lds, int tid_in, int wave, int vcu, int G) {
    float* UG = (float*)(a.ws + WS_A); float* NG = (float*)(a.ws + WS_NLOC); float* DG = (float*)(a.ws + WS_DEC);
    ldsp K = lds + 32768, V = lds + 65536; const int wi = wave >> 1, wj = wave & 1;
    for (int cg = vcu; cg < NGROUPS; cg += G) { const Grp gi = grp_of(cg); const int g = gi.g; const bool ml = g < NHG;
        KvRegs R; kv_load(a, g, gi.c0, tid_in, R);
        { int tid_g = tid_in; asm volatile("" : "+v"(tid_g)); mixer_setup(a, lds, g, gi.c0, gi.nch, tid_g, tid_g & 63, wave); }
        f32x16 accU[2], accN; float dprod = 1.0f;
#pragma unroll
        for (int i = 0; i < 16; ++i) { accU[0][i] = 0.f; accU[1][i] = 0.f; accN[i] = 0.f; }
        for (int ci = 0; ci < gi.nch; ++ci) { const int c = gi.c0 + ci;
            int tid_o = tid_in; asm volatile("" : "+v"(tid_o));
            const int tid = tid_o, lane = tid & 63;
            const LAS float* gt = (const LAS float*)(lds + GATE_OFF + (ml ? ci : 0) * 1536);
            kv_build(lds, g, gt, tid, R);
            kv_load(a, g, ci + 1 < gi.nch ? c + 1 : c, tid, R);
            const float dec = gt[256 + 127]; dprod *= dec;
            accU[0] = accU[0] * dec; accU[1] = accU[1] * dec; accN = accN * dec;
            { const TrB tk = trbase(wi, lane), tv0 = trbase(2 * wj, lane), tv1 = trbase(2 * wj + 1, lane);
              if (ml && wj == 0) {
#pragma unroll
                  for (int ks = 0; ks < 8; ++ks) { const bf16x8 af = trfrag(K, tk, ks), b0 = trfrag(V, tv0, ks), b1 = trfrag(V, tv1, ks);
                      accU[0] = MFMA32(af, b0, accU[0]); accU[1] = MFMA32(af, b1, accU[1]); accN = MFMA32(af, bf_ones(), accN); }
              } else {
#pragma unroll
                  for (int ks = 0; ks < 8; ++ks) { const bf16x8 af = trfrag(K, tk, ks), b0 = trfrag(V, tv0, ks), b1 = trfrag(V, tv1, ks);
                      accU[0] = MFMA32(af, b0, accU[0]); accU[1] = MFMA32(af, b1, accU[1]); }
              }
            }
            __syncthreads();
        }
        { int tid_o = tid_in; asm volatile("" : "+v"(tid_o)); const int lane = tid_o & 63, r = lane & 31, h = lane >> 5;
          float* o = UG + ((size_t)cg << 14) + wave * 2048 + lane;
#pragma unroll
          for (int n = 0; n < 2; ++n)
#pragma unroll
              for (int i = 0; i < 16; ++i) o[(n * 16 + i) * 64] = accU[n][i];
          if (ml && wj == 0 && r == 0) {
#pragma unroll
              for (int i = 0; i < 16; ++i) NG[(size_t)cg * HD + 32 * wi + crow(i, h)] = accN[i]; }
          if (tid_in == 0) DG[cg] = dprod; }
    }
}
constexpr int HALO_OFF = MISC_OFF + 1024;
static_assert(HALO_OFF + 3072 <= LDS_BYTES, "LDS map");
DI void m3_stage(const Args& a, ldsp lds, int g, int c, int lane, int wave) {
    const bf16* proj = (const bf16*)(a.ws + WS_B);
    const int colq = g < NHG ? PC_MQ + g * HD : PC_RQ + (g - NHG) * HD, colk = g < NHG ? PC_MK + g * HD : PC_RK + (g - NHG) * HD;
    const bf16* base = proj + (size_t)(c * CH + (lane >> 4)) * NPJ + 8 * (lane & 15) + (wave >= 4 ? colk : colq);
#pragma unroll
    for (int k = 0; k < 8; ++k) { const int p = wave * 8 + k;
        __builtin_amdgcn_global_load_lds((const unsigned*)(base + (size_t)(4 * (p & 31)) * NPJ), (LAS unsigned*)(lds + 65536 + p * 1024), 16, 0, 0); }
}
DI void m3_build_qk(const Args& a, ldsp lds, int g, int c, int par, const LAS float* gt, int tid, u32x4 (&vv)[4]) {
    const bf16* proj = (const bf16*)(a.ws + WS_B);
    const LAS float* sck = gt + 128;
    ldsp Q = lds, K = lds + 32768, SQ = lds + 65536, SK = lds + 98304, HAL = lds + HALO_OFF;
    const int sq = tid >> 4, dg = tid & 15, tb = c * CH + 4 * sq;
    if (g < NHG) {
        const bf16* pv = proj + PC_MV + g * HD + 8 * dg;
#pragma unroll
        for (int i = 0; i < 4; ++i) vv[i] = *(const GAS u32x4*)(pv + (size_t)(tb + i) * NPJ);
        const LAS float* cwl = (const LAS float*)(lds + CONVW_OFF);
#pragma unroll
        for (int qk = 0; qk < 2; ++qk) {
            ldsp S = qk == 0 ? SK : SQ; ldsp H = HAL + par * 1536 + (qk == 0 ? 768 : 0);
            u32x4 rr[7];
#pragma unroll
            for (int j = 0; j < 7; ++j) { const int row = 4 * sq - 3 + j;
                if (j < 3) rr[j] = row >= 0 ? *(const LAS u32x4*)(S + row * 256 + 16 * dg) : *(const LAS u32x4*)(H + (row + 3) * 256 + 16 * dg);
                else rr[j] = *(const LAS u32x4*)(S + row * 256 + 16 * dg); }
            if (sq == 31) { ldsp Hn = HAL + (par ^ 1) * 1536 + (qk == 0 ? 768 : 0);
#pragma unroll
                for (int j = 0; j < 3; ++j) *(LAS u32x4*)(Hn + j * 256 + 16 * dg) = rr[4 + j]; }
            const LAS float* wl = cwl + (qk == 0 ? 640 : 0) + 8 * dg;
            float w[5][8];
#pragma unroll
            for (int j = 0; j < 5; ++j) { const f32x4 w0 = *(const LAS f32x4*)(wl + j * 128), w1 = *(const LAS f32x4*)(wl + j * 128 + 4); w[j][0] = w0.x; w[j][1] = w0.y; w[j][2] = w0.z; w[j][3] = w0.w; w[j][4] = w1.x; w[j][5] = w1.y; w[j][6] = w1.z; w[j][7] = w1.w; }
#pragma unroll
            for (int i = 0; i < 4; ++i) { float acc[8];
#pragma unroll
                for (int e = 0; e < 8; ++e) acc[e] = w[4][e];
#pragma unroll
                for (int j = 0; j < 4; ++j) { float uu[8]; unpack8(rr[i + j], uu);
#pragma unroll
                    for (int e = 0; e < 8; ++e) acc[e] = __builtin_fmaf(w[j][e], uu[e], acc[e]); }
                const int srow = 4 * sq + i; const float sc = qk == 0 ? sck[srow] : 1.0f;
#pragma unroll
                for (int e = 0; e < 8; ++e) acc[e] = silu_f(acc[e]) * sc;
                *(LAS u32x4*)((qk == 0 ? K : Q) + offb(srow, dg)) = pack8(acc); }
        }
    } else {
        const int gr = g - NHG; const float* COS = (const float*)(a.ws + WS_COS); const float* SIN = (const float*)(a.ws + WS_SIN);
        const int s2 = tid >> 3, dgp = tid & 7; const bf16* pv = proj + PC_RV + gr * HD + 8 * dg;
        f32x4 cs[2][2], sn[2][2];
#pragma unroll
        for (int i = 0; i < 2; ++i) { const size_t t = (size_t)(c * CH + 2 * s2 + i);
            cs[i][0] = *(const GAS f32x4*)(COS + t * 64 + 8 * dgp); cs[i][1] = *(const GAS f32x4*)(COS + t * 64 + 8 * dgp + 4);
            sn[i][0] = *(const GAS f32x4*)(SIN + t * 64 + 8 * dgp); sn[i][1] = *(const GAS f32x4*)(SIN + t * 64 + 8 * dgp + 4); }
#pragma unroll
        for (int i = 0; i < 4; ++i) vv[i] = *(const GAS u32x4*)(pv + (size_t)(tb + i) * NPJ);
#pragma unroll
        for (int i = 0; i < 2; ++i) { const int srow = 2 * s2 + i;
            const float c8[8] = {cs[i][0].x, cs[i][0].y, cs[i][0].z, cs[i][0].w, cs[i][1].x, cs[i][1].y, cs[i][1].z, cs[i][1].w};
            const float s8[8] = {sn[i][0].x, sn[i][0].y, sn[i][0].z, sn[i][0].w, sn[i][1].x, sn[i][1].y, sn[i][1].z, sn[i][1].w};
            float lo[8], hi[8], olo[8], ohi[8];
            unpack8(*(const LAS u32x4*)(SK + srow * 256 + 16 * dgp), lo); unpack8(*(const LAS u32x4*)(SK + srow * 256 + 128 + 16 * dgp), hi);
            const float sc = sck[srow];
#pragma unroll
            for (int e = 0; e < 8; ++e) { olo[e] = __builtin_fmaf(lo[e], c8[e], -hi[e] * s8[e]) * sc; ohi[e] = __builtin_fmaf(hi[e], c8[e], lo[e] * s8[e]) * sc; }
            *(LAS u32x4*)(K + offb(srow, dgp)) = pack8(olo); *(LAS u32x4*)(K + offb(srow, 8 + dgp)) = pack8(ohi);
            unpack8(*(const LAS u32x4*)(SQ + srow * 256 + 16 * dgp), lo); unpack8(*(const LAS u32x4*)(SQ + srow * 256 + 128 + 16 * dgp), hi);
#pragma unroll
            for (int e = 0; e < 8; ++e) { olo[e] = __builtin_fmaf(lo[e], c8[e], -hi[e] * s8[e]); ohi[e] = __builtin_fmaf(hi[e], c8[e], lo[e] * s8[e]); }
            *(LAS u32x4*)(Q + offb(srow, dgp)) = pack8(olo); *(LAS u32x4*)(Q + offb(srow, 8 + dgp)) = pack8(ohi); }
    }
}
#define RAW_BARRIER() do { asm volatile("s_waitcnt lgkmcnt(0)" ::: "memory"); __builtin_amdgcn_s_barrier(); asm volatile("" ::: "memory"); } while (0)
DI void phase_m3(const Args& a, ldsp lds, int tid_in, int wave, int vcu, int G) {
    const bf16* proj = (const bf16*)(a.ws + WS_B); const float* UG = (const float*)(a.ws + WS_A); const float* NG = (const float*)(a.ws + WS_NLOC); const float* DG = (const float*)(a.ws + WS_DEC);
    bf16* mixb = (bf16*)a.out;
    LAS unsigned short* n0b = (LAS unsigned short*)(lds + N0B_OFF);
    ldsp Q = lds, K = lds + 32768, V = lds + 65536, C0 = lds + 98304, P = lds + 98304; LAS float* H = (LAS float*)lds;
    const int wi = wave >> 1, wj = wave & 1;
    for (int cg = vcu; cg < NGROUPS; cg += G) { const Grp gi = grp_of(cg); const int g = gi.g, grp = gi.grp; const bool ml = g < NHG;
        { int tid_s = tid_in; asm volatile("" : "+v"(tid_s));
          m3_stage(a, lds, g, gi.c0, tid_s & 63, wave);
          if (tid_s < 96) { const int which = tid_s / 48, j = (tid_s % 48) >> 4, dgh = tid_s & 15; const int t = gi.c0 * CH - 3 + j;
              u32x4 hv = {0u, 0u, 0u, 0u};
              if (ml && t >= 0) hv = *(const GAS u32x4*)(proj + (size_t)t * NPJ + (which ? PC_MK : PC_MQ) + g * HD + 8 * dgh);
              *(LAS u32x4*)(lds + HALO_OFF + (which ? 768 : 0) + j * 256 + 16 * dgh) = hv; } }
        { int tid_g = tid_in; asm volatile("" : "+v"(tid_g)); mixer_setup(a, lds, g, gi.c0, gi.nch, tid_g, tid_g & 63, wave); }
        f32x16 accC[2]; LAS float* nstate = (LAS float*)(lds + NST_OFF);
#pragma unroll
        for (int i = 0; i < 16; ++i) { accC[0][i] = 0.f; accC[1][i] = 0.f; }
        { int tid_o = tid_in; asm volatile("" : "+v"(tid_o)); const int lane = tid_o & 63;
          float nn = 0.f;
          for (int j = 0; j < grp; ++j) { const float* us = UG + ((size_t)(gi.base + j) << 14) + wave * 2048 + lane; const float dj = DG[gi.base + j];
#pragma unroll
              for (int i = 0; i < 16; ++i) { accC[0][i] = dj * accC[0][i] + us[i * 64]; accC[1][i] = dj * accC[1][i] + us[(16 + i) * 64]; }
              if (ml && tid_o < 128) nn = dj * nn + NG[(size_t)(gi.base + j) * HD + tid_o]; }
          if (tid_o < 128) nstate[tid_o] = nn;
          }
        asm volatile("s_waitcnt vmcnt(0)" ::: "memory"); LDS_WAIT(); __syncthreads();
        for (int ci = 0; ci < gi.nch; ++ci) { const int c = gi.c0 + ci;
            int tid_o = tid_in; asm volatile("" : "+v"(tid_o));
            const int tid = tid_o, lane = tid & 63, r = lane & 31, h = lane >> 5;
            const LAS float* gt = (const LAS float*)(lds + GATE_OFF + (ml ? ci : 0) * 1536);
            u32x4 vv[4];
            m3_build_qk(a, lds, g, c, ci & 1, gt, tid, vv);
            LDS_WAIT(); __syncthreads();
#pragma unroll
            for (int i = 0; i < 4; ++i) *(LAS u32x4*)(V + offb(4 * (tid >> 4) + i, tid & 15)) = vv[i];
#pragma unroll
            for (int n = 0; n < 2; ++n) { const int e = 64 * wj + 32 * n + r;
#pragma unroll
                for (int q = 0; q < 4; ++q) { u32x2 w; w.x = pk2(accC[n][4 * q], accC[n][4 * q + 1]); w.y = pk2(accC[n][4 * q + 2], accC[n][4 * q + 3]);
                    *(LAS u32x2*)(C0 + offb(e, 4 * wi + q) + 8 * h) = w; } }
            if (tid < 128) n0b[tid] = (unsigned short)pk2(nstate[tid], nstate[tid]);
            LDS_WAIT(); __syncthreads();
            f32x16 accO[2], accS[2], accD;
#pragma unroll
            for (int i = 0; i < 16; ++i) { accO[0][i] = 0.f; accO[1][i] = 0.f; accS[0][i] = 0.f; accS[1][i] = 0.f; accD[i] = 0.f; }
            const TrB tk = trbase(wi, lane), tv0 = trbase(2 * wj, lane), tv1 = trbase(2 * wj + 1, lane);
            const int rbq = rowbase(32 * wi + r, h), rbk = rowbase(64 * wj + r, h);
            if (ml) {
#pragma unroll
                for (int ks = 0; ks < 8; ++ks) { const bf16x8 af = rowfrag(Q, rbq, ks), b0 = rowfrag(C0, rbk, ks), b1 = rowfrag(C0 + 8192, rbk, ks), bn = *(const LAS bf16x8*)(n0b + 16 * ks + 8 * h);
                    accO[0] = MFMA32(af, b0, accO[0]); accO[1] = MFMA32(af, b1, accO[1]); accD = MFMA32(af, bn, accD); }
            } else {
#pragma unroll
                for (int ks = 0; ks < 8; ++ks) { const bf16x8 af = rowfrag(Q, rbq, ks), b0 = rowfrag(C0, rbk, ks), b1 = rowfrag(C0 + 8192, rbk, ks);
                    accO[0] = MFMA32(af, b0, accO[0]); accO[1] = MFMA32(af, b1, accO[1]); }
            }
#pragma unroll
            for (int i = 0; i < 16; ++i) { const int t = 32 * wi + crow(i, h); const float al = gt[256 + t]; accO[0][i] *= al; accO[1][i] *= al; accD[i] *= al; }
#pragma unroll
            for (int ks = 0; ks < 8; ++ks) { const bf16x8 af = rowfrag(Q, rbq, ks), b0 = rowfrag(K, rbk, ks), b1 = rowfrag(K + 8192, rbk, ks);
                accS[0] = MFMA32(b0, af, accS[0]); accS[1] = MFMA32(b1, af, accS[1]); }
            __syncthreads();
            { const int t = 32 * wi + r; const float fac = gt[t];
#pragma unroll
              for (int n = 0; n < 2; ++n)
#pragma unroll
                for (int q = 0; q < 4; ++q) { const int s0 = 64 * wj + 32 * n + 8 * q + 4 * h;
                    const float v0 = (s0 <= t) ? accS[n][4 * q] * fac : 0.f, v1 = (s0 + 1 <= t) ? accS[n][4 * q + 1] * fac : 0.f, v2 = (s0 + 2 <= t) ? accS[n][4 * q + 2] * fac : 0.f, v3 = (s0 + 3 <= t) ? accS[n][4 * q + 3] * fac : 0.f;
                    u32x2 w; w.x = pk2(v0, v1); w.y = pk2(v2, v3);
                    *(LAS u32x2*)(P + offb(t, 8 * wj + 4 * n + q) + 8 * h) = w; } }
            LDS_WAIT(); __syncthreads();
            u32x4 gpre[2][2];
            { const int tl = tid >> 3, eg = tid & 7; const int hc = ml ? g * HD + 16 * eg : (g - NHG) * HD + 16 * eg;
#pragma unroll
              for (int hh = 0; hh < 2; ++hh) { const bf16* gp = proj + (size_t)(c * CH + 64 * hh + tl) * NPJ + (ml ? PC_MO : PC_RG) + hc; gpre[hh][0] = *(const GAS u32x4*)gp; gpre[hh][1] = *(const GAS u32x4*)(gp + 8); } }
            const float dec = gt[256 + 127]; accC[0] = accC[0] * dec; accC[1] = accC[1] * dec;
            f32x16 accN;
#pragma unroll
            for (int i = 0; i < 16; ++i) accN[i] = 0.f;
            if (ml) {
#pragma unroll
                for (int ks = 0; ks < 8; ++ks) { const bf16x8 af = rowfrag(P, rbq, ks), ak = trfrag(K, tk, ks), b0 = trfrag(V, tv0, ks), b1 = trfrag(V, tv1, ks);
                    accO[0] = MFMA32(af, b0, accO[0]); accO[1] = MFMA32(af, b1, accO[1]); accC[0] = MFMA32(ak, b0, accC[0]); accC[1] = MFMA32(ak, b1, accC[1]);
                    accD = MFMA32(af, bf_ones(), accD); accN = MFMA32(ak, bf_ones(), accN); }
            } else {
#pragma unroll
                for (int ks = 0; ks < 8; ++ks) { const bf16x8 af = rowfrag(P, rbq, ks), ak = trfrag(K, tk, ks), b0 = trfrag(V, tv0, ks), b1 = trfrag(V, tv1, ks);
                    accO[0] = MFMA32(af, b0, accO[0]); accO[1] = MFMA32(af, b1, accO[1]); accC[0] = MFMA32(ak, b0, accC[0]); accC[1] = MFMA32(ak, b1, accC[1]); }
            }
            if (ml && wj == 0 && r == 0) {
#pragma unroll
                for (int i = 0; i < 16; ++i) { const int d = 32 * wi + crow(i, h); nstate[d] = dec * nstate[d] + accN[i]; } }
            asm volatile("" : "+v"(gpre[0][0]), "+v"(gpre[0][1]), "+v"(gpre[1][0]), "+v"(gpre[1][1]));
            __syncthreads();
            m3_stage(a, lds, g, ci + 1 < gi.nch ? c + 1 : c, lane, wave);
#pragma unroll
            for (int i = 0; i < 16; ++i) { const int t = 32 * wi + crow(i, h); const float rden = ml ? __builtin_amdgcn_rcpf(fmaxf(fabsf(accD[i]), 1.0f)) : 1.0f;
                H[t * HD + 64 * wj + r] = accO[0][i] * rden; H[t * HD + 64 * wj + 32 + r] = accO[1][i] * rden; }
            RAW_BARRIER();
#pragma unroll
            for (int hh = 0; hh < 2; ++hh) {
                const int tl = tid >> 3, eg = tid & 7, t = 64 * hh + tl;
                float hv[16]; float ss = 0.f;
#pragma unroll
                for (int q = 0; q < 4; ++q) { const f32x4 x4 = *(const LAS f32x4*)(H + t * HD + 16 * eg + 4 * q); hv[4 * q] = x4.x; hv[4 * q + 1] = x4.y; hv[4 * q + 2] = x4.z; hv[4 * q + 3] = x4.w; }
#pragma unroll
                for (int i = 0; i < 16; ++i) ss += hv[i] * hv[i];
                ss += __shfl_xor(ss, 1); ss += __shfl_xor(ss, 2); ss += __shfl_xor(ss, 4);
                const float rn = __builtin_amdgcn_rsqf(ss * (1.0f / HD) + NORM_EPS);
                const int tg = c * CH + t; const int hc = ml ? g * HD + 16 * eg : (g - NHG) * HD + 16 * eg;
                float gh[16]; {
#pragma unroll
                    for (int q = 0; q < 4; ++q) { const f32x4 g4 = *(const LAS f32x4*)((const LAS float*)(lds + GHL_OFF) + 16 * eg + 4 * q); gh[4 * q] = g4.x; gh[4 * q + 1] = g4.y; gh[4 * q + 2] = g4.z; gh[4 * q + 3] = g4.w; } }
                float ga[16]; { float t8[8]; unpack8(gpre[hh][0], t8);
#pragma unroll
                    for (int j = 0; j < 8; ++j) ga[j] = t8[j]; unpack8(gpre[hh][1], t8);
#pragma unroll
                    for (int j = 0; j < 8; ++j) ga[8 + j] = t8[j]; }
                float o[16];
#pragma unroll
                for (int i = 0; i < 16; ++i) o[i] = hv[i] * rn * gh[i] * (ml ? sigmoid_f(ga[i]) : silu_f(ga[i]));
                bf16* op = mixb + (size_t)tg * DM + (ml ? 0 : 1024) + hc;
                u32x4 w0, w1; w0.x = pk2(o[0], o[1]); w0.y = pk2(o[2], o[3]); w0.z = pk2(o[4], o[5]); w0.w = pk2(o[6], o[7]); w1.x = pk2(o[8], o[9]); w1.y = pk2(o[10], o[11]); w1.z = pk2(o[12], o[13]); w1.w = pk2(o[14], o[15]);
                *(GAS u32x4*)op = w0; *(GAS u32x4*)(op + 8) = w1;
            }
            asm volatile("s_waitcnt vmcnt(0)" ::: "memory");
            RAW_BARRIER();
        }
    }
}
DI void phase_r1(const Args& a, int lane, int wave, int vcu, int G) {
    const int gw = vcu * NWAVES + wave, NGW = G * NWAVES;
    const float* x = (const float*)a.in[IN_X]; const bf16* mix = (const bf16*)(a.ws + WS_B); bf16* x1 = (bf16*)(a.ws + WS_X1); float* rs2 = (float*)(a.ws + WS_RS);
    f32x4 ggv[8]; { const GAS f32x4* gp = (const GAS f32x4*)a.in[IN_GPOST] + lane;
#pragma unroll
      for (int j = 0; j < 8; ++j) ggv[j] = gp[64 * j]; }
#define R1_LOAD(bm, bx, mm) do { const GAS u32x2* mr_ = (const GAS u32x2*)(mix + (size_t)(mm) * DM) + lane; const GAS f32x4* xr_ = (const GAS f32x4*)(x + (size_t)(mm) * DM) + lane; \
        _Pragma("unroll") for (int j = 0; j < 8; ++j) { bm[j] = mr_[64 * j]; bx[j] = xr_[64 * j]; } } while (0)
#define R1_ROW(bm, bx, mm) do { f32x4 v[8]; float s_ = 0.f; \
        _Pragma("unroll") for (int j = 0; j < 8; ++j) { v[j] = (f32x4){bflo(bm[j].x), bfhi(bm[j].x), bflo(bm[j].y), bfhi(bm[j].y)}; s_ += (v[j].x * v[j].x + v[j].y * v[j].y) + (v[j].z * v[j].z + v[j].w * v[j].w); } \
        const float r_ = 1.0f / sqrtf(wave_sum(s_) * (1.0f / DM) + NORM_EPS); float s2_ = 0.f; GAS u32x2* xo_ = (GAS u32x2*)(x1 + (size_t)(mm) * DM) + lane; \
        _Pragma("unroll") for (int j = 0; j < 8; ++j) { const f32x4 gg = ggv[j]; v[j] = bx[j] + v[j] * r_ * gg; s2_ += (v[j].x * v[j].x + v[j].y * v[j].y) + (v[j].z * v[j].z + v[j].w * v[j].w); } \
        const float r2_ = 1.0f / sqrtf(wave_sum(s2_) * (1.0f / DM) + NORM_EPS); if (lane == 0) rs2[mm] = r2_; \
        _Pragma("unroll") for (int j = 0; j < 8; ++j) { u32x2 xw; xw.x = pk2(v[j].x * r2_, v[j].y * r2_); xw.y = pk2(v[j].z * r2_, v[j].w * r2_); xo_[64 * j] = xw; } } while (0)
    u32x2 ma[8], mb[8]; f32x4 xa[8], xb[8];
    int m = gw; if (m < SEQ) R1_LOAD(ma, xa, m);
    for (; m < SEQ; m += 2 * NGW) {
        if (m + NGW < SEQ) R1_LOAD(mb, xb, m + NGW);
        R1_ROW(ma, xa, m);
        if (m + 2 * NGW < SEQ) R1_LOAD(ma, xa, m + 2 * NGW);
        if (m + NGW < SEQ) R1_ROW(mb, xb, m + NGW);
    }
#undef R1_LOAD
#undef R1_ROW
}
DI void phase_r2(const Args& a, int lane, int wave, int vcu, int G, bool poison) {
    const int gw = vcu * NWAVES + wave, NGW = G * NWAVES;
    const bf16* ff = (const bf16*)(a.ws + WS_FF); const bf16* x1 = (const bf16*)(a.ws + WS_X1); const float* rs2 = (const float*)(a.ws + WS_RS); float* out = a.out;
    f32x4 ggv[8]; { const GAS f32x4* gp = (const GAS f32x4*)a.in[IN_GFPOST] + lane;
#pragma unroll
      for (int j = 0; j < 8; ++j) ggv[j] = gp[64 * j]; }
    const float qn = __builtin_nanf("");
#define R2_LOAD(bm, bx, mm) do { const GAS u32x2* fr_ = (const GAS u32x2*)(ff + (size_t)(mm) * DM) + lane; const GAS u32x2* xr_ = (const GAS u32x2*)(x1 + (size_t)(mm) * DM) + lane; \
        _Pragma("unroll") for (int j = 0; j < 8; ++j) { bm[j] = fr_[64 * j]; bx[j] = xr_[64 * j]; } bx[8].x = __builtin_bit_cast(unsigned, rs2[mm]); } while (0)
#define R2_ROW(bm, bx, mm) do { f32x4 v[8]; float s_ = 0.f; \
        _Pragma("unroll") for (int j = 0; j < 8; ++j) { v[j] = (f32x4){bflo(bm[j].x), bfhi(bm[j].x), bflo(bm[j].y), bfhi(bm[j].y)}; s_ += (v[j].x * v[j].x + v[j].y * v[j].y) + (v[j].z * v[j].z + v[j].w * v[j].w); } \
        const float r_ = 1.0f / sqrtf(wave_sum(s_) * (1.0f / DM) + NORM_EPS); const float inv2_ = 1.0f / __builtin_bit_cast(float, bx[8].x); GAS f32x4* xo_ = (GAS f32x4*)(out + (size_t)(mm) * DM) + lane; \
        _Pragma("unroll") for (int j = 0; j < 8; ++j) { const f32x4 gg = ggv[j]; f32x4 o = (f32x4){bflo(bx[j].x), bfhi(bx[j].x), bflo(bx[j].y), bfhi(bx[j].y)} * inv2_ + v[j] * r_ * gg; if (poison) o = (f32x4){qn, qn, qn, qn}; xo_[64 * j] = o; } } while (0)
    u32x2 ma[8], mb[8], xa[9], xb[9];
    int m = gw; if (m < SEQ) R2_LOAD(ma, xa, m);
    for (; m < SEQ; m += 2 * NGW) {
        if (m + NGW < SEQ) R2_LOAD(mb, xb, m + NGW);
        R2_ROW(ma, xa, m);
        if (m + 2 * NGW < SEQ) R2_LOAD(ma, xa, m + 2 * NGW);
        if (m + NGW < SEQ) R2_ROW(mb, xb, m + NGW);
    }
#undef R2_LOAD
#undef R2_ROW
}

DI int fresh_lane() { unsigned z = 0u; asm volatile("" : "+v"(z)); return (int)__builtin_amdgcn_mbcnt_hi(~0u, __builtin_amdgcn_mbcnt_lo(~0u, z)); }
__global__ void __launch_bounds__(NTHR, 2) fwd(Args a) {
    extern __shared__ __attribute__((aligned(16))) unsigned char lds_raw[];
    ldsp lds = (ldsp)lds_raw;
    const int wave = __builtin_amdgcn_readfirstlane((int)threadIdx.x >> 6);
#define FRESH_TID() (wave * 64 + fresh_lane())
    const int tid = FRESH_TID(), lane = tid & 63;
    const int G = gridDim.x; const int bx = blockIdx.x; const int vcu = (G % 8 == 0) ? (bx % 8) * (G / 8) + bx / 8 : bx;
    volatile LAS unsigned* MISC = (volatile LAS unsigned*)(lds + MISC_OFF);
    if (tid < 32) MISC[tid] = 0u;
    __syncthreads();
    unsigned* ctl = (unsigned*)(a.ws + WS_CTL);
    XcdBarrier bar; bar.bar = ctl + CW_BAR; bar.x = 0; bar.st = nullptr;
    if (N_LAUNCHES == 1) bar = xcd_barrier_post(ctl + CW_BAR, MISC + 8, tid);
    const int lo = a.ph_lo, hi = a.ph_hi;
#define IN(k) (lo <= (k) && (k) < hi)
#define SEAM(k) do { if (IN(k) && IN((k) + 1)) xcd_barrier(bar, FRESH_TID()); } while (0)

#define PH1_BODY { pg8::Gemm g{(const bf16*)(a.ws + WS_A), (const bf16*)(a.ws + WS_WIN), SEQ, NPJ, DM}; pg8::StaticOrder S; S.init(SEQ, NPJ, G, bx); \
        pg8::EpiBf16 E{(bf16*)(a.ws + WS_B), NPJ}; pg8::gemm_phase<pg8::EpiBf16, pg8::StaticOrder, true, true>(lds, g, S, E, FRESH_TID()); }
#define PH5_BODY { pg8::Gemm g{(const bf16*)a.out, (const bf16*)(a.ws + WS_WO), SEQ, DM, DM}; pg8::StaticOrder S; S.init(SEQ, DM, G, bx); \
        pg8::EpiBf16 E{(bf16*)(a.ws + WS_B), DM}; pg8::gemm_phase<pg8::EpiBf16, pg8::StaticOrder, true, true>(lds, g, S, E, FRESH_TID()); }
#define PH7_BODY { pg8::Gemm g{(const bf16*)(a.ws + WS_X1), (const bf16*)(a.ws + WS_WGU), SEQ, 2 * DFF, DM}; pg8::StaticOrder S; S.init(SEQ, 2 * DFF, G, bx); \
        pg8::EpiSwiGLU E{(bf16*)(a.ws + WS_B), DFF}; pg8::gemm_phase<pg8::EpiSwiGLU, pg8::StaticOrder, true, true>(lds, g, S, E, FRESH_TID()); }
#define PH8_BODY { pg8::Gemm g{(const bf16*)(a.ws + WS_B), (const bf16*)(a.ws + WS_WD), SEQ, DM, DFF}; pg8::StaticOrder S; S.init(SEQ, DM, G, bx); \
        pg8::EpiBf16 E{(bf16*)(a.ws + WS_FF), DM}; pg8::gemm_phase<pg8::EpiBf16, pg8::StaticOrder, true, true>(lds, g, S, E, FRESH_TID()); }
#define DUP(k) (((PROBE_DUP) >> (k)) & 1)
    if (IN(0)) { phase_p0(a, lds, tid, lane, wave, vcu, G); SEAM(0); }
    if (IN(1)) { PH1_BODY SEAM(1); }
    if (IN(2)) { phase_m1(a, lds, FRESH_TID(), wave, vcu, G); SEAM(2); }
    if (IN(4)) { phase_m3(a, lds, FRESH_TID(), wave, vcu, G); SEAM(4); }
    if (IN(5)) { PH5_BODY SEAM(5); }
    if (IN(6)) { phase_r1(a, lane, wave, vcu, G); if (DUP(6)) phase_r1(a, lane, wave, vcu, G); SEAM(6); }
    if (IN(7)) { PH7_BODY SEAM(7); }
    if (IN(8)) { PH8_BODY SEAM(8); }
    if (IN(9)) {
        bool poison = false;
        if (N_LAUNCHES == 1) poison = __hip_atomic_load(ctl + CW_BAR + XB_TMO, __ATOMIC_RELAXED, __HIP_MEMORY_SCOPE_AGENT) != 0u;
        phase_r2(a, lane, wave, vcu, G, poison);
    }
#undef PH1_BODY
#undef PH5_BODY
#undef PH7_BODY
#undef PH8_BODY
#undef DUP
#undef FRESH_TID
#undef IN
#undef SEAM
}

extern "C" void kernel_launch(void* const* d_in, const int* in_sizes, int n_in, void* d_out, int out_size, void* d_ws, size_t ws_size, hipStream_t stream) {
    static int grid = 0;
    if (grid == 0) {
        if (n_in != 17 || in_sizes[0] != SEQ * DM || out_size != SEQ * DM || ws_size < WS_END) {
            fprintf(stderr, "kernel_launch: unexpected shapes (n_in %d, in0 %d, out %d, ws %zu); nothing launched\n", n_in, n_in > 0 ? in_sizes[0] : -1, out_size, ws_size); grid = -1; return; }
        int dev = 0, cus = 0, per_cu = 0;
        if (hipGetDevice(&dev) != hipSuccess || hipDeviceGetAttribute(&cus, hipDeviceAttributeMultiprocessorCount, dev) != hipSuccess) { grid = -1; return; }
        if (hipFuncSetAttribute((const void*)fwd, hipFuncAttributeMaxDynamicSharedMemorySize, LDS_BYTES) != hipSuccess) { fprintf(stderr, "kernel_launch: hipFuncSetAttribute failed\n"); grid = -1; return; }
        if (hipOccupancyMaxActiveBlocksPerMultiprocessor(&per_cu, (const void*)fwd, NTHR, LDS_BYTES) != hipSuccess || per_cu < 1)
            fprintf(stderr, "kernel_launch: note: occupancy query reports %d workgroups per CU\n", per_cu);
        (void)hipGetLastError();
        grid = cus;
    }
    if (grid < 0) return;
    if (hipMemsetAsync((char*)d_ws + WS_CTL, 0, CTL_ZERO_BYTES, stream) != hipSuccess) return;
    Args a{};
    for (int i = 0; i < 17; ++i) a.in[i] = d_in[i];
    a.out = (float*)d_out; a.ws = (unsigned char*)d_ws;
    if (N_LAUNCHES == 1) { a.ph_lo = 0; a.ph_hi = NPHASES; a.li = 0; hipLaunchKernelGGL(fwd, dim3(grid), dim3(NTHR), LDS_BYTES, stream, a); }
    else for (int li = 0; li < NPHASES; ++li) { a.ph_lo = li; a.ph_hi = li + 1; a.li = li; hipLaunchKernelGGL(fwd, dim3(grid), dim3(NTHR), LDS_BYTES, stream, a); }
}
```

```cpp
#include <hip/hip_runtime.h>
#include <cstdio>
#include <cstdint>

#ifndef PROBE_DUP
#define PROBE_DUP 0
#endif
#ifndef MK_N_LAUNCHES
#define MK_N_LAUNCHES 1
#endif

namespace pg8 {
#define PG8_LAS __attribute__((address_space(3)))
typedef unsigned short bf16_t;
typedef short bf16x8 __attribute__((ext_vector_type(8)));
typedef float f32x4 __attribute__((ext_vector_type(4)));
typedef unsigned u32x4 __attribute__((ext_vector_type(4)));
constexpr int BM = 256, BK = 64, HALF = 128, HTB = HALF * BK * 2  , STAGE_BYTES = 8 * HTB, NXCD = 8, WGM = 4;

__host__ __device__ __forceinline__ int lds_byte(int r, int c) { const int st = (r >> 4) * 2 + (c >> 5), rr = r & 15, cc = c & 31, ob = rr * 64 + cc * 2; return st * 1024 + (ob ^ (((ob >> 9) & 1) << 5)); }
__host__ __device__ __forceinline__ void stage_rc(int b, int& R, int& C) { const int st = b / 1024, sb = b % 1024, swz = sb ^ (((sb >> 9) & 1) << 5); R = (st >> 1) * 16 + swz / 64; C = (st & 1) * 32 + (swz % 64) / 2; }
__host__ __device__ __forceinline__ int perm32(int rho) { const int n = rho >> 4, i = rho & 15; return 8 * (i >> 2) + 4 * n + (i & 3); }

struct Unit { int pm, pn; };
struct Gemm { const bf16_t* A; const bf16_t* Bt; int M, N, K; };

struct StaticOrder {
    int nM, nN, nwg, G, c;
    __host__ __device__ void init(int M, int N, int G_, int c_) { nM = M / BM; nN = N / BM; nwg = nM * nN; G = G_; c = c_; }
    __host__ __device__ bool next(int i, Unit& u) const {
        const long L = (long)i * G + c; if (L >= nwg) return false;
        int wgid = (int)L; { const int q = nwg / NXCD, r = nwg % NXCD, xcd = wgid % NXCD, off = wgid / NXCD; wgid = (xcd < r ? xcd * (q + 1) : r * (q + 1) + (xcd - r) * q) + off; }
        const int nig = WGM * nN, gid = wgid / nig, fm = gid * WGM, gsz = (nM - fm) < WGM ? (nM - fm) : WGM;
        u.pm = fm + ((wgid % nig) % gsz); u.pn = (wgid % nig) / gsz; return true;
    }
    __device__ __forceinline__ void a_ready(const Unit&) const {}
    __device__ __forceinline__ void done(const Unit&) const {}
};

typedef __bf16 bf16x2_t __attribute__((ext_vector_type(2))); typedef float f32x2_t __attribute__((ext_vector_type(2)));
__device__ __forceinline__ unsigned cvt_pk_bf16(float lo, float hi) { const f32x2_t v = {lo, hi}; return __builtin_bit_cast(unsigned, __builtin_convertvector(v, bf16x2_t)); }

struct EpiF32 {
    static constexpr bool PERM = false, AFTER_DRAIN = false;
    float* C; int ldc;
    __device__ __forceinline__ void operator()(const f32x4 (&acc)[2][2][4][2], const Unit& u, int wr, int wc, int fr, int fq) const {
        const int row0 = u.pm * BM + wr * 64 + fr, col0 = u.pn * BM + wc * 32 + 4 * fq;
#pragma unroll
        for (int ai = 0; ai < 2; ++ai)
#pragma unroll
            for (int m = 0; m < 4; ++m) { float* rowp = C + (size_t)(row0 + ai * HALF + m * 16) * ldc + col0;
#pragma unroll
                for (int bj = 0; bj < 2; ++bj)
#pragma unroll
                    for (int n = 0; n < 2; ++n) *(f32x4*)(rowp + bj * HALF + n * 16) = acc[ai][bj][m][n]; }
    }
};
struct EpiBf16 {
    static constexpr bool PERM = true, AFTER_DRAIN = false;
    bf16_t* O; int ldc;
    __device__ __forceinline__ void operator()(const f32x4 (&acc)[2][2][4][2], const Unit& u, int wr, int wc, int fr, int fq) const {
        const int row0 = u.pm * BM + wr * 64 + fr, col0 = u.pn * BM + wc * 32 + 8 * fq;
#pragma unroll
        for (int ai = 0; ai < 2; ++ai)
#pragma unroll
            for (int m = 0; m < 4; ++m) { bf16_t* rowp = O + (size_t)(row0 + ai * HALF + m * 16) * ldc + col0;
#pragma unroll
                for (int bj = 0; bj < 2; ++bj) { const f32x4 v0 = acc[ai][bj][m][0], v1 = acc[ai][bj][m][1];
                    u32x4 w; w.x = cvt_pk_bf16(v0[0], v0[1]); w.y = cvt_pk_bf16(v0[2], v0[3]); w.z = cvt_pk_bf16(v1[0], v1[1]); w.w = cvt_pk_bf16(v1[2], v1[3]);
                    *(u32x4*)(rowp + bj * HALF) = w; } }
    }
};
__device__ __forceinline__ float swiglu2(float g, float u) { return g * u * __builtin_amdgcn_rcpf(1.0f + __builtin_amdgcn_exp2f(g)); }
struct EpiSwiGLU {
    static constexpr bool PERM = true, AFTER_DRAIN = false;
    bf16_t* O; int ldc;
    __device__ __forceinline__ void operator()(const f32x4 (&acc)[2][2][4][2], const Unit& u, int wr, int wc, int fr, int fq) const {
        const int row0 = u.pm * BM + wr * 64 + fr, col0 = u.pn * HALF + wc * 32 + 8 * fq;
#pragma unroll
        for (int ai = 0; ai < 2; ++ai)
#pragma unroll
            for (int m = 0; m < 4; ++m) { bf16_t* rowp = O + (size_t)(row0 + ai * HALF + m * 16) * ldc + col0;
                const f32x4 g0 = acc[ai][0][m][0], g1 = acc[ai][0][m][1], u0 = acc[ai][1][m][0], u1 = acc[ai][1][m][1];
                u32x4 w; w.x = cvt_pk_bf16(swiglu2(g0[0], u0[0]), swiglu2(g0[1], u0[1])); w.y = cvt_pk_bf16(swiglu2(g0[2], u0[2]), swiglu2(g0[3], u0[3]));
                w.z = cvt_pk_bf16(swiglu2(g1[0], u1[0]), swiglu2(g1[1], u1[1])); w.w = cvt_pk_bf16(swiglu2(g1[2], u1[2]), swiglu2(g1[3], u1[3]));
                *(u32x4*)rowp = w; }
    }
};

template <class Epi, class Sched, bool ALIGN_EPI = false, bool SP2 = false>
__device__ __forceinline__ void gemm_phase(PG8_LAS unsigned char* lds, const Gemm g, const Sched& S, const Epi& E, const int tid) {
    const int wid = __builtin_amdgcn_readfirstlane(tid >> 6), lane = tid & 63, wr = wid >> 2, wc = wid & 3, fr = lane & 15, fq = lane >> 4;
    const int K = g.K, nt = K / BK;
    unsigned voffA[2], voffB[2];
#pragma unroll
    for (int i = 0; i < 2; ++i) { int R, C; stage_rc(tid * 16 + i * 8192, R, C); const int Rb = Epi::PERM ? ((R & ~31) + perm32(R & 31)) : R;
        voffA[i] = (unsigned)(R * K + C) * 2u; voffB[i] = (unsigned)(Rb * K + C) * 2u; }
    const size_t kstep = (size_t)(BK * 2);
    const size_t hstep = (size_t)HALF * K * 2;
    const size_t tstep = 2 * hstep;
    const unsigned ldsw = (unsigned)wid * 1024u;
    const int aoff = lds_byte(wr * 64 + fr, fq * 8), boff = lds_byte(wc * 32 + fr, fq * 8);
#define PG8_SA(b, h) (((b) * 2 + (h)) * HTB)
#define PG8_SB(b, h) ((4 + (b) * 2 + (h)) * HTB)
#define PG8_STAGE(bufoff, gbase, voff) do { _Pragma("unroll") for (int _i = 0; _i < 2; ++_i) \
        __builtin_amdgcn_global_load_lds((const unsigned*)((const char*)(gbase) + (voff)[_i]), (PG8_LAS unsigned*)(lds + (bufoff) + ldsw + _i * 8192), 16, 0, 0); } while (0)
#define PG8_LDA(dst, b, h) do { _Pragma("unroll") for (int m = 0; m < 4; ++m) _Pragma("unroll") for (int k = 0; k < 2; ++k) dst[m][k] = *(const PG8_LAS bf16x8*)(lds + PG8_SA(b, h) + aoff + m * 2048 + k * 1024); } while (0)
#define PG8_LDB(dst, b, h) do { _Pragma("unroll") for (int n = 0; n < 2; ++n) _Pragma("unroll") for (int k = 0; k < 2; ++k) dst[n][k] = *(const PG8_LAS bf16x8*)(lds + PG8_SB(b, h) + boff + n * 2048 + k * 1024); } while (0)
#define PG8_MMA(ai, bj, At, Bt) do { __builtin_amdgcn_s_setprio(1); _Pragma("unroll") for (int m = 0; m < 4; ++m) _Pragma("unroll") for (int n = 0; n < 2; ++n) _Pragma("unroll") for (int k = 0; k < 2; ++k) \
        acc[ai][bj][m][n] = __builtin_amdgcn_mfma_f32_16x16x32_bf16(Bt[n][k], At[m][k], acc[ai][bj][m][n], 0, 0, 0); __builtin_amdgcn_s_setprio(0); } while (0)
#define PG8_WAIT_V(n) asm volatile("s_waitcnt vmcnt(" #n ")" ::: "memory")
#define PG8_WAIT_L(n) asm volatile("s_waitcnt lgkmcnt(" #n ")" ::: "memory")
#define PG8_BAR __builtin_amdgcn_s_barrier()
#define PG8_SCHED __builtin_amdgcn_sched_barrier(0)
    Unit cur, nxt; int ui = 0;
    if (!S.next(0, cur)) return;
    f32x4 acc[2][2][4][2];
#pragma unroll
    for (int a = 0; a < 2; ++a)
#pragma unroll
        for (int b = 0; b < 2; ++b)
#pragma unroll
            for (int m = 0; m < 4; ++m)
#pragma unroll
                for (int n = 0; n < 2; ++n) acc[a][b][m][n] = (f32x4){0.f, 0.f, 0.f, 0.f};
    bf16x8 At[4][2], B0[2][2], B1[2][2];
    const char* cA = (const char*)g.A + (size_t)cur.pm * tstep; const char* cB = (const char*)g.Bt + (size_t)cur.pn * tstep;
    S.a_ready(cur);
    if constexpr (SP2) {
        PG8_STAGE(PG8_SB(0, 0), cB, voffB); PG8_STAGE(PG8_SB(0, 1), cB + hstep, voffB); PG8_STAGE(PG8_SA(0, 0), cA, voffA); PG8_STAGE(PG8_SA(0, 1), cA + hstep, voffA);
        if (wr == 1) PG8_BAR;
        PG8_WAIT_V(2); PG8_BAR;
        PG8_STAGE(PG8_SB(1, 0), cB + kstep, voffB); PG8_STAGE(PG8_SA(1, 0), cA + kstep, voffA); PG8_STAGE(PG8_SB(1, 1), cB + hstep + kstep, voffB);
        PG8_WAIT_V(6); PG8_BAR;
    } else {
        PG8_STAGE(PG8_SB(0, 0), cB, voffB); PG8_STAGE(PG8_SA(0, 0), cA, voffA); PG8_STAGE(PG8_SB(0, 1), cB + hstep, voffB); PG8_STAGE(PG8_SA(0, 1), cA + hstep, voffA);
        if (wr == 1) PG8_BAR;
        PG8_WAIT_V(4); PG8_BAR;
        PG8_STAGE(PG8_SB(1, 0), cB + kstep, voffB); PG8_STAGE(PG8_SA(1, 0), cA + kstep, voffA); PG8_STAGE(PG8_SB(1, 1), cB + hstep + kstep, voffB);
        PG8_WAIT_V(6); PG8_BAR;
    }
    for (;;) {
        const bool has_next = S.next(ui + 1, nxt);
        const char* nA = has_next ? (const char*)g.A + (size_t)nxt.pm * tstep : cA; const char* nB = has_next ? (const char*)g.Bt + (size_t)nxt.pn * tstep : cB;
        for (int t = 0; t < nt; t += 2) {
            const bool last = (t == nt - 2);
            const char* a1 = cA + (size_t)(t + 1) * kstep;
            const char* a2 = last ? nA : cA + (size_t)(t + 2) * kstep; const char* b2 = last ? nB : cB + (size_t)(t + 2) * kstep;
            const char* a3 = a2 + kstep; const char* b3 = b2 + kstep;
            if (last && has_next) S.a_ready(nxt);
            if constexpr (SP2) {
            PG8_LDB(B0, 0, 0); PG8_LDB(B1, 0, 1); PG8_SCHED; PG8_LDA(At, 0, 0); PG8_STAGE(PG8_SA(1, 1), a1 + hstep, voffA);
            PG8_WAIT_V(8); PG8_WAIT_L(0); PG8_BAR; PG8_MMA(0, 0, At, B0); PG8_MMA(0, 1, At, B1); PG8_BAR; PG8_SCHED;
            PG8_LDA(At, 0, 1); PG8_STAGE(PG8_SB(0, 0), b2, voffB); PG8_STAGE(PG8_SB(0, 1), b2 + hstep, voffB); PG8_STAGE(PG8_SA(0, 0), a2, voffA);
            PG8_WAIT_V(8); PG8_WAIT_L(0); PG8_BAR; PG8_MMA(1, 0, At, B0); PG8_MMA(1, 1, At, B1); PG8_BAR; PG8_SCHED;
            PG8_LDB(B0, 1, 0); PG8_LDB(B1, 1, 1); PG8_SCHED; PG8_LDA(At, 1, 0); PG8_STAGE(PG8_SA(0, 1), a2 + hstep, voffA);
            PG8_WAIT_V(8); PG8_WAIT_L(0); PG8_BAR; PG8_MMA(0, 0, At, B0); PG8_MMA(0, 1, At, B1); PG8_BAR; PG8_SCHED;
            PG8_LDA(At, 1, 1); PG8_STAGE(PG8_SB(1, 0), b3, voffB); PG8_STAGE(PG8_SB(1, 1), b3 + hstep, voffB); PG8_STAGE(PG8_SA(1, 0), a3, voffA);
            PG8_WAIT_V(8); PG8_WAIT_L(0); PG8_BAR; PG8_MMA(1, 0, At, B0); PG8_MMA(1, 1, At, B1); PG8_BAR; PG8_SCHED;
            } else {
            PG8_LDB(B0, 0, 0); PG8_SCHED; PG8_LDA(At, 0, 0); PG8_STAGE(PG8_SA(1, 1), a1 + hstep, voffA);
            PG8_WAIT_L(8); PG8_BAR; PG8_WAIT_L(0); PG8_MMA(0, 0, At, B0); PG8_BAR; PG8_SCHED;
            PG8_LDB(B1, 0, 1); PG8_STAGE(PG8_SB(0, 0), b2, voffB);
            PG8_BAR; PG8_WAIT_L(0); PG8_MMA(0, 1, At, B1); PG8_BAR;
            PG8_LDA(At, 0, 1); PG8_STAGE(PG8_SA(0, 0), a2, voffA);
            PG8_BAR; PG8_WAIT_L(0); PG8_MMA(1, 0, At, B0); PG8_BAR; PG8_SCHED;
            PG8_STAGE(PG8_SB(0, 1), b2 + hstep, voffB);
            PG8_WAIT_V(6); PG8_BAR; PG8_MMA(1, 1, At, B1); PG8_BAR;
            PG8_LDB(B0, 1, 0); PG8_SCHED; PG8_LDA(At, 1, 0); PG8_STAGE(PG8_SA(0, 1), a2 + hstep, voffA);
            PG8_WAIT_L(8); PG8_BAR; PG8_WAIT_L(0); PG8_MMA(0, 0, At, B0); PG8_BAR; PG8_SCHED;
            PG8_LDB(B1, 1, 1); PG8_STAGE(PG8_SB(1, 0), b3, voffB);
            PG8_BAR; PG8_WAIT_L(0); PG8_MMA(0, 1, At, B1); PG8_BAR;
            PG8_LDA(At, 1, 1); PG8_STAGE(PG8_SA(1, 0), a3, voffA);
            PG8_BAR; PG8_WAIT_L(0); PG8_MMA(1, 0, At, B0); PG8_BAR; PG8_SCHED;
            PG8_STAGE(PG8_SB(1, 1), b3 + hstep, voffB);
            PG8_WAIT_V(6); PG8_BAR; PG8_MMA(1, 1, At, B1); PG8_BAR;
            }
        }
        if constexpr (ALIGN_EPI) { if (wr == 0) PG8_BAR; }
        if constexpr (!Epi::AFTER_DRAIN) { E(acc, cur, wr, wc, fr, fq); S.done(cur); }
        if (!has_next) break;
#pragma unroll
        for (int a = 0; a < 2; ++a)
#pragma unroll
            for (int b = 0; b < 2; ++b)
#pragma unroll
                for (int m = 0; m < 4; ++m)
#pragma unroll
                    for (int n = 0; n < 2; ++n) acc[a][b][m][n] = (f32x4){0.f, 0.f, 0.f, 0.f};
        cur = nxt; cA = nA; cB = nB; ++ui;
        if constexpr (ALIGN_EPI) { if (wr == 1) PG8_BAR; }
    }
    PG8_WAIT_V(0);
    if constexpr (!ALIGN_EPI) { if (wr == 0) PG8_BAR; }
    PG8_BAR;
#undef PG8_SA
#undef PG8_SB
#undef PG8_STAGE
#undef PG8_LDA
#undef PG8_LDB
#undef PG8_MMA
#undef PG8_WAIT_V
#undef PG8_WAIT_L
#undef PG8_BAR
#undef PG8_SCHED
}
}

constexpr int NWAVES = 8, NTHR = 512;
constexpr int SEQ = 16384, DM = 2048, HD = 128, NHG = 8, DPROJ = 8208, NPJ = 8192, DFF = 5632, CH = 128, NCH = SEQ / CH, NHEADS = 16;
constexpr float NORM_EPS = 1e-6f;
constexpr int N_LAUNCHES = MK_N_LAUNCHES, NPHASES = 10;
constexpr int PC_MQ = 0, PC_MK = 1024, PC_MV = 2048, PC_MO = 3072, PC_RQ = 4096, PC_RK = 5120, PC_RV = 6144, PC_RG = 7168;

constexpr size_t MiB = 1u << 20;
constexpr size_t WS_CTL = 0, CTL_ZERO_BYTES = 64 * 1024;
constexpr size_t WS_WIN = 2 * MiB, WS_WO = 34 * MiB, WS_WGU = 42 * MiB, WS_WD = 86 * MiB;
constexpr size_t WS_PRE = 108 * MiB;
constexpr size_t WS_RS = 109 * MiB;
constexpr size_t WS_NLOC = 110 * MiB;
constexpr size_t WS_N0 = 110 * MiB + 512 * 1024;
constexpr size_t WS_DEC = 111 * MiB;
constexpr size_t WS_GHEAD = 111 * MiB + 65536;
constexpr size_t WS_COS = 112 * MiB, WS_SIN = 116 * MiB;
constexpr size_t WS_B = 128 * MiB;
constexpr size_t WS_A = 384 * MiB;
constexpr size_t WS_FF = WS_B + 176 * MiB;
constexpr size_t WS_X1 = 448 * MiB;
constexpr size_t WS_END = 512 * MiB;
constexpr int CW_BAR = 1024;

constexpr int RING_BYTES = 131072;
constexpr int GATE_OFF = RING_BYTES;
constexpr int N0B_OFF = GATE_OFF + 8 * 1536;
constexpr int CONVW_OFF = N0B_OFF + 256;
constexpr int NST_OFF = CONVW_OFF + 5120;
constexpr int GHL_OFF = NST_OFF + 512;
constexpr int MISC_OFF = GHL_OFF + 512;
constexpr int LDS_BYTES = 163840;
static_assert(MISC_OFF + 1024 + 5120 <= LDS_BYTES, "LDS map");

#define GAS __attribute__((address_space(1)))
#define LAS __attribute__((address_space(3)))
#define DI __device__ __forceinline__
typedef unsigned short bf16;
typedef unsigned u32x4 __attribute__((ext_vector_type(4)));
typedef unsigned u32x2 __attribute__((ext_vector_type(2)));
typedef float f32x4 __attribute__((ext_vector_type(4)));
typedef float f32x2 __attribute__((ext_vector_type(2)));
typedef LAS unsigned char* ldsp;
#define LDS_WAIT() asm volatile("s_waitcnt lgkmcnt(0)" ::: "memory")

DI unsigned f2bf(float f) { unsigned u = __builtin_bit_cast(unsigned, f); return (u + 0x7fffu + ((u >> 16) & 1u)) >> 16; }
typedef __bf16 bf16x2_t __attribute__((ext_vector_type(2)));
DI unsigned pk2(float lo, float hi) { const f32x2 v = {lo, hi}; return __builtin_bit_cast(unsigned, __builtin_convertvector(v, bf16x2_t)); }
DI float bflo(unsigned w) { return __builtin_bit_cast(float, w << 16); }
DI float bfhi(unsigned w) { return __builtin_bit_cast(float, w & 0xffff0000u); }
DI void unpack8(const u32x4 w, float (&f)[8]) { f[0] = bflo(w.x); f[1] = bfhi(w.x); f[2] = bflo(w.y); f[3] = bfhi(w.y); f[4] = bflo(w.z); f[5] = bfhi(w.z); f[6] = bflo(w.w); f[7] = bfhi(w.w); }
DI u32x4 pack8(const float (&f)[8]) { u32x4 w; w.x = pk2(f[0], f[1]); w.y = pk2(f[2], f[3]); w.z = pk2(f[4], f[5]); w.w = pk2(f[6], f[7]); return w; }
constexpr float NLOG2E = -1.4426950408889634f, NLN2 = -0.6931471805599453f;
DI float sig2(float y) { return __builtin_amdgcn_rcpf(1.0f + __builtin_amdgcn_exp2f(y)); }
DI float wave_sum(float v) {
#pragma unroll
    for (int o = 1; o < 64; o <<= 1) v += __shfl_xor(v, o);
    return v;
}

#define XB_TMO      128
#define XB_XCNT(j)  (256  + 64 * (j))
#define XB_XSUB(j)  (1280 + 64 * (j))
#define XB_XGEN(j)  (2304 + 64 * (j))
#define XB_TOP      3328
#define XB_TOPGEN   3392
#define XCD_BAR_WORDS 3456
#define XB_SPIN_CAP (1u << 18)
__device__ __forceinline__ unsigned xb_ld(unsigned* p)              { return __hip_atomic_load(p, __ATOMIC_RELAXED, __HIP_MEMORY_SCOPE_AGENT); }
__device__ __forceinline__ unsigned xb_add(unsigned* p, unsigned v) { return __hip_atomic_fetch_add(p, v, __ATOMIC_RELAXED, __HIP_MEMORY_SCOPE_AGENT); }
__device__ __forceinline__ unsigned xb_xcc_id() { return (unsigned)__builtin_amdgcn_s_getreg((3 << 11) | 20) & 0xFu; }
#define XB_SPIN(cond, bar) do { unsigned _sp = 0; while (cond) { __builtin_amdgcn_s_sleep(1); \
    if ((++_sp & 255u) == 0u) { if (xb_ld(&(bar)[XB_TMO])) break; if (_sp > XB_SPIN_CAP) { atomicAdd(&(bar)[XB_TMO], 1u); break; } } } } while (0)
struct XcdBarrier { unsigned* bar; unsigned x; volatile LAS unsigned* st; };
__device__ __forceinline__ XcdBarrier xcd_barrier_post(unsigned* bar, volatile LAS unsigned* st, int tid) {
    XcdBarrier b; b.bar = bar; b.x = xb_xcc_id(); b.st = st;
    if (tid == 0) (void)xb_add(&bar[XB_XCNT(b.x)], 1u);
    return b;
}
__device__ __forceinline__ void xcd_barrier_complete(unsigned* bar, unsigned x, unsigned& nloc, unsigned& nx) {
    const unsigned G = gridDim.x * gridDim.y * gridDim.z;
    unsigned sum, cnt, mine, sp = 0u;
    for (;;) {
        sum = 0u; cnt = 0u; mine = 0u;
#pragma unroll
        for (unsigned j = 0; j < 16; ++j) { const unsigned c = xb_ld(&bar[XB_XCNT(j)]); sum += c; cnt += (c > 0u) ? 1u : 0u; mine = (j == x) ? c : mine; }
        if (sum == G) break;
        __builtin_amdgcn_s_sleep(1);
        if ((++sp & 255u) == 0u) { if (xb_ld(&bar[XB_TMO])) break; if (sp > XB_SPIN_CAP) { atomicAdd(&bar[XB_TMO], 1u); break; } }
    }
    nloc = mine > 0u ? mine : 1u; nx = cnt > 0u ? cnt : 1u;
}
__device__ __forceinline__ void xcd_barrier(const XcdBarrier& b, int tid) {
    asm volatile("s_waitcnt vmcnt(0)" ::: "memory");
    __syncthreads();
    if (tid == 0) {
        unsigned* bar = b.bar;
        __builtin_amdgcn_s_waitcnt(0);
        unsigned nloc = b.st[0], nx = b.st[1];
        if (nloc == 0u) { xcd_barrier_complete(bar, b.x, nloc, nx); b.st[0] = nloc; b.st[1] = nx; }
        const unsigned old = xb_add(&bar[XB_XSUB(b.x)], 1u);
        const unsigned gen = old / nloc;
        if (old + 1u == (gen + 1u) * nloc) {
            __builtin_amdgcn_fence(__ATOMIC_RELEASE, "agent");
            asm volatile("s_waitcnt vmcnt(0)" ::: "memory");
            const unsigned og = xb_add(&bar[XB_TOP], 1u);
            const unsigned tg = og / nx;
            if (og + 1u == (tg + 1u) * nx) xb_add(&bar[XB_TOPGEN], 1u);
            else XB_SPIN(xb_ld(&bar[XB_TOPGEN]) == tg, bar);
            __builtin_amdgcn_fence(__ATOMIC_ACQUIRE, "agent");
            xb_add(&bar[XB_XGEN(b.x)], 1u);
            asm volatile("s_waitcnt vmcnt(0)" ::: "memory");
        } else {
            XB_SPIN(xb_ld(&bar[XB_XGEN(b.x)]) == gen, bar);
            __builtin_amdgcn_fence(__ATOMIC_ACQUIRE, "agent");
            asm volatile("s_waitcnt vmcnt(0)" ::: "memory");
        }
    }
    __syncthreads();
}

struct Args { const void* in[17]; float* out; unsigned char* ws; int ph_lo, ph_hi, li, pad; };
enum { IN_X = 0, IN_POS, IN_GPRE, IN_WIN, IN_CW, IN_CB, IN_BI, IN_BF, IN_GMH, IN_GRH, IN_WOUT, IN_GPOST, IN_GFPRE, IN_WG, IN_WU, IN_WDN, IN_GFPOST };

struct TrItem { const float* W; bf16* WT; const float* gk; float sc; int K, ldw, src_col, dst_row, kb; };
DI void p0_tr_load(const TrItem& it, int lane, f32x4 (&v)[8]) {
    const float* src = it.W + (size_t)(64 * it.kb + (lane >> 3)) * it.ldw + it.src_col + 4 * (lane & 7);
#pragma unroll
    for (int i = 0; i < 8; ++i) v[i] = *(const GAS f32x4*)(src + (size_t)(8 * i) * it.ldw);
    if (it.gk) {
#pragma unroll
        for (int i = 0; i < 8; ++i) v[i] = v[i] * it.gk[64 * it.kb + (lane >> 3) + 8 * i]; }
    if (it.sc != 1.0f) {
#pragma unroll
        for (int i = 0; i < 8; ++i) v[i] = v[i] * it.sc; }
}
DI void p0_tr_store(const TrItem& it, int lane, const f32x4 (&v)[8], LAS float* scr) {
#pragma unroll
    for (int i = 0; i < 8; ++i) *(LAS f32x4*)(scr + (8 * i + (lane >> 3)) * 36 + 4 * (lane & 7)) = v[i];
    LDS_WAIT(); asm volatile("" ::: "memory");
    const int c = lane & 7;
#pragma unroll
    for (int j = 0; j < 4; ++j) { const int n = (lane >> 3) + 8 * j; const LAS float* sp = scr + (8 * c) * 36 + n;
        u32x4 o; o.x = pk2(sp[0 * 36], sp[1 * 36]); o.y = pk2(sp[2 * 36], sp[3 * 36]); o.z = pk2(sp[4 * 36], sp[5 * 36]); o.w = pk2(sp[6 * 36], sp[7 * 36]);
        *(GAS u32x4*)(it.WT + (size_t)(it.dst_row + n) * it.K + 64 * it.kb + 8 * c) = o; }
    LDS_WAIT(); asm volatile("" ::: "memory");
}
constexpr int I_IN = 32 * 256, I_O = 32 * 64, I_G = 32 * 176, I_D = 88 * 64;
DI TrItem tr_item(const Args& a, int set, int r) {
    TrItem it; it.gk = nullptr; it.sc = 1.0f;
    if (set == 0) { const int kb = r / 256, nb = r % 256; it.W = (const float*)a.in[IN_WIN]; it.WT = (bf16*)(a.ws + WS_WIN); it.K = DM; it.ldw = DPROJ; it.src_col = nb < 128 ? 32 * nb : 4112 + 32 * (nb - 128); it.dst_row = 32 * nb; it.kb = kb; if ((nb & 127) >= 96) it.sc = NLOG2E; return it; }
    if (r < I_O) { const int kb = r / 64, nb = r % 64; it.W = (const float*)a.in[IN_WOUT]; it.WT = (bf16*)(a.ws + WS_WO); it.K = DM; it.ldw = DM; it.src_col = 32 * nb; it.dst_row = 32 * nb; it.kb = kb; return it; } r -= I_O;
    if (r < I_G) { const int kb = r / 176, nb = r % 176; it.W = (const float*)a.in[IN_WG]; it.gk = (const float*)a.in[IN_GFPRE]; it.WT = (bf16*)(a.ws + WS_WGU); it.K = DM; it.ldw = DFF; it.src_col = 32 * nb; it.dst_row = 256 * (nb >> 2) + 32 * (nb & 3); it.kb = kb; it.sc = NLOG2E; return it; } r -= I_G;
    if (r < I_G) { const int kb = r / 176, nb = r % 176; it.W = (const float*)a.in[IN_WU]; it.gk = (const float*)a.in[IN_GFPRE]; it.WT = (bf16*)(a.ws + WS_WGU); it.K = DM; it.ldw = DFF; it.src_col = 32 * nb; it.dst_row = 256 * (nb >> 2) + 128 + 32 * (nb & 3); it.kb = kb; it.sc = NLN2; return it; } r -= I_G;
    { const int kb = r / 64, nb = r % 64; it.W = (const float*)a.in[IN_WDN]; it.WT = (bf16*)(a.ws + WS_WD); it.K = DFF; it.ldw = DM; it.src_col = 32 * nb; it.dst_row = 32 * nb; it.kb = kb; return it; }
}
DI void convert_weights(const Args& a, ldsp lds, int set, int lane, int wave, int vcu, int G) {
    const int gw = vcu * NWAVES + wave, NGW = G * NWAVES, nitems = set == 0 ? I_IN : I_O + 2 * I_G + I_D;
    LAS float* scr = (LAS float*)(lds + wave * 16384);
    f32x4 va[8], vb[8];
    int it = gw; if (it < nitems) p0_tr_load(tr_item(a, set, it), lane, va);
    for (; it < nitems; it += 2 * NGW) {
        if (it + NGW < nitems) p0_tr_load(tr_item(a, set, it + NGW), lane, vb);
        p0_tr_store(tr_item(a, set, it), lane, va, scr);
        if (it + 2 * NGW < nitems) p0_tr_load(tr_item(a, set, it + 2 * NGW), lane, va);
        if (it + NGW < nitems) p0_tr_store(tr_item(a, set, it + NGW), lane, vb, scr);
    }
}
DI void phase_p0(const Args& a, ldsp lds, int tid, int lane, int wave, int vcu, int G) {
    const int gw = vcu * NWAVES + wave, NGW = G * NWAVES;
    const float* x = (const float*)a.in[IN_X]; const float* gpre = (const float*)a.in[IN_GPRE]; const float* w_in = (const float*)a.in[IN_WIN];
    bf16* hb = (bf16*)(a.ws + WS_A); float* PRE = (float*)(a.ws + WS_PRE);
    LAS unsigned short* Wf = (LAS unsigned short*)lds;
#pragma unroll 4
    for (int i = 0; i < 16; ++i) { const int idx = tid + NTHR * i, k = idx >> 2, c4 = idx & 3;
        const f32x4 w = *(const GAS f32x4*)(w_in + (size_t)k * DPROJ + 4096 + 4 * c4);
        LAS unsigned short* d = Wf + ((k >> 5) * 64 + ((k >> 3) & 3) * 16 + 4 * c4) * 8 + (k & 7);
        d[0] = (unsigned short)f2bf(w.x); d[8] = (unsigned short)f2bf(w.y); d[16] = (unsigned short)f2bf(w.z); d[24] = (unsigned short)f2bf(w.w); }
    LDS_WAIT(); __syncthreads();
    LAS float* part = (LAS float*)(lds + 65536);
    for (int rb = vcu; rb < SEQ / 64; rb += G) {
        {
            f32x4 ggv[8]; { const GAS f32x4* gr = (const GAS f32x4*)gpre + lane;
#pragma unroll
              for (int j = 0; j < 8; ++j) ggv[j] = gr[64 * j]; }
#define P0_LOAD(buf, mm) do { const GAS f32x4* xr_ = (const GAS f32x4*)(x + (size_t)(mm) * DM) + lane; _Pragma("unroll") for (int j = 0; j < 8; ++j) buf[j] = xr_[64 * j]; } while (0)
#define P0_ROW(buf, mm) do { float s_ = 0.f; _Pragma("unroll") for (int j = 0; j < 8; ++j) s_ += (buf[j].x * buf[j].x + buf[j].y * buf[j].y) + (buf[j].z * buf[j].z + buf[j].w * buf[j].w); \
            const float r_ = 1.0f / sqrtf(wave_sum(s_) * (1.0f / DM) + NORM_EPS); GAS u32x2* o_ = (GAS u32x2*)(hb + (size_t)(mm) * DM) + lane; \
            _Pragma("unroll") for (int j = 0; j < 8; ++j) { const f32x4 gg = ggv[j]; u32x2 w; w.x = pk2(buf[j].x * r_ * gg.x, buf[j].y * r_ * gg.y); w.y = pk2(buf[j].z * r_ * gg.z, buf[j].w * r_ * gg.w); o_[64 * j] = w; } } while (0)
            f32x4 va[8], vb[8];
            const int m0 = rb * 64 + wave * 8;
            P0_LOAD(va, m0);
#pragma unroll 1
            for (int i = 0; i < 8; i += 2) {
                P0_LOAD(vb, m0 + i + 1);
                P0_ROW(va, m0 + i);
                if (i + 2 < 8) P0_LOAD(va, m0 + i + 2);
                P0_ROW(vb, m0 + i + 1);
            }
#undef P0_LOAD
#undef P0_ROW
        }
        asm volatile("s_waitcnt vmcnt(0)" ::: "memory"); __syncthreads();
        {
            const int tile = wave & 3, kh = wave >> 2, row = lane & 15, kq = lane >> 4, t0 = rb * 64 + tile * 16;
            const GAS u32x4* hr = (const GAS u32x4*)(hb + (size_t)(t0 + row) * DM + kh * 1024 + 8 * kq);
            const LAS u32x4* wf = (const LAS u32x4*)lds + (kh * 32) * 64 + lane;
            pg8::f32x4 acc = {0.f, 0.f, 0.f, 0.f};
            for (int sp = 0; sp < 32; sp += 8) { u32x4 hv[8];
#pragma unroll
                for (int j = 0; j < 8; ++j) hv[j] = hr[4 * (sp + j)];
#pragma unroll
                for (int j = 0; j < 8; ++j) acc = __builtin_amdgcn_mfma_f32_16x16x32_bf16(__builtin_bit_cast(pg8::bf16x8, hv[j]), __builtin_bit_cast(pg8::bf16x8, wf[(sp + j) * 64]), acc, 0, 0, 0);
            }
            if (kh == 1) {
#pragma unroll
                for (int j = 0; j < 4; ++j) part[(tile * 4 + j) * 64 + lane] = acc[j]; }
            LDS_WAIT(); __syncthreads();
            if (kh == 0) {
#pragma unroll
                for (int j = 0; j < 4; ++j) PRE[(size_t)(t0 + 4 * kq + j) * 16 + row] = acc[j] + part[(tile * 4 + j) * 64 + lane]; }
            __syncthreads();
        }
    }
    __syncthreads();
    convert_weights(a, lds, 0, lane, wave, vcu, G);
    convert_weights(a, lds, 1, lane, wave, vcu, G);
    { float* GH = (float*)(a.ws + WS_GHEAD); const float* gmh = (const float*)a.in[IN_GMH]; const float* grh = (const float*)a.in[IN_GRH];
      for (int i = vcu * NTHR + tid; i < 1024; i += G * NTHR) GH[i] = gmh[i];
      for (int i = vcu * NTHR + tid; i < 1024; i += G * NTHR) GH[1024 + i] = grh[i]; }
    const int* pos = (const int*)a.in[IN_POS]; float* COS = (float*)(a.ws + WS_COS); float* SIN = (float*)(a.ws + WS_SIN);
    { LAS float* invf = (LAS float*)(lds + GATE_OFF);
      if (tid < 64) invf[tid] = (float)pow(10000.0, -(double)(2 * tid) / 128.0);
      LDS_WAIT(); __syncthreads();
      for (int i = vcu * NTHR + tid; i < SEQ * 64; i += G * NTHR) { const int t = i >> 6, j = i & 63;
          const float ang = (float)pos[t] * invf[j];
          double rev = (double)ang * 0.15915494309189533577; rev -= __builtin_rint(rev); const float fr = (float)rev;
          COS[i] = __builtin_amdgcn_cosf(fr); SIN[i] = __builtin_amdgcn_sinf(fr); } }
}

typedef short bf16x8 __attribute__((ext_vector_type(8)));
typedef short s16x4 __attribute__((ext_vector_type(4)));
typedef float f32x16 __attribute__((ext_vector_type(16)));
#define MFMA32(a, b, c) __builtin_amdgcn_mfma_f32_32x32x16_bf16((a), (b), (c), 0, 0, 0)
DI int crow(int reg, int h) { return (reg & 3) + 8 * (reg >> 2) + 4 * h; }
DI bf16x8 bf_ones() { return (bf16x8){16256, 16256, 16256, 16256, 16256, 16256, 16256, 16256}; }
DI int offb(int row, int ch) { return 256 * row + 16 * (ch ^ (((row & 3) << 2) | ((row >> 2) & 3))); }
DI int rowbase(int row, int h) { return offb(row, h); }
DI bf16x8 rowfrag(ldsp tile, int rb, int ks) { return *(const LAS bf16x8*)(tile + (rb ^ (ks << 5))); }
DI s16x4 tr_rd(ldsp p) { return __builtin_bit_cast(s16x4, __builtin_amdgcn_ds_read_tr16_b64_v4i16((LAS s16x4*)p)); }
struct TrB { int b0, b1; };
DI TrB trbase(int c, int lane) {
    const int h = lane >> 5, blk = (lane >> 4) & 1, q = (lane & 15) >> 2, p = lane & 3, ch = 4 * c + 2 * blk + (p >> 1);
    TrB b; b.b0 = offb(8 * h + q, ch) + 8 * (p & 1); b.b1 = offb(8 * h + 4 + q, ch) + 8 * (p & 1); return b;
}
DI bf16x8 trfrag(ldsp tile, const TrB b, int ks) {
    const s16x4 lo = tr_rd(tile + b.b0 + 4096 * ks), hi = tr_rd(tile + b.b1 + 4096 * ks);
    return __builtin_shufflevector(lo, hi, 0, 1, 2, 3, 4, 5, 6, 7);
}
DI void gload8(const bf16* p, float (&f)[8]) { unpack8(*(const GAS u32x4*)p, f); }

constexpr int NGROUPS = 256, GM = 18, GR = 14;
struct Grp { int g, grp, c0, nch, base; };
DI Grp grp_of(int cg) { Grp r;
    if (cg < NHG * GM) { r.g = cg / GM; r.grp = cg % GM; r.base = r.g * GM; r.c0 = r.grp < 2 ? 8 * r.grp : 16 + 7 * (r.grp - 2); r.nch = r.grp < 2 ? 8 : 7; }
    else { const int q = cg - NHG * GM; r.g = NHG + q / GR; r.grp = q % GR; r.base = NHG * GM + (r.g - NHG) * GR; r.c0 = r.grp < 2 ? 10 * r.grp : 20 + 9 * (r.grp - 2); r.nch = r.grp < 2 ? 10 : 9; }
    return r; }
constexpr float KSCALE = 0.08838834764831845f;
DI void mixer_setup(const Args& a, ldsp lds, int g, int c0, int nch, int tid, int lane, int wave) {
    if (g < NHG) {
      if (wave < nch) {
        LAS float* rowv = (LAS float*)(lds + GATE_OFF + wave * 1536); LAS float* colv = rowv + 128; LAS float* alog = rowv + 256;
        const float* PRE = (const float*)(a.ws + WS_PRE); const float bi = ((const float*)a.in[IN_BI])[g], bfg = ((const float*)a.in[IN_BF])[g];
        const int t0 = (c0 + wave) * CH + 2 * lane;
        const float i0 = PRE[(size_t)t0 * 16 + g] + bi, i1 = PRE[(size_t)(t0 + 1) * 16 + g] + bi;
        const float f0 = PRE[(size_t)t0 * 16 + 8 + g] + bfg, f1 = PRE[(size_t)(t0 + 1) * 16 + 8 + g] + bfg;
        const float l0 = fminf(f0, 0.f) - log1pf(__expf(-fabsf(f0))), l1 = fminf(f1, 0.f) - log1pf(__expf(-fabsf(f1)));
        float p = l0 + l1;
#pragma unroll
        for (int o = 1; o < 64; o <<= 1) { const float y = __shfl_up(p, o); if (lane >= o) p += y; }
        const float b1 = p, b0 = p - l1, rv127 = __shfl(b1, 63);
        rowv[2 * lane] = __expf(b0 - rv127); rowv[2 * lane + 1] = __expf(b1 - rv127); alog[2 * lane] = __expf(b0); alog[2 * lane + 1] = __expf(b1);
        colv[2 * lane] = (NLN2 * KSCALE) * __expf(rv127 + (i0 - b0)); colv[2 * lane + 1] = (NLN2 * KSCALE) * __expf(rv127 + (i1 - b1));
      }
        if (tid < 128) { LAS float* cwl = (LAS float*)(lds + CONVW_OFF); const float* cw = (const float*)a.in[IN_CW]; const float* cb = (const float*)a.in[IN_CB];
#pragma unroll
            for (int j = 0; j < 4; ++j) { cwl[j * 128 + tid] = NLOG2E * cw[j * 2048 + g * HD + tid]; cwl[640 + j * 128 + tid] = NLOG2E * cw[j * 2048 + 1024 + g * HD + tid]; }
            cwl[512 + tid] = NLOG2E * cb[g * HD + tid]; cwl[640 + 512 + tid] = NLOG2E * cb[1024 + g * HD + tid]; }
    } else if (tid < 128) {
        LAS float* rowv = (LAS float*)(lds + GATE_OFF); LAS float* colv = rowv + 128; LAS float* alog = rowv + 256;
        const float lg = log1pf(-exp2f(-5.0f - (float)(g - NHG)));
        rowv[tid] = __expf((float)tid * lg - 127.0f * lg); colv[tid] = KSCALE * __expf(127.0f * lg + (-(float)tid * lg)); alog[tid] = __expf((float)(tid + 1) * lg);
    }
    if (tid >= 128 && tid < 256) { const int e = tid - 128; ((LAS float*)(lds + GHL_OFF))[e] = ((const float*)(a.ws + WS_GHEAD))[g * HD + e] * (g < NHG ? 1.0f : NLN2); }
    LDS_WAIT(); __syncthreads();
}
struct KvRegs { u32x4 x[16]; };
DI void kv_load(const Args& a, int g, int c, int tid, KvRegs& R) {
    const bf16* proj = (const bf16*)(a.ws + WS_B);
    const int sq = tid >> 4, dg = tid & 15, tb = c * CH + 4 * sq;
    if (g < NHG) {
        const bf16* pk = proj + PC_MK + g * HD + 8 * dg; const bf16* pv = proj + PC_MV + g * HD + 8 * dg;
#pragma unroll
        for (int j = 0; j < 7; ++j) { const int tt = tb - 3 + j, tc = tt < 0 ? 0 : tt; R.x[j] = *(const GAS u32x4*)(pk + (size_t)tc * NPJ); if (tt < 0) R.x[j] = (u32x4){0u, 0u, 0u, 0u}; }
#pragma unroll
        for (int i = 0; i < 4; ++i) R.x[12 + i] = *(const GAS u32x4*)(pv + (size_t)(tb + i) * NPJ);
    } else {
        const int gr = g - NHG; const float* COS = (const float*)(a.ws + WS_COS); const float* SIN = (const float*)(a.ws + WS_SIN);
        const int s2 = tid >> 3, dgp = tid & 7; const bf16* pv = proj + PC_RV + gr * HD + 8 * dg;
#pragma unroll
        for (int i = 0; i < 2; ++i) { const size_t t = (size_t)(c * CH + 2 * s2 + i); const bf16* pr = proj + t * NPJ + gr * HD + 8 * dgp;
            R.x[i] = *(const GAS u32x4*)(pr + PC_RK); R.x[2 + i] = *(const GAS u32x4*)(pr + PC_RK + 64);
            R.x[4 + 4 * i] = *(const GAS u32x4*)(COS + t * 64 + 8 * dgp); R.x[5 + 4 * i] = *(const GAS u32x4*)(COS + t * 64 + 8 * dgp + 4);
            R.x[6 + 4 * i] = *(const GAS u32x4*)(SIN + t * 64 + 8 * dgp); R.x[7 + 4 * i] = *(const GAS u32x4*)(SIN + t * 64 + 8 * dgp + 4); }
#pragma unroll
        for (int i = 0; i < 4; ++i) R.x[12 + i] = *(const GAS u32x4*)(pv + (size_t)(tb + i) * NPJ);
    }
}
DI void kv_build(ldsp lds, int g, const LAS float* gt, int tid, const KvRegs& R) {
    const LAS float* sck = gt + 128;
    ldsp K = lds + 32768, V = lds + 65536;
    const int sq = tid >> 4, dg = tid & 15;
    if (g < NHG) {
        const LAS float* wl = (const LAS float*)(lds + CONVW_OFF) + 640 + 8 * dg;
#pragma unroll
        for (int i = 0; i < 4; ++i) { float acc[8];
            { const f32x4 w0 = *(const LAS f32x4*)(wl + 512), w1 = *(const LAS f32x4*)(wl + 516); acc[0] = w0.x; acc[1] = w0.y; acc[2] = w0.z; acc[3] = w0.w; acc[4] = w1.x; acc[5] = w1.y; acc[6] = w1.z; acc[7] = w1.w; }
#pragma unroll
            for (int j = 0; j < 4; ++j) { float uu[8]; unpack8(R.x[i + j], uu);
                const f32x4 w0 = *(const LAS f32x4*)(wl + j * 128), w1 = *(const LAS f32x4*)(wl + j * 128 + 4);
                acc[0] = __builtin_fmaf(w0.x, uu[0], acc[0]); acc[1] = __builtin_fmaf(w0.y, uu[1], acc[1]); acc[2] = __builtin_fmaf(w0.z, uu[2], acc[2]); acc[3] = __builtin_fmaf(w0.w, uu[3], acc[3]); acc[4] = __builtin_fmaf(w1.x, uu[4], acc[4]); acc[5] = __builtin_fmaf(w1.y, uu[5], acc[5]); acc[6] = __builtin_fmaf(w1.z, uu[6], acc[6]); acc[7] = __builtin_fmaf(w1.w, uu[7], acc[7]); }
            const int srow = 4 * sq + i; const float sc = sck[srow];
#pragma unroll
            for (int e = 0; e < 8; ++e) acc[e] = acc[e] * sig2(acc[e]) * sc;
            *(LAS u32x4*)(K + offb(srow, dg)) = pack8(acc); }
    } else {
        const int s2 = tid >> 3, dgp = tid & 7;
#pragma unroll
        for (int i = 0; i < 2; ++i) { const int srow = 2 * s2 + i;
            const f32x4 cA = __builtin_bit_cast(f32x4, R.x[4 + 4 * i]), cB = __builtin_bit_cast(f32x4, R.x[5 + 4 * i]), sA = __builtin_bit_cast(f32x4, R.x[6 + 4 * i]), sB = __builtin_bit_cast(f32x4, R.x[7 + 4 * i]);
            const float c8[8] = {cA.x, cA.y, cA.z, cA.w, cB.x, cB.y, cB.z, cB.w};
            const float s8[8] = {sA.x, sA.y, sA.z, sA.w, sB.x, sB.y, sB.z, sB.w};
            float lo[8], hi[8], olo[8], ohi[8]; unpack8(R.x[i], lo); unpack8(R.x[2 + i], hi);
            const float sc = sck[srow];
#pragma unroll
            for (int e = 0; e < 8; ++e) { olo[e] = __builtin_fmaf(lo[e], c8[e], -hi[e] * s8[e]) * sc; ohi[e] = __builtin_fmaf(hi[e], c8[e], lo[e] * s8[e]) * sc; }
            *(LAS u32x4*)(K + offb(srow, dgp)) = pack8(olo); *(LAS u32x4*)(K + offb(srow, 8 + dgp)) = pack8(ohi); }
    }
#pragma unroll
    for (int i = 0; i < 4; ++i) *(LAS u32x4*)(V + offb(4 * sq + i, dg)) = R.x[12 + i];
    LDS_WAIT(); __syncthreads();
}
DI void phase_m1(const Args& a, ldsp lds, int tid_in, int wave, int vcu, int G) {
    float* UG = (float*)(a.ws + WS_A); float* NG = (float*)(a.ws + WS_NLOC); float* DG = (float*)(a.ws + WS_DEC);
    ldsp K = lds + 32768, V = lds + 65536; const int wi = wave >> 1, wj = wave & 1;
    for (int cg = vcu; cg < NGROUPS; cg += G) { const Grp gi = grp_of(cg); const int g = gi.g; const bool ml = g < NHG;
        KvRegs R; kv_load(a, g, gi.c0, tid_in, R);
        { int tid_g = tid_in; asm volatile("" : "+v"(tid_g)); mixer_setup(a, lds, g, gi.c0, gi.nch, tid_g, tid_g & 63, wave); }
        f32x16 accU[2], accN; float dprod = 1.0f;
#pragma unroll
        for (int i = 0; i < 16; ++i) { accU[0][i] = 0.f; accU[1][i] = 0.f; accN[i] = 0.f; }
        for (int ci = 0; ci < gi.nch; ++ci) { const int c = gi.c0 + ci;
            int tid_o = tid_in; asm volatile("" : "+v"(tid_o));
            const int tid = tid_o, lane = tid & 63;
            const LAS float* gt = (const LAS float*)(lds + GATE_OFF + (ml ? ci : 0) * 1536);
            kv_build(lds, g, gt, tid, R);
            kv_load(a, g, ci + 1 < gi.nch ? c + 1 : c, tid, R);
            const float dec = gt[256 + 127]; dprod *= dec;
            accU[0] = accU[0] * dec; accU[1] = accU[1] * dec; accN = accN * dec;
            { const TrB tk = trbase(wi, lane), tv0 = trbase(2 * wj, lane), tv1 = trbase(2 * wj + 1, lane);
              if (ml && wj == 0) {
#pragma unroll
                  for (int ks = 0; ks < 8; ++ks) { const bf16x8 af = trfrag(K, tk, ks), b0 = trfrag(V, tv0, ks), b1 = trfrag(V, tv1, ks);
                      accU[0] = MFMA32(af, b0, accU[0]); accU[1] = MFMA32(af, b1, accU[1]); accN = MFMA32(af, bf_ones(), accN); }
              } else {
#pragma unroll
                  for (int ks = 0; ks < 8; ++ks) { const bf16x8 af = trfrag(K, tk, ks), b0 = trfrag(V, tv0, ks), b1 = trfrag(V, tv1, ks);
                      accU[0] = MFMA32(af, b0, accU[0]); accU[1] = MFMA32(af, b1, accU[1]); }
              }
            }
            __syncthreads();
        }
        { int tid_o = tid_in; asm volatile("" : "+v"(tid_o)); const int lane = tid_o & 63, r = lane & 31, h = lane >> 5;
          float* o = UG + ((size_t)cg << 14) + wave * 2048 + lane;
#pragma unroll
          for (int n = 0; n < 2; ++n)
#pragma unroll
              for (int i = 0; i < 16; ++i) o[(n * 16 + i) * 64] = accU[n][i];
          if (ml && wj == 0 && r == 0) {
#pragma unroll
              for (int i = 0; i < 16; ++i) NG[(size_t)cg * HD + 32 * wi + crow(i, h)] = accN[i]; }
          if (tid_in == 0) DG[cg] = dprod; }
    }
}
constexpr int HALO_OFF = MISC_OFF + 1024;
static_assert(HALO_OFF + 3072 <= LDS_BYTES, "LDS map");
DI void m3_stage(const Args& a, ldsp lds, int g, int c, int lane, int wave) {
    const bf16* proj = (const bf16*)(a.ws + WS_B);
    const int colq = g < NHG ? PC_MQ + g * HD : PC_RQ + (g - NHG) * HD, colk = g < NHG ? PC_MK + g * HD : PC_RK + (g - NHG) * HD;
    const bf16* base = proj + (size_t)(c * CH + (lane >> 4)) * NPJ + 8 * (lane & 15) + (wave >= 4 ? colk : colq);
#pragma unroll
    for (int k = 0; k < 8; ++k) { const int p = wave * 8 + k;
        __builtin_amdgcn_global_load_lds((const unsigned*)(base + (size_t)(4 * (p & 31)) * NPJ), (LAS unsigned*)(lds + 65536 + p * 1024), 16, 0, 0); }
}
DI void m3_build_qk(const Args& a, ldsp lds, int g, int c, int par, const LAS float* gt, int tid, u32x4 (&vv)[4]) {
    const bf16* proj = (const bf16*)(a.ws + WS_B);
    const LAS float* sck = gt + 128;
    ldsp Q = lds, K = lds + 32768, SQ = lds + 65536, SK = lds + 98304, HAL = lds + HALO_OFF;
    const int sq = tid >> 4, dg = tid & 15, tb = c * CH + 4 * sq;
    if (g < NHG) {
        const bf16* pv = proj + PC_MV + g * HD + 8 * dg;
#pragma unroll
        for (int i = 0; i < 4; ++i) vv[i] = *(const GAS u32x4*)(pv + (size_t)(tb + i) * NPJ);
        const LAS float* cwl = (const LAS float*)(lds + CONVW_OFF);
#pragma unroll
        for (int qk = 0; qk < 2; ++qk) {
            ldsp S = qk == 0 ? SK : SQ; ldsp H = HAL + par * 1536 + (qk == 0 ? 768 : 0);
            u32x4 rr[7];
#pragma unroll
            for (int j = 0; j < 7; ++j) { const int row = 4 * sq - 3 + j;
                if (j < 3) rr[j] = row >= 0 ? *(const LAS u32x4*)(S + row * 256 + 16 * dg) : *(const LAS u32x4*)(H + (row + 3) * 256 + 16 * dg);
                else rr[j] = *(const LAS u32x4*)(S + row * 256 + 16 * dg); }
            if (sq == 31) { ldsp Hn = HAL + (par ^ 1) * 1536 + (qk == 0 ? 768 : 0);
#pragma unroll
                for (int j = 0; j < 3; ++j) *(LAS u32x4*)(Hn + j * 256 + 16 * dg) = rr[4 + j]; }
            const LAS float* wl = cwl + (qk == 0 ? 640 : 0) + 8 * dg;
            float w[5][8];
#pragma unroll
            for (int j = 0; j < 5; ++j) { const f32x4 w0 = *(const LAS f32x4*)(wl + j * 128), w1 = *(const LAS f32x4*)(wl + j * 128 + 4); w[j][0] = w0.x; w[j][1] = w0.y; w[j][2] = w0.z; w[j][3] = w0.w; w[j][4] = w1.x; w[j][5] = w1.y; w[j][6] = w1.z; w[j][7] = w1.w; }
#pragma unroll
            for (int i = 0; i < 4; ++i) { float acc[8];
#pragma unroll
                for (int e = 0; e < 8; ++e) acc[e] = w[4][e];
#pragma unroll
                for (int j = 0; j < 4; ++j) { float uu[8]; unpack8(rr[i + j], uu);
#pragma unroll
                    for (int e = 0; e < 8; ++e) acc[e] = __builtin_fmaf(w[j][e], uu[e], acc[e]); }
                const int srow = 4 * sq + i; const float sc = qk == 0 ? sck[srow] : NLN2;
#pragma unroll
                for (int e = 0; e < 8; ++e) acc[e] = acc[e] * sig2(acc[e]) * sc;
                *(LAS u32x4*)((qk == 0 ? K : Q) + offb(srow, dg)) = pack8(acc); }
        }
    } else {
        const int gr = g - NHG; const float* COS = (const float*)(a.ws + WS_COS); const float* SIN = (const float*)(a.ws + WS_SIN);
        const int s2 = tid >> 3, dgp = tid & 7; const bf16* pv = proj + PC_RV + gr * HD + 8 * dg;
        f32x4 cs[2][2], sn[2][2];
#pragma unroll
        for (int i = 0; i < 2; ++i) { const size_t t = (size_t)(c * CH + 2 * s2 + i);
            cs[i][0] = *(const GAS f32x4*)(COS + t * 64 + 8 * dgp); cs[i][1] = *(const GAS f32x4*)(COS + t * 64 + 8 * dgp + 4);
            sn[i][0] = *(const GAS f32x4*)(SIN + t * 64 + 8 * dgp); sn[i][1] = *(const GAS f32x4*)(SIN + t * 64 + 8 * dgp + 4); }
#pragma unroll
        for (int i = 0; i < 4; ++i) vv[i] = *(const GAS u32x4*)(pv + (size_t)(tb + i) * NPJ);
#pragma unroll
        for (int i = 0; i < 2; ++i) { const int srow = 2 * s2 + i;
            const float c8[8] = {cs[i][0].x, cs[i][0].y, cs[i][0].z, cs[i][0].w, cs[i][1].x, cs[i][1].y, cs[i][1].z, cs[i][1].w};
            const float s8[8] = {sn[i][0].x, sn[i][0].y, sn[i][0].z, sn[i][0].w, sn[i][1].x, sn[i][1].y, sn[i][1].z, sn[i][1].w};
            float lo[8], hi[8], olo[8], ohi[8];
            unpack8(*(const LAS u32x4*)(SK + srow * 256 + 16 * dgp), lo); unpack8(*(const LAS u32x4*)(SK + srow * 256 + 128 + 16 * dgp), hi);
            const float sc = sck[srow];
#pragma unroll
            for (int e = 0; e < 8; ++e) { olo[e] = __builtin_fmaf(lo[e], c8[e], -hi[e] * s8[e]) * sc; ohi[e] = __builtin_fmaf(hi[e], c8[e], lo[e] * s8[e]) * sc; }
            *(LAS u32x4*)(K + offb(srow, dgp)) = pack8(olo); *(LAS u32x4*)(K + offb(srow, 8 + dgp)) = pack8(ohi);
            unpack8(*(const LAS u32x4*)(SQ + srow * 256 + 16 * dgp), lo); unpack8(*(const LAS u32x4*)(SQ + srow * 256 + 128 + 16 * dgp), hi);
#pragma unroll
            for (int e = 0; e < 8; ++e) { olo[e] = __builtin_fmaf(lo[e], c8[e], -hi[e] * s8[e]); ohi[e] = __builtin_fmaf(hi[e], c8[e], lo[e] * s8[e]); }
            *(LAS u32x4*)(Q + offb(srow, dgp)) = pack8(olo); *(LAS u32x4*)(Q + offb(srow, 8 + dgp)) = pack8(ohi); }
    }
}
#define RAW_BARRIER() do { asm volatile("s_waitcnt lgkmcnt(0)" ::: "memory"); __builtin_amdgcn_s_barrier(); asm volatile("" ::: "memory"); } while (0)
DI void phase_m3(const Args& a, ldsp lds, int tid_in, int wave, int vcu, int G) {
    const bf16* proj = (const bf16*)(a.ws + WS_B); const float* UG = (const float*)(a.ws + WS_A); const float* NG = (const float*)(a.ws + WS_NLOC); const float* DG = (const float*)(a.ws + WS_DEC);
    bf16* mixb = (bf16*)a.out;
    LAS unsigned short* n0b = (LAS unsigned short*)(lds + N0B_OFF);
    ldsp Q = lds, K = lds + 32768, V = lds + 65536, C0 = lds + 98304, P = lds + 98304; LAS float* H = (LAS float*)lds;
    const int wi = wave >> 1, wj = wave & 1;
    for (int cg = vcu; cg < NGROUPS; cg += G) { const Grp gi = grp_of(cg); const int g = gi.g, grp = gi.grp; const bool ml = g < NHG;
        { int tid_s = tid_in; asm volatile("" : "+v"(tid_s));
          m3_stage(a, lds, g, gi.c0, tid_s & 63, wave);
          if (tid_s < 96) { const int which = tid_s / 48, j = (tid_s % 48) >> 4, dgh = tid_s & 15; const int t = gi.c0 * CH - 3 + j;
              u32x4 hv = {0u, 0u, 0u, 0u};
              if (ml && t >= 0) hv = *(const GAS u32x4*)(proj + (size_t)t * NPJ + (which ? PC_MK : PC_MQ) + g * HD + 8 * dgh);
              *(LAS u32x4*)(lds + HALO_OFF + (which ? 768 : 0) + j * 256 + 16 * dgh) = hv; } }
        { int tid_g = tid_in; asm volatile("" : "+v"(tid_g)); mixer_setup(a, lds, g, gi.c0, gi.nch, tid_g, tid_g & 63, wave); }
        f32x16 accC[2]; LAS float* nstate = (LAS float*)(lds + NST_OFF);
#pragma unroll
        for (int i = 0; i < 16; ++i) { accC[0][i] = 0.f; accC[1][i] = 0.f; }
        { int tid_o = tid_in; asm volatile("" : "+v"(tid_o)); const int lane = tid_o & 63;
          float nn = 0.f;
          for (int j = 0; j < grp; ++j) { const float* us = UG + ((size_t)(gi.base + j) << 14) + wave * 2048 + lane; const float dj = DG[gi.base + j];
#pragma unroll
              for (int i = 0; i < 16; ++i) { accC[0][i] = dj * accC[0][i] + us[i * 64]; accC[1][i] = dj * accC[1][i] + us[(16 + i) * 64]; }
              if (ml && tid_o < 128) nn = dj * nn + NG[(size_t)(gi.base + j) * HD + tid_o]; }
          if (tid_o < 128) nstate[tid_o] = nn;
          }
        asm volatile("s_waitcnt vmcnt(0)" ::: "memory"); LDS_WAIT(); __syncthreads();
        for (int ci = 0; ci < gi.nch; ++ci) { const int c = gi.c0 + ci;
            int tid_o = tid_in; asm volatile("" : "+v"(tid_o));
            const int tid = tid_o, lane = tid & 63, r = lane & 31, h = lane >> 5;
            const LAS float* gt = (const LAS float*)(lds + GATE_OFF + (ml ? ci : 0) * 1536);
            u32x4 vv[4];
            m3_build_qk(a, lds, g, c, ci & 1, gt, tid, vv);
            LDS_WAIT(); __syncthreads();
#pragma unroll
            for (int i = 0; i < 4; ++i) *(LAS u32x4*)(V + offb(4 * (tid >> 4) + i, tid & 15)) = vv[i];
#pragma unroll
            for (int n = 0; n < 2; ++n) { const int e = 64 * wj + 32 * n + r;
#pragma unroll
                for (int q = 0; q < 4; ++q) { u32x2 w; w.x = pk2(accC[n][4 * q], accC[n][4 * q + 1]); w.y = pk2(accC[n][4 * q + 2], accC[n][4 * q + 3]);
                    *(LAS u32x2*)(C0 + offb(e, 4 * wi + q) + 8 * h) = w; } }
            if (tid < 128) n0b[tid] = (unsigned short)pk2(nstate[tid], nstate[tid]);
            LDS_WAIT(); __syncthreads();
            f32x16 accO[2], accS[2], accD;
#pragma unroll
            for (int i = 0; i < 16; ++i) { accO[0][i] = 0.f; accO[1][i] = 0.f; accS[0][i] = 0.f; accS[1][i] = 0.f; accD[i] = 0.f; }
            const TrB tk = trbase(wi, lane), tv0 = trbase(2 * wj, lane), tv1 = trbase(2 * wj + 1, lane);
            const int rbq = rowbase(32 * wi + r, h), rbk = rowbase(64 * wj + r, h);
            if (ml) {
#pragma unroll
                for (int ks = 0; ks < 8; ++ks) { const bf16x8 af = rowfrag(Q, rbq, ks), b0 = rowfrag(C0, rbk, ks), b1 = rowfrag(C0 + 8192, rbk, ks), bn = *(const LAS bf16x8*)(n0b + 16 * ks + 8 * h);
                    accO[0] = MFMA32(af, b0, accO[0]); accO[1] = MFMA32(af, b1, accO[1]); accD = MFMA32(af, bn, accD); }
            } else {
#pragma unroll
                for (int ks = 0; ks < 8; ++ks) { const bf16x8 af = rowfrag(Q, rbq, ks), b0 = rowfrag(C0, rbk, ks), b1 = rowfrag(C0 + 8192, rbk, ks);
                    accO[0] = MFMA32(af, b0, accO[0]); accO[1] = MFMA32(af, b1, accO[1]); }
            }
#pragma unroll
            for (int i = 0; i < 16; ++i) { const int t = 32 * wi + crow(i, h); const float al = gt[256 + t]; accO[0][i] *= al; accO[1][i] *= al; accD[i] *= al; }
#pragma unroll
            for (int ks = 0; ks < 8; ++ks) { const bf16x8 af = rowfrag(Q, rbq, ks), b0 = rowfrag(K, rbk, ks), b1 = rowfrag(K + 8192, rbk, ks);
                accS[0] = MFMA32(b0, af, accS[0]); accS[1] = MFMA32(b1, af, accS[1]); }
            __syncthreads();
            { const int t = 32 * wi + r; const float fac = gt[t];
#pragma unroll
              for (int n = 0; n < 2; ++n)
#pragma unroll
                for (int q = 0; q < 4; ++q) { const int s0 = 64 * wj + 32 * n + 8 * q + 4 * h;
                    const float v0 = (s0 <= t) ? accS[n][4 * q] * fac : 0.f, v1 = (s0 + 1 <= t) ? accS[n][4 * q + 1] * fac : 0.f, v2 = (s0 + 2 <= t) ? accS[n][4 * q + 2] * fac : 0.f, v3 = (s0 + 3 <= t) ? accS[n][4 * q + 3] * fac : 0.f;
                    u32x2 w; w.x = pk2(v0, v1); w.y = pk2(v2, v3);
                    *(LAS u32x2*)(P + offb(t, 8 * wj + 4 * n + q) + 8 * h) = w; } }
            LDS_WAIT(); __syncthreads();
            u32x4 gpre[2][2];
            { const int tl = tid >> 3, eg = tid & 7; const int hc = ml ? g * HD + 16 * eg : (g - NHG) * HD + 16 * eg;
#pragma unroll
              for (int hh = 0; hh < 2; ++hh) { const bf16* gp = proj + (size_t)(c * CH + 64 * hh + tl) * NPJ + (ml ? PC_MO : PC_RG) + hc; gpre[hh][0] = *(const GAS u32x4*)gp; gpre[hh][1] = *(const GAS u32x4*)(gp + 8); } }
            const float dec = gt[256 + 127]; accC[0] = accC[0] * dec; accC[1] = accC[1] * dec;
            f32x16 accN;
#pragma unroll
            for (int i = 0; i < 16; ++i) accN[i] = 0.f;
            if (ml) {
#pragma unroll
                for (int ks = 0; ks < 8; ++ks) { const bf16x8 af = rowfrag(P, rbq, ks), ak = trfrag(K, tk, ks), b0 = trfrag(V, tv0, ks), b1 = trfrag(V, tv1, ks);
                    accO[0] = MFMA32(af, b0, accO[0]); accO[1] = MFMA32(af, b1, accO[1]); accC[0] = MFMA32(ak, b0, accC[0]); accC[1] = MFMA32(ak, b1, accC[1]);
                    accD = MFMA32(af, bf_ones(), accD); accN = MFMA32(ak, bf_ones(), accN); }
            } else {
#pragma unroll
                for (int ks = 0; ks < 8; ++ks) { const bf16x8 af = rowfrag(P, rbq, ks), ak = trfrag(K, tk, ks), b0 = trfrag(V, tv0, ks), b1 = trfrag(V, tv1, ks);
                    accO[0] = MFMA32(af, b0, accO[0]); accO[1] = MFMA32(af, b1, accO[1]); accC[0] = MFMA32(ak, b0, accC[0]); accC[1] = MFMA32(ak, b1, accC[1]); }
            }
            if (ml && wj == 0 && r == 0) {
#pragma unroll
                for (int i = 0; i < 16; ++i) { const int d = 32 * wi + crow(i, h); nstate[d] = dec * nstate[d] + accN[i]; } }
            asm volatile("" : "+v"(gpre[0][0]), "+v"(gpre[0][1]), "+v"(gpre[1][0]), "+v"(gpre[1][1]));
            __syncthreads();
            m3_stage(a, lds, g, ci + 1 < gi.nch ? c + 1 : c, lane, wave);
#pragma unroll
            for (int i = 0; i < 16; ++i) { const int t = 32 * wi + crow(i, h); const float rden = ml ? __builtin_amdgcn_rcpf(fmaxf(fabsf(accD[i]), 1.0f)) : 1.0f;
                H[t * HD + 64 * wj + r] = accO[0][i] * rden; H[t * HD + 64 * wj + 32 + r] = accO[1][i] * rden; }
            RAW_BARRIER();
#pragma unroll
            for (int hh = 0; hh < 2; ++hh) {
                const int tl = tid >> 3, eg = tid & 7, t = 64 * hh + tl;
                float hv[16]; float ss = 0.f;
#pragma unroll
                for (int q = 0; q < 4; ++q) { const f32x4 x4 = *(const LAS f32x4*)(H + t * HD + 16 * eg + 4 * q); hv[4 * q] = x4.x; hv[4 * q + 1] = x4.y; hv[4 * q + 2] = x4.z; hv[4 * q + 3] = x4.w; }
#pragma unroll
                for (int i = 0; i < 16; ++i) ss += hv[i] * hv[i];
                ss += __shfl_xor(ss, 1); ss += __shfl_xor(ss, 2); ss += __shfl_xor(ss, 4);
                const float rn = __builtin_amdgcn_rsqf(ss * (1.0f / HD) + NORM_EPS);
                const int tg = c * CH + t; const int hc = ml ? g * HD + 16 * eg : (g - NHG) * HD + 16 * eg;
                float gh[16]; {
#pragma unroll
                    for (int q = 0; q < 4; ++q) { const f32x4 g4 = *(const LAS f32x4*)((const LAS float*)(lds + GHL_OFF) + 16 * eg + 4 * q); gh[4 * q] = g4.x; gh[4 * q + 1] = g4.y; gh[4 * q + 2] = g4.z; gh[4 * q + 3] = g4.w; } }
                float ga[16]; { float t8[8]; unpack8(gpre[hh][0], t8);
#pragma unroll
                    for (int j = 0; j < 8; ++j) ga[j] = t8[j]; unpack8(gpre[hh][1], t8);
#pragma unroll
                    for (int j = 0; j < 8; ++j) ga[8 + j] = t8[j]; }
                float o[16];
#pragma unroll
                for (int i = 0; i < 16; ++i) o[i] = hv[i] * rn * gh[i] * (ml ? sig2(ga[i]) : ga[i] * sig2(ga[i]));
                bf16* op = mixb + (size_t)tg * DM + (ml ? 0 : 1024) + hc;
                u32x4 w0, w1; w0.x = pk2(o[0], o[1]); w0.y = pk2(o[2], o[3]); w0.z = pk2(o[4], o[5]); w0.w = pk2(o[6], o[7]); w1.x = pk2(o[8], o[9]); w1.y = pk2(o[10], o[11]); w1.z = pk2(o[12], o[13]); w1.w = pk2(o[14], o[15]);
                *(GAS u32x4*)op = w0; *(GAS u32x4*)(op + 8) = w1;
            }
            asm volatile("s_waitcnt vmcnt(0)" ::: "memory");
            RAW_BARRIER();
        }
    }
}
DI void phase_r1(const Args& a, int lane, int wave, int vcu, int G) {
    const int gw = vcu * NWAVES + wave, NGW = G * NWAVES;
    const float* x = (const float*)a.in[IN_X]; const bf16* mix = (const bf16*)(a.ws + WS_B); bf16* x1 = (bf16*)(a.ws + WS_X1); float* rs2 = (float*)(a.ws + WS_RS);
    f32x4 ggv[8]; { const GAS f32x4* gp = (const GAS f32x4*)a.in[IN_GPOST] + lane;
#pragma unroll
      for (int j = 0; j < 8; ++j) ggv[j] = gp[64 * j]; }
#define R1_LOAD(bm, bx, mm) do { const GAS u32x2* mr_ = (const GAS u32x2*)(mix + (size_t)(mm) * DM) + lane; const GAS f32x4* xr_ = (const GAS f32x4*)(x + (size_t)(mm) * DM) + lane; \
        _Pragma("unroll") for (int j = 0; j < 8; ++j) { bm[j] = mr_[64 * j]; bx[j] = xr_[64 * j]; } } while (0)
#define R1_ROW(bm, bx, mm) do { f32x4 v[8]; float s_ = 0.f; \
        _Pragma("unroll") for (int j = 0; j < 8; ++j) { v[j] = (f32x4){bflo(bm[j].x), bfhi(bm[j].x), bflo(bm[j].y), bfhi(bm[j].y)}; s_ += (v[j].x * v[j].x + v[j].y * v[j].y) + (v[j].z * v[j].z + v[j].w * v[j].w); } \
        const float r_ = 1.0f / sqrtf(wave_sum(s_) * (1.0f / DM) + NORM_EPS); float s2_ = 0.f; GAS u32x2* xo_ = (GAS u32x2*)(x1 + (size_t)(mm) * DM) + lane; \
        _Pragma("unroll") for (int j = 0; j < 8; ++j) { const f32x4 gg = ggv[j]; v[j] = bx[j] + v[j] * r_ * gg; s2_ += (v[j].x * v[j].x + v[j].y * v[j].y) + (v[j].z * v[j].z + v[j].w * v[j].w); } \
        const float r2_ = 1.0f / sqrtf(wave_sum(s2_) * (1.0f / DM) + NORM_EPS); if (lane == 0) rs2[mm] = r2_; \
        _Pragma("unroll") for (int j = 0; j < 8; ++j) { u32x2 xw; xw.x = pk2(v[j].x * r2_, v[j].y * r2_); xw.y = pk2(v[j].z * r2_, v[j].w * r2_); xo_[64 * j] = xw; } } while (0)
    u32x2 ma[8], mb[8]; f32x4 xa[8], xb[8];
    int m = gw; if (m < SEQ) R1_LOAD(ma, xa, m);
    for (; m < SEQ; m += 2 * NGW) {
        if (m + NGW < SEQ) R1_LOAD(mb, xb, m + NGW);
        R1_ROW(ma, xa, m);
        if (m + 2 * NGW < SEQ) R1_LOAD(ma, xa, m + 2 * NGW);
        if (m + NGW < SEQ) R1_ROW(mb, xb, m + NGW);
    }
#undef R1_LOAD
#undef R1_ROW
}
DI void phase_r2(const Args& a, int lane, int wave, int vcu, int G, bool poison) {
    const int gw = vcu * NWAVES + wave, NGW = G * NWAVES;
    const bf16* ff = (const bf16*)(a.ws + WS_FF); const bf16* x1 = (const bf16*)(a.ws + WS_X1); const float* rs2 = (const float*)(a.ws + WS_RS); float* out = a.out;
    f32x4 ggv[8]; { const GAS f32x4* gp = (const GAS f32x4*)a.in[IN_GFPOST] + lane;
#pragma unroll
      for (int j = 0; j < 8; ++j) ggv[j] = gp[64 * j]; }
    const float qn = __builtin_nanf("");
#define R2_LOAD(bm, bx, mm) do { const GAS u32x2* fr_ = (const GAS u32x2*)(ff + (size_t)(mm) * DM) + lane; const GAS u32x2* xr_ = (const GAS u32x2*)(x1 + (size_t)(mm) * DM) + lane; \
        _Pragma("unroll") for (int j = 0; j < 8; ++j) { bm[j] = fr_[64 * j]; bx[j] = xr_[64 * j]; } bx[8].x = __builtin_bit_cast(unsigned, rs2[mm]); } while (0)
#define R2_ROW(bm, bx, mm) do { f32x4 v[8]; float s_ = 0.f; \
        _Pragma("unroll") for (int j = 0; j < 8; ++j) { v[j] = (f32x4){bflo(bm[j].x), bfhi(bm[j].x), bflo(bm[j].y), bfhi(bm[j].y)}; s_ += (v[j].x * v[j].x + v[j].y * v[j].y) + (v[j].z * v[j].z + v[j].w * v[j].w); } \
        const float r_ = 1.0f / sqrtf(wave_sum(s_) * (1.0f / DM) + NORM_EPS); const float inv2_ = 1.0f / __builtin_bit_cast(float, bx[8].x); GAS f32x4* xo_ = (GAS f32x4*)(out + (size_t)(mm) * DM) + lane; \
        _Pragma("unroll") for (int j = 0; j < 8; ++j) { const f32x4 gg = ggv[j]; f32x4 o = (f32x4){bflo(bx[j].x), bfhi(bx[j].x), bflo(bx[j].y), bfhi(bx[j].y)} * inv2_ + v[j] * r_ * gg; if (poison) o = (f32x4){qn, qn, qn, qn}; xo_[64 * j] = o; } } while (0)
    u32x2 ma[8], mb[8], xa[9], xb[9];
    int m = gw; if (m < SEQ) R2_LOAD(ma, xa, m);
    for (; m < SEQ; m += 2 * NGW) {
        if (m + NGW < SEQ) R2_LOAD(mb, xb, m + NGW);
        R2_ROW(ma, xa, m);
        if (m + 2 * NGW < SEQ) R2_LOAD(ma, xa, m + 2 * NGW);
        if (m + NGW < SEQ) R2_ROW(mb, xb, m + NGW);
    }
#undef R2_LOAD
#undef R2_ROW
}

DI int fresh_lane() { unsigned z = 0u; asm volatile("" : "+v"(z)); return (int)__builtin_amdgcn_mbcnt_hi(~0u, __builtin_amdgcn_mbcnt_lo(~0u, z)); }
__global__ void __launch_bounds__(NTHR, 2) fwd(Args a) {
    extern __shared__ __attribute__((aligned(16))) unsigned char lds_raw[];
    ldsp lds = (ldsp)lds_raw;
    const int wave = __builtin_amdgcn_readfirstlane((int)threadIdx.x >> 6);
#define FRESH_TID() (wave * 64 + fresh_lane())
    const int tid = FRESH_TID(), lane = tid & 63;
    const int G = gridDim.x; const int bx = blockIdx.x; const int vcu = (G % 8 == 0) ? (bx % 8) * (G / 8) + bx / 8 : bx;
    volatile LAS unsigned* MISC = (volatile LAS unsigned*)(lds + MISC_OFF);
    if (tid < 32) MISC[tid] = 0u;
    __syncthreads();
    unsigned* ctl = (unsigned*)(a.ws + WS_CTL);
    XcdBarrier bar; bar.bar = ctl + CW_BAR; bar.x = 0; bar.st = nullptr;
    if (N_LAUNCHES == 1) bar = xcd_barrier_post(ctl + CW_BAR, MISC + 8, tid);
    const int lo = a.ph_lo, hi = a.ph_hi;
#define IN(k) (lo <= (k) && (k) < hi)
#define SEAM(k) do { if (IN(k) && IN((k) + 1)) xcd_barrier(bar, FRESH_TID()); } while (0)

#define PH1_BODY { pg8::Gemm g{(const bf16*)(a.ws + WS_A), (const bf16*)(a.ws + WS_WIN), SEQ, NPJ, DM}; pg8::StaticOrder S; S.init(SEQ, NPJ, G, bx); \
        pg8::EpiBf16 E{(bf16*)(a.ws + WS_B), NPJ}; pg8::gemm_phase<pg8::EpiBf16, pg8::StaticOrder, true, true>(lds, g, S, E, FRESH_TID()); }
#define PH5_BODY { pg8::Gemm g{(const bf16*)a.out, (const bf16*)(a.ws + WS_WO), SEQ, DM, DM}; pg8::StaticOrder S; S.init(SEQ, DM, G, bx); \
        pg8::EpiBf16 E{(bf16*)(a.ws + WS_B), DM}; pg8::gemm_phase<pg8::EpiBf16, pg8::StaticOrder, true, true>(lds, g, S, E, FRESH_TID()); }
#define PH7_BODY { pg8::Gemm g{(const bf16*)(a.ws + WS_X1), (const bf16*)(a.ws + WS_WGU), SEQ, 2 * DFF, DM}; pg8::StaticOrder S; S.init(SEQ, 2 * DFF, G, bx); \
        pg8::EpiSwiGLU E{(bf16*)(a.ws + WS_B), DFF}; pg8::gemm_phase<pg8::EpiSwiGLU, pg8::StaticOrder, true, true>(lds, g, S, E, FRESH_TID()); }
#define PH8_BODY { pg8::Gemm g{(const bf16*)(a.ws + WS_B), (const bf16*)(a.ws + WS_WD), SEQ, DM, DFF}; pg8::StaticOrder S; S.init(SEQ, DM, G, bx); \
        pg8::EpiBf16 E{(bf16*)(a.ws + WS_FF), DM}; pg8::gemm_phase<pg8::EpiBf16, pg8::StaticOrder, true, true>(lds, g, S, E, FRESH_TID()); }
#define DUP(k) (((PROBE_DUP) >> (k)) & 1)
    if (IN(0)) { phase_p0(a, lds, tid, lane, wave, vcu, G); SEAM(0); }
    if (IN(1)) { PH1_BODY SEAM(1); }
    if (IN(2)) { phase_m1(a, lds, FRESH_TID(), wave, vcu, G); SEAM(2); }
    if (IN(4)) { phase_m3(a, lds, FRESH_TID(), wave, vcu, G); SEAM(4); }
    if (IN(5)) { PH5_BODY SEAM(5); }
    if (IN(6)) { phase_r1(a, lane, wave, vcu, G); if (DUP(6)) phase_r1(a, lane, wave, vcu, G); SEAM(6); }
    if (IN(7)) { PH7_BODY SEAM(7); }
    if (IN(8)) { PH8_BODY SEAM(8); }
    if (IN(9)) {
        bool poison = false;
        if (N_LAUNCHES == 1) poison = __hip_atomic_load(ctl + CW_BAR + XB_TMO, __ATOMIC_RELAXED, __HIP_MEMORY_SCOPE_AGENT) != 0u;
        phase_r2(a, lane, wave, vcu, G, poison);
    }
#undef PH1_BODY
#undef PH5_BODY
#undef PH7_BODY
#undef PH8_BODY
#undef DUP
#undef FRESH_TID
#undef IN
#undef SEAM
}

extern "C" void kernel_launch(void* const* d_in, const int* in_sizes, int n_in, void* d_out, int out_size, void* d_ws, size_t ws_size, hipStream_t stream) {
    static int grid = 0;
    if (grid == 0) {
        if (n_in != 17 || in_sizes[0] != SEQ * DM || out_size != SEQ * DM || ws_size < WS_END) {
            fprintf(stderr, "kernel_launch: unexpected shapes (n_in %d, in0 %d, out %d, ws %zu); nothing launched\n", n_in, n_in > 0 ? in_sizes[0] : -1, out_size, ws_size); grid = -1; return; }
        int dev = 0, cus = 0, per_cu = 0;
        if (hipGetDevice(&dev) != hipSuccess || hipDeviceGetAttribute(&cus, hipDeviceAttributeMultiprocessorCount, dev) != hipSuccess) { grid = -1; return; }
        if (hipFuncSetAttribute((const void*)fwd, hipFuncAttributeMaxDynamicSharedMemorySize, LDS_BYTES) != hipSuccess) { fprintf(stderr, "kernel_launch: hipFuncSetAttribute failed\n"); grid = -1; return; }
        if (hipOccupancyMaxActiveBlocksPerMultiprocessor(&per_cu, (const void*)fwd, NTHR, LDS_BYTES) != hipSuccess || per_cu < 1)
            fprintf(stderr, "kernel_launch: note: occupancy query reports %d workgroups per CU\n", per_cu);
        (void)hipGetLastError();
        grid = cus;
    }
    if (grid < 0) return;
    if (hipMemsetAsync((char*)d_ws + WS_CTL, 0, CTL_ZERO_BYTES, stream) != hipSuccess) return;
    Args a{};
    for (int i = 0; i < 17; ++i) a.in[i] = d_in[i];
    a.out = (float*)d_out; a.ws = (unsigned char*)d_ws;
    if (N_LAUNCHES == 1) { a.ph_lo = 0; a.ph_hi = NPHASES; a.li = 0; hipLaunchKernelGGL(fwd, dim3(grid), dim3(NTHR), LDS_BYTES, stream, a); }
    else for (int li = 0; li < NPHASES; ++li) { a.ph_lo = li; a.ph_hi = li + 1; a.li = li; hipLaunchKernelGGL(fwd, dim3(grid), dim3(NTHR), LDS_BYTES, stream, a); }
}
```

```cpp
#include <hip/hip_runtime.h>
#include <cstdio>
#include <cstdint>

#ifndef PROBE_DUP
#define PROBE_DUP 0
#endif
#ifndef MK_N_LAUNCHES
#define MK_N_LAUNCHES 1
#endif

namespace pg8 {
#define PG8_LAS __attribute__((address_space(3)))
typedef unsigned short bf16_t;
typedef short bf16x8 __attribute__((ext_vector_type(8)));
typedef float f32x4 __attribute__((ext_vector_type(4)));
typedef unsigned u32x4 __attribute__((ext_vector_type(4)));
constexpr int BM = 256, BK = 64, HALF = 128, HTB = HALF * BK * 2  , STAGE_BYTES = 8 * HTB, NXCD = 8, WGM = 4;

__host__ __device__ __forceinline__ int lds_byte(int r, int c) { const int st = (r >> 4) * 2 + (c >> 5), rr = r & 15, cc = c & 31, ob = rr * 64 + cc * 2; return st * 1024 + (ob ^ (((ob >> 9) & 1) << 5)); }
__host__ __device__ __forceinline__ void stage_rc(int b, int& R, int& C) { const int st = b / 1024, sb = b % 1024, swz = sb ^ (((sb >> 9) & 1) << 5); R = (st >> 1) * 16 + swz / 64; C = (st & 1) * 32 + (swz % 64) / 2; }
__host__ __device__ __forceinline__ int perm32(int rho) { const int n = rho >> 4, i = rho & 15; return 8 * (i >> 2) + 4 * n + (i & 3); }

struct Unit { int pm, pn; };
struct Gemm { const bf16_t* A; const bf16_t* Bt; int M, N, K; };

struct StaticOrder {
    int nM, nN, nwg, G, c;
    __host__ __device__ void init(int M, int N, int G_, int c_) { nM = M / BM; nN = N / BM; nwg = nM * nN; G = G_; c = c_; }
    __host__ __device__ bool next(int i, Unit& u) const {
        const long L = (long)i * G + c; if (L >= nwg) return false;
        int wgid = (int)L; { const int q = nwg / NXCD, r = nwg % NXCD, xcd = wgid % NXCD, off = wgid / NXCD; wgid = (xcd < r ? xcd * (q + 1) : r * (q + 1) + (xcd - r) * q) + off; }
        const int nig = WGM * nN, gid = wgid / nig, fm = gid * WGM, gsz = (nM - fm) < WGM ? (nM - fm) : WGM;
        u.pm = fm + ((wgid % nig) % gsz); u.pn = (wgid % nig) / gsz; return true;
    }
    __device__ __forceinline__ void a_ready(const Unit&) const {}
    __device__ __forceinline__ void done(const Unit&) const {}
};

typedef __bf16 bf16x2_t __attribute__((ext_vector_type(2))); typedef float f32x2_t __attribute__((ext_vector_type(2)));
__device__ __forceinline__ unsigned cvt_pk_bf16(float lo, float hi) { const f32x2_t v = {lo, hi}; return __builtin_bit_cast(unsigned, __builtin_convertvector(v, bf16x2_t)); }

struct EpiF32 {
    static constexpr bool PERM = false, AFTER_DRAIN = false;
    float* C; int ldc;
    __device__ __forceinline__ void operator()(const f32x4 (&acc)[2][2][4][2], const Unit& u, int wr, int wc, int fr, int fq) const {
        const int row0 = u.pm * BM + wr * 64 + fr, col0 = u.pn * BM + wc * 32 + 4 * fq;
#pragma unroll
        for (int ai = 0; ai < 2; ++ai)
#pragma unroll
            for (int m = 0; m < 4; ++m) { float* rowp = C + (size_t)(row0 + ai * HALF + m * 16) * ldc + col0;
#pragma unroll
                for (int bj = 0; bj < 2; ++bj)
#pragma unroll
                    for (int n = 0; n < 2; ++n) *(f32x4*)(rowp + bj * HALF + n * 16) = acc[ai][bj][m][n]; }
    }
};
struct EpiBf16 {
    static constexpr bool PERM = true, AFTER_DRAIN = false;
    bf16_t* O; int ldc;
    __device__ __forceinline__ void operator()(const f32x4 (&acc)[2][2][4][2], const Unit& u, int wr, int wc, int fr, int fq) const {
        const int row0 = u.pm * BM + wr * 64 + fr, col0 = u.pn * BM + wc * 32 + 8 * fq;
#pragma unroll
        for (int ai = 0; ai < 2; ++ai)
#pragma unroll
            for (int m = 0; m < 4; ++m) { bf16_t* rowp = O + (size_t)(row0 + ai * HALF + m * 16) * ldc + col0;
#pragma unroll
                for (int bj = 0; bj < 2; ++bj) { const f32x4 v0 = acc[ai][bj][m][0], v1 = acc[ai][bj][m][1];
                    u32x4 w; w.x = cvt_pk_bf16(v0[0], v0[1]); w.y = cvt_pk_bf16(v0[2], v0[3]); w.z = cvt_pk_bf16(v1[0], v1[1]); w.w = cvt_pk_bf16(v1[2], v1[3]);
                    *(u32x4*)(rowp + bj * HALF) = w; } }
    }
};
struct EpiBf16Blk {
    static constexpr bool PERM = true, AFTER_DRAIN = false;
    bf16_t* O; int M;
    __device__ __forceinline__ void operator()(const f32x4 (&acc)[2][2][4][2], const Unit& u, int wr, int wc, int fr, int fq) const {
        const int row0 = u.pm * BM + wr * 64 + fr, cin = wc * 32 + 8 * fq;
#pragma unroll
        for (int ai = 0; ai < 2; ++ai)
#pragma unroll
            for (int m = 0; m < 4; ++m) {
#pragma unroll
                for (int bj = 0; bj < 2; ++bj) { const f32x4 v0 = acc[ai][bj][m][0], v1 = acc[ai][bj][m][1];
                    u32x4 w; w.x = cvt_pk_bf16(v0[0], v0[1]); w.y = cvt_pk_bf16(v0[2], v0[3]); w.z = cvt_pk_bf16(v1[0], v1[1]); w.w = cvt_pk_bf16(v1[2], v1[3]);
                    *(u32x4*)(O + ((size_t)(2 * u.pn + bj) * M + (row0 + ai * HALF + m * 16)) * 128 + cin) = w; } }
    }
};
__device__ __forceinline__ float swiglu2(float g, float u) { return g * u * __builtin_amdgcn_rcpf(1.0f + __builtin_amdgcn_exp2f(g)); }
struct EpiSwiGLU {
    static constexpr bool PERM = true, AFTER_DRAIN = false;
    bf16_t* O; int ldc;
    __device__ __forceinline__ void operator()(const f32x4 (&acc)[2][2][4][2], const Unit& u, int wr, int wc, int fr, int fq) const {
        const int row0 = u.pm * BM + wr * 64 + fr, col0 = u.pn * HALF + wc * 32 + 8 * fq;
#pragma unroll
        for (int ai = 0; ai < 2; ++ai)
#pragma unroll
            for (int m = 0; m < 4; ++m) { bf16_t* rowp = O + (size_t)(row0 + ai * HALF + m * 16) * ldc + col0;
                const f32x4 g0 = acc[ai][0][m][0], g1 = acc[ai][0][m][1], u0 = acc[ai][1][m][0], u1 = acc[ai][1][m][1];
                u32x4 w; w.x = cvt_pk_bf16(swiglu2(g0[0], u0[0]), swiglu2(g0[1], u0[1])); w.y = cvt_pk_bf16(swiglu2(g0[2], u0[2]), swiglu2(g0[3], u0[3]));
                w.z = cvt_pk_bf16(swiglu2(g1[0], u1[0]), swiglu2(g1[1], u1[1])); w.w = cvt_pk_bf16(swiglu2(g1[2], u1[2]), swiglu2(g1[3], u1[3]));
                *(u32x4*)rowp = w; }
    }
};

template <class Epi, class Sched, bool ALIGN_EPI = false, bool SP2 = false>
__device__ __forceinline__ void gemm_phase(PG8_LAS unsigned char* lds, const Gemm g, const Sched& S, const Epi& E, const int tid) {
    const int wid = __builtin_amdgcn_readfirstlane(tid >> 6), lane = tid & 63, wr = wid >> 2, wc = wid & 3, fr = lane & 15, fq = lane >> 4;
    const int K = g.K, nt = K / BK;
    unsigned voffA[2], voffB[2];
#pragma unroll
    for (int i = 0; i < 2; ++i) { int R, C; stage_rc(tid * 16 + i * 8192, R, C); const int Rb = Epi::PERM ? ((R & ~31) + perm32(R & 31)) : R;
        voffA[i] = (unsigned)(R * K + C) * 2u; voffB[i] = (unsigned)(Rb * K + C) * 2u; }
    const size_t kstep = (size_t)(BK * 2);
    const size_t hstep = (size_t)HALF * K * 2;
    const size_t tstep = 2 * hstep;
    const unsigned ldsw = (unsigned)wid * 1024u;
    const int aoff = lds_byte(wr * 64 + fr, fq * 8), boff = lds_byte(wc * 32 + fr, fq * 8);
#define PG8_SA(b, h) (((b) * 2 + (h)) * HTB)
#define PG8_SB(b, h) ((4 + (b) * 2 + (h)) * HTB)
#define PG8_STAGE(bufoff, gbase, voff) do { _Pragma("unroll") for (int _i = 0; _i < 2; ++_i) \
        __builtin_amdgcn_global_load_lds((const unsigned*)((const char*)(gbase) + (voff)[_i]), (PG8_LAS unsigned*)(lds + (bufoff) + ldsw + _i * 8192), 16, 0, 0); } while (0)
#define PG8_LDA(dst, b, h) do { _Pragma("unroll") for (int m = 0; m < 4; ++m) _Pragma("unroll") for (int k = 0; k < 2; ++k) dst[m][k] = *(const PG8_LAS bf16x8*)(lds + PG8_SA(b, h) + aoff + m * 2048 + k * 1024); } while (0)
#define PG8_LDB(dst, b, h) do { _Pragma("unroll") for (int n = 0; n < 2; ++n) _Pragma("unroll") for (int k = 0; k < 2; ++k) dst[n][k] = *(const PG8_LAS bf16x8*)(lds + PG8_SB(b, h) + boff + n * 2048 + k * 1024); } while (0)
#define PG8_MMA(ai, bj, At, Bt) do { __builtin_amdgcn_s_setprio(1); _Pragma("unroll") for (int m = 0; m < 4; ++m) _Pragma("unroll") for (int n = 0; n < 2; ++n) _Pragma("unroll") for (int k = 0; k < 2; ++k) \
        acc[ai][bj][m][n] = __builtin_amdgcn_mfma_f32_16x16x32_bf16(Bt[n][k], At[m][k], acc[ai][bj][m][n], 0, 0, 0); __builtin_amdgcn_s_setprio(0); } while (0)
#define PG8_WAIT_V(n) asm volatile("s_waitcnt vmcnt(" #n ")" ::: "memory")
#define PG8_WAIT_L(n) asm volatile("s_waitcnt lgkmcnt(" #n ")" ::: "memory")
#define PG8_BAR __builtin_amdgcn_s_barrier()
#define PG8_SCHED __builtin_amdgcn_sched_barrier(0)
    Unit cur, nxt; int ui = 0;
    if (!S.next(0, cur)) return;
    f32x4 acc[2][2][4][2];
#pragma unroll
    for (int a = 0; a < 2; ++a)
#pragma unroll
        for (int b = 0; b < 2; ++b)
#pragma unroll
            for (int m = 0; m < 4; ++m)
#pragma unroll
                for (int n = 0; n < 2; ++n) acc[a][b][m][n] = (f32x4){0.f, 0.f, 0.f, 0.f};
    bf16x8 At[4][2], B0[2][2], B1[2][2];
    const char* cA = (const char*)g.A + (size_t)cur.pm * tstep; const char* cB = (const char*)g.Bt + (size_t)cur.pn * tstep;
    S.a_ready(cur);
    if constexpr (SP2) {
        PG8_STAGE(PG8_SB(0, 0), cB, voffB); PG8_STAGE(PG8_SB(0, 1), cB + hstep, voffB); PG8_STAGE(PG8_SA(0, 0), cA, voffA); PG8_STAGE(PG8_SA(0, 1), cA + hstep, voffA);
        if (wr == 1) PG8_BAR;
        PG8_WAIT_V(2); PG8_BAR;
        PG8_STAGE(PG8_SB(1, 0), cB + kstep, voffB); PG8_STAGE(PG8_SA(1, 0), cA + kstep, voffA); PG8_STAGE(PG8_SB(1, 1), cB + hstep + kstep, voffB);
        PG8_WAIT_V(6); PG8_BAR;
    } else {
        PG8_STAGE(PG8_SB(0, 0), cB, voffB); PG8_STAGE(PG8_SA(0, 0), cA, voffA); PG8_STAGE(PG8_SB(0, 1), cB + hstep, voffB); PG8_STAGE(PG8_SA(0, 1), cA + hstep, voffA);
        if (wr == 1) PG8_BAR;
        PG8_WAIT_V(4); PG8_BAR;
        PG8_STAGE(PG8_SB(1, 0), cB + kstep, voffB); PG8_STAGE(PG8_SA(1, 0), cA + kstep, voffA); PG8_STAGE(PG8_SB(1, 1), cB + hstep + kstep, voffB);
        PG8_WAIT_V(6); PG8_BAR;
    }
    for (;;) {
        const bool has_next = S.next(ui + 1, nxt);
        const char* nA = has_next ? (const char*)g.A + (size_t)nxt.pm * tstep : cA; const char* nB = has_next ? (const char*)g.Bt + (size_t)nxt.pn * tstep : cB;
        for (int t = 0; t < nt; t += 2) {
            const bool last = (t == nt - 2);
            const char* a1 = cA + (size_t)(t + 1) * kstep;
            const char* a2 = last ? nA : cA + (size_t)(t + 2) * kstep; const char* b2 = last ? nB : cB + (size_t)(t + 2) * kstep;
            const char* a3 = a2 + kstep; const char* b3 = b2 + kstep;
            if (last && has_next) S.a_ready(nxt);
            if constexpr (SP2) {
            PG8_LDB(B0, 0, 0); PG8_LDB(B1, 0, 1); PG8_SCHED; PG8_LDA(At, 0, 0); PG8_STAGE(PG8_SA(1, 1), a1 + hstep, voffA);
            PG8_WAIT_V(8); PG8_WAIT_L(0); PG8_BAR; PG8_MMA(0, 0, At, B0); PG8_MMA(0, 1, At, B1); PG8_BAR; PG8_SCHED;
            PG8_LDA(At, 0, 1); PG8_STAGE(PG8_SB(0, 0), b2, voffB); PG8_STAGE(PG8_SB(0, 1), b2 + hstep, voffB); PG8_STAGE(PG8_SA(0, 0), a2, voffA);
            PG8_WAIT_V(8); PG8_WAIT_L(0); PG8_BAR; PG8_MMA(1, 0, At, B0); PG8_MMA(1, 1, At, B1); PG8_BAR; PG8_SCHED;
            PG8_LDB(B0, 1, 0); PG8_LDB(B1, 1, 1); PG8_SCHED; PG8_LDA(At, 1, 0); PG8_STAGE(PG8_SA(0, 1), a2 + hstep, voffA);
            PG8_WAIT_V(8); PG8_WAIT_L(0); PG8_BAR; PG8_MMA(0, 0, At, B0); PG8_MMA(0, 1, At, B1); PG8_BAR; PG8_SCHED;
            PG8_LDA(At, 1, 1); PG8_STAGE(PG8_SB(1, 0), b3, voffB); PG8_STAGE(PG8_SB(1, 1), b3 + hstep, voffB); PG8_STAGE(PG8_SA(1, 0), a3, voffA);
            PG8_WAIT_V(8); PG8_WAIT_L(0); PG8_BAR; PG8_MMA(1, 0, At, B0); PG8_MMA(1, 1, At, B1); PG8_BAR; PG8_SCHED;
            } else {
            PG8_LDB(B0, 0, 0); PG8_SCHED; PG8_LDA(At, 0, 0); PG8_STAGE(PG8_SA(1, 1), a1 + hstep, voffA);
            PG8_WAIT_L(8); PG8_BAR; PG8_WAIT_L(0); PG8_MMA(0, 0, At, B0); PG8_BAR; PG8_SCHED;
            PG8_LDB(B1, 0, 1); PG8_STAGE(PG8_SB(0, 0), b2, voffB);
            PG8_BAR; PG8_WAIT_L(0); PG8_MMA(0, 1, At, B1); PG8_BAR;
            PG8_LDA(At, 0, 1); PG8_STAGE(PG8_SA(0, 0), a2, voffA);
            PG8_BAR; PG8_WAIT_L(0); PG8_MMA(1, 0, At, B0); PG8_BAR; PG8_SCHED;
            PG8_STAGE(PG8_SB(0, 1), b2 + hstep, voffB);
            PG8_WAIT_V(6); PG8_BAR; PG8_MMA(1, 1, At, B1); PG8_BAR;
            PG8_LDB(B0, 1, 0); PG8_SCHED; PG8_LDA(At, 1, 0); PG8_STAGE(PG8_SA(0, 1), a2 + hstep, voffA);
            PG8_WAIT_L(8); PG8_BAR; PG8_WAIT_L(0); PG8_MMA(0, 0, At, B0); PG8_BAR; PG8_SCHED;
            PG8_LDB(B1, 1, 1); PG8_STAGE(PG8_SB(1, 0), b3, voffB);
            PG8_BAR; PG8_WAIT_L(0); PG8_MMA(0, 1, At, B1); PG8_BAR;
            PG8_LDA(At, 1, 1); PG8_STAGE(PG8_SA(1, 0), a3, voffA);
            PG8_BAR; PG8_WAIT_L(0); PG8_MMA(1, 0, At, B0); PG8_BAR; PG8_SCHED;
            PG8_STAGE(PG8_SB(1, 1), b3 + hstep, voffB);
            PG8_WAIT_V(6); PG8_BAR; PG8_MMA(1, 1, At, B1); PG8_BAR;
            }
        }
        if constexpr (ALIGN_EPI) { if (wr == 0) PG8_BAR; }
        if constexpr (!Epi::AFTER_DRAIN) { E(acc, cur, wr, wc, fr, fq); S.done(cur); }
        if (!has_next) break;
#pragma unroll
        for (int a = 0; a < 2; ++a)
#pragma unroll
            for (int b = 0; b < 2; ++b)
#pragma unroll
                for (int m = 0; m < 4; ++m)
#pragma unroll
                    for (int n = 0; n < 2; ++n) acc[a][b][m][n] = (f32x4){0.f, 0.f, 0.f, 0.f};
        cur = nxt; cA = nA; cB = nB; ++ui;
        if constexpr (ALIGN_EPI) { if (wr == 1) PG8_BAR; }
    }
    PG8_WAIT_V(0);
    if constexpr (!ALIGN_EPI) { if (wr == 0) PG8_BAR; }
    PG8_BAR;
#undef PG8_SA
#undef PG8_SB
#undef PG8_STAGE
#undef PG8_LDA
#undef PG8_LDB
#undef PG8_MMA
#undef PG8_WAIT_V
#undef PG8_WAIT_L
#undef PG8_BAR
#undef PG8_SCHED
}
}

constexpr int NWAVES = 8, NTHR = 512;
constexpr int SEQ = 16384, DM = 2048, HD = 128, NHG = 8, DPROJ = 8208, NPJ = 8192, DFF = 5632, CH = 128, NCH = SEQ / CH, NHEADS = 16;
constexpr float NORM_EPS = 1e-6f;
constexpr int N_LAUNCHES = MK_N_LAUNCHES, NPHASES = 10;
constexpr int PC_MQ = 0, PC_MK = 1024, PC_MV = 2048, PC_MO = 3072, PC_RQ = 4096, PC_RK = 5120, PC_RV = 6144, PC_RG = 7168;

constexpr size_t MiB = 1u << 20;
constexpr size_t WS_CTL = 0, CTL_ZERO_BYTES = 64 * 1024;
constexpr size_t WS_WIN = 2 * MiB, WS_WO = 34 * MiB, WS_WGU = 42 * MiB, WS_WD = 86 * MiB;
constexpr size_t WS_PRE = 108 * MiB;
constexpr size_t WS_RS = 109 * MiB;
constexpr size_t WS_NLOC = 110 * MiB;
constexpr size_t WS_N0 = 110 * MiB + 512 * 1024;
constexpr size_t WS_DEC = 111 * MiB;
constexpr size_t WS_GHEAD = 111 * MiB + 65536;
constexpr size_t WS_COS = 112 * MiB, WS_SIN = 116 * MiB;
constexpr size_t WS_B = 128 * MiB;
constexpr size_t WS_A = 384 * MiB;
constexpr size_t WS_FF = WS_B + 176 * MiB;
constexpr size_t WS_X1 = 448 * MiB;
constexpr size_t WS_END = 512 * MiB;
constexpr int CW_BAR = 1024;

constexpr int RING_BYTES = 131072;
constexpr int GATE_OFF = RING_BYTES;
constexpr int N0B_OFF = GATE_OFF + 8 * 1536;
constexpr int CONVW_OFF = N0B_OFF + 256;
constexpr int NST_OFF = CONVW_OFF + 5120;
constexpr int GHL_OFF = NST_OFF + 512;
constexpr int MISC_OFF = GHL_OFF + 512;
constexpr int LDS_BYTES = 163840;
static_assert(MISC_OFF + 1024 + 5120 <= LDS_BYTES, "LDS map");

#define GAS __attribute__((address_space(1)))
#define LAS __attribute__((address_space(3)))
#define DI __device__ __forceinline__
typedef unsigned short bf16;
typedef unsigned u32x4 __attribute__((ext_vector_type(4)));
typedef unsigned u32x2 __attribute__((ext_vector_type(2)));
typedef float f32x4 __attribute__((ext_vector_type(4)));
typedef float f32x2 __attribute__((ext_vector_type(2)));
typedef LAS unsigned char* ldsp;
#define LDS_WAIT() asm volatile("s_waitcnt lgkmcnt(0)" ::: "memory")

DI unsigned f2bf(float f) { unsigned u = __builtin_bit_cast(unsigned, f); return (u + 0x7fffu + ((u >> 16) & 1u)) >> 16; }
typedef __bf16 bf16x2_t __attribute__((ext_vector_type(2)));
DI unsigned pk2(float lo, float hi) { const f32x2 v = {lo, hi}; return __builtin_bit_cast(unsigned, __builtin_convertvector(v, bf16x2_t)); }
DI float bflo(unsigned w) { return __builtin_bit_cast(float, w << 16); }
DI float bfhi(unsigned w) { return __builtin_bit_cast(float, w & 0xffff0000u); }
DI void unpack8(const u32x4 w, float (&f)[8]) { f[0] = bflo(w.x); f[1] = bfhi(w.x); f[2] = bflo(w.y); f[3] = bfhi(w.y); f[4] = bflo(w.z); f[5] = bfhi(w.z); f[6] = bflo(w.w); f[7] = bfhi(w.w); }
DI u32x4 pack8(const float (&f)[8]) { u32x4 w; w.x = pk2(f[0], f[1]); w.y = pk2(f[2], f[3]); w.z = pk2(f[4], f[5]); w.w = pk2(f[6], f[7]); return w; }
constexpr float NLOG2E = -1.4426950408889634f, NLN2 = -0.6931471805599453f;
DI float sig2(float y) { return __builtin_amdgcn_rcpf(1.0f + __builtin_amdgcn_exp2f(y)); }
DI float wave_sum(float v) {
#pragma unroll
    for (int o = 1; o < 64; o <<= 1) v += __shfl_xor(v, o);
    return v;
}

#define XB_TMO      128
#define XB_XCNT(j)  (256  + 64 * (j))
#define XB_XSUB(j)  (1280 + 64 * (j))
#define XB_XGEN(j)  (2304 + 64 * (j))
#define XB_TOP      3328
#define XB_TOPGEN   3392
#define XCD_BAR_WORDS 3456
#define XB_SPIN_CAP (1u << 18)
__device__ __forceinline__ unsigned xb_ld(unsigned* p)              { return __hip_atomic_load(p, __ATOMIC_RELAXED, __HIP_MEMORY_SCOPE_AGENT); }
__device__ __forceinline__ unsigned xb_add(unsigned* p, unsigned v) { return __hip_atomic_fetch_add(p, v, __ATOMIC_RELAXED, __HIP_MEMORY_SCOPE_AGENT); }
__device__ __forceinline__ unsigned xb_xcc_id() { return (unsigned)__builtin_amdgcn_s_getreg((3 << 11) | 20) & 0xFu; }
#define XB_SPIN(cond, bar) do { unsigned _sp = 0; while (cond) { __builtin_amdgcn_s_sleep(1); \
    if ((++_sp & 255u) == 0u) { if (xb_ld(&(bar)[XB_TMO])) break; if (_sp > XB_SPIN_CAP) { atomicAdd(&(bar)[XB_TMO], 1u); break; } } } } while (0)
struct XcdBarrier { unsigned* bar; unsigned x; volatile LAS unsigned* st; };
__device__ __forceinline__ XcdBarrier xcd_barrier_post(unsigned* bar, volatile LAS unsigned* st, int tid) {
    XcdBarrier b; b.bar = bar; b.x = xb_xcc_id(); b.st = st;
    if (tid == 0) (void)xb_add(&bar[XB_XCNT(b.x)], 1u);
    return b;
}
__device__ __forceinline__ void xcd_barrier_complete(unsigned* bar, unsigned x, unsigned& nloc, unsigned& nx) {
    const unsigned G = gridDim.x * gridDim.y * gridDim.z;
    unsigned sum, cnt, mine, sp = 0u;
    for (;;) {
        sum = 0u; cnt = 0u; mine = 0u;
#pragma unroll
        for (unsigned j = 0; j < 16; ++j) { const unsigned c = xb_ld(&bar[XB_XCNT(j)]); sum += c; cnt += (c > 0u) ? 1u : 0u; mine = (j == x) ? c : mine; }
        if (sum == G) break;
        __builtin_amdgcn_s_sleep(1);
        if ((++sp & 255u) == 0u) { if (xb_ld(&bar[XB_TMO])) break; if (sp > XB_SPIN_CAP) { atomicAdd(&bar[XB_TMO], 1u); break; } }
    }
    nloc = mine > 0u ? mine : 1u; nx = cnt > 0u ? cnt : 1u;
}
__device__ __forceinline__ void xcd_barrier(const XcdBarrier& b, int tid) {
    asm volatile("s_waitcnt vmcnt(0)" ::: "memory");
    __syncthreads();
    if (tid == 0) {
        unsigned* bar = b.bar;
        __builtin_amdgcn_s_waitcnt(0);
        unsigned nloc = b.st[0], nx = b.st[1];
        if (nloc == 0u) { xcd_barrier_complete(bar, b.x, nloc, nx); b.st[0] = nloc; b.st[1] = nx; }
        const unsigned old = xb_add(&bar[XB_XSUB(b.x)], 1u);
        const unsigned gen = old / nloc;
        if (old + 1u == (gen + 1u) * nloc) {
            __builtin_amdgcn_fence(__ATOMIC_RELEASE, "agent");
            asm volatile("s_waitcnt vmcnt(0)" ::: "memory");
            const unsigned og = xb_add(&bar[XB_TOP], 1u);
            const unsigned tg = og / nx;
            if (og + 1u == (tg + 1u) * nx) xb_add(&bar[XB_TOPGEN], 1u);
            else XB_SPIN(xb_ld(&bar[XB_TOPGEN]) == tg, bar);
            __builtin_amdgcn_fence(__ATOMIC_ACQUIRE, "agent");
            xb_add(&bar[XB_XGEN(b.x)], 1u);
            asm volatile("s_waitcnt vmcnt(0)" ::: "memory");
        } else {
            XB_SPIN(xb_ld(&bar[XB_XGEN(b.x)]) == gen, bar);
            __builtin_amdgcn_fence(__ATOMIC_ACQUIRE, "agent");
            asm volatile("s_waitcnt vmcnt(0)" ::: "memory");
        }
    }
    __syncthreads();
}

struct Args { const void* in[17]; float* out; unsigned char* ws; int ph_lo, ph_hi, li, pad; };
enum { IN_X = 0, IN_POS, IN_GPRE, IN_WIN, IN_CW, IN_CB, IN_BI, IN_BF, IN_GMH, IN_GRH, IN_WOUT, IN_GPOST, IN_GFPRE, IN_WG, IN_WU, IN_WDN, IN_GFPOST };

struct TrItem { const float* W; bf16* WT; const float* gk; float sc; int K, ldw, src_col, dst_row, kb; };
DI void p0_tr_load(const TrItem& it, int lane, f32x4 (&v)[8]) {
    const float* src = it.W + (size_t)(64 * it.kb + (lane >> 3)) * it.ldw + it.src_col + 4 * (lane & 7);
#pragma unroll
    for (int i = 0; i < 8; ++i) v[i] = *(const GAS f32x4*)(src + (size_t)(8 * i) * it.ldw);
    if (it.gk) {
#pragma unroll
        for (int i = 0; i < 8; ++i) v[i] = v[i] * it.gk[64 * it.kb + (lane >> 3) + 8 * i]; }
    if (it.sc != 1.0f) {
#pragma unroll
        for (int i = 0; i < 8; ++i) v[i] = v[i] * it.sc; }
}
DI void p0_tr_store(const TrItem& it, int lane, const f32x4 (&v)[8], LAS float* scr) {
#pragma unroll
    for (int i = 0; i < 8; ++i) *(LAS f32x4*)(scr + (8 * i + (lane >> 3)) * 36 + 4 * (lane & 7)) = v[i];
    LDS_WAIT(); asm volatile("" ::: "memory");
    const int c = lane & 7;
#pragma unroll
    for (int j = 0; j < 4; ++j) { const int n = (lane >> 3) + 8 * j; const LAS float* sp = scr + (8 * c) * 36 + n;
        u32x4 o; o.x = pk2(sp[0 * 36], sp[1 * 36]); o.y = pk2(sp[2 * 36], sp[3 * 36]); o.z = pk2(sp[4 * 36], sp[5 * 36]); o.w = pk2(sp[6 * 36], sp[7 * 36]);
        *(GAS u32x4*)(it.WT + (size_t)(it.dst_row + n) * it.K + 64 * it.kb + 8 * c) = o; }
    LDS_WAIT(); asm volatile("" ::: "memory");
}
constexpr int I_IN = 32 * 256, I_O = 32 * 64, I_G = 32 * 176, I_D = 88 * 64;
DI TrItem tr_item(const Args& a, int set, int r) {
    TrItem it; it.gk = nullptr; it.sc = 1.0f;
    if (set == 0) { const int kb = r / 256, nb = r % 256; it.W = (const float*)a.in[IN_WIN]; it.WT = (bf16*)(a.ws + WS_WIN); it.K = DM; it.ldw = DPROJ; it.src_col = nb < 128 ? 32 * nb : 4112 + 32 * (nb - 128); it.dst_row = 32 * nb; it.kb = kb; if ((nb & 127) >= 96) it.sc = NLOG2E; return it; }
    if (r < I_O) { const int kb = r / 64, nb = r % 64; it.W = (const float*)a.in[IN_WOUT]; it.WT = (bf16*)(a.ws + WS_WO); it.K = DM; it.ldw = DM; it.src_col = 32 * nb; it.dst_row = 32 * nb; it.kb = kb; return it; } r -= I_O;
    if (r < I_G) { const int kb = r / 176, nb = r % 176; it.W = (const float*)a.in[IN_WG]; it.gk = (const float*)a.in[IN_GFPRE]; it.WT = (bf16*)(a.ws + WS_WGU); it.K = DM; it.ldw = DFF; it.src_col = 32 * nb; it.dst_row = 256 * (nb >> 2) + 32 * (nb & 3); it.kb = kb; it.sc = NLOG2E; return it; } r -= I_G;
    if (r < I_G) { const int kb = r / 176, nb = r % 176; it.W = (const float*)a.in[IN_WU]; it.gk = (const float*)a.in[IN_GFPRE]; it.WT = (bf16*)(a.ws + WS_WGU); it.K = DM; it.ldw = DFF; it.src_col = 32 * nb; it.dst_row = 256 * (nb >> 2) + 128 + 32 * (nb & 3); it.kb = kb; it.sc = NLN2; return it; } r -= I_G;
    { const int kb = r / 64, nb = r % 64; it.W = (const float*)a.in[IN_WDN]; it.WT = (bf16*)(a.ws + WS_WD); it.K = DFF; it.ldw = DM; it.src_col = 32 * nb; it.dst_row = 32 * nb; it.kb = kb; return it; }
}
DI void convert_weights(const Args& a, ldsp lds, int set, int lane, int wave, int vcu, int G) {
    const int gw = vcu * NWAVES + wave, NGW = G * NWAVES, nitems = set == 0 ? I_IN : I_O + 2 * I_G + I_D;
    LAS float* scr = (LAS float*)(lds + wave * 16384);
    f32x4 va[8], vb[8];
    int it = gw; if (it < nitems) p0_tr_load(tr_item(a, set, it), lane, va);
    for (; it < nitems; it += 2 * NGW) {
        if (it + NGW < nitems) p0_tr_load(tr_item(a, set, it + NGW), lane, vb);
        p0_tr_store(tr_item(a, set, it), lane, va, scr);
        if (it + 2 * NGW < nitems) p0_tr_load(tr_item(a, set, it + 2 * NGW), lane, va);
        if (it + NGW < nitems) p0_tr_store(tr_item(a, set, it + NGW), lane, vb, scr);
    }
}
DI void phase_p0(const Args& a, ldsp lds, int tid, int lane, int wave, int vcu, int G) {
    const int gw = vcu * NWAVES + wave, NGW = G * NWAVES;
    const float* x = (const float*)a.in[IN_X]; const float* gpre = (const float*)a.in[IN_GPRE]; const float* w_in = (const float*)a.in[IN_WIN];
    bf16* hb = (bf16*)(a.ws + WS_A); float* PRE = (float*)(a.ws + WS_PRE);
    LAS unsigned short* Wf = (LAS unsigned short*)lds;
#pragma unroll 4
    for (int i = 0; i < 16; ++i) { const int idx = tid + NTHR * i, k = idx >> 2, c4 = idx & 3;
        const f32x4 w = *(const GAS f32x4*)(w_in + (size_t)k * DPROJ + 4096 + 4 * c4);
        LAS unsigned short* d = Wf + ((k >> 5) * 64 + ((k >> 3) & 3) * 16 + 4 * c4) * 8 + (k & 7);
        d[0] = (unsigned short)f2bf(w.x); d[8] = (unsigned short)f2bf(w.y); d[16] = (unsigned short)f2bf(w.z); d[24] = (unsigned short)f2bf(w.w); }
    LDS_WAIT(); __syncthreads();
    LAS float* part = (LAS float*)(lds + 65536);
    for (int rb = vcu; rb < SEQ / 64; rb += G) {
        {
            f32x4 ggv[8]; { const GAS f32x4* gr = (const GAS f32x4*)gpre + lane;
#pragma unroll
              for (int j = 0; j < 8; ++j) ggv[j] = gr[64 * j]; }
#define P0_LOAD(buf, mm) do { const GAS f32x4* xr_ = (const GAS f32x4*)(x + (size_t)(mm) * DM) + lane; _Pragma("unroll") for (int j = 0; j < 8; ++j) buf[j] = xr_[64 * j]; } while (0)
#define P0_ROW(buf, mm) do { float s_ = 0.f; _Pragma("unroll") for (int j = 0; j < 8; ++j) s_ += (buf[j].x * buf[j].x + buf[j].y * buf[j].y) + (buf[j].z * buf[j].z + buf[j].w * buf[j].w); \
            const float r_ = 1.0f / sqrtf(wave_sum(s_) * (1.0f / DM) + NORM_EPS); GAS u32x2* o_ = (GAS u32x2*)(hb + (size_t)(mm) * DM) + lane; \
            _Pragma("unroll") for (int j = 0; j < 8; ++j) { const f32x4 gg = ggv[j]; u32x2 w; w.x = pk2(buf[j].x * r_ * gg.x, buf[j].y * r_ * gg.y); w.y = pk2(buf[j].z * r_ * gg.z, buf[j].w * r_ * gg.w); o_[64 * j] = w; } } while (0)
            f32x4 va[8], vb[8];
            const int m0 = rb * 64 + wave * 8;
            P0_LOAD(va, m0);
#pragma unroll 1
            for (int i = 0; i < 8; i += 2) {
                P0_LOAD(vb, m0 + i + 1);
                P0_ROW(va, m0 + i);
                if (i + 2 < 8) P0_LOAD(va, m0 + i + 2);
                P0_ROW(vb, m0 + i + 1);
            }
#undef P0_LOAD
#undef P0_ROW
        }
        asm volatile("s_waitcnt vmcnt(0)" ::: "memory"); __syncthreads();
        {
            const int tile = wave & 3, kh = wave >> 2, row = lane & 15, kq = lane >> 4, t0 = rb * 64 + tile * 16;
            const GAS u32x4* hr = (const GAS u32x4*)(hb + (size_t)(t0 + row) * DM + kh * 1024 + 8 * kq);
            const LAS u32x4* wf = (const LAS u32x4*)lds + (kh * 32) * 64 + lane;
            pg8::f32x4 acc = {0.f, 0.f, 0.f, 0.f};
            for (int sp = 0; sp < 32; sp += 8) { u32x4 hv[8];
#pragma unroll
                for (int j = 0; j < 8; ++j) hv[j] = hr[4 * (sp + j)];
#pragma unroll
                for (int j = 0; j < 8; ++j) acc = __builtin_amdgcn_mfma_f32_16x16x32_bf16(__builtin_bit_cast(pg8::bf16x8, hv[j]), __builtin_bit_cast(pg8::bf16x8, wf[(sp + j) * 64]), acc, 0, 0, 0);
            }
            if (kh == 1) {
#pragma unroll
                for (int j = 0; j < 4; ++j) part[(tile * 4 + j) * 64 + lane] = acc[j]; }
            LDS_WAIT(); __syncthreads();
            if (kh == 0) {
#pragma unroll
                for (int j = 0; j < 4; ++j) PRE[(size_t)(t0 + 4 * kq + j) * 16 + row] = acc[j] + part[(tile * 4 + j) * 64 + lane]; }
            __syncthreads();
        }
    }
    __syncthreads();
    convert_weights(a, lds, 0, lane, wave, vcu, G);
    convert_weights(a, lds, 1, lane, wave, vcu, G);
    { float* GH = (float*)(a.ws + WS_GHEAD); const float* gmh = (const float*)a.in[IN_GMH]; const float* grh = (const float*)a.in[IN_GRH];
      for (int i = vcu * NTHR + tid; i < 1024; i += G * NTHR) GH[i] = gmh[i];
      for (int i = vcu * NTHR + tid; i < 1024; i += G * NTHR) GH[1024 + i] = grh[i]; }
    const int* pos = (const int*)a.in[IN_POS]; float* COS = (float*)(a.ws + WS_COS); float* SIN = (float*)(a.ws + WS_SIN);
    { LAS float* invf = (LAS float*)(lds + GATE_OFF);
      if (tid < 64) invf[tid] = (float)pow(10000.0, -(double)(2 * tid) / 128.0);
      LDS_WAIT(); __syncthreads();
      for (int i = vcu * NTHR + tid; i < SEQ * 64; i += G * NTHR) { const int t = i >> 6, j = i & 63;
          const float ang = (float)pos[t] * invf[j];
          double rev = (double)ang * 0.15915494309189533577; rev -= __builtin_rint(rev); const float fr = (float)rev;
          COS[i] = __builtin_amdgcn_cosf(fr); SIN[i] = __builtin_amdgcn_sinf(fr); } }
}

typedef short bf16x8 __attribute__((ext_vector_type(8)));
typedef short s16x4 __attribute__((ext_vector_type(4)));
typedef float f32x16 __attribute__((ext_vector_type(16)));
#define MFMA32(a, b, c) __builtin_amdgcn_mfma_f32_32x32x16_bf16((a), (b), (c), 0, 0, 0)
DI int crow(int reg, int h) { return (reg & 3) + 8 * (reg >> 2) + 4 * h; }
DI bf16x8 bf_ones() { return (bf16x8){16256, 16256, 16256, 16256, 16256, 16256, 16256, 16256}; }
DI int offb(int row, int ch) { return 256 * row + 16 * (ch ^ (((row & 3) << 2) | ((row >> 2) & 3))); }
DI int rowbase(int row, int h) { return offb(row, h); }
DI bf16x8 rowfrag(ldsp tile, int rb, int ks) { return *(const LAS bf16x8*)(tile + (rb ^ (ks << 5))); }
DI s16x4 tr_rd(ldsp p) { return __builtin_bit_cast(s16x4, __builtin_amdgcn_ds_read_tr16_b64_v4i16((LAS s16x4*)p)); }
struct TrB { int b0, b1; };
DI TrB trbase(int c, int lane) {
    const int h = lane >> 5, blk = (lane >> 4) & 1, q = (lane & 15) >> 2, p = lane & 3, ch = 4 * c + 2 * blk + (p >> 1);
    TrB b; b.b0 = offb(8 * h + q, ch) + 8 * (p & 1); b.b1 = offb(8 * h + 4 + q, ch) + 8 * (p & 1); return b;
}
DI bf16x8 trfrag(ldsp tile, const TrB b, int ks) {
    const s16x4 lo = tr_rd(tile + b.b0 + 4096 * ks), hi = tr_rd(tile + b.b1 + 4096 * ks);
    return __builtin_shufflevector(lo, hi, 0, 1, 2, 3, 4, 5, 6, 7);
}
DI void gload8(const bf16* p, float (&f)[8]) { unpack8(*(const GAS u32x4*)p, f); }

constexpr int NGROUPS = 256, GM = 18, GR = 14;
struct Grp { int g, grp, c0, nch, base; };
DI Grp grp_of(int cg) { Grp r;
    if (cg < NHG * GM) { r.g = cg / GM; r.grp = cg % GM; r.base = r.g * GM; r.c0 = r.grp < 2 ? 8 * r.grp : 16 + 7 * (r.grp - 2); r.nch = r.grp < 2 ? 8 : 7; }
    else { const int q = cg - NHG * GM; r.g = NHG + q / GR; r.grp = q % GR; r.base = NHG * GM + (r.g - NHG) * GR; r.c0 = r.grp < 2 ? 10 * r.grp : 20 + 9 * (r.grp - 2); r.nch = r.grp < 2 ? 10 : 9; }
    return r; }
constexpr float KSCALE = 0.08838834764831845f;
DI void mixer_setup(const Args& a, ldsp lds, int g, int c0, int nch, int tid, int lane, int wave) {
    if (g < NHG) {
      if (wave < nch) {
        LAS float* rowv = (LAS float*)(lds + GATE_OFF + wave * 1536); LAS float* colv = rowv + 128; LAS float* alog = rowv + 256;
        const float* PRE = (const float*)(a.ws + WS_PRE); const float bi = ((const float*)a.in[IN_BI])[g], bfg = ((const float*)a.in[IN_BF])[g];
        const int t0 = (c0 + wave) * CH + 2 * lane;
        const float i0 = PRE[(size_t)t0 * 16 + g] + bi, i1 = PRE[(size_t)(t0 + 1) * 16 + g] + bi;
        const float f0 = PRE[(size_t)t0 * 16 + 8 + g] + bfg, f1 = PRE[(size_t)(t0 + 1) * 16 + 8 + g] + bfg;
        const float l0 = fminf(f0, 0.f) - log1pf(__expf(-fabsf(f0))), l1 = fminf(f1, 0.f) - log1pf(__expf(-fabsf(f1)));
        float p = l0 + l1;
#pragma unroll
        for (int o = 1; o < 64; o <<= 1) { const float y = __shfl_up(p, o); if (lane >= o) p += y; }
        const float b1 = p, b0 = p - l1, rv127 = __shfl(b1, 63);
        rowv[2 * lane] = __expf(b0 - rv127); rowv[2 * lane + 1] = __expf(b1 - rv127); alog[2 * lane] = __expf(b0); alog[2 * lane + 1] = __expf(b1);
        colv[2 * lane] = (NLN2 * KSCALE) * __expf(rv127 + (i0 - b0)); colv[2 * lane + 1] = (NLN2 * KSCALE) * __expf(rv127 + (i1 - b1));
      }
        if (tid < 128) { LAS float* cwl = (LAS float*)(lds + CONVW_OFF); const float* cw = (const float*)a.in[IN_CW]; const float* cb = (const float*)a.in[IN_CB];
#pragma unroll
            for (int j = 0; j < 4; ++j) { cwl[j * 128 + tid] = NLOG2E * cw[j * 2048 + g * HD + tid]; cwl[640 + j * 128 + tid] = NLOG2E * cw[j * 2048 + 1024 + g * HD + tid]; }
            cwl[512 + tid] = NLOG2E * cb[g * HD + tid]; cwl[640 + 512 + tid] = NLOG2E * cb[1024 + g * HD + tid]; }
    } else if (tid < 128) {
        LAS float* rowv = (LAS float*)(lds + GATE_OFF); LAS float* colv = rowv + 128; LAS float* alog = rowv + 256;
        const float lg = log1pf(-exp2f(-5.0f - (float)(g - NHG)));
        rowv[tid] = __expf((float)tid * lg - 127.0f * lg); colv[tid] = KSCALE * __expf(127.0f * lg + (-(float)tid * lg)); alog[tid] = __expf((float)(tid + 1) * lg);
    }
    if (tid >= 128 && tid < 256) { const int e = tid - 128; ((LAS float*)(lds + GHL_OFF))[e] = ((const float*)(a.ws + WS_GHEAD))[g * HD + e] * (g < NHG ? 1.0f : NLN2); }
    LDS_WAIT(); __syncthreads();
}
#define RAW_BARRIER() do { asm volatile("s_waitcnt lgkmcnt(0)" ::: "memory"); __builtin_amdgcn_s_barrier(); asm volatile("" ::: "memory"); } while (0)
template <bool ML> struct KvRegs { u32x4 x[ML ? 7 : 12]; u32x4 v[4]; };
template <bool ML> DI void kv_load(const Args& a, int g, int c, int tid, KvRegs<ML>& R) {
    const bf16* proj = (const bf16*)(a.ws + WS_B);
    const int sq = tid >> 4, dg = tid & 15, tb = c * CH + 4 * sq;
    { const bf16* pv = proj + (size_t)(ML ? PC_MV + g * HD : PC_RV + (g - NHG) * HD) * SEQ + 8 * dg;
#pragma unroll
      for (int i = 0; i < 4; ++i) R.v[i] = *(const GAS u32x4*)(pv + (size_t)(tb + i) * 128); }
    if constexpr (ML) {
        const bf16* pk = proj + (size_t)(PC_MK + g * HD) * SEQ + 8 * dg;
#pragma unroll
        for (int j = 0; j < 7; ++j) { const int tt = tb - 3 + j, tc = tt < 0 ? 0 : tt; R.x[j] = *(const GAS u32x4*)(pk + (size_t)tc * 128); }
    } else {
        const int gr = g - NHG; const float* COS = (const float*)(a.ws + WS_COS); const float* SIN = (const float*)(a.ws + WS_SIN);
        const int s2 = tid >> 3, dgp = tid & 7;
#pragma unroll
        for (int i = 0; i < 2; ++i) { const size_t t = (size_t)(c * CH + 2 * s2 + i); const bf16* pr = proj + (size_t)(PC_RK + gr * HD) * SEQ + t * 128 + 8 * dgp;
            R.x[i] = *(const GAS u32x4*)pr; R.x[2 + i] = *(const GAS u32x4*)(pr + 64);
            R.x[4 + 4 * i] = *(const GAS u32x4*)(COS + t * 64 + 8 * dgp); R.x[5 + 4 * i] = *(const GAS u32x4*)(COS + t * 64 + 8 * dgp + 4);
            R.x[6 + 4 * i] = *(const GAS u32x4*)(SIN + t * 64 + 8 * dgp); R.x[7 + 4 * i] = *(const GAS u32x4*)(SIN + t * 64 + 8 * dgp + 4); }
    }
}
template <bool ML> DI void kv_build(ldsp lds, int g, const LAS float* gt, int tid, const KvRegs<ML>& R, bool seq_start) {
    const LAS float* sck = gt + 128;
    ldsp K = lds + 32768;
    const int sq = tid >> 4, dg = tid & 15;
    if constexpr (ML) {
        const LAS float* wl = (const LAS float*)(lds + CONVW_OFF) + 640 + 8 * dg;
        const u32x4 zz = {0u, 0u, 0u, 0u};
        const u32x4 rr[7] = {(seq_start && sq == 0) ? zz : R.x[0], (seq_start && sq == 0) ? zz : R.x[1], (seq_start && sq == 0) ? zz : R.x[2], R.x[3], R.x[4], R.x[5], R.x[6]};
#pragma unroll
        for (int i = 0; i < 4; ++i) { float acc[8];
            { const f32x4 w0 = *(const LAS f32x4*)(wl + 512), w1 = *(const LAS f32x4*)(wl + 516); acc[0] = w0.x; acc[1] = w0.y; acc[2] = w0.z; acc[3] = w0.w; acc[4] = w1.x; acc[5] = w1.y; acc[6] = w1.z; acc[7] = w1.w; }
#pragma unroll
            for (int j = 0; j < 4; ++j) { float uu[8]; unpack8(rr[i + j], uu);
                const f32x4 w0 = *(const LAS f32x4*)(wl + j * 128), w1 = *(const LAS f32x4*)(wl + j * 128 + 4);
                acc[0] = __builtin_fmaf(w0.x, uu[0], acc[0]); acc[1] = __builtin_fmaf(w0.y, uu[1], acc[1]); acc[2] = __builtin_fmaf(w0.z, uu[2], acc[2]); acc[3] = __builtin_fmaf(w0.w, uu[3], acc[3]); acc[4] = __builtin_fmaf(w1.x, uu[4], acc[4]); acc[5] = __builtin_fmaf(w1.y, uu[5], acc[5]); acc[6] = __builtin_fmaf(w1.z, uu[6], acc[6]); acc[7] = __builtin_fmaf(w1.w, uu[7], acc[7]); }
            const int srow = 4 * sq + i; const float sc = sck[srow];
#pragma unroll
            for (int e = 0; e < 8; ++e) acc[e] = acc[e] * sig2(acc[e]) * sc;
            *(LAS u32x4*)(K + offb(srow, dg)) = pack8(acc); }
    } else {
        const int s2 = tid >> 3, dgp = tid & 7;
#pragma unroll
        for (int i = 0; i < 2; ++i) { const int srow = 2 * s2 + i;
            const f32x4 cA = __builtin_bit_cast(f32x4, R.x[4 + 4 * i]), cB = __builtin_bit_cast(f32x4, R.x[5 + 4 * i]), sA = __builtin_bit_cast(f32x4, R.x[6 + 4 * i]), sB = __builtin_bit_cast(f32x4, R.x[7 + 4 * i]);
            const float c8[8] = {cA.x, cA.y, cA.z, cA.w, cB.x, cB.y, cB.z, cB.w};
            const float s8[8] = {sA.x, sA.y, sA.z, sA.w, sB.x, sB.y, sB.z, sB.w};
            float lo[8], hi[8], olo[8], ohi[8]; unpack8(R.x[i], lo); unpack8(R.x[2 + i], hi);
            const float sc = sck[srow];
#pragma unroll
            for (int e = 0; e < 8; ++e) { olo[e] = __builtin_fmaf(lo[e], c8[e], -hi[e] * s8[e]) * sc; ohi[e] = __builtin_fmaf(hi[e], c8[e], lo[e] * s8[e]) * sc; }
            *(LAS u32x4*)(K + offb(srow, dgp)) = pack8(olo); *(LAS u32x4*)(K + offb(srow, 8 + dgp)) = pack8(ohi); }
    }
#pragma unroll
    for (int i = 0; i < 4; ++i) *(LAS u32x4*)(lds + 65536 + offb(4 * sq + i, dg)) = R.v[i];
}
template <bool ML> DI void m1_group(const Args& a, ldsp lds, int tid_in, int wave, int cg, const Grp gi) {
    float* UG = (float*)(a.ws + WS_A); float* NG = (float*)(a.ws + WS_NLOC); float* DG = (float*)(a.ws + WS_DEC);
    ldsp K = lds + 32768; const int wi = wave >> 1, wj = wave & 1;
    { const int g = gi.g; constexpr bool ml = ML;
        KvRegs<ML> RA, RB; kv_load<ML>(a, g, gi.c0, tid_in, RA); kv_load<ML>(a, g, gi.c0 + 1, tid_in, RB);
        { int tid_g = tid_in; asm volatile("" : "+v"(tid_g)); mixer_setup(a, lds, g, gi.c0, gi.nch, tid_g, tid_g & 63, wave); }
        f32x16 accU[2], accN; float dprod = 1.0f;
#pragma unroll
        for (int i = 0; i < 16; ++i) { accU[0][i] = 0.f; accU[1][i] = 0.f; accN[i] = 0.f; }
#define M1_CHUNK(RS, CI, VB) do { const int ci_ = (CI), c = gi.c0 + ci_; \
            int tid_o = tid_in; asm volatile("" : "+v"(tid_o));             \
            const int tid = tid_o, lane = tid & 63; \
            const LAS float* gt = (const LAS float*)(lds + GATE_OFF + (ml ? ci_ : 0) * 1536); \
            kv_build<ML>(lds, g, gt, tid, RS, c == 0); \
            kv_load<ML>(a, g, ci_ + 2 < gi.nch ? c + 2 : gi.c0 + gi.nch - 1, tid, RS);       \
            RAW_BARRIER(); \
            const float dec = gt[256 + 127]; dprod *= dec; \
            accU[0] = accU[0] * dec; accU[1] = accU[1] * dec; accN = accN * dec; \
            { const TrB tk = trbase(wi, lane), tv0 = trbase(2 * wj, lane), tv1 = trbase(2 * wj + 1, lane); ldsp V = lds + 65536;     \
              if (ml && wj == 0) { \
                  _Pragma("unroll") for (int ks = 0; ks < 8; ++ks) { const bf16x8 af = trfrag(K, tk, ks), b0 = trfrag(V, tv0, ks), b1 = trfrag(V, tv1, ks); \
                      accU[0] = MFMA32(af, b0, accU[0]); accU[1] = MFMA32(af, b1, accU[1]); accN = MFMA32(af, bf_ones(), accN); } \
              } else { \
                  _Pragma("unroll") for (int ks = 0; ks < 8; ++ks) { const bf16x8 af = trfrag(K, tk, ks), b0 = trfrag(V, tv0, ks), b1 = trfrag(V, tv1, ks); \
                      accU[0] = MFMA32(af, b0, accU[0]); accU[1] = MFMA32(af, b1, accU[1]); } \
              } \
            } \
            RAW_BARRIER(); } while (0)
        for (int ci = 0; ci + 1 < gi.nch; ci += 2) { M1_CHUNK(RA, ci, 0); M1_CHUNK(RB, ci + 1, 1); }
        if (gi.nch & 1) M1_CHUNK(RA, gi.nch - 1, 0);
#undef M1_CHUNK
        { int tid_o = tid_in; asm volatile("" : "+v"(tid_o)); const int lane = tid_o & 63, r = lane & 31, h = lane >> 5;
          float* o = UG + ((size_t)cg << 14) + wave * 2048 + lane;
#pragma unroll
          for (int n = 0; n < 2; ++n)
#pragma unroll
              for (int i = 0; i < 16; ++i) o[(n * 16 + i) * 64] = accU[n][i];
          if (ml && wj == 0 && r == 0) {
#pragma unroll
              for (int i = 0; i < 16; ++i) NG[(size_t)cg * HD + 32 * wi + crow(i, h)] = accN[i]; }
          if (tid_in == 0) DG[cg] = dprod; }
    }
}
DI void phase_m1(const Args& a, ldsp lds, int tid_in, int wave, int vcu, int G) {
    for (int cg = vcu; cg < NGROUPS; cg += G) { const Grp gi = grp_of(cg);
        if (gi.g < NHG) m1_group<true>(a, lds, tid_in, wave, cg, gi); else m1_group<false>(a, lds, tid_in, wave, cg, gi); }
}
constexpr int HALO_OFF = MISC_OFF + 1024;
static_assert(HALO_OFF + 3072 <= LDS_BYTES, "LDS map");
DI void m3_stage(const Args& a, ldsp lds, int g, int c, int lane, int wave) {
    const bf16* proj = (const bf16*)(a.ws + WS_B);
    const int colq = g < NHG ? PC_MQ + g * HD : PC_RQ + (g - NHG) * HD, colk = g < NHG ? PC_MK + g * HD : PC_RK + (g - NHG) * HD;
    const bf16* base = proj + (size_t)(wave >= 4 ? colk : colq) * SEQ + (size_t)(c * CH + (lane >> 4)) * 128 + 8 * (lane & 15);
#pragma unroll
    for (int k = 0; k < 8; ++k) { const int p = wave * 8 + k;
        __builtin_amdgcn_global_load_lds((const unsigned*)(base + (size_t)(4 * (p & 31)) * 128), (LAS unsigned*)(lds + 65536 + p * 1024), 16, 0, 0); }
}
DI void m3_build_qk(const Args& a, ldsp lds, int g, int c, int par, const LAS float* gt, int tid, u32x4 (&vv)[4]) {
    const bf16* proj = (const bf16*)(a.ws + WS_B);
    const LAS float* sck = gt + 128;
    ldsp Q = lds, K = lds + 32768, SQ = lds + 65536, SK = lds + 98304, HAL = lds + HALO_OFF;
    const int sq = tid >> 4, dg = tid & 15, tb = c * CH + 4 * sq;
    if (g < NHG) {
        const bf16* pv = proj + (size_t)(PC_MV + g * HD) * SEQ + 8 * dg;
#pragma unroll
        for (int i = 0; i < 4; ++i) vv[i] = *(const GAS u32x4*)(pv + (size_t)(tb + i) * 128);
        const LAS float* cwl = (const LAS float*)(lds + CONVW_OFF);
#pragma unroll
        for (int qk = 0; qk < 2; ++qk) {
            ldsp S = qk == 0 ? SK : SQ; ldsp H = HAL + par * 1536 + (qk == 0 ? 768 : 0);
            u32x4 rr[7];
#pragma unroll
            for (int j = 0; j < 7; ++j) { const int row = 4 * sq - 3 + j;
                if (j < 3) rr[j] = row >= 0 ? *(const LAS u32x4*)(S + row * 256 + 16 * dg) : *(const LAS u32x4*)(H + (row + 3) * 256 + 16 * dg);
                else rr[j] = *(const LAS u32x4*)(S + row * 256 + 16 * dg); }
            if (sq == 31) { ldsp Hn = HAL + (par ^ 1) * 1536 + (qk == 0 ? 768 : 0);
#pragma unroll
                for (int j = 0; j < 3; ++j) *(LAS u32x4*)(Hn + j * 256 + 16 * dg) = rr[4 + j]; }
            const LAS float* wl = cwl + (qk == 0 ? 640 : 0) + 8 * dg;
            float w[5][8];
#pragma unroll
            for (int j = 0; j < 5; ++j) { const f32x4 w0 = *(const LAS f32x4*)(wl + j * 128), w1 = *(const LAS f32x4*)(wl + j * 128 + 4); w[j][0] = w0.x; w[j][1] = w0.y; w[j][2] = w0.z; w[j][3] = w0.w; w[j][4] = w1.x; w[j][5] = w1.y; w[j][6] = w1.z; w[j][7] = w1.w; }
#pragma unroll
            for (int i = 0; i < 4; ++i) { float acc[8];
#pragma unroll
                for (int e = 0; e < 8; ++e) acc[e] = w[4][e];
#pragma unroll
                for (int j = 0; j < 4; ++j) { float uu[8]; unpack8(rr[i + j], uu);
#pragma unroll
                    for (int e = 0; e < 8; ++e) acc[e] = __builtin_fmaf(w[j][e], uu[e], acc[e]); }
                const int srow = 4 * sq + i; const float sc = qk == 0 ? sck[srow] : NLN2;
#pragma unroll
                for (int e = 0; e < 8; ++e) acc[e] = acc[e] * sig2(acc[e]) * sc;
                *(LAS u32x4*)((qk == 0 ? K : Q) + offb(srow, dg)) = pack8(acc); }
        }
    } else {
        const int gr = g - NHG; const float* COS = (const float*)(a.ws + WS_COS); const float* SIN = (const float*)(a.ws + WS_SIN);
        const int s2 = tid >> 3, dgp = tid & 7; const bf16* pv = proj + (size_t)(PC_RV + gr * HD) * SEQ + 8 * dg;
        f32x4 cs[2][2], sn[2][2];
#pragma unroll
        for (int i = 0; i < 2; ++i) { const size_t t = (size_t)(c * CH + 2 * s2 + i);
            cs[i][0] = *(const GAS f32x4*)(COS + t * 64 + 8 * dgp); cs[i][1] = *(const GAS f32x4*)(COS + t * 64 + 8 * dgp + 4);
            sn[i][0] = *(const GAS f32x4*)(SIN + t * 64 + 8 * dgp); sn[i][1] = *(const GAS f32x4*)(SIN + t * 64 + 8 * dgp + 4); }
#pragma unroll
        for (int i = 0; i < 4; ++i) vv[i] = *(const GAS u32x4*)(pv + (size_t)(tb + i) * 128);
#pragma unroll
        for (int i = 0; i < 2; ++i) { const int srow = 2 * s2 + i;
            const float c8[8] = {cs[i][0].x, cs[i][0].y, cs[i][0].z, cs[i][0].w, cs[i][1].x, cs[i][1].y, cs[i][1].z, cs[i][1].w};
            const float s8[8] = {sn[i][0].x, sn[i][0].y, sn[i][0].z, sn[i][0].w, sn[i][1].x, sn[i][1].y, sn[i][1].z, sn[i][1].w};
            float lo[8], hi[8], olo[8], ohi[8];
            unpack8(*(const LAS u32x4*)(SK + srow * 256 + 16 * dgp), lo); unpack8(*(const LAS u32x4*)(SK + srow * 256 + 128 + 16 * dgp), hi);
            const float sc = sck[srow];
#pragma unroll
            for (int e = 0; e < 8; ++e) { olo[e] = __builtin_fmaf(lo[e], c8[e], -hi[e] * s8[e]) * sc; ohi[e] = __builtin_fmaf(hi[e], c8[e], lo[e] * s8[e]) * sc; }
            *(LAS u32x4*)(K + offb(srow, dgp)) = pack8(olo); *(LAS u32x4*)(K + offb(srow, 8 + dgp)) = pack8(ohi);
            unpack8(*(const LAS u32x4*)(SQ + srow * 256 + 16 * dgp), lo); unpack8(*(const LAS u32x4*)(SQ + srow * 256 + 128 + 16 * dgp), hi);
#pragma unroll
            for (int e = 0; e < 8; ++e) { olo[e] = __builtin_fmaf(lo[e], c8[e], -hi[e] * s8[e]); ohi[e] = __builtin_fmaf(hi[e], c8[e], lo[e] * s8[e]); }
            *(LAS u32x4*)(Q + offb(srow, dgp)) = pack8(olo); *(LAS u32x4*)(Q + offb(srow, 8 + dgp)) = pack8(ohi); }
    }
}
DI void phase_m3(const Args& a, ldsp lds, int tid_in, int wave, int vcu, int G) {
    const bf16* proj = (const bf16*)(a.ws + WS_B); const float* UG = (const float*)(a.ws + WS_A); const float* NG = (const float*)(a.ws + WS_NLOC); const float* DG = (const float*)(a.ws + WS_DEC);
    bf16* mixb = (bf16*)a.out;
    LAS unsigned short* n0b = (LAS unsigned short*)(lds + N0B_OFF);
    ldsp Q = lds, K = lds + 32768, V = lds + 65536, C0 = lds + 98304, P = lds + 98304; LAS float* H = (LAS float*)lds;
    const int wi = wave >> 1, wj = wave & 1;
    for (int cg = vcu; cg < NGROUPS; cg += G) { const Grp gi = grp_of(cg); const int g = gi.g, grp = gi.grp; const bool ml = g < NHG;
        { int tid_s = tid_in; asm volatile("" : "+v"(tid_s));
          m3_stage(a, lds, g, gi.c0, tid_s & 63, wave);
          if (tid_s < 96) { const int which = tid_s / 48, j = (tid_s % 48) >> 4, dgh = tid_s & 15; const int t = gi.c0 * CH - 3 + j;
              u32x4 hv = {0u, 0u, 0u, 0u};
              if (ml && t >= 0) hv = *(const GAS u32x4*)(proj + (size_t)((which ? PC_MK : PC_MQ) + g * HD) * SEQ + (size_t)t * 128 + 8 * dgh);
              *(LAS u32x4*)(lds + HALO_OFF + (which ? 768 : 0) + j * 256 + 16 * dgh) = hv; } }
        { int tid_g = tid_in; asm volatile("" : "+v"(tid_g)); mixer_setup(a, lds, g, gi.c0, gi.nch, tid_g, tid_g & 63, wave); }
        f32x16 accC[2]; LAS float* nstate = (LAS float*)(lds + NST_OFF);
#pragma unroll
        for (int i = 0; i < 16; ++i) { accC[0][i] = 0.f; accC[1][i] = 0.f; }
        { int tid_o = tid_in; asm volatile("" : "+v"(tid_o)); const int lane = tid_o & 63;
          float nn = 0.f;
          for (int j = 0; j < grp; ++j) { const float* us = UG + ((size_t)(gi.base + j) << 14) + wave * 2048 + lane; const float dj = DG[gi.base + j];
#pragma unroll
              for (int i = 0; i < 16; ++i) { accC[0][i] = dj * accC[0][i] + us[i * 64]; accC[1][i] = dj * accC[1][i] + us[(16 + i) * 64]; }
              if (ml && tid_o < 128) nn = dj * nn + NG[(size_t)(gi.base + j) * HD + tid_o]; }
          if (tid_o < 128) nstate[tid_o] = nn;
          }
        asm volatile("s_waitcnt vmcnt(0)" ::: "memory"); LDS_WAIT(); __syncthreads();
        for (int ci = 0; ci < gi.nch; ++ci) { const int c = gi.c0 + ci;
            int tid_o = tid_in; asm volatile("" : "+v"(tid_o));
            const int tid = tid_o, lane = tid & 63, r = lane & 31, h = lane >> 5;
            const LAS float* gt = (const LAS float*)(lds + GATE_OFF + (ml ? ci : 0) * 1536);
            u32x4 vv[4];
            m3_build_qk(a, lds, g, c, ci & 1, gt, tid, vv);
            LDS_WAIT(); __syncthreads();
#pragma unroll
            for (int i = 0; i < 4; ++i) *(LAS u32x4*)(V + offb(4 * (tid >> 4) + i, tid & 15)) = vv[i];
#pragma unroll
            for (int n = 0; n < 2; ++n) { const int e = 64 * wj + 32 * n + r;
#pragma unroll
                for (int q = 0; q < 4; ++q) { u32x2 w; w.x = pk2(accC[n][4 * q], accC[n][4 * q + 1]); w.y = pk2(accC[n][4 * q + 2], accC[n][4 * q + 3]);
                    *(LAS u32x2*)(C0 + offb(e, 4 * wi + q) + 8 * h) = w; } }
            if (tid < 128) n0b[tid] = (unsigned short)pk2(nstate[tid], nstate[tid]);
            LDS_WAIT(); __syncthreads();
            f32x16 accO[2], accS[2], accD;
#pragma unroll
            for (int i = 0; i < 16; ++i) { accO[0][i] = 0.f; accO[1][i] = 0.f; accS[0][i] = 0.f; accS[1][i] = 0.f; accD[i] = 0.f; }
            const TrB tk = trbase(wi, lane), tv0 = trbase(2 * wj, lane), tv1 = trbase(2 * wj + 1, lane);
            const int rbq = rowbase(32 * wi + r, h), rbk = rowbase(64 * wj + r, h);
            if (ml) {
#pragma unroll
                for (int ks = 0; ks < 8; ++ks) { const bf16x8 af = rowfrag(Q, rbq, ks), b0 = rowfrag(C0, rbk, ks), b1 = rowfrag(C0 + 8192, rbk, ks), bn = *(const LAS bf16x8*)(n0b + 16 * ks + 8 * h);
                    accO[0] = MFMA32(af, b0, accO[0]); accO[1] = MFMA32(af, b1, accO[1]); accD = MFMA32(af, bn, accD); }
            } else {
#pragma unroll
                for (int ks = 0; ks < 8; ++ks) { const bf16x8 af = rowfrag(Q, rbq, ks), b0 = rowfrag(C0, rbk, ks), b1 = rowfrag(C0 + 8192, rbk, ks);
                    accO[0] = MFMA32(af, b0, accO[0]); accO[1] = MFMA32(af, b1, accO[1]); }
            }
#pragma unroll
            for (int i = 0; i < 16; ++i) { const int t = 32 * wi + crow(i, h); const float al = gt[256 + t]; accO[0][i] *= al; accO[1][i] *= al; accD[i] *= al; }
#pragma unroll
            for (int ks = 0; ks < 8; ++ks) { const bf16x8 af = rowfrag(Q, rbq, ks), b0 = rowfrag(K, rbk, ks), b1 = rowfrag(K + 8192, rbk, ks);
                accS[0] = MFMA32(b0, af, accS[0]); accS[1] = MFMA32(b1, af, accS[1]); }
            __syncthreads();
            { const int t = 32 * wi + r; const float fac = gt[t];
#pragma unroll
              for (int n = 0; n < 2; ++n)
#pragma unroll
                for (int q = 0; q < 4; ++q) { const int s0 = 64 * wj + 32 * n + 8 * q + 4 * h;
                    const float v0 = (s0 <= t) ? accS[n][4 * q] * fac : 0.f, v1 = (s0 + 1 <= t) ? accS[n][4 * q + 1] * fac : 0.f, v2 = (s0 + 2 <= t) ? accS[n][4 * q + 2] * fac : 0.f, v3 = (s0 + 3 <= t) ? accS[n][4 * q + 3] * fac : 0.f;
                    u32x2 w; w.x = pk2(v0, v1); w.y = pk2(v2, v3);
                    *(LAS u32x2*)(P + offb(t, 8 * wj + 4 * n + q) + 8 * h) = w; } }
            LDS_WAIT(); __syncthreads();
            u32x4 gpre[2][2];
            { const int tl = tid >> 3, eg = tid & 7; const int gcol = ml ? PC_MO + g * HD : PC_RG + (g - NHG) * HD;
#pragma unroll
              for (int hh = 0; hh < 2; ++hh) { const bf16* gp = proj + (size_t)gcol * SEQ + (size_t)(c * CH + 64 * hh + tl) * 128 + 16 * eg; gpre[hh][0] = *(const GAS u32x4*)gp; gpre[hh][1] = *(const GAS u32x4*)(gp + 8); } }
            const float dec = gt[256 + 127]; accC[0] = accC[0] * dec; accC[1] = accC[1] * dec;
            f32x16 accN;
#pragma unroll
            for (int i = 0; i < 16; ++i) accN[i] = 0.f;
            if (ml) {
#pragma unroll
                for (int ks = 0; ks < 8; ++ks) { const bf16x8 af = rowfrag(P, rbq, ks), ak = trfrag(K, tk, ks), b0 = trfrag(V, tv0, ks), b1 = trfrag(V, tv1, ks);
                    accO[0] = MFMA32(af, b0, accO[0]); accO[1] = MFMA32(af, b1, accO[1]); accC[0] = MFMA32(ak, b0, accC[0]); accC[1] = MFMA32(ak, b1, accC[1]);
                    accD = MFMA32(af, bf_ones(), accD); accN = MFMA32(ak, bf_ones(), accN); }
            } else {
#pragma unroll
                for (int ks = 0; ks < 8; ++ks) { const bf16x8 af = rowfrag(P, rbq, ks), ak = trfrag(K, tk, ks), b0 = trfrag(V, tv0, ks), b1 = trfrag(V, tv1, ks);
                    accO[0] = MFMA32(af, b0, accO[0]); accO[1] = MFMA32(af, b1, accO[1]); accC[0] = MFMA32(ak, b0, accC[0]); accC[1] = MFMA32(ak, b1, accC[1]); }
            }
            if (ml && wj == 0 && r == 0) {
#pragma unroll
                for (int i = 0; i < 16; ++i) { const int d = 32 * wi + crow(i, h); nstate[d] = dec * nstate[d] + accN[i]; } }
            asm volatile("" : "+v"(gpre[0][0]), "+v"(gpre[0][1]), "+v"(gpre[1][0]), "+v"(gpre[1][1]));
            __syncthreads();
            m3_stage(a, lds, g, ci + 1 < gi.nch ? c + 1 : c, lane, wave);
#pragma unroll
            for (int i = 0; i < 16; ++i) { const int t = 32 * wi + crow(i, h); const float rden = ml ? __builtin_amdgcn_rcpf(fmaxf(fabsf(accD[i]), 1.0f)) : 1.0f;
                H[t * HD + 64 * wj + r] = accO[0][i] * rden; H[t * HD + 64 * wj + 32 + r] = accO[1][i] * rden; }
            RAW_BARRIER();
#pragma unroll
            for (int hh = 0; hh < 2; ++hh) {
                const int tl = tid >> 3, eg = tid & 7, t = 64 * hh + tl;
                float hv[16]; float ss = 0.f;
#pragma unroll
                for (int q = 0; q < 4; ++q) { const f32x4 x4 = *(const LAS f32x4*)(H + t * HD + 16 * eg + 4 * q); hv[4 * q] = x4.x; hv[4 * q + 1] = x4.y; hv[4 * q + 2] = x4.z; hv[4 * q + 3] = x4.w; }
#pragma unroll
                for (int i = 0; i < 16; ++i) ss += hv[i] * hv[i];
                ss += __shfl_xor(ss, 1); ss += __shfl_xor(ss, 2); ss += __shfl_xor(ss, 4);
                const float rn = __builtin_amdgcn_rsqf(ss * (1.0f / HD) + NORM_EPS);
                const int tg = c * CH + t; const int hc = ml ? g * HD + 16 * eg : (g - NHG) * HD + 16 * eg;
                float gh[16]; {
#pragma unroll
                    for (int q = 0; q < 4; ++q) { const f32x4 g4 = *(const LAS f32x4*)((const LAS float*)(lds + GHL_OFF) + 16 * eg + 4 * q); gh[4 * q] = g4.x; gh[4 * q + 1] = g4.y; gh[4 * q + 2] = g4.z; gh[4 * q + 3] = g4.w; } }
                float ga[16]; { float t8[8]; unpack8(gpre[hh][0], t8);
#pragma unroll
                    for (int j = 0; j < 8; ++j) ga[j] = t8[j]; unpack8(gpre[hh][1], t8);
#pragma unroll
                    for (int j = 0; j < 8; ++j) ga[8 + j] = t8[j]; }
                float o[16];
#pragma unroll
                for (int i = 0; i < 16; ++i) o[i] = hv[i] * rn * gh[i] * (ml ? sig2(ga[i]) : ga[i] * sig2(ga[i]));
                bf16* op = mixb + (size_t)tg * DM + (ml ? 0 : 1024) + hc;
                u32x4 w0, w1; w0.x = pk2(o[0], o[1]); w0.y = pk2(o[2], o[3]); w0.z = pk2(o[4], o[5]); w0.w = pk2(o[6], o[7]); w1.x = pk2(o[8], o[9]); w1.y = pk2(o[10], o[11]); w1.z = pk2(o[12], o[13]); w1.w = pk2(o[14], o[15]);
                *(GAS u32x4*)op = w0; *(GAS u32x4*)(op + 8) = w1;
            }
            asm volatile("s_waitcnt vmcnt(0)" ::: "memory");
            RAW_BARRIER();
        }
    }
}
DI void phase_r1(const Args& a, int lane, int wave, int vcu, int G) {
    const int gw = vcu * NWAVES + wave, NGW = G * NWAVES;
    const float* x = (const float*)a.in[IN_X]; const bf16* mix = (const bf16*)(a.ws + WS_B); bf16* x1 = (bf16*)(a.ws + WS_X1); float* rs2 = (float*)(a.ws + WS_RS);
    f32x4 ggv[8]; { const GAS f32x4* gp = (const GAS f32x4*)a.in[IN_GPOST] + lane;
#pragma unroll
      for (int j = 0; j < 8; ++j) ggv[j] = gp[64 * j]; }
#define R1_LOAD(bm, bx, mm) do { const GAS u32x2* mr_ = (const GAS u32x2*)(mix + (size_t)(mm) * DM) + lane; const GAS f32x4* xr_ = (const GAS f32x4*)(x + (size_t)(mm) * DM) + lane; \
        _Pragma("unroll") for (int j = 0; j < 8; ++j) { bm[j] = mr_[64 * j]; bx[j] = xr_[64 * j]; } } while (0)
#define R1_ROW(bm, bx, mm) do { f32x4 v[8]; float s_ = 0.f; \
        _Pragma("unroll") for (int j = 0; j < 8; ++j) { v[j] = (f32x4){bflo(bm[j].x), bfhi(bm[j].x), bflo(bm[j].y), bfhi(bm[j].y)}; s_ += (v[j].x * v[j].x + v[j].y * v[j].y) + (v[j].z * v[j].z + v[j].w * v[j].w); } \
        const float r_ = 1.0f / sqrtf(wave_sum(s_) * (1.0f / DM) + NORM_EPS); float s2_ = 0.f; GAS u32x2* xo_ = (GAS u32x2*)(x1 + (size_t)(mm) * DM) + lane; \
        _Pragma("unroll") for (int j = 0; j < 8; ++j) { const f32x4 gg = ggv[j]; v[j] = bx[j] + v[j] * r_ * gg; s2_ += (v[j].x * v[j].x + v[j].y * v[j].y) + (v[j].z * v[j].z + v[j].w * v[j].w); } \
        const float r2_ = 1.0f / sqrtf(wave_sum(s2_) * (1.0f / DM) + NORM_EPS); if (lane == 0) rs2[mm] = r2_; \
        _Pragma("unroll") for (int j = 0; j < 8; ++j) { u32x2 xw; xw.x = pk2(v[j].x * r2_, v[j].y * r2_); xw.y = pk2(v[j].z * r2_, v[j].w * r2_); xo_[64 * j] = xw; } } while (0)
    u32x2 ma[8], mb[8]; f32x4 xa[8], xb[8];
    int m = gw; if (m < SEQ) R1_LOAD(ma, xa, m);
    for (; m < SEQ; m += 2 * NGW) {
        if (m + NGW < SEQ) R1_LOAD(mb, xb, m + NGW);
        R1_ROW(ma, xa, m);
        if (m + 2 * NGW < SEQ) R1_LOAD(ma, xa, m + 2 * NGW);
        if (m + NGW < SEQ) R1_ROW(mb, xb, m + NGW);
    }
#undef R1_LOAD
#undef R1_ROW
}
DI void phase_r2(const Args& a, int lane, int wave, int vcu, int G, bool poison) {
    const int gw = vcu * NWAVES + wave, NGW = G * NWAVES;
    const bf16* ff = (const bf16*)(a.ws + WS_FF); const bf16* x1 = (const bf16*)(a.ws + WS_X1); const float* rs2 = (const float*)(a.ws + WS_RS); float* out = a.out;
    f32x4 ggv[8]; { const GAS f32x4* gp = (const GAS f32x4*)a.in[IN_GFPOST] + lane;
#pragma unroll
      for (int j = 0; j < 8; ++j) ggv[j] = gp[64 * j]; }
    const float qn = __builtin_nanf("");
#define R2_LOAD(bm, bx, mm) do { const GAS u32x2* fr_ = (const GAS u32x2*)(ff + (size_t)(mm) * DM) + lane; const GAS u32x2* xr_ = (const GAS u32x2*)(x1 + (size_t)(mm) * DM) + lane; \
        _Pragma("unroll") for (int j = 0; j < 8; ++j) { bm[j] = fr_[64 * j]; bx[j] = xr_[64 * j]; } bx[8].x = __builtin_bit_cast(unsigned, rs2[mm]); } while (0)
#define R2_ROW(bm, bx, mm) do { f32x4 v[8]; float s_ = 0.f; \
        _Pragma("unroll") for (int j = 0; j < 8; ++j) { v[j] = (f32x4){bflo(bm[j].x), bfhi(bm[j].x), bflo(bm[j].y), bfhi(bm[j].y)}; s_ += (v[j].x * v[j].x + v[j].y * v[j].y) + (v[j].z * v[j].z + v[j].w * v[j].w); } \
        const float r_ = 1.0f / sqrtf(wave_sum(s_) * (1.0f / DM) + NORM_EPS); const float inv2_ = 1.0f / __builtin_bit_cast(float, bx[8].x); GAS f32x4* xo_ = (GAS f32x4*)(out + (size_t)(mm) * DM) + lane; \
        _Pragma("unroll") for (int j = 0; j < 8; ++j) { const f32x4 gg = ggv[j]; f32x4 o = (f32x4){bflo(bx[j].x), bfhi(bx[j].x), bflo(bx[j].y), bfhi(bx[j].y)} * inv2_ + v[j] * r_ * gg; if (poison) o = (f32x4){qn, qn, qn, qn}; xo_[64 * j] = o; } } while (0)
    u32x2 ma[8], mb[8], xa[9], xb[9];
    int m = gw; if (m < SEQ) R2_LOAD(ma, xa, m);
    for (; m < SEQ; m += 2 * NGW) {
        if (m + NGW < SEQ) R2_LOAD(mb, xb, m + NGW);
        R2_ROW(ma, xa, m);
        if (m + 2 * NGW < SEQ) R2_LOAD(ma, xa, m + 2 * NGW);
        if (m + NGW < SEQ) R2_ROW(mb, xb, m + NGW);
    }
#undef R2_LOAD
#undef R2_ROW
}

DI int fresh_lane() { unsigned z = 0u; asm volatile("" : "+v"(z)); return (int)__builtin_amdgcn_mbcnt_hi(~0u, __builtin_amdgcn_mbcnt_lo(~0u, z)); }
__global__ void __launch_bounds__(NTHR, 2) fwd(Args a) {
    extern __shared__ __attribute__((aligned(16))) unsigned char lds_raw[];
    ldsp lds = (ldsp)lds_raw;
    const int wave = __builtin_amdgcn_readfirstlane((int)threadIdx.x >> 6);
#define FRESH_TID() (wave * 64 + fresh_lane())
    const int tid = FRESH_TID(), lane = tid & 63;
    const int G = gridDim.x; const int bx = blockIdx.x; const int vcu = (G % 8 == 0) ? (bx % 8) * (G / 8) + bx / 8 : bx;
    volatile LAS unsigned* MISC = (volatile LAS unsigned*)(lds + MISC_OFF);
    if (tid < 32) MISC[tid] = 0u;
    __syncthreads();
    unsigned* ctl = (unsigned*)(a.ws + WS_CTL);
    XcdBarrier bar; bar.bar = ctl + CW_BAR; bar.x = 0; bar.st = nullptr;
    if (N_LAUNCHES == 1) bar = xcd_barrier_post(ctl + CW_BAR, MISC + 8, tid);
    const int lo = a.ph_lo, hi = a.ph_hi;
#define IN(k) (lo <= (k) && (k) < hi)
#define SEAM(k) do { if (IN(k) && IN((k) + 1)) xcd_barrier(bar, FRESH_TID()); } while (0)

#define PH1_BODY { pg8::Gemm g{(const bf16*)(a.ws + WS_A), (const bf16*)(a.ws + WS_WIN), SEQ, NPJ, DM}; pg8::StaticOrder S; S.init(SEQ, NPJ, G, bx); \
        pg8::EpiBf16Blk E{(bf16*)(a.ws + WS_B), SEQ}; pg8::gemm_phase<pg8::EpiBf16Blk, pg8::StaticOrder, true, true>(lds, g, S, E, FRESH_TID()); }
#define PH5_BODY { pg8::Gemm g{(const bf16*)a.out, (const bf16*)(a.ws + WS_WO), SEQ, DM, DM}; pg8::StaticOrder S; S.init(SEQ, DM, G, bx); \
        pg8::EpiBf16 E{(bf16*)(a.ws + WS_B), DM}; pg8::gemm_phase<pg8::EpiBf16, pg8::StaticOrder, true, true>(lds, g, S, E, FRESH_TID()); }
#define PH7_BODY { pg8::Gemm g{(const bf16*)(a.ws + WS_X1), (const bf16*)(a.ws + WS_WGU), SEQ, 2 * DFF, DM}; pg8::StaticOrder S; S.init(SEQ, 2 * DFF, G, bx); \
        pg8::EpiSwiGLU E{(bf16*)(a.ws + WS_B), DFF}; pg8::gemm_phase<pg8::EpiSwiGLU, pg8::StaticOrder, true, true>(lds, g, S, E, FRESH_TID()); }
#define PH8_BODY { pg8::Gemm g{(const bf16*)(a.ws + WS_B), (const bf16*)(a.ws + WS_WD), SEQ, DM, DFF}; pg8::StaticOrder S; S.init(SEQ, DM, G, bx); \
        pg8::EpiBf16 E{(bf16*)(a.ws + WS_FF), DM}; pg8::gemm_phase<pg8::EpiBf16, pg8::StaticOrder, true, true>(lds, g, S, E, FRESH_TID()); }
#define DUP(k) (((PROBE_DUP) >> (k)) & 1)
    if (IN(0)) { phase_p0(a, lds, tid, lane, wave, vcu, G); SEAM(0); }
    if (IN(1)) { PH1_BODY SEAM(1); }
    if (IN(2)) { phase_m1(a, lds, FRESH_TID(), wave, vcu, G); SEAM(2); }
    if (IN(4)) { phase_m3(a, lds, FRESH_TID(), wave, vcu, G); SEAM(4); }
    if (IN(5)) { PH5_BODY SEAM(5); }
    if (IN(6)) { phase_r1(a, lane, wave, vcu, G); if (DUP(6)) phase_r1(a, lane, wave, vcu, G); SEAM(6); }
    if (IN(7)) { PH7_BODY SEAM(7); }
    if (IN(8)) { PH8_BODY SEAM(8); }
    if (IN(9)) {
        bool poison = false;
        if (N_LAUNCHES == 1) poison = __hip_atomic_load(ctl + CW_BAR + XB_TMO, __ATOMIC_RELAXED, __HIP_MEMORY_SCOPE_AGENT) != 0u;
        phase_r2(a, lane, wave, vcu, G, poison);
    }
#undef PH1_BODY
#undef PH5_BODY
#undef PH7_BODY
#undef PH8_BODY
#undef DUP
#undef FRESH_TID
#undef IN
#undef SEAM
}

extern "C" void kernel_launch(void* const* d_in, const int* in_sizes, int n_in, void* d_out, int out_size, void* d_ws, size_t ws_size, hipStream_t stream) {
    static int grid = 0;
    if (grid == 0) {
        if (n_in != 17 || in_sizes[0] != SEQ * DM || out_size != SEQ * DM || ws_size < WS_END) {
            fprintf(stderr, "kernel_launch: unexpected shapes (n_in %d, in0 %d, out %d, ws %zu); nothing launched\n", n_in, n_in > 0 ? in_sizes[0] : -1, out_size, ws_size); grid = -1; return; }
        int dev = 0, cus = 0, per_cu = 0;
        if (hipGetDevice(&dev) != hipSuccess || hipDeviceGetAttribute(&cus, hipDeviceAttributeMultiprocessorCount, dev) != hipSuccess) { grid = -1; return; }
        if (hipFuncSetAttribute((const void*)fwd, hipFuncAttributeMaxDynamicSharedMemorySize, LDS_BYTES) != hipSuccess) { fprintf(stderr, "kernel_launch: hipFuncSetAttribute failed\n"); grid = -1; return; }
        if (hipOccupancyMaxActiveBlocksPerMultiprocessor(&per_cu, (const void*)fwd, NTHR, LDS_BYTES) != hipSuccess || per_cu < 1)
            fprintf(stderr, "kernel_launch: note: occupancy query reports %d workgroups per CU\n", per_cu);
        (void)hipGetLastError();
        grid = cus;
    }
    if (grid < 0) return;
    if (hipMemsetAsync((char*)d_ws + WS_CTL, 0, CTL_ZERO_BYTES, stream) != hipSuccess) return;
    Args a{};
    for (int i = 0; i < 17; ++i) a.in[i] = d_in[i];
    a.out = (float*)d_out; a.ws = (unsigned char*)d_ws;
    if (N_LAUNCHES == 1) { a.ph_lo = 0; a.ph_hi = NPHASES; a.li = 0; hipLaunchKernelGGL(fwd, dim3(grid), dim3(NTHR), LDS_BYTES, stream, a); }
    else for (int li = 0; li < NPHASES; ++li) { a.ph_lo = li; a.ph_hi = li + 1; a.li = li; hipLaunchKernelGGL(fwd, dim3(grid), dim3(NTHR), LDS_BYTES, stream, a); }
}
```
